# Optimizing an MI355X kernel written in HIP

```python
import jax
import jax.numpy as jnp
from jax import lax
import numpy as np

D_MODEL = 2048
BATCH = 4
SEQ = 2048
DEPTH = 1

CHUNK = 64
NORM_EPS = 1e-6

RW_HEAD_DIM = 64
RW_WIDTH = D_MODEL // 2
RW_HEADS = RW_WIDTH // RW_HEAD_DIM
RW_DECAY_LORA = 96
RW_A_LORA = 96
RW_GATE_LORA = 256
RW_LN_EPS = 64e-5
RW_COLS = 3 * RW_WIDTH + RW_DECAY_LORA + RW_A_LORA + RW_GATE_LORA

RET_HEADS = 8
RET_QK_DIM = 128
RET_V_DIM = 256
RET_QK_WIDTH = RET_HEADS * RET_QK_DIM
RET_V_WIDTH = RET_HEADS * RET_V_DIM
RET_COLS = 2 * RET_QK_WIDTH + 2 * RET_V_WIDTH
ROPE_BASE = 10000.0

GATE_COLS = 2 * D_MODEL
IN_COLS = RW_COLS + RET_COLS + GATE_COLS

N_GROUPS = 4
EXPERTS_PER_GROUP = 8
N_EXPERTS = N_GROUPS * EXPERTS_PER_GROUP
TOP_K = 2
EXPERT_FF = 512
MOE_BLOCK = 128

kernel_name = 'hybrid_rwkv7_retention_hmoe_block'


def rms_norm(x, g):
    xf = x.astype(jnp.float32)
    y = xf * lax.rsqrt(jnp.mean(xf * xf, axis=-1, keepdims=True) + NORM_EPS)
    return (y * g.astype(jnp.float32)).astype(x.dtype)


def rotary(t, pos):
    half = t.shape[-1] // 2
    inv = ROPE_BASE ** (-jnp.arange(half, dtype=jnp.float32) / half)
    ang = pos[:, None] * inv[None, :]
    cos = jnp.cos(ang)[None, :, None, :]
    sin = jnp.sin(ang)[None, :, None, :]
    t1, t2 = t[..., :half], t[..., half:]
    return jnp.concatenate([t1 * cos - t2 * sin, t1 * sin + t2 * cos], axis=-1)


def rwkv7_recurrence(r, w, k, v, a, b):
    bsz, _, nh, n = r.shape

    def step(state, inp):
        r_t, w_t, k_t, v_t, a_t, b_t = inp
        sa = jnp.einsum('bhvk,bhk->bhv', state, a_t)
        state = (state * w_t[:, :, None, :] + sa[..., None] * b_t[:, :, None, :]
                 + v_t[..., None] * k_t[:, :, None, :])
        return state, jnp.einsum('bhvk,bhk->bhv', state, r_t)

    xs = tuple(jnp.swapaxes(t, 0, 1) for t in (r, w, k, v, a, b))
    state0 = jnp.zeros((bsz, nh, n, n), jnp.float32)
    _, y = lax.scan(step, state0, xs)
    return jnp.swapaxes(y, 0, 1)


def rwkv7_time_mix(p, mu, w0, w2, a0, a2, g2, k_k, k_a, r_k, lnx_g, lnx_b):
    bsz, seq, _ = p.shape
    f32 = jnp.float32
    hd = (RW_HEADS, RW_HEAD_DIM)
    shp = (bsz, seq) + hd
    p_prev = jnp.pad(p[:, :-1], ((0, 0), (1, 0), (0, 0)))
    p = p + (p_prev - p) * mu
    cuts = [RW_WIDTH, 2 * RW_WIDTH, 3 * RW_WIDTH, 3 * RW_WIDTH + RW_DECAY_LORA,
            3 * RW_WIDTH + RW_DECAY_LORA + RW_A_LORA]
    r, k, v, xw, xa, xg = jnp.split(p, cuts, axis=-1)
    w_log = -jax.nn.softplus(-(w0 + jnp.tanh(xw) @ w2).astype(f32)) - 0.5
    decay = jnp.exp(-jnp.exp(w_log)).reshape(shp)
    a = jax.nn.sigmoid((a0 + xa @ a2).astype(f32)).reshape(shp)
    g = (jax.nn.sigmoid(xg) @ g2).astype(f32)
    r_h = r.astype(f32).reshape(shp)
    k_h = k.astype(f32).reshape(shp)
    v_h = v.astype(f32).reshape(shp)
    kk = k_h * k_k.astype(f32).reshape(hd)
    kk = kk * lax.rsqrt(jnp.maximum(jnp.sum(kk * kk, axis=-1, keepdims=True), 1e-24))
    k_h = k_h * (1.0 + (a - 1.0) * k_a.astype(f32).reshape(hd))
    y = rwkv7_recurrence(r_h, decay, k_h, v_h, -kk, kk * a)
    mean = jnp.mean(y, axis=-1, keepdims=True)
    var = jnp.mean(jnp.square(y - mean), axis=-1, keepdims=True)
    y = (y - mean) * lax.rsqrt(var + RW_LN_EPS)
    y = y * lnx_g.astype(f32).reshape(hd) + lnx_b.astype(f32).reshape(hd)
    bonus = jnp.sum(r_h * k_h * r_k.astype(f32).reshape(hd), axis=-1, keepdims=True) * v_h
    y = (y + bonus).reshape(bsz, seq, RW_WIDTH)
    return (y * g).astype(p.dtype)


def retention_mix(p, norm_g):
    bsz, seq, _ = p.shape
    f32 = jnp.float32
    n_chunks = seq // CHUNK
    q, k, v, g = jnp.split(p, [RET_QK_WIDTH, 2 * RET_QK_WIDTH, 2 * RET_QK_WIDTH + RET_V_WIDTH], axis=-1)
    pos = jnp.arange(seq, dtype=f32)
    q = rotary(q.astype(f32).reshape(bsz, seq, RET_HEADS, RET_QK_DIM), pos)
    k = rotary(k.astype(f32).reshape(bsz, seq, RET_HEADS, RET_QK_DIM), pos) * (RET_QK_DIM ** -0.5)
    cs = (bsz, n_chunks, CHUNK, RET_HEADS)
    q = q.reshape(cs + (RET_QK_DIM,))
    k = k.reshape(cs + (RET_QK_DIM,))
    v = v.astype(f32).reshape(cs + (RET_V_DIM,))
    log_gamma = jnp.log1p(-jnp.exp2(-5.0 - jnp.arange(RET_HEADS, dtype=f32)))
    idx = jnp.arange(CHUNK, dtype=f32)
    dist = jnp.abs(idx[:, None] - idx[None, :])
    d_intra = jnp.exp(dist[None] * log_gamma[:, None, None])
    scores = jnp.einsum('bnihd,bnjhd->bnhij', q, k) * d_intra
    o_intra = jnp.einsum('bnhij,bnjhe->bnihe', scores, v)
    k_decay = jnp.exp((CHUNK - 1.0 - idx)[:, None] * log_gamma[None, :])
    kv = jnp.einsum('bnjhd,jh,bnjhe->nbhde', k, k_decay, v)
    chunk_decay = jnp.exp(CHUNK * log_gamma)[:, None, None]

    def step(state, kv_n):
        return state * chunk_decay + kv_n, state

    _, s_prev = lax.scan(step, jnp.zeros(kv.shape[1:], f32), kv)
    q_decay = jnp.exp((idx + 1.0)[:, None] * log_gamma[None, :])
    o_inter = jnp.einsum('bnihd,ih,nbhde->bnihe', q, q_decay, s_prev)
    o = (o_intra + o_inter).reshape(bsz, seq, RET_HEADS, RET_V_DIM)
    o = o * lax.rsqrt(jnp.mean(o * o, axis=-1, keepdims=True) + NORM_EPS)
    o = o.reshape(bsz, seq, RET_V_WIDTH) * norm_g.astype(f32)
    return (o * jax.nn.silu(g.astype(f32))).astype(p.dtype)


def hier_moe(h, w_group, b_group, w_expert, b_expert, e_gate, e_up, e_down):
    bsz, seq, d = h.shape
    f32 = jnp.float32
    n_tok = bsz * seq
    hf = h.reshape(n_tok, d)
    g_logits = (hf @ w_group).astype(f32) + b_group.astype(f32)
    g_prob = jax.nn.softmax(g_logits, axis=-1)
    g_sel = jnp.argmax(g_logits, axis=-1)
    g_w = jnp.take_along_axis(g_prob, g_sel[:, None], axis=-1)
    e_logits = ((hf @ w_expert).astype(f32) + b_expert.astype(f32)).reshape(n_tok, N_GROUPS, EXPERTS_PER_GROUP)
    e_in = jnp.take_along_axis(e_logits, g_sel[:, None, None], axis=1)[:, 0]
    top_l, top_i = lax.top_k(e_in, TOP_K)
    top_w = jax.nn.softmax(top_l, axis=-1) * g_w
    expert_id = (g_sel[:, None] * EXPERTS_PER_GROUP + top_i).reshape(-1).astype(jnp.int32)
    token_id = jnp.repeat(jnp.arange(n_tok, dtype=jnp.int32), TOP_K)
    weight = top_w.reshape(-1)
    n_assign = n_tok * TOP_K
    order = jnp.argsort(expert_id)
    e_sorted = expert_id[order]
    counts = jax.ops.segment_sum(jnp.ones((n_assign,), jnp.int32), expert_id, num_segments=N_EXPERTS)
    starts = jnp.cumsum(counts) - counts
    padded = (counts + MOE_BLOCK - 1) // MOE_BLOCK * MOE_BLOCK
    pad_end = jnp.cumsum(padded)
    pad_start = pad_end - padded
    dest = pad_start[e_sorted] + jnp.arange(n_assign, dtype=jnp.int32) - starts[e_sorted]
    n_blocks = -(-n_assign // MOE_BLOCK) + N_EXPERTS
    n_slots = n_blocks * MOE_BLOCK
    slot_tok = jnp.full((n_slots,), n_tok, jnp.int32).at[dest].set(token_id[order])
    slot_w = jnp.zeros((n_slots,), f32).at[dest].set(weight[order])
    block_e = jnp.minimum(
        jnp.searchsorted(pad_end, jnp.arange(n_blocks, dtype=jnp.int32) * MOE_BLOCK, side='right'),
        N_EXPERTS - 1)
    h_pad = jnp.concatenate([hf, jnp.zeros((1, d), hf.dtype)], axis=0)

    def expert_block(args):
        tok_b, e = args
        xb = h_pad[tok_b]
        return (jax.nn.silu(xb @ e_gate[e]) * (xb @ e_up[e])) @ e_down[e]

    out = lax.map(expert_block, (slot_tok.reshape(n_blocks, MOE_BLOCK), block_e))
    out = out.reshape(n_slots, d).astype(f32) * slot_w[:, None]
    y = jax.ops.segment_sum(out, slot_tok, num_segments=n_tok + 1)[:n_tok]
    return y.reshape(bsz, seq, d).astype(h.dtype)


def setup_inputs(seed: int = 0) -> dict:
    key = jax.random.key(seed)
    ks = jax.random.split(key, 32)
    f32 = jnp.float32
    L = DEPTH

    def nrm(k, shape, scale):
        return jax.random.normal(k, shape, f32) * scale

    def gain(k, shape):
        return 1.0 + 0.01 * jax.random.normal(k, shape, f32)

    return {
        'x': nrm(ks[0], (BATCH, SEQ, D_MODEL), 1.0),
        'norm1_g': gain(ks[1], (L, D_MODEL)),
        'w_in': nrm(ks[2], (L, D_MODEL, IN_COLS), D_MODEL ** -0.5),
        'mu_shift': jax.random.uniform(ks[3], (L, RW_COLS), f32),
        'rw_w0': jax.random.uniform(ks[4], (L, RW_WIDTH), f32, -6.0, 0.0),
        'rw_w2': nrm(ks[5], (L, RW_DECAY_LORA, RW_WIDTH), 0.5 * RW_DECAY_LORA ** -0.5),
        'rw_a0': nrm(ks[6], (L, RW_WIDTH), 0.1),
        'rw_a2': nrm(ks[7], (L, RW_A_LORA, RW_WIDTH), 0.5 * RW_A_LORA ** -0.5),
        'rw_g2': nrm(ks[8], (L, RW_GATE_LORA, RW_WIDTH), RW_GATE_LORA ** -0.5),
        'rw_k_k': 0.85 + nrm(ks[9], (L, RW_WIDTH), 0.05),
        'rw_k_a': 1.0 + nrm(ks[10], (L, RW_WIDTH), 0.05),
        'rw_r_k': nrm(ks[11], (L, RW_WIDTH), 0.1),
        'rw_lnx_g': gain(ks[12], (L, RW_WIDTH)),
        'rw_lnx_b': nrm(ks[13], (L, RW_WIDTH), 0.01),
        'ret_norm_g': gain(ks[14], (L, RET_V_WIDTH)),
        'w_up_a': nrm(ks[15], (L, RW_WIDTH, D_MODEL), RW_WIDTH ** -0.5),
        'w_up_b': nrm(ks[16], (L, RET_V_WIDTH, D_MODEL), RET_V_WIDTH ** -0.5),
        'w_out': nrm(ks[17], (L, D_MODEL, D_MODEL), D_MODEL ** -0.5),
        'norm2_g': gain(ks[18], (L, D_MODEL)),
        'w_group': nrm(ks[19], (L, D_MODEL, N_GROUPS), D_MODEL ** -0.5),
        'b_group': nrm(ks[20], (L, N_GROUPS), 0.01),
        'w_expert': nrm(ks[21], (L, D_MODEL, N_EXPERTS), D_MODEL ** -0.5),
        'b_expert': nrm(ks[22], (L, N_EXPERTS), 0.01),
        'e_gate': nrm(ks[23], (L, N_EXPERTS, D_MODEL, EXPERT_FF), D_MODEL ** -0.5),
        'e_up': nrm(ks[24], (L, N_EXPERTS, D_MODEL, EXPERT_FF), D_MODEL ** -0.5),
        'e_down': nrm(ks[25], (L, N_EXPERTS, EXPERT_FF, D_MODEL), EXPERT_FF ** -0.5),
        'final_norm_g': gain(ks[26], (D_MODEL,)),
    }


def reference(x, norm1_g, w_in, mu_shift, rw_w0, rw_w2, rw_a0, rw_a2, rw_g2, rw_k_k, rw_k_a,
              rw_r_k, rw_lnx_g, rw_lnx_b, ret_norm_g, w_up_a, w_up_b, w_out, norm2_g,
              w_group, b_group, w_expert, b_expert, e_gate, e_up, e_down, final_norm_g):
    for l in range(DEPTH):
        h = rms_norm(x, norm1_g[l])
        p = h @ w_in[l]
        p_rw, p_ret, p_gate = jnp.split(p, [RW_COLS, RW_COLS + RET_COLS], axis=-1)
        o_a = rwkv7_time_mix(p_rw, mu_shift[l], rw_w0[l], rw_w2[l], rw_a0[l], rw_a2[l], rw_g2[l],
                             rw_k_k[l], rw_k_a[l], rw_r_k[l], rw_lnx_g[l], rw_lnx_b[l])
        o_b = retention_mix(p_ret, ret_norm_g[l])
        gate_a, gate_b = jnp.split(jax.nn.sigmoid(p_gate), 2, axis=-1)
        merged = gate_a * (o_a @ w_up_a[l]) + gate_b * (o_b @ w_up_b[l])
        x = x + merged @ w_out[l]
        x = x + hier_moe(rms_norm(x, norm2_g[l]), w_group[l], b_group[l], w_expert[l], b_expert[l],
                         e_gate[l], e_up[l], e_down[l])
    return rms_norm(x, final_norm_g)
```

```cpp
#include <hip/hip_runtime.h>
#include <cstdio>
#include <cstdint>
namespace pg8 {
#define PG8_LAS __attribute__((address_space(3)))
typedef unsigned short bf16_t;
typedef short bf16x8 __attribute__((ext_vector_type(8)));
typedef float f32x4 __attribute__((ext_vector_type(4)));
typedef unsigned u32x4 __attribute__((ext_vector_type(4)));
constexpr int BM = 256, BK = 64, HALF = 128, HTB = HALF * BK * 2  , STAGE_BYTES = 8 * HTB, NXCD = 8, WGM = 8;

__host__ __device__ __forceinline__ int lds_byte(int r, int c) { const int st = (r >> 4) * 2 + (c >> 5), rr = r & 15, cc = c & 31, ob = rr * 64 + cc * 2; return st * 1024 + (ob ^ (((ob >> 9) & 1) << 5)); }
__host__ __device__ __forceinline__ void stage_rc(int b, int& R, int& C) { const int st = b / 1024, sb = b % 1024, swz = sb ^ (((sb >> 9) & 1) << 5); R = (st >> 1) * 16 + swz / 64; C = (st & 1) * 32 + (swz % 64) / 2; }
__host__ __device__ __forceinline__ int perm32(int rho) { const int n = rho >> 4, i = rho & 15; return 8 * (i >> 2) + 4 * n + (i & 3); }

struct Unit { int pm, pn; };
struct Gemm { const bf16_t* A; const bf16_t* Bt; int M, N, K; };

struct StaticOrder {
    int nM, nN, nwg, G, c;
    __host__ __device__ void init(int M, int N, int G_, int c_) { nM = M / BM; nN = N / BM; nwg = nM * nN; G = G_; c = c_; }
    __host__ __device__ bool next(int i, Unit& u) const {
        const long L = (long)i * G + c; if (L >= nwg) return false;
        int wgid = (int)L; { const int q = nwg / NXCD, r = nwg % NXCD, xcd = wgid % NXCD, off = wgid / NXCD; wgid = (xcd < r ? xcd * (q + 1) : r * (q + 1) + (xcd - r) * q) + off; }
        const int nig = WGM * nN, gid = wgid / nig, fm = gid * WGM, gsz = (nM - fm) < WGM ? (nM - fm) : WGM;
        u.pm = fm + ((wgid % nig) % gsz); u.pn = (wgid % nig) / gsz; return true;
    }
    __device__ __forceinline__ void a_ready(const Unit&) const {}
    __device__ __forceinline__ void done(const Unit&) const {}
};

__device__ __forceinline__ unsigned cvt_pk_bf16(float lo, float hi) { unsigned r; asm volatile("v_cvt_pk_bf16_f32 %0, %1, %2" : "=v"(r) : "v"(lo), "v"(hi)); return r; }
typedef float f32x2 __attribute__((ext_vector_type(2)));
template <class Epi, class Sched, bool ALIGN_EPI = false, bool SP2 = false>
__device__ __forceinline__ void gemm_phase(PG8_LAS unsigned char* lds, const Gemm g, const Sched& S, const Epi& E) {
    const int tid = threadIdx.x, wid = __builtin_amdgcn_readfirstlane(tid >> 6), lane = tid & 63, wr = wid >> 2, wc = wid & 3, fr = lane & 15, fq = lane >> 4;
    const int K = g.K, nt = K / BK;
    unsigned voffA[2], voffB[2];
#pragma unroll
    for (int i = 0; i < 2; ++i) { int R, C; stage_rc(tid * 16 + i * 8192, R, C); const int Rb = Epi::PERM ? ((R & ~31) + perm32(R & 31)) : R;
        voffA[i] = (unsigned)(R * K + C) * 2u; voffB[i] = (unsigned)(Rb * K + C) * 2u; }
    const size_t kstep = (size_t)(BK * 2);
    const size_t hstep = (size_t)HALF * K * 2;
    const size_t tstep = 2 * hstep;
    const unsigned ldsw = (unsigned)wid * 1024u;
    const int aoff = lds_byte(wr * 64 + fr, fq * 8), boff = lds_byte(wc * 32 + fr, fq * 8);
#define PG8_SA(b, h) (((b) * 2 + (h)) * HTB)
#define PG8_SB(b, h) ((4 + (b) * 2 + (h)) * HTB)
#define PG8_STAGE(bufoff, gbase, voff) do { _Pragma("unroll") for (int _i = 0; _i < 2; ++_i) \
        __builtin_amdgcn_global_load_lds((const unsigned*)((const char*)(gbase) + (voff)[_i]), (PG8_LAS unsigned*)(lds + (bufoff) + ldsw + _i * 8192), 16, 0, 0); } while (0)
#define PG8_LDA(dst, b, h) do { _Pragma("unroll") for (int m = 0; m < 4; ++m) _Pragma("unroll") for (int k = 0; k < 2; ++k) dst[m][k] = *(const PG8_LAS bf16x8*)(lds + PG8_SA(b, h) + aoff + m * 2048 + k * 1024); } while (0)
#define PG8_LDB(dst, b, h) do { _Pragma("unroll") for (int n = 0; n < 2; ++n) _Pragma("unroll") for (int k = 0; k < 2; ++k) dst[n][k] = *(const PG8_LAS bf16x8*)(lds + PG8_SB(b, h) + boff + n * 2048 + k * 1024); } while (0)
#define PG8_MMA(ai, bj, At, Bt) do { __builtin_amdgcn_s_setprio(1); _Pragma("unroll") for (int m = 0; m < 4; ++m) _Pragma("unroll") for (int n = 0; n < 2; ++n) _Pragma("unroll") for (int k = 0; k < 2; ++k) \
        acc[ai][bj][m][n] = __builtin_amdgcn_mfma_f32_16x16x32_bf16(Bt[n][k], At[m][k], acc[ai][bj][m][n], 0, 0, 0); __builtin_amdgcn_s_setprio(0); } while (0)
#define PG8_WAIT_V(n) asm volatile("s_waitcnt vmcnt(" #n ")" ::: "memory")
#define PG8_WAIT_L(n) asm volatile("s_waitcnt lgkmcnt(" #n ")" ::: "memory")
#define PG8_BAR __builtin_amdgcn_s_barrier()
#define PG8_SCHED __builtin_amdgcn_sched_barrier(0)
    Unit cur, nxt; int ui = 0;
    if (!S.next(0, cur)) return;
    f32x4 acc[2][2][4][2];
#pragma unroll
    for (int a = 0; a < 2; ++a)
#pragma unroll
        for (int b = 0; b < 2; ++b)
#pragma unroll
            for (int m = 0; m < 4; ++m)
#pragma unroll
                for (int n = 0; n < 2; ++n) acc[a][b][m][n] = (f32x4){0.f, 0.f, 0.f, 0.f};
    bf16x8 At[4][2], B0[2][2], B1[2][2];
    const char* cA = (const char*)g.A + (size_t)cur.pm * tstep; const char* cB = (const char*)g.Bt + (size_t)cur.pn * tstep;
    S.a_ready(cur);
    if constexpr (SP2) {
        PG8_STAGE(PG8_SB(0, 0), cB, voffB); PG8_STAGE(PG8_SB(0, 1), cB + hstep, voffB); PG8_STAGE(PG8_SA(0, 0), cA, voffA); PG8_STAGE(PG8_SA(0, 1), cA + hstep, voffA);
        if (wr == 1) PG8_BAR;
        PG8_WAIT_V(2); PG8_BAR;
        PG8_STAGE(PG8_SB(1, 0), cB + kstep, voffB); PG8_STAGE(PG8_SA(1, 0), cA + kstep, voffA); PG8_STAGE(PG8_SB(1, 1), cB + hstep + kstep, voffB);
        PG8_WAIT_V(6); PG8_BAR;
    } else {
        PG8_STAGE(PG8_SB(0, 0), cB, voffB); PG8_STAGE(PG8_SA(0, 0), cA, voffA); PG8_STAGE(PG8_SB(0, 1), cB + hstep, voffB); PG8_STAGE(PG8_SA(0, 1), cA + hstep, voffA);
        if (wr == 1) PG8_BAR;
        PG8_WAIT_V(4); PG8_BAR;
        PG8_STAGE(PG8_SB(1, 0), cB + kstep, voffB); PG8_STAGE(PG8_SA(1, 0), cA + kstep, voffA); PG8_STAGE(PG8_SB(1, 1), cB + hstep + kstep, voffB);
        PG8_WAIT_V(6); PG8_BAR;
    }
    for (;;) {
        const bool has_next = S.next(ui + 1, nxt);
        const char* nA = has_next ? (const char*)g.A + (size_t)nxt.pm * tstep : cA; const char* nB = has_next ? (const char*)g.Bt + (size_t)nxt.pn * tstep : cB;
        for (int t = 0; t < nt; t += 2) {
            const bool last = (t == nt - 2);
            const char* a1 = cA + (size_t)(t + 1) * kstep;
            const char* a2 = last ? nA : cA + (size_t)(t + 2) * kstep; const char* b2 = last ? nB : cB + (size_t)(t + 2) * kstep;
            const char* a3 = a2 + kstep; const char* b3 = b2 + kstep;
            if (last && has_next) S.a_ready(nxt);
            if constexpr (SP2) {
            PG8_LDB(B0, 0, 0); PG8_LDB(B1, 0, 1); PG8_SCHED; PG8_LDA(At, 0, 0); PG8_STAGE(PG8_SA(1, 1), a1 + hstep, voffA);
            PG8_WAIT_V(8); PG8_WAIT_L(0); PG8_BAR; PG8_MMA(0, 0, At, B0); PG8_MMA(0, 1, At, B1); PG8_BAR; PG8_SCHED;
            PG8_LDA(At, 0, 1); PG8_STAGE(PG8_SB(0, 0), b2, voffB); PG8_STAGE(PG8_SB(0, 1), b2 + hstep, voffB); PG8_STAGE(PG8_SA(0, 0), a2, voffA);
            PG8_WAIT_V(8); PG8_WAIT_L(0); PG8_BAR; PG8_MMA(1, 0, At, B0); PG8_MMA(1, 1, At, B1); PG8_BAR; PG8_SCHED;
            PG8_LDB(B0, 1, 0); PG8_LDB(B1, 1, 1); PG8_SCHED; PG8_LDA(At, 1, 0); PG8_STAGE(PG8_SA(0, 1), a2 + hstep, voffA);
            PG8_WAIT_V(8); PG8_WAIT_L(0); PG8_BAR; PG8_MMA(0, 0, At, B0); PG8_MMA(0, 1, At, B1); PG8_BAR; PG8_SCHED;
            PG8_LDA(At, 1, 1); PG8_STAGE(PG8_SB(1, 0), b3, voffB); PG8_STAGE(PG8_SB(1, 1), b3 + hstep, voffB); PG8_STAGE(PG8_SA(1, 0), a3, voffA);
            PG8_WAIT_V(8); PG8_WAIT_L(0); PG8_BAR; PG8_MMA(1, 0, At, B0); PG8_MMA(1, 1, At, B1); PG8_BAR; PG8_SCHED;
            } else {
            PG8_LDB(B0, 0, 0); PG8_SCHED; PG8_LDA(At, 0, 0); PG8_STAGE(PG8_SA(1, 1), a1 + hstep, voffA);
            PG8_WAIT_L(8); PG8_BAR; PG8_WAIT_L(0); PG8_MMA(0, 0, At, B0); PG8_BAR; PG8_SCHED;
            PG8_LDB(B1, 0, 1); PG8_STAGE(PG8_SB(0, 0), b2, voffB);
            PG8_BAR; PG8_WAIT_L(0); PG8_MMA(0, 1, At, B1); PG8_BAR;
            PG8_LDA(At, 0, 1); PG8_STAGE(PG8_SA(0, 0), a2, voffA);
            PG8_BAR; PG8_WAIT_L(0); PG8_MMA(1, 0, At, B0); PG8_BAR; PG8_SCHED;
            PG8_STAGE(PG8_SB(0, 1), b2 + hstep, voffB);
            PG8_WAIT_V(6); PG8_BAR; PG8_MMA(1, 1, At, B1); PG8_BAR;
            PG8_LDB(B0, 1, 0); PG8_SCHED; PG8_LDA(At, 1, 0); PG8_STAGE(PG8_SA(0, 1), a2 + hstep, voffA);
            PG8_WAIT_L(8); PG8_BAR; PG8_WAIT_L(0); PG8_MMA(0, 0, At, B0); PG8_BAR; PG8_SCHED;
            PG8_LDB(B1, 1, 1); PG8_STAGE(PG8_SB(1, 0), b3, voffB);
            PG8_BAR; PG8_WAIT_L(0); PG8_MMA(0, 1, At, B1); PG8_BAR;
            PG8_LDA(At, 1, 1); PG8_STAGE(PG8_SA(1, 0), a3, voffA);
            PG8_BAR; PG8_WAIT_L(0); PG8_MMA(1, 0, At, B0); PG8_BAR; PG8_SCHED;
            PG8_STAGE(PG8_SB(1, 1), b3 + hstep, voffB);
            PG8_WAIT_V(6); PG8_BAR; PG8_MMA(1, 1, At, B1); PG8_BAR;
            }
        }
        if constexpr (ALIGN_EPI) { if (wr == 0) PG8_BAR; }
        if constexpr (!Epi::AFTER_DRAIN) { E(acc, cur, wr, wc, fr, fq); S.done(cur); }
        if (!has_next) break;
#pragma unroll
        for (int a = 0; a < 2; ++a)
#pragma unroll
            for (int b = 0; b < 2; ++b)
#pragma unroll
                for (int m = 0; m < 4; ++m)
#pragma unroll
                    for (int n = 0; n < 2; ++n) acc[a][b][m][n] = (f32x4){0.f, 0.f, 0.f, 0.f};
        cur = nxt; cA = nA; cB = nB; ++ui;
        if constexpr (ALIGN_EPI) { if (wr == 1) PG8_BAR; }
    }
    PG8_WAIT_V(0);
    if constexpr (!ALIGN_EPI) { if (wr == 0) PG8_BAR; }
    PG8_BAR;
    if constexpr (Epi::AFTER_DRAIN) { E.fused(acc, cur, wr, wc, fr, fq, lds, wid, lane); S.done(cur); }
#undef PG8_SA
#undef PG8_SB
#undef PG8_STAGE
#undef PG8_LDA
#undef PG8_LDB
#undef PG8_MMA
#undef PG8_WAIT_V
#undef PG8_WAIT_L
#undef PG8_BAR
#undef PG8_SCHED
}
}

#define GAS __attribute__((address_space(1)))
#define LAS __attribute__((address_space(3)))
typedef unsigned short bf16;
typedef unsigned v4u __attribute__((ext_vector_type(4)));
typedef unsigned v2u __attribute__((ext_vector_type(2)));
typedef float f32x4 __attribute__((ext_vector_type(4)));
typedef GAS unsigned gu32;
#define RLX_AGENT __ATOMIC_RELAXED, __HIP_MEMORY_SCOPE_AGENT
#define LDS_WAIT() asm volatile("s_waitcnt lgkmcnt(0)" ::: "memory")
#define VM_WAIT() asm volatile("s_waitcnt vmcnt(0)" ::: "memory")

constexpr int NTOK = 8192, SEQ = 2048, DM = 2048, NP = 13824, NWAVES = 8, NTHR = 512;
constexpr int RW_W = 1024, RW_H = 16, RW_N = 64;
constexpr int P_XW = 3072, P_XA = 3168, P_XG = 3264;
constexpr int P_RQ = 3584, P_RK = 4608, P_RV = 5632, P_RG = 7680, P_GA = 9728, P_GB = 11776;
constexpr int RET_H = 8, RET_DK = 128, RET_DV = 256, RET_VW = 2048;
constexpr int NEXP = 32, EFF = 512, MAXT = 96, MAXSLOT = MAXT * 256;

constexpr size_t MiB = 1u << 20;
constexpr size_t WS_CTL = 0, CTL_ZERO_BYTES = 256 * 1024;
constexpr size_t WS_ROT = 1 * MiB;
constexpr size_t WS_TOKE = 2 * MiB;
constexpr size_t WS_TOKW = WS_TOKE + 65536;
constexpr size_t WS_TOKP = WS_TOKW + 65536;
constexpr size_t WS_TOKS = WS_TOKP + 65536;
constexpr size_t WS_BONUS = WS_TOKS + 65536;
constexpr size_t WS_WUPA = 3 * MiB, WS_WUPB = 7 * MiB, WS_WOUT = 15 * MiB;
constexpr size_t WS_WGU = 23 * MiB, WS_WDN = 151 * MiB;
constexpr size_t WS_P = 215 * MiB;
constexpr size_t WS_RA = 431 * MiB;
constexpr size_t WS_WIN = WS_RA, WS_H1 = WS_RA + 54 * MiB;
constexpr size_t WS_OA = WS_RA, WS_OB = WS_RA + 16 * MiB;
constexpr size_t WS_RB = 517 * MiB;
constexpr size_t WS_RWE = WS_RB, WS_RWA = WS_RB + 16 * MiB, WS_RWB = WS_RB + 32 * MiB, WS_MERGED = WS_RB;
constexpr size_t WS_END = 565 * MiB;
constexpr size_t WS_H2 = WS_P, WS_XG = WS_P + 32 * MiB, WS_YS = WS_XG, WS_ACT = WS_XG + 96 * MiB;
constexpr int CW_BAR = 1024;
constexpr int CW_CNT = 8192;
constexpr int CW_NT = 8256;
constexpr int CW_TE = 8320;
constexpr int CW_PS = 8448;

constexpr int RING_BYTES = 131072, MISC_OFF = RING_BYTES + 320, LDS_BYTES = 147456;

struct Args { const float* in[27]; float* out; unsigned char* ws; int ph_lo, ph_hi; };

__device__ __forceinline__ float bf2f(unsigned short b) { return __uint_as_float(((unsigned)b) << 16); }
__device__ __forceinline__ float bflo(unsigned u) { return __uint_as_float(u << 16); }
__device__ __forceinline__ float bfhi(unsigned u) { return __uint_as_float(u & 0xffff0000u); }
__device__ __forceinline__ unsigned f2bf(float f) { unsigned u = __float_as_uint(f); return (u + 0x7fffu + ((u >> 16) & 1u)) >> 16; }
__device__ __forceinline__ unsigned pk2(float lo, float hi) { return f2bf(lo) | (f2bf(hi) << 16); }
__device__ __forceinline__ float sigmoidf_(float x) { return 1.0f / (1.0f + __expf(-x)); }
__device__ __forceinline__ float wave_sum(float v) {
#pragma unroll
    for (int o = 1; o < 64; o <<= 1) v += __shfl_xor(v, o);
    return v;
}

struct EpiP {
    static constexpr bool PERM = true, AFTER_DRAIN = false;
    bf16* O;
    __device__ __forceinline__ void operator()(const pg8::f32x4 (&acc)[2][2][4][2], const pg8::Unit& u, int wr, int wc, int fr, int fq) const {
        const int row0 = u.pm * 256 + wr * 64 + fr, col0 = u.pn * 256 + wc * 32 + 8 * fq;
        const int mode = u.pn >= 38 ? 2 : (u.pn >= 30 ? 1 : 0);
#pragma unroll
        for (int ai = 0; ai < 2; ++ai)
#pragma unroll
            for (int m = 0; m < 4; ++m) { bf16* rowp = O + (size_t)(row0 + ai * 128 + m * 16) * NP + col0;
#pragma unroll
                for (int bj = 0; bj < 2; ++bj) { pg8::f32x4 v0 = acc[ai][bj][m][0], v1 = acc[ai][bj][m][1];
                    if (mode) {
#pragma unroll
                        for (int j = 0; j < 4; ++j) { const float s0 = sigmoidf_(v0[j]), s1 = sigmoidf_(v1[j]); v0[j] = mode == 2 ? s0 : v0[j] * s0; v1[j] = mode == 2 ? s1 : v1[j] * s1; } }
                    pg8::u32x4 w; w.x = pg8::cvt_pk_bf16(v0[0], v0[1]); w.y = pg8::cvt_pk_bf16(v0[2], v0[3]); w.z = pg8::cvt_pk_bf16(v1[0], v1[1]); w.w = pg8::cvt_pk_bf16(v1[2], v1[3]);
                    *(pg8::u32x4*)(rowp + bj * 128) = w; } }
    }
};
template <int MODE> struct EpiUp {
    static constexpr bool PERM = true, AFTER_DRAIN = false;
    bf16* O; const bf16* P;
    __device__ __forceinline__ void operator()(const pg8::f32x4 (&acc)[2][2][4][2], const pg8::Unit& u, int wr, int wc, int fr, int fq) const {
        const int row0 = u.pm * 256 + wr * 64 + fr, col0 = u.pn * 256 + wc * 32 + 8 * fq;
#pragma unroll
        for (int ai = 0; ai < 2; ++ai)
#pragma unroll
            for (int m = 0; m < 4; ++m) { const int row = row0 + ai * 128 + m * 16; bf16* rowp = O + (size_t)row * DM + col0; const bf16* gp = P + (size_t)row * NP + (MODE ? P_GB : P_GA) + col0;
#pragma unroll
                for (int bj = 0; bj < 2; ++bj) { const pg8::f32x4 v0 = acc[ai][bj][m][0], v1 = acc[ai][bj][m][1];
                    const pg8::u32x4 g = *(const pg8::u32x4*)(gp + bj * 128);
                    float o[8] = { v0[0] * bflo(g.x), v0[1] * bfhi(g.x), v0[2] * bflo(g.y), v0[3] * bfhi(g.y), v1[0] * bflo(g.z), v1[1] * bfhi(g.z), v1[2] * bflo(g.w), v1[3] * bfhi(g.w) };
                    if (MODE) { const pg8::u32x4 p = *(const pg8::u32x4*)(rowp + bj * 128);
                        o[0] += bflo(p.x); o[1] += bfhi(p.x); o[2] += bflo(p.y); o[3] += bfhi(p.y); o[4] += bflo(p.z); o[5] += bfhi(p.z); o[6] += bflo(p.w); o[7] += bfhi(p.w); }
                    pg8::u32x4 w; w.x = pg8::cvt_pk_bf16(o[0], o[1]); w.y = pg8::cvt_pk_bf16(o[2], o[3]); w.z = pg8::cvt_pk_bf16(o[4], o[5]); w.w = pg8::cvt_pk_bf16(o[6], o[7]);
                    *(pg8::u32x4*)(rowp + bj * 128) = w; } }
    }
};
struct EpiX1 {
    static constexpr bool PERM = false, AFTER_DRAIN = false;
    const float* X; float* O;
    __device__ __forceinline__ void operator()(const pg8::f32x4 (&acc)[2][2][4][2], const pg8::Unit& u, int wr, int wc, int fr, int fq) const {
        const int row0 = u.pm * 256 + wr * 64 + fr, col0 = u.pn * 256 + wc * 32 + 4 * fq;
#pragma unroll
        for (int ai = 0; ai < 2; ++ai)
#pragma unroll
            for (int m = 0; m < 4; ++m) { const size_t off = (size_t)(row0 + ai * 128 + m * 16) * DM + col0;
#pragma unroll
                for (int bj = 0; bj < 2; ++bj)
#pragma unroll
                    for (int n = 0; n < 2; ++n) { const pg8::f32x4 xv = *(const pg8::f32x4*)(X + off + bj * 128 + n * 16); *(pg8::f32x4*)(O + off + bj * 128 + n * 16) = xv + acc[ai][bj][m][n]; } }
    }
};
struct EpiGU {
    static constexpr bool PERM = true, AFTER_DRAIN = false;
    bf16* O;
    __device__ __forceinline__ void operator()(const pg8::f32x4 (&acc)[2][2][4][2], const pg8::Unit& u, int wr, int wc, int fr, int fq) const {
        const int row0 = u.pm * 256 + wr * 64 + fr, col0 = (u.pn & 3) * 128 + wc * 32 + 8 * fq;
#pragma unroll
        for (int ai = 0; ai < 2; ++ai)
#pragma unroll
            for (int m = 0; m < 4; ++m) { bf16* rowp = O + (size_t)(row0 + ai * 128 + m * 16) * EFF + col0;
                const pg8::f32x4 g0 = acc[ai][0][m][0], g1 = acc[ai][0][m][1], u0 = acc[ai][1][m][0], u1 = acc[ai][1][m][1];
                float o[8];
#pragma unroll
                for (int j = 0; j < 4; ++j) { o[j] = g0[j] * sigmoidf_(g0[j]) * u0[j]; o[4 + j] = g1[j] * sigmoidf_(g1[j]) * u1[j]; }
                pg8::u32x4 w; w.x = pg8::cvt_pk_bf16(o[0], o[1]); w.y = pg8::cvt_pk_bf16(o[2], o[3]); w.z = pg8::cvt_pk_bf16(o[4], o[5]); w.w = pg8::cvt_pk_bf16(o[6], o[7]);
                *(pg8::u32x4*)rowp = w; }
    }
};
struct EpiDn {
    static constexpr bool PERM = true, AFTER_DRAIN = false;
    bf16* O;
    __device__ __forceinline__ void operator()(const pg8::f32x4 (&acc)[2][2][4][2], const pg8::Unit& u, int wr, int wc, int fr, int fq) const {
        const int row0 = u.pm * 256 + wr * 64 + fr, col0 = (u.pn & 7) * 256 + wc * 32 + 8 * fq;
#pragma unroll
        for (int ai = 0; ai < 2; ++ai)
#pragma unroll
            for (int m = 0; m < 4; ++m) { bf16* rowp = O + (size_t)(row0 + ai * 128 + m * 16) * DM + col0;
#pragma unroll
                for (int bj = 0; bj < 2; ++bj) { const pg8::f32x4 v0 = acc[ai][bj][m][0], v1 = acc[ai][bj][m][1];
                    pg8::u32x4 w; w.x = pg8::cvt_pk_bf16(v0[0], v0[1]); w.y = pg8::cvt_pk_bf16(v0[2], v0[3]); w.z = pg8::cvt_pk_bf16(v1[0], v1[1]); w.w = pg8::cvt_pk_bf16(v1[2], v1[3]);
                    *(pg8::u32x4*)(rowp + bj * 128) = w; } }
    }
};
template <int NB> struct MoeOrder {
    const unsigned* ctl; int G, c, nunits;
    __device__ __forceinline__ void init(const unsigned* ctl_, int G_, int c_) { ctl = ctl_; G = G_; c = c_; nunits = (int)ctl_[CW_NT] * NB; }
    __device__ __forceinline__ bool next(int i, pg8::Unit& u) const {
        const int L = i * G + c; if (L >= nunits) return false;
        u.pm = L / NB; u.pn = (int)ctl[CW_TE + u.pm] * NB + (L % NB); return true;
    }
    __device__ __forceinline__ void a_ready(const pg8::Unit&) const {}
    __device__ __forceinline__ void done(const pg8::Unit&) const {}
};
#define XB_TMO      128
#define XB_XCNT(j)  (256  + 64 * (j))
#define XB_XSUB(j)  (1280 + 64 * (j))
#define XB_XGEN(j)  (2304 + 64 * (j))
#define XB_TOP      3328
#define XB_TOPGEN   3392
#define XCD_BAR_WORDS 3456
#define XB_SPIN_CAP (1u << 18)

__device__ __forceinline__ unsigned xb_ld(unsigned* p)              { return __hip_atomic_load(p, __ATOMIC_RELAXED, __HIP_MEMORY_SCOPE_AGENT); }
__device__ __forceinline__ unsigned xb_add(unsigned* p, unsigned v) { return __hip_atomic_fetch_add(p, v, __ATOMIC_RELAXED, __HIP_MEMORY_SCOPE_AGENT); }
__device__ __forceinline__ unsigned xb_xcc_id() { return (unsigned)__builtin_amdgcn_s_getreg((3 << 11) | 20) & 0xFu; }
#define XB_SPIN(cond, bar) do { unsigned _sp = 0; while (cond) { __builtin_amdgcn_s_sleep(1); \
    if ((++_sp & 255u) == 0u) { if (xb_ld(&(bar)[XB_TMO])) break; if (_sp > XB_SPIN_CAP) { atomicAdd(&(bar)[XB_TMO], 1u); break; } } } } while (0)

struct XcdBarrier {
    unsigned* bar; unsigned x;
    volatile LAS unsigned* st;
};

__device__ __forceinline__ XcdBarrier xcd_barrier_post(unsigned* bar, volatile LAS unsigned* st) {
    XcdBarrier b; b.bar = bar; b.x = xb_xcc_id(); b.st = st;
    if (threadIdx.x == 0) (void)xb_add(&bar[XB_XCNT(b.x)], 1u);
    return b;
}
__device__ __forceinline__ void xcd_barrier_complete(unsigned* bar, unsigned x, unsigned& nloc, unsigned& nx) {
    const unsigned G = gridDim.x * gridDim.y * gridDim.z;
    unsigned sum, cnt, mine, sp = 0u;
    for (;;) {
        sum = 0u; cnt = 0u; mine = 0u;
#pragma unroll
        for (unsigned j = 0; j < 16; ++j) { const unsigned c = xb_ld(&bar[XB_XCNT(j)]); sum += c; cnt += (c > 0u) ? 1u : 0u; mine = (j == x) ? c : mine; }
        if (sum == G) break;
        __builtin_amdgcn_s_sleep(1);
        if ((++sp & 255u) == 0u) { if (xb_ld(&bar[XB_TMO])) break; if (sp > XB_SPIN_CAP) { atomicAdd(&bar[XB_TMO], 1u); break; } }
    }
    nloc = mine > 0u ? mine : 1u; nx = cnt > 0u ? cnt : 1u;
}

__device__ __forceinline__ void xcd_barrier(const XcdBarrier& b) {
    asm volatile("s_waitcnt vmcnt(0)" ::: "memory");
    __syncthreads();
    if (threadIdx.x == 0) {
        unsigned* bar = b.bar;
        __builtin_amdgcn_s_waitcnt(0);
        unsigned nloc = b.st[0], nx = b.st[1];
        if (nloc == 0u) { xcd_barrier_complete(bar, b.x, nloc, nx); b.st[0] = nloc; b.st[1] = nx; }
        const unsigned old = xb_add(&bar[XB_XSUB(b.x)], 1u);
        const unsigned gen = old / nloc;
        if (old + 1u == (gen + 1u) * nloc) {
            __builtin_amdgcn_fence(__ATOMIC_RELEASE, "agent");
            asm volatile("s_waitcnt vmcnt(0)" ::: "memory");
            const unsigned og = xb_add(&bar[XB_TOP], 1u);
            const unsigned tg = og / nx;
            if (og + 1u == (tg + 1u) * nx) xb_add(&bar[XB_TOPGEN], 1u);
            else XB_SPIN(xb_ld(&bar[XB_TOPGEN]) == tg, bar);
            __builtin_amdgcn_fence(__ATOMIC_ACQUIRE, "agent");
            xb_add(&bar[XB_XGEN(b.x)], 1u);
            asm volatile("s_waitcnt vmcnt(0)" ::: "memory");
        } else {
            XB_SPIN(xb_ld(&bar[XB_XGEN(b.x)]) == gen, bar);
            __builtin_amdgcn_fence(__ATOMIC_ACQUIRE, "agent");
            asm volatile("s_waitcnt vmcnt(0)" ::: "memory");
        }
    }
    __syncthreads();
}

__device__ __forceinline__ void tr_item(const float* W, int ldw, int k0, int n0, bf16* WT, int K, size_t drow0, LAS float* scr, int lane) {
#pragma unroll 8
    for (int i = 0; i < 32; ++i) { const int kk = 2 * i + (lane >> 5); scr[kk * 33 + (lane & 31)] = W[(size_t)(k0 + kk) * ldw + n0 + (lane & 31)]; }
    LDS_WAIT(); asm volatile("" ::: "memory");
    const int c = lane & 7;
#pragma unroll
    for (int j = 0; j < 4; ++j) { const int n = (lane >> 3) + 8 * j; const LAS float* s = scr + (8 * c) * 33 + n;
        v4u o; o.x = pk2(s[0 * 33], s[1 * 33]); o.y = pk2(s[2 * 33], s[3 * 33]); o.z = pk2(s[4 * 33], s[5 * 33]); o.w = pk2(s[6 * 33], s[7 * 33]);
        *(v4u*)(WT + (drow0 + n) * (size_t)K + k0 + 8 * c) = o; }
    LDS_WAIT(); asm volatile("" ::: "memory");
}
__device__ __forceinline__ void phase_prologue(const Args& a, LAS unsigned char* lds, int tid, int lane, int wave, int bid, int G) {
    unsigned char* ws = a.ws;
    LAS float* scr = (LAS float*)(lds + wave * 16384);
    const int gw = bid * NWAVES + wave, NGW = G * NWAVES;
    constexpr int I_IN = 32 * 430, I_UA = 16 * 64, I_UB = 32 * 64, I_WO = 32 * 64, I_EG = 32 * 32 * 16, I_ED = 32 * 8 * 64;
    constexpr int NITEMS = I_IN + I_UA + I_UB + I_WO + 2 * I_EG + I_ED;
    for (int it = gw; it < NITEMS; it += NGW) {
        int r = it;
        if (r < I_IN) { const int kb = r / 430, nb = r % 430, n0 = nb * 32; tr_item(a.in[2], 13760, kb * 64, n0, (bf16*)(ws + WS_WIN), 2048, (size_t)(n0 + (n0 >= 3520 ? 64 : 0)), scr, lane); continue; } r -= I_IN;
        if (r < I_UA) { const int kb = r / 64, nb = r % 64; tr_item(a.in[15], 2048, kb * 64, nb * 32, (bf16*)(ws + WS_WUPA), 1024, (size_t)(nb * 32), scr, lane); continue; } r -= I_UA;
        if (r < I_UB) { const int kb = r / 64, nb = r % 64; tr_item(a.in[16], 2048, kb * 64, nb * 32, (bf16*)(ws + WS_WUPB), 2048, (size_t)(nb * 32), scr, lane); continue; } r -= I_UB;
        if (r < I_WO) { const int kb = r / 64, nb = r % 64; tr_item(a.in[17], 2048, kb * 64, nb * 32, (bf16*)(ws + WS_WOUT), 2048, (size_t)(nb * 32), scr, lane); continue; } r -= I_WO;
        if (r < 2 * I_EG) { const int half = r / I_EG; const int q = r % I_EG; const int e = q / 512, kb = (q % 512) / 16, nb = q % 16, n0 = nb * 32;
            const float* W = a.in[23 + half] + (size_t)e * 2048 * 512;
            tr_item(W, 512, kb * 64, n0, (bf16*)(ws + WS_WGU), 2048, (size_t)e * 1024 + (n0 >> 7) * 256 + half * 128 + (n0 & 127), scr, lane); continue; } r -= 2 * I_EG;
        { const int e = r / 512, kb = (r % 512) / 64, nb = r % 64; const float* W = a.in[25] + (size_t)e * 512 * 2048;
            tr_item(W, 2048, kb * 64, nb * 32, (bf16*)(ws + WS_WDN), 512, (size_t)e * 2048 + nb * 32, scr, lane); }
    }
    { v4u* z = (v4u*)(ws + WS_WIN + (size_t)3520 * 2048 * 2); const int n16 = 64 * 2048 * 2 / 16;
      for (int i = bid * NTHR + tid; i < n16; i += G * NTHR) z[i] = (v4u){0u, 0u, 0u, 0u}; }
    { float2* rot = (float2*)(ws + WS_ROT);
      for (int i = bid * NTHR + tid; i < SEQ * 64; i += G * NTHR) { const int pos = i >> 6, d = i & 63;
          const float inv = exp2f(-(float)d * (13.287712379549449f / 64.0f)); const float ang = (float)pos * inv;
          double rev = (double)ang * 0.15915494309189535; rev -= __builtin_rint(rev); const float rf = (float)rev;
          rot[i] = make_float2(__builtin_amdgcn_cosf(rf), __builtin_amdgcn_sinf(rf)); } }
    { const float* g1 = a.in[1]; bf16* H1 = (bf16*)(ws + WS_H1);
      for (int m = gw; m < NTOK; m += NGW) { const f32x4* xr = (const f32x4*)(a.in[0] + (size_t)m * DM) + lane; f32x4 v[8]; float s = 0.f;
#pragma unroll
          for (int j = 0; j < 8; ++j) { v[j] = xr[64 * j]; s += (v[j].x * v[j].x + v[j].y * v[j].y) + (v[j].z * v[j].z + v[j].w * v[j].w); }
          const float rs = rsqrtf(wave_sum(s) * (1.0f / DM) + 1e-6f);
          v2u* o8 = (v2u*)(H1 + (size_t)m * DM) + lane;
#pragma unroll
          for (int j = 0; j < 8; ++j) { const f32x4 g = ((const f32x4*)g1)[64 * j + lane]; v2u o; o.x = pk2(v[j].x * rs * g.x, v[j].y * rs * g.y); o.y = pk2(v[j].z * rs * g.z, v[j].w * rs * g.w); o8[64 * j] = o; } } }
}

__device__ __forceinline__ float shiftp(const bf16* P, int t, int col, float mu, bool first) {
    const float cur = bf2f(P[(size_t)t * NP + col]); const float prev = first ? 0.f : bf2f(P[(size_t)(t - 1) * NP + col]);
    return cur + (prev - cur) * mu;
}
__device__ __forceinline__ void phase_rwprep(const Args& a, LAS unsigned char* lds, int tid, int lane, int wave, int bid, int G) {
    unsigned char* ws = a.ws; const bf16* P = (const bf16*)(ws + WS_P);
    LAS float* xs = (LAS float*)lds;
    const float* mu = a.in[3]; const float* w0 = a.in[4]; const float* w2 = a.in[5]; const float* a0 = a.in[6]; const float* a2 = a.in[7]; const float* g2 = a.in[8];
    const float* k_k = a.in[9]; const float* k_a = a.in[10]; const float* r_k = a.in[11];
    bf16* RR = (bf16*)a.out; bf16* RK = RR + (size_t)NTOK * RW_W; bf16* RV = RK + (size_t)NTOK * RW_W; bf16* RG = RV + (size_t)NTOK * RW_W;
    bf16* RE = (bf16*)(ws + WS_RWE); bf16* RA = (bf16*)(ws + WS_RWA); bf16* RB = (bf16*)(ws + WS_RWB); float* BON = (float*)(ws + WS_BONUS);
    for (int u = bid; u < NTOK / 8; u += G) {
        const int t0 = u * 8;
        __syncthreads();
        for (int i = tid; i < 448 * 8; i += NTHR) { const int j = i >> 3, tt = i & 7, t = t0 + tt; const int col = P_XW + j;
            float v = shiftp(P, t, col, mu[col], (t & (SEQ - 1)) == 0);
            if (j < 96) v = tanhf(v); else if (j >= 192) v = sigmoidf_(v);
            xs[i] = v; }
        __syncthreads();
        float aw[2][8], aa[2][8], ag[2][8];
#pragma unroll
        for (int c = 0; c < 2; ++c)
#pragma unroll
            for (int tt = 0; tt < 8; ++tt) { aw[c][tt] = 0.f; aa[c][tt] = 0.f; ag[c][tt] = 0.f; }
        for (int j = 0; j < 96; ++j) { const float wa = w2[j * RW_W + tid], wb = w2[j * RW_W + tid + 512]; const f32x4 x0 = *(const LAS f32x4*)(xs + j * 8), x1 = *(const LAS f32x4*)(xs + j * 8 + 4);
#pragma unroll
            for (int tt = 0; tt < 4; ++tt) { aw[0][tt] += x0[tt] * wa; aw[1][tt] += x0[tt] * wb; aw[0][4 + tt] += x1[tt] * wa; aw[1][4 + tt] += x1[tt] * wb; } }
        for (int j = 0; j < 96; ++j) { const float wa = a2[j * RW_W + tid], wb = a2[j * RW_W + tid + 512]; const f32x4 x0 = *(const LAS f32x4*)(xs + (96 + j) * 8), x1 = *(const LAS f32x4*)(xs + (96 + j) * 8 + 4);
#pragma unroll
            for (int tt = 0; tt < 4; ++tt) { aa[0][tt] += x0[tt] * wa; aa[1][tt] += x0[tt] * wb; aa[0][4 + tt] += x1[tt] * wa; aa[1][4 + tt] += x1[tt] * wb; } }
        for (int j = 0; j < 256; ++j) { const float wa = g2[j * RW_W + tid], wb = g2[j * RW_W + tid + 512]; const f32x4 x0 = *(const LAS f32x4*)(xs + (192 + j) * 8), x1 = *(const LAS f32x4*)(xs + (192 + j) * 8 + 4);
#pragma unroll
            for (int tt = 0; tt < 4; ++tt) { ag[0][tt] += x0[tt] * wa; ag[1][tt] += x0[tt] * wb; ag[0][4 + tt] += x1[tt] * wa; ag[1][4 + tt] += x1[tt] * wb; } }
#pragma unroll
        for (int c = 0; c < 2; ++c) { const int ch = tid + c * 512; const int head = ch >> 6;
            const float mur = mu[ch], muk = mu[1024 + ch], muv = mu[2048 + ch], w0c = w0[ch], a0c = a0[ch], kkc = k_k[ch], kac = k_a[ch], rkc = r_k[ch];
#pragma unroll
            for (int tt = 0; tt < 8; ++tt) { const int t = t0 + tt; const bool first = (t & (SEQ - 1)) == 0;
                const float r = shiftp(P, t, ch, mur, first), k = shiftp(P, t, 1024 + ch, muk, first), v = shiftp(P, t, 2048 + ch, muv, first);
                const float e = sigmoidf_(w0c + aw[c][tt]) * 0.6065306597126334f;
                const float av = sigmoidf_(a0c + aa[c][tt]);
                float kk = k * kkc; const float ss = wave_sum(kk * kk); kk *= rsqrtf(fmaxf(ss, 1e-24f));
                const float kp = k * (1.0f + (av - 1.0f) * kac);
                const float bs = wave_sum(r * kp * rkc);
                const size_t o = (size_t)t * RW_W + ch;
                RR[o] = (bf16)f2bf(r); RK[o] = (bf16)f2bf(kp); RV[o] = (bf16)f2bf(v); RG[o] = (bf16)f2bf(ag[c][tt]);
                RE[o] = (bf16)f2bf(e); RA[o] = (bf16)f2bf(-kk); RB[o] = (bf16)f2bf(kk * av);
                if (lane == 0) BON[t * RW_H + head] = bs; } }
    }
}

__device__ __forceinline__ void unpack16(const v4u& p0, const v4u& p1, float (&f)[16]) {
    f[0] = bflo(p0.x); f[1] = bfhi(p0.x); f[2] = bflo(p0.y); f[3] = bfhi(p0.y); f[4] = bflo(p0.z); f[5] = bfhi(p0.z); f[6] = bflo(p0.w); f[7] = bfhi(p0.w);
    f[8] = bflo(p1.x); f[9] = bfhi(p1.x); f[10] = bflo(p1.y); f[11] = bfhi(p1.y); f[12] = bflo(p1.z); f[13] = bfhi(p1.z); f[14] = bflo(p1.w); f[15] = bfhi(p1.w);
}
__device__ __forceinline__ void phase_rwrec(const Args& a, int lane, int wave, int bid, int G) {
    if (wave != 0) return;
    unsigned char* ws = a.ws;
    const bf16* RR = (const bf16*)a.out; const bf16* RK = RR + (size_t)NTOK * RW_W; const bf16* RV = RK + (size_t)NTOK * RW_W;
    const bf16* RE = (const bf16*)(ws + WS_RWE); const bf16* RA = (const bf16*)(ws + WS_RWA); const bf16* RB = (const bf16*)(ws + WS_RWB);
    bf16* Y = (bf16*)(ws + WS_OA);
    for (int u = bid; u < 256; u += G) {
        const int b = u >> 6, h = (u >> 2) & 15, sl = u & 3, row = lane >> 2, kq = lane & 3, iv = sl * 16 + row;
        float S[16];
#pragma unroll
        for (int k = 0; k < 16; ++k) S[k] = 0.f;
        size_t base = (size_t)(b * SEQ) * RW_W + h * 64;
        const v4u* pr = (const v4u*)(RR + base + kq * 16); const v4u* pe = (const v4u*)(RE + base + kq * 16); const v4u* pk = (const v4u*)(RK + base + kq * 16);
        const v4u* pa = (const v4u*)(RA + base + kq * 16); const v4u* pb = (const v4u*)(RB + base + kq * 16);
        v4u nr0 = pr[0], nr1 = pr[1], ne0 = pe[0], ne1 = pe[1], nk0 = pk[0], nk1 = pk[1], na0 = pa[0], na1 = pa[1], nb0 = pb[0], nb1 = pb[1];
        unsigned short nv = RV[base + iv];
        for (int t = 0; t < SEQ; ++t) {
            const v4u r0 = nr0, r1 = nr1, e0 = ne0, e1 = ne1, k0 = nk0, k1 = nk1, a0 = na0, a1 = na1, b0 = nb0, b1 = nb1; const float v = bf2f(nv);
            if (t + 1 < SEQ) { const int q = (t + 1) * (RW_W / 8);
                nr0 = pr[q]; nr1 = pr[q + 1]; ne0 = pe[q]; ne1 = pe[q + 1]; nk0 = pk[q]; nk1 = pk[q + 1]; na0 = pa[q]; na1 = pa[q + 1]; nb0 = pb[q]; nb1 = pb[q + 1];
                nv = RV[base + (size_t)(t + 1) * RW_W + iv]; }
            float fr[16], fe[16], fk[16], fa[16], fb[16];
            unpack16(r0, r1, fr); unpack16(e0, e1, fe); unpack16(k0, k1, fk); unpack16(a0, a1, fa); unpack16(b0, b1, fb);
            float sa = 0.f;
#pragma unroll
            for (int k = 0; k < 16; ++k) sa += S[k] * fa[k];
            sa += __shfl_xor(sa, 1); sa += __shfl_xor(sa, 2);
            float y = 0.f;
#pragma unroll
            for (int k = 0; k < 16; ++k) { const float w = __expf(-fe[k]); S[k] = S[k] * w + (sa * fb[k] + v * fk[k]); y += S[k] * fr[k]; }
            y += __shfl_xor(y, 1); y += __shfl_xor(y, 2);
            if (kq == 0) Y[base + (size_t)t * RW_W + iv] = (bf16)f2bf(y);
        }
    }
}

__device__ __forceinline__ void phase_ret(const Args& a, LAS unsigned char* lds, int tid, int bid, int G) {
    unsigned char* ws = a.ws; const bf16* P = (const bf16*)(ws + WS_P); const float2* rot = (const float2*)(ws + WS_ROT); bf16* OB = (bf16*)(ws + WS_OB);
    LAS float* Qs = (LAS float*)lds;
    LAS float* Ks = Qs + 64 * 129;
    LAS float* Vs = Ks + 64 * 129;
    LAS float* Sc = Vs + 64 * 32;
    LAS float* St = Sc + 64 * 65;
    LAS float* gp = St + 128 * 32;
    for (int u = bid; u < 256; u += G) {
        const int b = u >> 6, h = (u >> 3) & 7, vs = u & 7;
        __syncthreads();
        const float lg = log1pf(-exp2f(-5.0f - (float)h));
        if (tid < 65) gp[tid] = expf((float)tid * lg);
        for (int i = tid; i < 128 * 32; i += NTHR) St[i] = 0.f;
        for (int n = 0; n < SEQ / 64; ++n) {
            __syncthreads();
            for (int idx = tid; idx < 64 * 64; idx += NTHR) { const int i = idx >> 6, d = idx & 63, pos = n * 64 + i; const size_t t = (size_t)(b * SEQ + pos);
                const float2 cs = rot[pos * 64 + d];
                const float q1 = bf2f(P[t * NP + P_RQ + h * 128 + d]), q2 = bf2f(P[t * NP + P_RQ + h * 128 + 64 + d]);
                const float k1 = bf2f(P[t * NP + P_RK + h * 128 + d]) * 0.08838834764831845f, k2 = bf2f(P[t * NP + P_RK + h * 128 + 64 + d]) * 0.08838834764831845f;
                Qs[i * 129 + d] = q1 * cs.x - q2 * cs.y; Qs[i * 129 + 64 + d] = q1 * cs.y + q2 * cs.x;
                Ks[i * 129 + d] = k1 * cs.x - k2 * cs.y; Ks[i * 129 + 64 + d] = k1 * cs.y + k2 * cs.x; }
            for (int idx = tid; idx < 64 * 32; idx += NTHR) { const int j = idx >> 5, e = idx & 31; const size_t t = (size_t)(b * SEQ + n * 64 + j);
                Vs[idx] = bf2f(P[t * NP + P_RV + h * 256 + vs * 32 + e]); }
            __syncthreads();
            { const int i = tid >> 3, jb = tid & 7; float s[8];
#pragma unroll
              for (int jj = 0; jj < 8; ++jj) s[jj] = 0.f;
              for (int d = 0; d < 128; ++d) { const float q = Qs[i * 129 + d];
#pragma unroll
                  for (int jj = 0; jj < 8; ++jj) s[jj] += q * Ks[(jb + 8 * jj) * 129 + d]; }
#pragma unroll
              for (int jj = 0; jj < 8; ++jj) { const int j = jb + 8 * jj; const int dist = i > j ? i - j : j - i; Sc[i * 65 + j] = s[jj] * gp[dist]; } }
            __syncthreads();
            { const int e = tid & 31, ib = tid >> 5; float o1[4], o2[4];
#pragma unroll
              for (int ii = 0; ii < 4; ++ii) { o1[ii] = 0.f; o2[ii] = 0.f; }
              for (int j = 0; j < 64; ++j) { const float v = Vs[j * 32 + e];
#pragma unroll
                  for (int ii = 0; ii < 4; ++ii) o1[ii] += Sc[(ib + 16 * ii) * 65 + j] * v; }
              for (int d = 0; d < 128; ++d) { const float s = St[d * 32 + e];
#pragma unroll
                  for (int ii = 0; ii < 4; ++ii) o2[ii] += Qs[(ib + 16 * ii) * 129 + d] * s; }
#pragma unroll
              for (int ii = 0; ii < 4; ++ii) { const int i = ib + 16 * ii; const size_t t = (size_t)(b * SEQ + n * 64 + i);
                  OB[t * RET_VW + h * 256 + vs * 32 + e] = (bf16)f2bf(o1[ii] + gp[i + 1] * o2[ii]); } }
            __syncthreads();
            { const int e = tid & 31, db = tid >> 5; float s[8];
#pragma unroll
              for (int dd = 0; dd < 8; ++dd) s[dd] = 0.f;
              for (int j = 0; j < 64; ++j) { const float v = Vs[j * 32 + e] * gp[63 - j];
#pragma unroll
                  for (int dd = 0; dd < 8; ++dd) s[dd] += Ks[j * 129 + db + 16 * dd] * v; }
#pragma unroll
              for (int dd = 0; dd < 8; ++dd) { const int d = db + 16 * dd; St[d * 32 + e] = St[d * 32 + e] * gp[64] + s[dd]; } }
        }
    }
}

__device__ __forceinline__ void phase_post(const Args& a, int lane, int wave, int bid, int G) {
    unsigned char* ws = a.ws; const bf16* P = (const bf16*)(ws + WS_P);
    const int gw = bid * NWAVES + wave, NGW = G * NWAVES;
    { bf16* Y = (bf16*)(ws + WS_OA); const bf16* RR = (const bf16*)a.out; const bf16* RV = RR + (size_t)2 * NTOK * RW_W; const bf16* RG = RR + (size_t)3 * NTOK * RW_W;
      const float* BON = (const float*)(ws + WS_BONUS); const float* lg = a.in[12]; const float* lb = a.in[13];
      for (int it = gw; it < NTOK * RW_H; it += NGW) { const int t = it >> 4, h = it & 15; const size_t o = (size_t)t * RW_W + h * 64 + lane;
          const float y = bf2f(Y[o]); const float mean = wave_sum(y) * (1.0f / 64.0f); const float dy = y - mean; const float var = wave_sum(dy * dy) * (1.0f / 64.0f);
          float yn = dy * rsqrtf(var + 64e-5f) * lg[h * 64 + lane] + lb[h * 64 + lane];
          yn += BON[it] * bf2f(RV[o]);
          Y[o] = (bf16)f2bf(yn * bf2f(RG[o])); } }
    { bf16* OB = (bf16*)(ws + WS_OB); const float* ng = a.in[14];
      for (int it = gw; it < NTOK * RET_H; it += NGW) { const int t = it >> 3, h = it & 7; const size_t o = (size_t)t * RET_VW + h * 256 + lane * 4;
          const v2u raw = *(const v2u*)(OB + o); const float v0 = bflo(raw.x), v1 = bfhi(raw.x), v2 = bflo(raw.y), v3 = bfhi(raw.y);
          const float rs = rsqrtf(wave_sum((v0 * v0 + v1 * v1) + (v2 * v2 + v3 * v3)) * (1.0f / 256.0f) + 1e-6f);
          const v2u gr = *(const v2u*)(P + (size_t)t * NP + P_RG + h * 256 + lane * 4); const f32x4 g = *(const f32x4*)(ng + h * 256 + lane * 4);
          v2u w; w.x = pk2(v0 * rs * g.x * bflo(gr.x), v1 * rs * g.y * bfhi(gr.x)); w.y = pk2(v2 * rs * g.z * bflo(gr.y), v3 * rs * g.w * bfhi(gr.y));
          *(v2u*)(OB + o) = w; } }
}

__device__ __forceinline__ void phase_router(const Args& a, int lane, int wave, int bid, int G) {
    unsigned char* ws = a.ws; const float* X1 = a.out; bf16* H2 = (bf16*)(ws + WS_H2);
    const float* g2 = a.in[18]; const float* wg = a.in[19]; const float* bg = a.in[20]; const float* we = a.in[21]; const float* be = a.in[22];
    unsigned* ctl = (unsigned*)(ws + WS_CTL); int* TE = (int*)(ws + WS_TOKE); float* TW = (float*)(ws + WS_TOKW); int* TP = (int*)(ws + WS_TOKP);
    const int gw = bid * NWAVES + wave, NGW = G * NWAVES;
    for (int t = gw; t < NTOK; t += NGW) {
        const f32x4* xr = (const f32x4*)(X1 + (size_t)t * DM) + lane; float s = 0.f;
#pragma unroll
        for (int j = 0; j < 8; ++j) { const f32x4 x = xr[64 * j]; s += (x.x * x.x + x.y * x.y) + (x.z * x.z + x.w * x.w); }
        const float rs = rsqrtf(wave_sum(s) * (1.0f / DM) + 1e-6f);
        float lgt[36];
#pragma unroll
        for (int q = 0; q < 36; ++q) lgt[q] = 0.f;
        v2u* o8 = (v2u*)(H2 + (size_t)t * DM) + lane;
#pragma unroll 1
        for (int j = 0; j < 8; ++j) { const f32x4 x = xr[64 * j]; const f32x4 g = ((const f32x4*)g2)[64 * j + lane]; const f32x4 hv = {x.x * rs * g.x, x.y * rs * g.y, x.z * rs * g.z, x.w * rs * g.w};
            v2u o; o.x = pk2(hv.x, hv.y); o.y = pk2(hv.z, hv.w); o8[64 * j] = o;
            const int col = 256 * j + 4 * lane;
#pragma unroll
            for (int c = 0; c < 4; ++c) { const float hc = hv[c]; const f32x4 w4 = *(const f32x4*)(wg + (size_t)(col + c) * 4);
                lgt[0] += hc * w4.x; lgt[1] += hc * w4.y; lgt[2] += hc * w4.z; lgt[3] += hc * w4.w;
#pragma unroll
                for (int q = 0; q < 8; ++q) { const f32x4 e4 = *(const f32x4*)(we + (size_t)(col + c) * 32 + 4 * q);
                    lgt[4 + 4 * q] += hc * e4.x; lgt[5 + 4 * q] += hc * e4.y; lgt[6 + 4 * q] += hc * e4.z; lgt[7 + 4 * q] += hc * e4.w; } }
            asm volatile("" ::: "memory"); }
#pragma unroll
        for (int q = 0; q < 36; ++q) lgt[q] = wave_sum(lgt[q]);
        float gl[4];
#pragma unroll
        for (int q = 0; q < 4; ++q) gl[q] = lgt[q] + bg[q];
        int gs = 0; float gm = gl[0];
#pragma unroll
        for (int q = 1; q < 4; ++q) if (gl[q] > gm) { gm = gl[q]; gs = q; }
        float den = 0.f;
#pragma unroll
        for (int q = 0; q < 4; ++q) den += expf(gl[q] - gm);
        const float gwt = 1.0f / den;
        float el[8];
#pragma unroll
        for (int q = 0; q < 8; ++q) { float x = 0.f;
#pragma unroll
            for (int gq = 0; gq < 4; ++gq) x = (gs == gq) ? lgt[4 + gq * 8 + q] + be[gq * 8 + q] : x;
            el[q] = x; }
        int i0 = 0; float m0 = el[0];
#pragma unroll
        for (int q = 1; q < 8; ++q) if (el[q] > m0) { m0 = el[q]; i0 = q; }
        int i1 = -1; float m1 = -3.0e38f;
#pragma unroll
        for (int q = 0; q < 8; ++q) if (q != i0 && el[q] > m1) { m1 = el[q]; i1 = q; }
        const float e1 = expf(m1 - m0); const float w0 = gwt / (1.0f + e1), w1 = gwt * e1 / (1.0f + e1);
        if (lane == 0) { const int ex0 = gs * 8 + i0, ex1 = gs * 8 + i1;
            const unsigned p0 = __hip_atomic_fetch_add(ctl + CW_CNT + ex0, 1u, RLX_AGENT), p1 = __hip_atomic_fetch_add(ctl + CW_CNT + ex1, 1u, RLX_AGENT);
            TE[2 * t] = ex0; TE[2 * t + 1] = ex1; TW[2 * t] = w0; TW[2 * t + 1] = w1; TP[2 * t] = (int)p0; TP[2 * t + 1] = (int)p1; }
    }
}

__device__ __forceinline__ void phase_gather(const Args& a, LAS unsigned char* lds, int tid, int lane, int wave, int bid, int G) {
    unsigned char* ws = a.ws; unsigned* ctl = (unsigned*)(ws + WS_CTL); const bf16* H2 = (const bf16*)(ws + WS_H2); bf16* XG = (bf16*)(ws + WS_XG);
    const int* TE = (const int*)(ws + WS_TOKE); const int* TP = (const int*)(ws + WS_TOKP); int* TS = (int*)(ws + WS_TOKS);
    LAS int* ps = (LAS int*)lds;
    __syncthreads();
    if (tid == 0) { int acc = 0, nt = 0;
        for (int e = 0; e < NEXP; ++e) { const int c = (int)__hip_atomic_load(ctl + CW_CNT + e, RLX_AGENT); ps[e] = acc; ps[64 + e] = c; const int tl = (c + 255) >> 8;
            if (bid == 0) for (int q = 0; q < tl; ++q) ctl[CW_TE + nt + q] = (unsigned)e;
            nt += tl; acc += tl * 256; }
        ps[32] = acc; if (bid == 0) ctl[CW_NT] = (unsigned)nt; }
    __syncthreads();
    const int gw = bid * NWAVES + wave, NGW = G * NWAVES;
    for (int it = gw; it < NTOK * 2; it += NGW) { const int t = it >> 1; const int e = TE[it]; const int slot = ps[e] + TP[it];
        const v4u* src = (const v4u*)(H2 + (size_t)t * DM) + lane; v4u* dst = (v4u*)(XG + (size_t)slot * DM) + lane;
#pragma unroll
        for (int j = 0; j < 4; ++j) dst[64 * j] = src[64 * j];
        if (lane == 0) TS[it] = slot; }
    for (int e = 0; e < NEXP; ++e) { const int c = ps[64 + e], base = ps[e] + c, npad = ps[e + 1] - base;
        for (int r = gw; r < npad; r += NGW) { v4u* dst = (v4u*)(XG + (size_t)(base + r) * DM) + lane;
#pragma unroll
            for (int j = 0; j < 4; ++j) dst[64 * j] = (v4u){0u, 0u, 0u, 0u}; } }
}

__device__ __forceinline__ void phase_final(const Args& a, int lane, int wave, int bid, int G) {
    unsigned char* ws = a.ws; float* X1 = a.out; const bf16* YS = (const bf16*)(ws + WS_YS); const int* TS = (const int*)(ws + WS_TOKS); const float* TW = (const float*)(ws + WS_TOKW); const float* fg = a.in[26];
    const int gw = bid * NWAVES + wave, NGW = G * NWAVES;
    for (int t = gw; t < NTOK; t += NGW) { const int s0 = TS[2 * t], s1 = TS[2 * t + 1]; const float w0 = TW[2 * t], w1 = TW[2 * t + 1];
        f32x4* xr = (f32x4*)(X1 + (size_t)t * DM) + lane; const v2u* y0 = (const v2u*)(YS + (size_t)s0 * DM) + lane; const v2u* y1 = (const v2u*)(YS + (size_t)s1 * DM) + lane;
        f32x4 v[8]; float s = 0.f;
#pragma unroll
        for (int j = 0; j < 8; ++j) { const f32x4 x = xr[64 * j]; const v2u a0 = y0[64 * j], a1 = y1[64 * j];
            v[j].x = x.x + w0 * bflo(a0.x) + w1 * bflo(a1.x); v[j].y = x.y + w0 * bfhi(a0.x) + w1 * bfhi(a1.x); v[j].z = x.z + w0 * bflo(a0.y) + w1 * bflo(a1.y); v[j].w = x.w + w0 * bfhi(a0.y) + w1 * bfhi(a1.y);
            s += (v[j].x * v[j].x + v[j].y * v[j].y) + (v[j].z * v[j].z + v[j].w * v[j].w); }
        const float rs = rsqrtf(wave_sum(s) * (1.0f / DM) + 1e-6f);
#pragma unroll
        for (int j = 0; j < 8; ++j) { const f32x4 g = ((const f32x4*)fg)[64 * j + lane]; xr[64 * j] = (f32x4){v[j].x * rs * g.x, v[j].y * rs * g.y, v[j].z * rs * g.z, v[j].w * rs * g.w}; } }
}

constexpr int NPHASE = 14;
__global__ void __launch_bounds__(NTHR, 2) mega_fwd(Args args) {
    extern __shared__ __attribute__((aligned(16))) unsigned char lds_raw[];
    LAS unsigned char* lds = (LAS unsigned char*)lds_raw;
    const int tid = threadIdx.x, lane = tid & 63, wave = __builtin_amdgcn_readfirstlane(tid >> 6), bid = blockIdx.x, G = gridDim.x;
    unsigned char* ws = args.ws; unsigned* ctl = (unsigned*)(ws + WS_CTL);
    volatile LAS unsigned* MISC = (volatile LAS unsigned*)(lds + MISC_OFF);
    for (int u = tid; u < (LDS_BYTES - RING_BYTES) / 4; u += NTHR) ((LAS unsigned*)(lds + RING_BYTES))[u] = 0u;
    __syncthreads();
    const int lo = args.ph_lo, hi = args.ph_hi;
    const bool multi = (hi - lo) > 1;
    XcdBarrier bar; bar.bar = ctl + CW_BAR; bar.x = 0; bar.st = nullptr;
    if (multi) bar = xcd_barrier_post(ctl + CW_BAR, MISC + 8);
#ifndef PH_MASK
#define PH_MASK 0x3fff
#endif
#define IN(k) (((PH_MASK >> (k)) & 1) && lo <= (k) && (k) < hi)
#define SEAM(k) do { if (IN(k) && IN((k) + 1)) xcd_barrier(bar); } while (0)
    bf16* P = (bf16*)(ws + WS_P);

    if (IN(0)) { phase_prologue(args, lds, tid, lane, wave, bid, G); } SEAM(0);
    if (IN(1)) { pg8::Gemm g{(const bf16*)(ws + WS_H1), (const bf16*)(ws + WS_WIN), NTOK, NP, DM}; pg8::StaticOrder S; S.init(NTOK, NP, G, bid);
        EpiP E{P}; pg8::gemm_phase<EpiP, pg8::StaticOrder, true, true>(lds, g, S, E); } SEAM(1);
    if (IN(2)) { phase_rwprep(args, lds, tid, lane, wave, bid, G); } SEAM(2);
    if (IN(3)) { phase_ret(args, lds, tid, bid, G); } SEAM(3);
    if (IN(4)) { phase_rwrec(args, lane, wave, bid, G); } SEAM(4);
    if (IN(5)) { phase_post(args, lane, wave, bid, G); } SEAM(5);
    if (IN(6)) { pg8::Gemm g{(const bf16*)(ws + WS_OA), (const bf16*)(ws + WS_WUPA), NTOK, DM, 1024}; pg8::StaticOrder S; S.init(NTOK, DM, G, bid);
        EpiUp<0> E{(bf16*)(ws + WS_MERGED), P}; pg8::gemm_phase<EpiUp<0>, pg8::StaticOrder, false, true>(lds, g, S, E); } SEAM(6);
    if (IN(7)) { pg8::Gemm g{(const bf16*)(ws + WS_OB), (const bf16*)(ws + WS_WUPB), NTOK, DM, DM}; pg8::StaticOrder S; S.init(NTOK, DM, G, bid);
        EpiUp<1> E{(bf16*)(ws + WS_MERGED), P}; pg8::gemm_phase<EpiUp<1>, pg8::StaticOrder, false, true>(lds, g, S, E); } SEAM(7);
    if (IN(8)) { pg8::Gemm g{(const bf16*)(ws + WS_MERGED), (const bf16*)(ws + WS_WOUT), NTOK, DM, DM}; pg8::StaticOrder S; S.init(NTOK, DM, G, bid);
        EpiX1 E{args.in[0], args.out}; pg8::gemm_phase<EpiX1, pg8::StaticOrder, false, true>(lds, g, S, E); } SEAM(8);
    if (IN(9)) { phase_router(args, lane, wave, bid, G); } SEAM(9);
    if (IN(10)) { phase_gather(args, lds, tid, lane, wave, bid, G); } SEAM(10);
    if (IN(11)) { pg8::Gemm g{(const bf16*)(ws + WS_XG), (const bf16*)(ws + WS_WGU), MAXSLOT, NEXP * 1024, DM}; MoeOrder<4> S; S.init(ctl, G, bid);
        EpiGU E{(bf16*)(ws + WS_ACT)}; pg8::gemm_phase<EpiGU, MoeOrder<4>, true, true>(lds, g, S, E); } SEAM(11);
    if (IN(12)) { pg8::Gemm g{(const bf16*)(ws + WS_ACT), (const bf16*)(ws + WS_WDN), MAXSLOT, NEXP * 2048, EFF}; MoeOrder<8> S; S.init(ctl, G, bid);
        EpiDn E{(bf16*)(ws + WS_YS)}; pg8::gemm_phase<EpiDn, MoeOrder<8>, true, true>(lds, g, S, E); } SEAM(12);
    if (IN(13)) { phase_final(args, lane, wave, bid, G); }
#undef IN
#undef SEAM
}

#ifndef MK_ONE_LAUNCH
#define MK_ONE_LAUNCH 1
#endif
extern "C" void kernel_launch(void* const* d_in, const int* in_sizes, int n_in, void* d_out, int out_size, void* d_ws, size_t ws_size, hipStream_t stream) {
    static int grid = 0;
    if (grid == 0) {
        if (n_in != 27 || out_size != NTOK * DM || ws_size < WS_END) { fprintf(stderr, "kernel_launch: unexpected shapes (n_in %d out %d ws %zu, need %zu)\n", n_in, out_size, ws_size, (size_t)WS_END); grid = -1; return; }
        int dev = 0, cus = 0, per_cu = 0;
        if (hipGetDevice(&dev) != hipSuccess || hipDeviceGetAttribute(&cus, hipDeviceAttributeMultiprocessorCount, dev) != hipSuccess) { grid = -1; return; }
        if (hipFuncSetAttribute((const void*)mega_fwd, hipFuncAttributeMaxDynamicSharedMemorySize, LDS_BYTES) != hipSuccess) { fprintf(stderr, "kernel_launch: hipFuncSetAttribute failed\n"); grid = -1; return; }
        if (hipOccupancyMaxActiveBlocksPerMultiprocessor(&per_cu, (const void*)mega_fwd, NTHR, LDS_BYTES) != hipSuccess || per_cu < 1) { fprintf(stderr, "kernel_launch: occupancy query says %d\n", per_cu); grid = -1; (void)hipGetLastError(); return; }
        grid = cus;
    }
    if (grid < 0) return;
    (void)in_sizes;
    if (hipMemsetAsync((char*)d_ws + WS_CTL, 0, CTL_ZERO_BYTES, stream) != hipSuccess) return;
    Args a{};
    for (int i = 0; i < 27; ++i) a.in[i] = (const float*)d_in[i];
    a.out = (float*)d_out; a.ws = (unsigned char*)d_ws;
#if MK_ONE_LAUNCH
    a.ph_lo = 0; a.ph_hi = NPHASE;
    hipLaunchKernelGGL(mega_fwd, dim3(grid), dim3(NTHR), LDS_BYTES, stream, a);
#else
    for (int p = 0; p < NPHASE; ++p) { a.ph_lo = p; a.ph_hi = p + 1; hipLaunchKernelGGL(mega_fwd, dim3(grid), dim3(NTHR), LDS_BYTES, stream, a); }
#endif
}
```

```cpp
#include <hip/hip_runtime.h>
#include <cstdio>
#include <cstdint>
namespace pg8 {
#define PG8_LAS __attribute__((address_space(3)))
typedef unsigned short bf16_t;
typedef short bf16x8 __attribute__((ext_vector_type(8)));
typedef float f32x4 __attribute__((ext_vector_type(4)));
typedef unsigned u32x4 __attribute__((ext_vector_type(4)));
constexpr int BM = 256, BK = 64, HALF = 128, HTB = HALF * BK * 2  , STAGE_BYTES = 8 * HTB, NXCD = 8, WGM = 8;

__host__ __device__ __forceinline__ int lds_byte(int r, int c) { const int st = (r >> 4) * 2 + (c >> 5), rr = r & 15, cc = c & 31, ob = rr * 64 + cc * 2; return st * 1024 + (ob ^ (((ob >> 9) & 1) << 5)); }
__host__ __device__ __forceinline__ void stage_rc(int b, int& R, int& C) { const int st = b / 1024, sb = b % 1024, swz = sb ^ (((sb >> 9) & 1) << 5); R = (st >> 1) * 16 + swz / 64; C = (st & 1) * 32 + (swz % 64) / 2; }
__host__ __device__ __forceinline__ int perm32(int rho) { const int n = rho >> 4, i = rho & 15; return 8 * (i >> 2) + 4 * n + (i & 3); }

struct Unit { int pm, pn; };
struct Gemm { const bf16_t* A; const bf16_t* Bt; int M, N, K; };

struct StaticOrder {
    int nM, nN, nwg, G, c;
    __host__ __device__ void init(int M, int N, int G_, int c_) { nM = M / BM; nN = N / BM; nwg = nM * nN; G = G_; c = c_; }
    __host__ __device__ bool next(int i, Unit& u) const {
        const long L = (long)i * G + c; if (L >= nwg) return false;
        int wgid = (int)L; { const int q = nwg / NXCD, r = nwg % NXCD, xcd = wgid % NXCD, off = wgid / NXCD; wgid = (xcd < r ? xcd * (q + 1) : r * (q + 1) + (xcd - r) * q) + off; }
        const int nig = WGM * nN, gid = wgid / nig, fm = gid * WGM, gsz = (nM - fm) < WGM ? (nM - fm) : WGM;
        u.pm = fm + ((wgid % nig) % gsz); u.pn = (wgid % nig) / gsz; return true;
    }
    __device__ __forceinline__ void a_ready(const Unit&) const {}
    __device__ __forceinline__ void done(const Unit&) const {}
};

__device__ __forceinline__ unsigned cvt_pk_bf16(float lo, float hi) { unsigned r; asm volatile("v_cvt_pk_bf16_f32 %0, %1, %2" : "=v"(r) : "v"(lo), "v"(hi)); return r; }
typedef float f32x2 __attribute__((ext_vector_type(2)));
template <class Epi, class Sched, bool ALIGN_EPI = false, bool SP2 = false>
__device__ __forceinline__ void gemm_phase(PG8_LAS unsigned char* lds, const Gemm g, const Sched& S, const Epi& E) {
    const int tid = threadIdx.x, wid = __builtin_amdgcn_readfirstlane(tid >> 6), lane = tid & 63, wr = wid >> 2, wc = wid & 3, fr = lane & 15, fq = lane >> 4;
    const int K = g.K, nt = K / BK;
    unsigned voffA[2], voffB[2];
#pragma unroll
    for (int i = 0; i < 2; ++i) { int R, C; stage_rc(tid * 16 + i * 8192, R, C); const int Rb = Epi::PERM ? ((R & ~31) + perm32(R & 31)) : R;
        voffA[i] = (unsigned)(R * K + C) * 2u; voffB[i] = (unsigned)(Rb * K + C) * 2u; }
    const size_t kstep = (size_t)(BK * 2);
    const size_t hstep = (size_t)HALF * K * 2;
    const size_t tstep = 2 * hstep;
    const unsigned ldsw = (unsigned)wid * 1024u;
    const int aoff = lds_byte(wr * 64 + fr, fq * 8), boff = lds_byte(wc * 32 + fr, fq * 8);
#define PG8_SA(b, h) (((b) * 2 + (h)) * HTB)
#define PG8_SB(b, h) ((4 + (b) * 2 + (h)) * HTB)
#define PG8_STAGE(bufoff, gbase, voff) do { _Pragma("unroll") for (int _i = 0; _i < 2; ++_i) \
        __builtin_amdgcn_global_load_lds((const unsigned*)((const char*)(gbase) + (voff)[_i]), (PG8_LAS unsigned*)(lds + (bufoff) + ldsw + _i * 8192), 16, 0, 0); } while (0)
#define PG8_LDA(dst, b, h) do { _Pragma("unroll") for (int m = 0; m < 4; ++m) _Pragma("unroll") for (int k = 0; k < 2; ++k) dst[m][k] = *(const PG8_LAS bf16x8*)(lds + PG8_SA(b, h) + aoff + m * 2048 + k * 1024); } while (0)
#define PG8_LDB(dst, b, h) do { _Pragma("unroll") for (int n = 0; n < 2; ++n) _Pragma("unroll") for (int k = 0; k < 2; ++k) dst[n][k] = *(const PG8_LAS bf16x8*)(lds + PG8_SB(b, h) + boff + n * 2048 + k * 1024); } while (0)
#define PG8_MMA(ai, bj, At, Bt) do { __builtin_amdgcn_s_setprio(1); _Pragma("unroll") for (int m = 0; m < 4; ++m) _Pragma("unroll") for (int n = 0; n < 2; ++n) _Pragma("unroll") for (int k = 0; k < 2; ++k) \
        acc[ai][bj][m][n] = __builtin_amdgcn_mfma_f32_16x16x32_bf16(Bt[n][k], At[m][k], acc[ai][bj][m][n], 0, 0, 0); __builtin_amdgcn_s_setprio(0); } while (0)
#define PG8_WAIT_V(n) asm volatile("s_waitcnt vmcnt(" #n ")" ::: "memory")
#define PG8_WAIT_L(n) asm volatile("s_waitcnt lgkmcnt(" #n ")" ::: "memory")
#define PG8_BAR __builtin_amdgcn_s_barrier()
#define PG8_SCHED __builtin_amdgcn_sched_barrier(0)
    Unit cur, nxt; int ui = 0;
    if (!S.next(0, cur)) return;
    f32x4 acc[2][2][4][2];
#pragma unroll
    for (int a = 0; a < 2; ++a)
#pragma unroll
        for (int b = 0; b < 2; ++b)
#pragma unroll
            for (int m = 0; m < 4; ++m)
#pragma unroll
                for (int n = 0; n < 2; ++n) acc[a][b][m][n] = (f32x4){0.f, 0.f, 0.f, 0.f};
    bf16x8 At[4][2], B0[2][2], B1[2][2];
    const char* cA = (const char*)g.A + (size_t)cur.pm * tstep; const char* cB = (const char*)g.Bt + (size_t)cur.pn * tstep;
    S.a_ready(cur);
    if constexpr (SP2) {
        PG8_STAGE(PG8_SB(0, 0), cB, voffB); PG8_STAGE(PG8_SB(0, 1), cB + hstep, voffB); PG8_STAGE(PG8_SA(0, 0), cA, voffA); PG8_STAGE(PG8_SA(0, 1), cA + hstep, voffA);
        if (wr == 1) PG8_BAR;
        PG8_WAIT_V(2); PG8_BAR;
        PG8_STAGE(PG8_SB(1, 0), cB + kstep, voffB); PG8_STAGE(PG8_SA(1, 0), cA + kstep, voffA); PG8_STAGE(PG8_SB(1, 1), cB + hstep + kstep, voffB);
        PG8_WAIT_V(6); PG8_BAR;
    } else {
        PG8_STAGE(PG8_SB(0, 0), cB, voffB); PG8_STAGE(PG8_SA(0, 0), cA, voffA); PG8_STAGE(PG8_SB(0, 1), cB + hstep, voffB); PG8_STAGE(PG8_SA(0, 1), cA + hstep, voffA);
        if (wr == 1) PG8_BAR;
        PG8_WAIT_V(4); PG8_BAR;
        PG8_STAGE(PG8_SB(1, 0), cB + kstep, voffB); PG8_STAGE(PG8_SA(1, 0), cA + kstep, voffA); PG8_STAGE(PG8_SB(1, 1), cB + hstep + kstep, voffB);
        PG8_WAIT_V(6); PG8_BAR;
    }
    for (;;) {
        const bool has_next = S.next(ui + 1, nxt);
        const char* nA = has_next ? (const char*)g.A + (size_t)nxt.pm * tstep : cA; const char* nB = has_next ? (const char*)g.Bt + (size_t)nxt.pn * tstep : cB;
        for (int t = 0; t < nt; t += 2) {
            const bool last = (t == nt - 2);
            const char* a1 = cA + (size_t)(t + 1) * kstep;
            const char* a2 = last ? nA : cA + (size_t)(t + 2) * kstep; const char* b2 = last ? nB : cB + (size_t)(t + 2) * kstep;
            const char* a3 = a2 + kstep; const char* b3 = b2 + kstep;
            if (last && has_next) S.a_ready(nxt);
            if constexpr (SP2) {
            PG8_LDB(B0, 0, 0); PG8_LDB(B1, 0, 1); PG8_SCHED; PG8_LDA(At, 0, 0); PG8_STAGE(PG8_SA(1, 1), a1 + hstep, voffA);
            PG8_WAIT_V(8); PG8_WAIT_L(0); PG8_BAR; PG8_MMA(0, 0, At, B0); PG8_MMA(0, 1, At, B1); PG8_BAR; PG8_SCHED;
            PG8_LDA(At, 0, 1); PG8_STAGE(PG8_SB(0, 0), b2, voffB); PG8_STAGE(PG8_SB(0, 1), b2 + hstep, voffB); PG8_STAGE(PG8_SA(0, 0), a2, voffA);
            PG8_WAIT_V(8); PG8_WAIT_L(0); PG8_BAR; PG8_MMA(1, 0, At, B0); PG8_MMA(1, 1, At, B1); PG8_BAR; PG8_SCHED;
            PG8_LDB(B0, 1, 0); PG8_LDB(B1, 1, 1); PG8_SCHED; PG8_LDA(At, 1, 0); PG8_STAGE(PG8_SA(0, 1), a2 + hstep, voffA);
            PG8_WAIT_V(8); PG8_WAIT_L(0); PG8_BAR; PG8_MMA(0, 0, At, B0); PG8_MMA(0, 1, At, B1); PG8_BAR; PG8_SCHED;
            PG8_LDA(At, 1, 1); PG8_STAGE(PG8_SB(1, 0), b3, voffB); PG8_STAGE(PG8_SB(1, 1), b3 + hstep, voffB); PG8_STAGE(PG8_SA(1, 0), a3, voffA);
            PG8_WAIT_V(8); PG8_WAIT_L(0); PG8_BAR; PG8_MMA(1, 0, At, B0); PG8_MMA(1, 1, At, B1); PG8_BAR; PG8_SCHED;
            } else {
            PG8_LDB(B0, 0, 0); PG8_SCHED; PG8_LDA(At, 0, 0); PG8_STAGE(PG8_SA(1, 1), a1 + hstep, voffA);
            PG8_WAIT_L(8); PG8_BAR; PG8_WAIT_L(0); PG8_MMA(0, 0, At, B0); PG8_BAR; PG8_SCHED;
            PG8_LDB(B1, 0, 1); PG8_STAGE(PG8_SB(0, 0), b2, voffB);
            PG8_BAR; PG8_WAIT_L(0); PG8_MMA(0, 1, At, B1); PG8_BAR;
            PG8_LDA(At, 0, 1); PG8_STAGE(PG8_SA(0, 0), a2, voffA);
            PG8_BAR; PG8_WAIT_L(0); PG8_MMA(1, 0, At, B0); PG8_BAR; PG8_SCHED;
            PG8_STAGE(PG8_SB(0, 1), b2 + hstep, voffB);
            PG8_WAIT_V(6); PG8_BAR; PG8_MMA(1, 1, At, B1); PG8_BAR;
            PG8_LDB(B0, 1, 0); PG8_SCHED; PG8_LDA(At, 1, 0); PG8_STAGE(PG8_SA(0, 1), a2 + hstep, voffA);
            PG8_WAIT_L(8); PG8_BAR; PG8_WAIT_L(0); PG8_MMA(0, 0, At, B0); PG8_BAR; PG8_SCHED;
            PG8_LDB(B1, 1, 1); PG8_STAGE(PG8_SB(1, 0), b3, voffB);
            PG8_BAR; PG8_WAIT_L(0); PG8_MMA(0, 1, At, B1); PG8_BAR;
            PG8_LDA(At, 1, 1); PG8_STAGE(PG8_SA(1, 0), a3, voffA);
            PG8_BAR; PG8_WAIT_L(0); PG8_MMA(1, 0, At, B0); PG8_BAR; PG8_SCHED;
            PG8_STAGE(PG8_SB(1, 1), b3 + hstep, voffB);
            PG8_WAIT_V(6); PG8_BAR; PG8_MMA(1, 1, At, B1); PG8_BAR;
            }
        }
        if constexpr (ALIGN_EPI) { if (wr == 0) PG8_BAR; }
        if constexpr (!Epi::AFTER_DRAIN) { E(acc, cur, wr, wc, fr, fq); S.done(cur); }
        if (!has_next) break;
#pragma unroll
        for (int a = 0; a < 2; ++a)
#pragma unroll
            for (int b = 0; b < 2; ++b)
#pragma unroll
                for (int m = 0; m < 4; ++m)
#pragma unroll
                    for (int n = 0; n < 2; ++n) acc[a][b][m][n] = (f32x4){0.f, 0.f, 0.f, 0.f};
        cur = nxt; cA = nA; cB = nB; ++ui;
        if constexpr (ALIGN_EPI) { if (wr == 1) PG8_BAR; }
    }
    PG8_WAIT_V(0);
    if constexpr (!ALIGN_EPI) { if (wr == 0) PG8_BAR; }
    PG8_BAR;
    if constexpr (Epi::AFTER_DRAIN) { E.fused(acc, cur, wr, wc, fr, fq, lds, wid, lane); S.done(cur); }
#undef PG8_SA
#undef PG8_SB
#undef PG8_STAGE
#undef PG8_LDA
#undef PG8_LDB
#undef PG8_MMA
#undef PG8_WAIT_V
#undef PG8_WAIT_L
#undef PG8_BAR
#undef PG8_SCHED
}
}

#define GAS __attribute__((address_space(1)))
#define LAS __attribute__((address_space(3)))
typedef unsigned short bf16;
typedef unsigned v4u __attribute__((ext_vector_type(4)));
typedef unsigned v2u __attribute__((ext_vector_type(2)));
typedef float f32x4 __attribute__((ext_vector_type(4)));
typedef GAS unsigned gu32;
#define RLX_AGENT __ATOMIC_RELAXED, __HIP_MEMORY_SCOPE_AGENT
#define LDS_WAIT() asm volatile("s_waitcnt lgkmcnt(0)" ::: "memory")
#define VM_WAIT() asm volatile("s_waitcnt vmcnt(0)" ::: "memory")

constexpr int NTOK = 8192, SEQ = 2048, DM = 2048, NP = 13824, NWAVES = 8, NTHR = 512;
constexpr int RW_W = 1024, RW_H = 16, RW_N = 64;
constexpr int P_XW = 3072, P_XA = 3168, P_XG = 3264;
constexpr int P_RQ = 3584, P_RK = 4608, P_RV = 5632, P_RG = 7680, P_GA = 9728, P_GB = 11776;
constexpr int RET_H = 8, RET_DK = 128, RET_DV = 256, RET_VW = 2048;
constexpr int NEXP = 32, EFF = 512, MAXT = 96, MAXSLOT = MAXT * 256;

constexpr size_t MiB = 1u << 20;
constexpr size_t WS_CTL = 0, CTL_ZERO_BYTES = 256 * 1024;
constexpr size_t WS_ROT = 1 * MiB;
constexpr size_t WS_TOKE = 2 * MiB;
constexpr size_t WS_TOKW = WS_TOKE + 65536;
constexpr size_t WS_TOKP = WS_TOKW + 65536;
constexpr size_t WS_TOKS = WS_TOKP + 65536;
constexpr size_t WS_BONUS = WS_TOKS + 65536;
constexpr size_t WS_WUPA = 3 * MiB, WS_WUPB = 7 * MiB, WS_WOUT = 15 * MiB;
constexpr size_t WS_WGU = 23 * MiB, WS_WDN = 151 * MiB;
constexpr size_t WS_P = 215 * MiB;
constexpr size_t WS_RA = 431 * MiB;
constexpr size_t WS_WIN = WS_RA, WS_H1 = WS_RA + 54 * MiB;
constexpr size_t WS_OA = WS_RA, WS_OB = WS_RA + 16 * MiB;
constexpr size_t WS_RB = 517 * MiB;
constexpr size_t WS_RWE = WS_RB, WS_RWA = WS_RB + 16 * MiB, WS_RWB = WS_RB + 32 * MiB, WS_MERGED = WS_RB;
constexpr size_t WS_END = 565 * MiB;
constexpr size_t WS_H2 = WS_P, WS_XG = WS_P + 32 * MiB, WS_YS = WS_XG, WS_ACT = WS_XG + 96 * MiB;
constexpr int CW_BAR = 1024;
constexpr int CW_CNT = 8192;
constexpr int CW_NT = 8256;
constexpr int CW_TE = 8320;
constexpr int CW_PS = 8448;

constexpr int RING_BYTES = 131072, MISC_OFF = RING_BYTES + 320, LDS_BYTES = 147456;

struct Args { const float* in[27]; float* out; unsigned char* ws; int ph_lo, ph_hi; };

__device__ __forceinline__ float bf2f(unsigned short b) { return __uint_as_float(((unsigned)b) << 16); }
__device__ __forceinline__ float bflo(unsigned u) { return __uint_as_float(u << 16); }
__device__ __forceinline__ float bfhi(unsigned u) { return __uint_as_float(u & 0xffff0000u); }
__device__ __forceinline__ unsigned f2bf(float f) { unsigned u = __float_as_uint(f); return (u + 0x7fffu + ((u >> 16) & 1u)) >> 16; }
__device__ __forceinline__ unsigned pk2(float lo, float hi) { return f2bf(lo) | (f2bf(hi) << 16); }
__device__ __forceinline__ float sigmoidf_(float x) { return 1.0f / (1.0f + __expf(-x)); }
__device__ __forceinline__ float wave_sum(float v) {
#pragma unroll
    for (int o = 1; o < 64; o <<= 1) v += __shfl_xor(v, o);
    return v;
}

struct EpiP {
    static constexpr bool PERM = true, AFTER_DRAIN = false;
    bf16* O;
    __device__ __forceinline__ void operator()(const pg8::f32x4 (&acc)[2][2][4][2], const pg8::Unit& u, int wr, int wc, int fr, int fq) const {
        const int row0 = u.pm * 256 + wr * 64 + fr, col0 = u.pn * 256 + wc * 32 + 8 * fq;
        const int mode = u.pn >= 38 ? 2 : (u.pn >= 30 ? 1 : 0);
#pragma unroll
        for (int ai = 0; ai < 2; ++ai)
#pragma unroll
            for (int m = 0; m < 4; ++m) { bf16* rowp = O + (size_t)(row0 + ai * 128 + m * 16) * NP + col0;
#pragma unroll
                for (int bj = 0; bj < 2; ++bj) { pg8::f32x4 v0 = acc[ai][bj][m][0], v1 = acc[ai][bj][m][1];
                    if (mode) {
#pragma unroll
                        for (int j = 0; j < 4; ++j) { const float s0 = sigmoidf_(v0[j]), s1 = sigmoidf_(v1[j]); v0[j] = mode == 2 ? s0 : v0[j] * s0; v1[j] = mode == 2 ? s1 : v1[j] * s1; } }
                    pg8::u32x4 w; w.x = pg8::cvt_pk_bf16(v0[0], v0[1]); w.y = pg8::cvt_pk_bf16(v0[2], v0[3]); w.z = pg8::cvt_pk_bf16(v1[0], v1[1]); w.w = pg8::cvt_pk_bf16(v1[2], v1[3]);
                    *(pg8::u32x4*)(rowp + bj * 128) = w; } }
    }
};
template <int MODE> struct EpiUp {
    static constexpr bool PERM = true, AFTER_DRAIN = false;
    bf16* O; const bf16* P;
    __device__ __forceinline__ void operator()(const pg8::f32x4 (&acc)[2][2][4][2], const pg8::Unit& u, int wr, int wc, int fr, int fq) const {
        const int row0 = u.pm * 256 + wr * 64 + fr, col0 = u.pn * 256 + wc * 32 + 8 * fq;
#pragma unroll
        for (int ai = 0; ai < 2; ++ai)
#pragma unroll
            for (int m = 0; m < 4; ++m) { const int row = row0 + ai * 128 + m * 16; bf16* rowp = O + (size_t)row * DM + col0; const bf16* gp = P + (size_t)row * NP + (MODE ? P_GB : P_GA) + col0;
#pragma unroll
                for (int bj = 0; bj < 2; ++bj) { const pg8::f32x4 v0 = acc[ai][bj][m][0], v1 = acc[ai][bj][m][1];
                    const pg8::u32x4 g = *(const pg8::u32x4*)(gp + bj * 128);
                    float o[8] = { v0[0] * bflo(g.x), v0[1] * bfhi(g.x), v0[2] * bflo(g.y), v0[3] * bfhi(g.y), v1[0] * bflo(g.z), v1[1] * bfhi(g.z), v1[2] * bflo(g.w), v1[3] * bfhi(g.w) };
                    if (MODE) { const pg8::u32x4 p = *(const pg8::u32x4*)(rowp + bj * 128);
                        o[0] += bflo(p.x); o[1] += bfhi(p.x); o[2] += bflo(p.y); o[3] += bfhi(p.y); o[4] += bflo(p.z); o[5] += bfhi(p.z); o[6] += bflo(p.w); o[7] += bfhi(p.w); }
                    pg8::u32x4 w; w.x = pg8::cvt_pk_bf16(o[0], o[1]); w.y = pg8::cvt_pk_bf16(o[2], o[3]); w.z = pg8::cvt_pk_bf16(o[4], o[5]); w.w = pg8::cvt_pk_bf16(o[6], o[7]);
                    *(pg8::u32x4*)(rowp + bj * 128) = w; } }
    }
};
struct EpiX1 {
    static constexpr bool PERM = false, AFTER_DRAIN = false;
    const float* X; float* O;
    __device__ __forceinline__ void operator()(const pg8::f32x4 (&acc)[2][2][4][2], const pg8::Unit& u, int wr, int wc, int fr, int fq) const {
        const int row0 = u.pm * 256 + wr * 64 + fr, col0 = u.pn * 256 + wc * 32 + 4 * fq;
#pragma unroll
        for (int ai = 0; ai < 2; ++ai)
#pragma unroll
            for (int m = 0; m < 4; ++m) { const size_t off = (size_t)(row0 + ai * 128 + m * 16) * DM + col0;
#pragma unroll
                for (int bj = 0; bj < 2; ++bj)
#pragma unroll
                    for (int n = 0; n < 2; ++n) { const pg8::f32x4 xv = *(const pg8::f32x4*)(X + off + bj * 128 + n * 16); *(pg8::f32x4*)(O + off + bj * 128 + n * 16) = xv + acc[ai][bj][m][n]; } }
    }
};
struct EpiGU {
    static constexpr bool PERM = true, AFTER_DRAIN = false;
    bf16* O;
    __device__ __forceinline__ void operator()(const pg8::f32x4 (&acc)[2][2][4][2], const pg8::Unit& u, int wr, int wc, int fr, int fq) const {
        const int row0 = u.pm * 256 + wr * 64 + fr, col0 = (u.pn & 3) * 128 + wc * 32 + 8 * fq;
#pragma unroll
        for (int ai = 0; ai < 2; ++ai)
#pragma unroll
            for (int m = 0; m < 4; ++m) { bf16* rowp = O + (size_t)(row0 + ai * 128 + m * 16) * EFF + col0;
                const pg8::f32x4 g0 = acc[ai][0][m][0], g1 = acc[ai][0][m][1], u0 = acc[ai][1][m][0], u1 = acc[ai][1][m][1];
                float o[8];
#pragma unroll
                for (int j = 0; j < 4; ++j) { o[j] = g0[j] * sigmoidf_(g0[j]) * u0[j]; o[4 + j] = g1[j] * sigmoidf_(g1[j]) * u1[j]; }
                pg8::u32x4 w; w.x = pg8::cvt_pk_bf16(o[0], o[1]); w.y = pg8::cvt_pk_bf16(o[2], o[3]); w.z = pg8::cvt_pk_bf16(o[4], o[5]); w.w = pg8::cvt_pk_bf16(o[6], o[7]);
                *(pg8::u32x4*)rowp = w; }
    }
};
struct EpiDn {
    static constexpr bool PERM = true, AFTER_DRAIN = false;
    bf16* O;
    __device__ __forceinline__ void operator()(const pg8::f32x4 (&acc)[2][2][4][2], const pg8::Unit& u, int wr, int wc, int fr, int fq) const {
        const int row0 = u.pm * 256 + wr * 64 + fr, col0 = (u.pn & 7) * 256 + wc * 32 + 8 * fq;
#pragma unroll
        for (int ai = 0; ai < 2; ++ai)
#pragma unroll
            for (int m = 0; m < 4; ++m) { bf16* rowp = O + (size_t)(row0 + ai * 128 + m * 16) * DM + col0;
#pragma unroll
                for (int bj = 0; bj < 2; ++bj) { const pg8::f32x4 v0 = acc[ai][bj][m][0], v1 = acc[ai][bj][m][1];
                    pg8::u32x4 w; w.x = pg8::cvt_pk_bf16(v0[0], v0[1]); w.y = pg8::cvt_pk_bf16(v0[2], v0[3]); w.z = pg8::cvt_pk_bf16(v1[0], v1[1]); w.w = pg8::cvt_pk_bf16(v1[2], v1[3]);
                    *(pg8::u32x4*)(rowp + bj * 128) = w; } }
    }
};
template <int NB> struct MoeOrder {
    const unsigned* ctl; int G, c, nunits;
    __device__ __forceinline__ void init(const unsigned* ctl_, int G_, int c_) { ctl = ctl_; G = G_; c = c_; nunits = (int)ctl_[CW_NT] * NB; }
    __device__ __forceinline__ bool next(int i, pg8::Unit& u) const {
        const int L = i * G + c; if (L >= nunits) return false;
        u.pm = L / NB; u.pn = (int)ctl[CW_TE + u.pm] * NB + (L % NB); return true;
    }
    __device__ __forceinline__ void a_ready(const pg8::Unit&) const {}
    __device__ __forceinline__ void done(const pg8::Unit&) const {}
};
#define XB_TMO      128
#define XB_XCNT(j)  (256  + 64 * (j))
#define XB_XSUB(j)  (1280 + 64 * (j))
#define XB_XGEN(j)  (2304 + 64 * (j))
#define XB_TOP      3328
#define XB_TOPGEN   3392
#define XCD_BAR_WORDS 3456
#define XB_SPIN_CAP (1u << 18)

__device__ __forceinline__ unsigned xb_ld(unsigned* p)              { return __hip_atomic_load(p, __ATOMIC_RELAXED, __HIP_MEMORY_SCOPE_AGENT); }
__device__ __forceinline__ unsigned xb_add(unsigned* p, unsigned v) { return __hip_atomic_fetch_add(p, v, __ATOMIC_RELAXED, __HIP_MEMORY_SCOPE_AGENT); }
__device__ __forceinline__ unsigned xb_xcc_id() { return (unsigned)__builtin_amdgcn_s_getreg((3 << 11) | 20) & 0xFu; }
#define XB_SPIN(cond, bar) do { unsigned _sp = 0; while (cond) { __builtin_amdgcn_s_sleep(1); \
    if ((++_sp & 255u) == 0u) { if (xb_ld(&(bar)[XB_TMO])) break; if (_sp > XB_SPIN_CAP) { atomicAdd(&(bar)[XB_TMO], 1u); break; } } } } while (0)

struct XcdBarrier {
    unsigned* bar; unsigned x;
    volatile LAS unsigned* st;
};

__device__ __forceinline__ XcdBarrier xcd_barrier_post(unsigned* bar, volatile LAS unsigned* st) {
    XcdBarrier b; b.bar = bar; b.x = xb_xcc_id(); b.st = st;
    if (threadIdx.x == 0) (void)xb_add(&bar[XB_XCNT(b.x)], 1u);
    return b;
}
__device__ __forceinline__ void xcd_barrier_complete(unsigned* bar, unsigned x, unsigned& nloc, unsigned& nx) {
    const unsigned G = gridDim.x * gridDim.y * gridDim.z;
    unsigned sum, cnt, mine, sp = 0u;
    for (;;) {
        sum = 0u; cnt = 0u; mine = 0u;
#pragma unroll
        for (unsigned j = 0; j < 16; ++j) { const unsigned c = xb_ld(&bar[XB_XCNT(j)]); sum += c; cnt += (c > 0u) ? 1u : 0u; mine = (j == x) ? c : mine; }
        if (sum == G) break;
        __builtin_amdgcn_s_sleep(1);
        if ((++sp & 255u) == 0u) { if (xb_ld(&bar[XB_TMO])) break; if (sp > XB_SPIN_CAP) { atomicAdd(&bar[XB_TMO], 1u); break; } }
    }
    nloc = mine > 0u ? mine : 1u; nx = cnt > 0u ? cnt : 1u;
}

__device__ __forceinline__ void xcd_barrier(const XcdBarrier& b) {
    asm volatile("s_waitcnt vmcnt(0)" ::: "memory");
    __syncthreads();
    if (threadIdx.x == 0) {
        unsigned* bar = b.bar;
        __builtin_amdgcn_s_waitcnt(0);
        unsigned nloc = b.st[0], nx = b.st[1];
        if (nloc == 0u) { xcd_barrier_complete(bar, b.x, nloc, nx); b.st[0] = nloc; b.st[1] = nx; }
        const unsigned old = xb_add(&bar[XB_XSUB(b.x)], 1u);
        const unsigned gen = old / nloc;
        if (old + 1u == (gen + 1u) * nloc) {
            __builtin_amdgcn_fence(__ATOMIC_RELEASE, "agent");
            asm volatile("s_waitcnt vmcnt(0)" ::: "memory");
            const unsigned og = xb_add(&bar[XB_TOP], 1u);
            const unsigned tg = og / nx;
            if (og + 1u == (tg + 1u) * nx) xb_add(&bar[XB_TOPGEN], 1u);
            else XB_SPIN(xb_ld(&bar[XB_TOPGEN]) == tg, bar);
            __builtin_amdgcn_fence(__ATOMIC_ACQUIRE, "agent");
            xb_add(&bar[XB_XGEN(b.x)], 1u);
            asm volatile("s_waitcnt vmcnt(0)" ::: "memory");
        } else {
            XB_SPIN(xb_ld(&bar[XB_XGEN(b.x)]) == gen, bar);
            __builtin_amdgcn_fence(__ATOMIC_ACQUIRE, "agent");
            asm volatile("s_waitcnt vmcnt(0)" ::: "memory");
        }
    }
    __syncthreads();
}

__device__ __forceinline__ void tr_item(const float* W, int ldw, int k0, int n0, bf16* WT, int K, size_t drow0, LAS float* scr, int lane) {
#pragma unroll 8
    for (int i = 0; i < 32; ++i) { const int kk = 2 * i + (lane >> 5); scr[kk * 33 + (lane & 31)] = W[(size_t)(k0 + kk) * ldw + n0 + (lane & 31)]; }
    LDS_WAIT(); asm volatile("" ::: "memory");
    const int c = lane & 7;
#pragma unroll
    for (int j = 0; j < 4; ++j) { const int n = (lane >> 3) + 8 * j; const LAS float* s = scr + (8 * c) * 33 + n;
        v4u o; o.x = pk2(s[0 * 33], s[1 * 33]); o.y = pk2(s[2 * 33], s[3 * 33]); o.z = pk2(s[4 * 33], s[5 * 33]); o.w = pk2(s[6 * 33], s[7 * 33]);
        *(v4u*)(WT + (drow0 + n) * (size_t)K + k0 + 8 * c) = o; }
    LDS_WAIT(); asm volatile("" ::: "memory");
}
__device__ __forceinline__ void phase_prologue(const Args& a, LAS unsigned char* lds, int tid, int lane, int wave, int bid, int G) {
    unsigned char* ws = a.ws;
    LAS float* scr = (LAS float*)(lds + wave * 16384);
    const int gw = bid * NWAVES + wave, NGW = G * NWAVES;
    constexpr int I_IN = 32 * 430, I_UA = 16 * 64, I_UB = 32 * 64, I_WO = 32 * 64, I_EG = 32 * 32 * 16, I_ED = 32 * 8 * 64;
    constexpr int NITEMS = I_IN + I_UA + I_UB + I_WO + 2 * I_EG + I_ED;
    for (int it = gw; it < NITEMS; it += NGW) {
        int r = it;
        if (r < I_IN) { const int kb = r / 430, nb = r % 430, n0 = nb * 32; tr_item(a.in[2], 13760, kb * 64, n0, (bf16*)(ws + WS_WIN), 2048, (size_t)(n0 + (n0 >= 3520 ? 64 : 0)), scr, lane); continue; } r -= I_IN;
        if (r < I_UA) { const int kb = r / 64, nb = r % 64; tr_item(a.in[15], 2048, kb * 64, nb * 32, (bf16*)(ws + WS_WUPA), 1024, (size_t)(nb * 32), scr, lane); continue; } r -= I_UA;
        if (r < I_UB) { const int kb = r / 64, nb = r % 64; tr_item(a.in[16], 2048, kb * 64, nb * 32, (bf16*)(ws + WS_WUPB), 2048, (size_t)(nb * 32), scr, lane); continue; } r -= I_UB;
        if (r < I_WO) { const int kb = r / 64, nb = r % 64; tr_item(a.in[17], 2048, kb * 64, nb * 32, (bf16*)(ws + WS_WOUT), 2048, (size_t)(nb * 32), scr, lane); continue; } r -= I_WO;
        if (r < 2 * I_EG) { const int half = r / I_EG; const int q = r % I_EG; const int e = q / 512, kb = (q % 512) / 16, nb = q % 16, n0 = nb * 32;
            const float* W = a.in[23 + half] + (size_t)e * 2048 * 512;
            tr_item(W, 512, kb * 64, n0, (bf16*)(ws + WS_WGU), 2048, (size_t)e * 1024 + (n0 >> 7) * 256 + half * 128 + (n0 & 127), scr, lane); continue; } r -= 2 * I_EG;
        { const int e = r / 512, kb = (r % 512) / 64, nb = r % 64; const float* W = a.in[25] + (size_t)e * 512 * 2048;
            tr_item(W, 2048, kb * 64, nb * 32, (bf16*)(ws + WS_WDN), 512, (size_t)e * 2048 + nb * 32, scr, lane); }
    }
    { v4u* z = (v4u*)(ws + WS_WIN + (size_t)3520 * 2048 * 2); const int n16 = 64 * 2048 * 2 / 16;
      for (int i = bid * NTHR + tid; i < n16; i += G * NTHR) z[i] = (v4u){0u, 0u, 0u, 0u}; }
    { float2* rot = (float2*)(ws + WS_ROT);
      for (int i = bid * NTHR + tid; i < SEQ * 64; i += G * NTHR) { const int pos = i >> 6, d = i & 63;
          const float inv = exp2f(-(float)d * (13.287712379549449f / 64.0f)); const float ang = (float)pos * inv;
          double rev = (double)ang * 0.15915494309189535; rev -= __builtin_rint(rev); const float rf = (float)rev;
          rot[i] = make_float2(__builtin_amdgcn_cosf(rf), __builtin_amdgcn_sinf(rf)); } }
    { const float* g1 = a.in[1]; bf16* H1 = (bf16*)(ws + WS_H1);
      for (int m = gw; m < NTOK; m += NGW) { const f32x4* xr = (const f32x4*)(a.in[0] + (size_t)m * DM) + lane; f32x4 v[8]; float s = 0.f;
#pragma unroll
          for (int j = 0; j < 8; ++j) { v[j] = xr[64 * j]; s += (v[j].x * v[j].x + v[j].y * v[j].y) + (v[j].z * v[j].z + v[j].w * v[j].w); }
          const float rs = rsqrtf(wave_sum(s) * (1.0f / DM) + 1e-6f);
          v2u* o8 = (v2u*)(H1 + (size_t)m * DM) + lane;
#pragma unroll
          for (int j = 0; j < 8; ++j) { const f32x4 g = ((const f32x4*)g1)[64 * j + lane]; v2u o; o.x = pk2(v[j].x * rs * g.x, v[j].y * rs * g.y); o.y = pk2(v[j].z * rs * g.z, v[j].w * rs * g.w); o8[64 * j] = o; } } }
}

__device__ __forceinline__ float shiftp(const bf16* P, int t, int col, float mu, bool first) {
    const float cur = bf2f(P[(size_t)t * NP + col]); const float prev = first ? 0.f : bf2f(P[(size_t)(t - 1) * NP + col]);
    return cur + (prev - cur) * mu;
}
__device__ __forceinline__ void phase_rwprep(const Args& a, LAS unsigned char* lds, int tid, int lane, int wave, int bid, int G) {
    unsigned char* ws = a.ws; const bf16* P = (const bf16*)(ws + WS_P);
    LAS float* xs = (LAS float*)lds;
    const float* mu = a.in[3]; const float* w0 = a.in[4]; const float* w2 = a.in[5]; const float* a0 = a.in[6]; const float* a2 = a.in[7]; const float* g2 = a.in[8];
    const float* k_k = a.in[9]; const float* k_a = a.in[10]; const float* r_k = a.in[11];
    bf16* RR = (bf16*)a.out; bf16* RK = RR + (size_t)NTOK * RW_W; bf16* RV = RK + (size_t)NTOK * RW_W; bf16* RG = RV + (size_t)NTOK * RW_W;
    bf16* RE = (bf16*)(ws + WS_RWE); bf16* RA = (bf16*)(ws + WS_RWA); bf16* RB = (bf16*)(ws + WS_RWB); float* BON = (float*)(ws + WS_BONUS);
    for (int u = bid; u < NTOK / 8; u += G) {
        const int t0 = u * 8;
        __syncthreads();
        for (int i = tid; i < 448 * 8; i += NTHR) { const int j = i >> 3, tt = i & 7, t = t0 + tt; const int col = P_XW + j;
            float v = shiftp(P, t, col, mu[col], (t & (SEQ - 1)) == 0);
            if (j < 96) v = tanhf(v); else if (j >= 192) v = sigmoidf_(v);
            xs[i] = v; }
        __syncthreads();
        float aw[2][8], aa[2][8], ag[2][8];
#pragma unroll
        for (int c = 0; c < 2; ++c)
#pragma unroll
            for (int tt = 0; tt < 8; ++tt) { aw[c][tt] = 0.f; aa[c][tt] = 0.f; ag[c][tt] = 0.f; }
        for (int j = 0; j < 96; ++j) { const float wa = w2[j * RW_W + tid], wb = w2[j * RW_W + tid + 512]; const f32x4 x0 = *(const LAS f32x4*)(xs + j * 8), x1 = *(const LAS f32x4*)(xs + j * 8 + 4);
#pragma unroll
            for (int tt = 0; tt < 4; ++tt) { aw[0][tt] += x0[tt] * wa; aw[1][tt] += x0[tt] * wb; aw[0][4 + tt] += x1[tt] * wa; aw[1][4 + tt] += x1[tt] * wb; } }
        for (int j = 0; j < 96; ++j) { const float wa = a2[j * RW_W + tid], wb = a2[j * RW_W + tid + 512]; const f32x4 x0 = *(const LAS f32x4*)(xs + (96 + j) * 8), x1 = *(const LAS f32x4*)(xs + (96 + j) * 8 + 4);
#pragma unroll
            for (int tt = 0; tt < 4; ++tt) { aa[0][tt] += x0[tt] * wa; aa[1][tt] += x0[tt] * wb; aa[0][4 + tt] += x1[tt] * wa; aa[1][4 + tt] += x1[tt] * wb; } }
        for (int j = 0; j < 256; ++j) { const float wa = g2[j * RW_W + tid], wb = g2[j * RW_W + tid + 512]; const f32x4 x0 = *(const LAS f32x4*)(xs + (192 + j) * 8), x1 = *(const LAS f32x4*)(xs + (192 + j) * 8 + 4);
#pragma unroll
            for (int tt = 0; tt < 4; ++tt) { ag[0][tt] += x0[tt] * wa; ag[1][tt] += x0[tt] * wb; ag[0][4 + tt] += x1[tt] * wa; ag[1][4 + tt] += x1[tt] * wb; } }
#pragma unroll
        for (int c = 0; c < 2; ++c) { const int ch = tid + c * 512; const int head = ch >> 6;
            const float mur = mu[ch], muk = mu[1024 + ch], muv = mu[2048 + ch], w0c = w0[ch], a0c = a0[ch], kkc = k_k[ch], kac = k_a[ch], rkc = r_k[ch];
#pragma unroll
            for (int tt = 0; tt < 8; ++tt) { const int t = t0 + tt; const bool first = (t & (SEQ - 1)) == 0;
                const float r = shiftp(P, t, ch, mur, first), k = shiftp(P, t, 1024 + ch, muk, first), v = shiftp(P, t, 2048 + ch, muv, first);
                const float e = sigmoidf_(w0c + aw[c][tt]) * 0.6065306597126334f;
                const float av = sigmoidf_(a0c + aa[c][tt]);
                float kk = k * kkc; const float ss = wave_sum(kk * kk); kk *= rsqrtf(fmaxf(ss, 1e-24f));
                const float kp = k * (1.0f + (av - 1.0f) * kac);
                const float bs = wave_sum(r * kp * rkc);
                const size_t o = (size_t)t * RW_W + ch;
                RR[o] = (bf16)f2bf(r); RK[o] = (bf16)f2bf(kp); RV[o] = (bf16)f2bf(v); RG[o] = (bf16)f2bf(ag[c][tt]);
                RE[o] = (bf16)f2bf(e); RA[o] = (bf16)f2bf(-kk); RB[o] = (bf16)f2bf(kk * av);
                if (lane == 0) BON[t * RW_H + head] = bs; } }
    }
}

__device__ __forceinline__ void unpack16(const v4u& p0, const v4u& p1, float (&f)[16]) {
    f[0] = bflo(p0.x); f[1] = bfhi(p0.x); f[2] = bflo(p0.y); f[3] = bfhi(p0.y); f[4] = bflo(p0.z); f[5] = bfhi(p0.z); f[6] = bflo(p0.w); f[7] = bfhi(p0.w);
    f[8] = bflo(p1.x); f[9] = bfhi(p1.x); f[10] = bflo(p1.y); f[11] = bfhi(p1.y); f[12] = bflo(p1.z); f[13] = bfhi(p1.z); f[14] = bflo(p1.w); f[15] = bfhi(p1.w);
}
__device__ __forceinline__ void phase_rwrec(const Args& a, int lane, int wave, int bid, int G) {
    if (wave != 0) return;
    unsigned char* ws = a.ws;
    const bf16* RR = (const bf16*)a.out; const bf16* RK = RR + (size_t)NTOK * RW_W; const bf16* RV = RK + (size_t)NTOK * RW_W;
    const bf16* RE = (const bf16*)(ws + WS_RWE); const bf16* RA = (const bf16*)(ws + WS_RWA); const bf16* RB = (const bf16*)(ws + WS_RWB);
    bf16* Y = (bf16*)(ws + WS_OA);
    for (int u = bid; u < 256; u += G) {
        const int b = u >> 6, h = (u >> 2) & 15, sl = u & 3, row = lane >> 2, kq = lane & 3, iv = sl * 16 + row;
        float S[16];
#pragma unroll
        for (int k = 0; k < 16; ++k) S[k] = 0.f;
        size_t base = (size_t)(b * SEQ) * RW_W + h * 64;
        const v4u* pr = (const v4u*)(RR + base + kq * 16); const v4u* pe = (const v4u*)(RE + base + kq * 16); const v4u* pk = (const v4u*)(RK + base + kq * 16);
        const v4u* pa = (const v4u*)(RA + base + kq * 16); const v4u* pb = (const v4u*)(RB + base + kq * 16);
        v4u nr0 = pr[0], nr1 = pr[1], ne0 = pe[0], ne1 = pe[1], nk0 = pk[0], nk1 = pk[1], na0 = pa[0], na1 = pa[1], nb0 = pb[0], nb1 = pb[1];
        unsigned short nv = RV[base + iv];
        for (int t = 0; t < SEQ; ++t) {
            const v4u r0 = nr0, r1 = nr1, e0 = ne0, e1 = ne1, k0 = nk0, k1 = nk1, a0 = na0, a1 = na1, b0 = nb0, b1 = nb1; const float v = bf2f(nv);
            if (t + 1 < SEQ) { const int q = (t + 1) * (RW_W / 8);
                nr0 = pr[q]; nr1 = pr[q + 1]; ne0 = pe[q]; ne1 = pe[q + 1]; nk0 = pk[q]; nk1 = pk[q + 1]; na0 = pa[q]; na1 = pa[q + 1]; nb0 = pb[q]; nb1 = pb[q + 1];
                nv = RV[base + (size_t)(t + 1) * RW_W + iv]; }
            float fr[16], fe[16], fk[16], fa[16], fb[16];
            unpack16(r0, r1, fr); unpack16(e0, e1, fe); unpack16(k0, k1, fk); unpack16(a0, a1, fa); unpack16(b0, b1, fb);
            float sa = 0.f;
#pragma unroll
            for (int k = 0; k < 16; ++k) sa += S[k] * fa[k];
            sa += __shfl_xor(sa, 1); sa += __shfl_xor(sa, 2);
            float y = 0.f;
#pragma unroll
            for (int k = 0; k < 16; ++k) { const float w = __expf(-fe[k]); S[k] = S[k] * w + (sa * fb[k] + v * fk[k]); y += S[k] * fr[k]; }
            y += __shfl_xor(y, 1); y += __shfl_xor(y, 2);
            if (kq == 0) Y[base + (size_t)t * RW_W + iv] = (bf16)f2bf(y);
        }
    }
}

__device__ __forceinline__ void phase_ret(const Args& a, LAS unsigned char* lds, int tid, int bid, int G) {
    unsigned char* ws = a.ws; const bf16* P = (const bf16*)(ws + WS_P); const float2* rot = (const float2*)(ws + WS_ROT); bf16* OB = (bf16*)(ws + WS_OB);
    LAS float* Qs = (LAS float*)lds;
    LAS float* Ks = Qs + 64 * 129;
    LAS float* Vs = Ks + 64 * 129;
    LAS float* Sc = Vs + 64 * 32;
    LAS float* St = Sc + 64 * 65;
    LAS float* gp = St + 128 * 32;
    for (int u = bid; u < 256; u += G) {
        const int b = u >> 6, h = (u >> 3) & 7, vs = u & 7;
        __syncthreads();
        const float lg = log1pf(-exp2f(-5.0f - (float)h));
        if (tid < 65) gp[tid] = expf((float)tid * lg);
        for (int i = tid; i < 128 * 32; i += NTHR) St[i] = 0.f;
        for (int n = 0; n < SEQ / 64; ++n) {
            __syncthreads();
            for (int idx = tid; idx < 64 * 64; idx += NTHR) { const int i = idx >> 6, d = idx & 63, pos = n * 64 + i; const size_t t = (size_t)(b * SEQ + pos);
                const float2 cs = rot[pos * 64 + d];
                const float q1 = bf2f(P[t * NP + P_RQ + h * 128 + d]), q2 = bf2f(P[t * NP + P_RQ + h * 128 + 64 + d]);
                const float k1 = bf2f(P[t * NP + P_RK + h * 128 + d]) * 0.08838834764831845f, k2 = bf2f(P[t * NP + P_RK + h * 128 + 64 + d]) * 0.08838834764831845f;
                Qs[i * 129 + d] = q1 * cs.x - q2 * cs.y; Qs[i * 129 + 64 + d] = q1 * cs.y + q2 * cs.x;
                Ks[i * 129 + d] = k1 * cs.x - k2 * cs.y; Ks[i * 129 + 64 + d] = k1 * cs.y + k2 * cs.x; }
            for (int idx = tid; idx < 64 * 32; idx += NTHR) { const int j = idx >> 5, e = idx & 31; const size_t t = (size_t)(b * SEQ + n * 64 + j);
                Vs[idx] = bf2f(P[t * NP + P_RV + h * 256 + vs * 32 + e]); }
            __syncthreads();
            { const int i = tid >> 3, jb = tid & 7; float s[8];
#pragma unroll
              for (int jj = 0; jj < 8; ++jj) s[jj] = 0.f;
              for (int d = 0; d < 128; ++d) { const float q = Qs[i * 129 + d];
#pragma unroll
                  for (int jj = 0; jj < 8; ++jj) s[jj] += q * Ks[(jb + 8 * jj) * 129 + d]; }
#pragma unroll
              for (int jj = 0; jj < 8; ++jj) { const int j = jb + 8 * jj; const int dist = i > j ? i - j : j - i; Sc[i * 65 + j] = s[jj] * gp[dist]; } }
            __syncthreads();
            { const int e = tid & 31, ib = tid >> 5; float o1[4], o2[4];
#pragma unroll
              for (int ii = 0; ii < 4; ++ii) { o1[ii] = 0.f; o2[ii] = 0.f; }
              for (int j = 0; j < 64; ++j) { const float v = Vs[j * 32 + e];
#pragma unroll
                  for (int ii = 0; ii < 4; ++ii) o1[ii] += Sc[(ib + 16 * ii) * 65 + j] * v; }
              for (int d = 0; d < 128; ++d) { const float s = St[d * 32 + e];
#pragma unroll
                  for (int ii = 0; ii < 4; ++ii) o2[ii] += Qs[(ib + 16 * ii) * 129 + d] * s; }
#pragma unroll
              for (int ii = 0; ii < 4; ++ii) { const int i = ib + 16 * ii; const size_t t = (size_t)(b * SEQ + n * 64 + i);
                  OB[t * RET_VW + h * 256 + vs * 32 + e] = (bf16)f2bf(o1[ii] + gp[i + 1] * o2[ii]); } }
            __syncthreads();
            { const int e = tid & 31, db = tid >> 5; float s[8];
#pragma unroll
              for (int dd = 0; dd < 8; ++dd) s[dd] = 0.f;
              for (int j = 0; j < 64; ++j) { const float v = Vs[j * 32 + e] * gp[63 - j];
#pragma unroll
                  for (int dd = 0; dd < 8; ++dd) s[dd] += Ks[j * 129 + db + 16 * dd] * v; }
#pragma unroll
              for (int dd = 0; dd < 8; ++dd) { const int d = db + 16 * dd; St[d * 32 + e] = St[d * 32 + e] * gp[64] + s[dd]; } }
        }
    }
}

__device__ __forceinline__ void phase_post(const Args& a, int lane, int wave, int bid, int G) {
    unsigned char* ws = a.ws; const bf16* P = (const bf16*)(ws + WS_P);
    const int gw = bid * NWAVES + wave, NGW = G * NWAVES;
    { bf16* Y = (bf16*)(ws + WS_OA); const bf16* RR = (const bf16*)a.out; const bf16* RV = RR + (size_t)2 * NTOK * RW_W; const bf16* RG = RR + (size_t)3 * NTOK * RW_W;
      const float* BON = (const float*)(ws + WS_BONUS); const float* lg = a.in[12]; const float* lb = a.in[13];
      for (int it = gw; it < NTOK * RW_H; it += NGW) { const int t = it >> 4, h = it & 15; const size_t o = (size_t)t * RW_W + h * 64 + lane;
          const float y = bf2f(Y[o]); const float mean = wave_sum(y) * (1.0f / 64.0f); const float dy = y - mean; const float var = wave_sum(dy * dy) * (1.0f / 64.0f);
          float yn = dy * rsqrtf(var + 64e-5f) * lg[h * 64 + lane] + lb[h * 64 + lane];
          yn += BON[it] * bf2f(RV[o]);
          Y[o] = (bf16)f2bf(yn * bf2f(RG[o])); } }
    { bf16* OB = (bf16*)(ws + WS_OB); const float* ng = a.in[14];
      for (int it = gw; it < NTOK * RET_H; it += NGW) { const int t = it >> 3, h = it & 7; const size_t o = (size_t)t * RET_VW + h * 256 + lane * 4;
          const v2u raw = *(const v2u*)(OB + o); const float v0 = bflo(raw.x), v1 = bfhi(raw.x), v2 = bflo(raw.y), v3 = bfhi(raw.y);
          const float rs = rsqrtf(wave_sum((v0 * v0 + v1 * v1) + (v2 * v2 + v3 * v3)) * (1.0f / 256.0f) + 1e-6f);
          const v2u gr = *(const v2u*)(P + (size_t)t * NP + P_RG + h * 256 + lane * 4); const f32x4 g = *(const f32x4*)(ng + h * 256 + lane * 4);
          v2u w; w.x = pk2(v0 * rs * g.x * bflo(gr.x), v1 * rs * g.y * bfhi(gr.x)); w.y = pk2(v2 * rs * g.z * bflo(gr.y), v3 * rs * g.w * bfhi(gr.y));
          *(v2u*)(OB + o) = w; } }
}

__device__ __forceinline__ void phase_router(const Args& a, int lane, int wave, int bid, int G) {
    unsigned char* ws = a.ws; const float* X1 = a.out; bf16* H2 = (bf16*)(ws + WS_H2);
    const float* g2 = a.in[18]; const float* wg = a.in[19]; const float* bg = a.in[20]; const float* we = a.in[21]; const float* be = a.in[22];
    unsigned* ctl = (unsigned*)(ws + WS_CTL); int* TE = (int*)(ws + WS_TOKE); float* TW = (float*)(ws + WS_TOKW); int* TP = (int*)(ws + WS_TOKP);
    const int gw = bid * NWAVES + wave, NGW = G * NWAVES;
    for (int t = gw; t < NTOK; t += NGW) {
        const f32x4* xr = (const f32x4*)(X1 + (size_t)t * DM) + lane; float s = 0.f;
#pragma unroll
        for (int j = 0; j < 8; ++j) { const f32x4 x = xr[64 * j]; s += (x.x * x.x + x.y * x.y) + (x.z * x.z + x.w * x.w); }
        const float rs = rsqrtf(wave_sum(s) * (1.0f / DM) + 1e-6f);
        float lgt[36];
#pragma unroll
        for (int q = 0; q < 36; ++q) lgt[q] = 0.f;
        v2u* o8 = (v2u*)(H2 + (size_t)t * DM) + lane;
#pragma unroll 1
        for (int j = 0; j < 8; ++j) { const f32x4 x = xr[64 * j]; const f32x4 g = ((const f32x4*)g2)[64 * j + lane]; const f32x4 hv = {x.x * rs * g.x, x.y * rs * g.y, x.z * rs * g.z, x.w * rs * g.w};
            v2u o; o.x = pk2(hv.x, hv.y); o.y = pk2(hv.z, hv.w); o8[64 * j] = o;
            const int col = 256 * j + 4 * lane;
#pragma unroll
            for (int c = 0; c < 4; ++c) { const float hc = hv[c]; const f32x4 w4 = *(const f32x4*)(wg + (size_t)(col + c) * 4);
                lgt[0] += hc * w4.x; lgt[1] += hc * w4.y; lgt[2] += hc * w4.z; lgt[3] += hc * w4.w;
#pragma unroll
                for (int q = 0; q < 8; ++q) { const f32x4 e4 = *(const f32x4*)(we + (size_t)(col + c) * 32 + 4 * q);
                    lgt[4 + 4 * q] += hc * e4.x; lgt[5 + 4 * q] += hc * e4.y; lgt[6 + 4 * q] += hc * e4.z; lgt[7 + 4 * q] += hc * e4.w; } }
            asm volatile("" ::: "memory"); }
#pragma unroll
        for (int q = 0; q < 36; ++q) lgt[q] = wave_sum(lgt[q]);
        float gl[4];
#pragma unroll
        for (int q = 0; q < 4; ++q) gl[q] = lgt[q] + bg[q];
        int gs = 0; float gm = gl[0];
#pragma unroll
        for (int q = 1; q < 4; ++q) if (gl[q] > gm) { gm = gl[q]; gs = q; }
        float den = 0.f;
#pragma unroll
        for (int q = 0; q < 4; ++q) den += expf(gl[q] - gm);
        const float gwt = 1.0f / den;
        float el[8];
#pragma unroll
        for (int q = 0; q < 8; ++q) { float x = 0.f;
#pragma unroll
            for (int gq = 0; gq < 4; ++gq) x = (gs == gq) ? lgt[4 + gq * 8 + q] + be[gq * 8 + q] : x;
            el[q] = x; }
        int i0 = 0; float m0 = el[0];
#pragma unroll
        for (int q = 1; q < 8; ++q) if (el[q] > m0) { m0 = el[q]; i0 = q; }
        int i1 = -1; float m1 = -3.0e38f;
#pragma unroll
        for (int q = 0; q < 8; ++q) if (q != i0 && el[q] > m1) { m1 = el[q]; i1 = q; }
        const float e1 = expf(m1 - m0); const float w0 = gwt / (1.0f + e1), w1 = gwt * e1 / (1.0f + e1);
        if (lane == 0) { const int ex0 = gs * 8 + i0, ex1 = gs * 8 + i1;
            const unsigned p0 = __hip_atomic_fetch_add(ctl + CW_CNT + ex0, 1u, RLX_AGENT), p1 = __hip_atomic_fetch_add(ctl + CW_CNT + ex1, 1u, RLX_AGENT);
            TE[2 * t] = ex0; TE[2 * t + 1] = ex1; TW[2 * t] = w0; TW[2 * t + 1] = w1; TP[2 * t] = (int)p0; TP[2 * t + 1] = (int)p1; }
    }
}

__device__ __forceinline__ void phase_gather(const Args& a, LAS unsigned char* lds, int tid, int lane, int wave, int bid, int G) {
    unsigned char* ws = a.ws; unsigned* ctl = (unsigned*)(ws + WS_CTL); const bf16* H2 = (const bf16*)(ws + WS_H2); bf16* XG = (bf16*)(ws + WS_XG);
    const int* TE = (const int*)(ws + WS_TOKE); const int* TP = (const int*)(ws + WS_TOKP); int* TS = (int*)(ws + WS_TOKS);
    LAS int* ps = (LAS int*)lds;
    __syncthreads();
    if (tid == 0) { int acc = 0, nt = 0;
        for (int e = 0; e < NEXP; ++e) { const int c = (int)__hip_atomic_load(ctl + CW_CNT + e, RLX_AGENT); ps[e] = acc; ps[64 + e] = c; const int tl = (c + 255) >> 8;
            if (bid == 0) for (int q = 0; q < tl; ++q) ctl[CW_TE + nt + q] = (unsigned)e;
            nt += tl; acc += tl * 256; }
        ps[32] = acc; if (bid == 0) ctl[CW_NT] = (unsigned)nt; }
    __syncthreads();
    const int gw = bid * NWAVES + wave, NGW = G * NWAVES;
    for (int it = gw; it < NTOK * 2; it += NGW) { const int t = it >> 1; const int e = TE[it]; const int slot = ps[e] + TP[it];
        const v4u* src = (const v4u*)(H2 + (size_t)t * DM) + lane; v4u* dst = (v4u*)(XG + (size_t)slot * DM) + lane;
#pragma unroll
        for (int j = 0; j < 4; ++j) dst[64 * j] = src[64 * j];
        if (lane == 0) TS[it] = slot; }
    for (int e = 0; e < NEXP; ++e) { const int c = ps[64 + e], base = ps[e] + c, npad = ps[e + 1] - base;
        for (int r = gw; r < npad; r += NGW) { v4u* dst = (v4u*)(XG + (size_t)(base + r) * DM) + lane;
#pragma unroll
            for (int j = 0; j < 4; ++j) dst[64 * j] = (v4u){0u, 0u, 0u, 0u}; } }
}

__device__ __forceinline__ void phase_final(const Args& a, int lane, int wave, int bid, int G) {
    unsigned char* ws = a.ws; float* X1 = a.out; const bf16* YS = (const bf16*)(ws + WS_YS); const int* TS = (const int*)(ws + WS_TOKS); const float* TW = (const float*)(ws + WS_TOKW); const float* fg = a.in[26];
    const int gw = bid * NWAVES + wave, NGW = G * NWAVES;
    for (int t = gw; t < NTOK; t += NGW) { const int s0 = TS[2 * t], s1 = TS[2 * t + 1]; const float w0 = TW[2 * t], w1 = TW[2 * t + 1];
        f32x4* xr = (f32x4*)(X1 + (size_t)t * DM) + lane; const v2u* y0 = (const v2u*)(YS + (size_t)s0 * DM) + lane; const v2u* y1 = (const v2u*)(YS + (size_t)s1 * DM) + lane;
        f32x4 v[8]; float s = 0.f;
#pragma unroll
        for (int j = 0; j < 8; ++j) { const f32x4 x = xr[64 * j]; const v2u a0 = y0[64 * j], a1 = y1[64 * j];
            v[j].x = x.x + w0 * bflo(a0.x) + w1 * bflo(a1.x); v[j].y = x.y + w0 * bfhi(a0.x) + w1 * bfhi(a1.x); v[j].z = x.z + w0 * bflo(a0.y) + w1 * bflo(a1.y); v[j].w = x.w + w0 * bfhi(a0.y) + w1 * bfhi(a1.y);
            s += (v[j].x * v[j].x + v[j].y * v[j].y) + (v[j].z * v[j].z + v[j].w * v[j].w); }
        const float rs = rsqrtf(wave_sum(s) * (1.0f / DM) + 1e-6f);
#pragma unroll
        for (int j = 0; j < 8; ++j) { const f32x4 g = ((const f32x4*)fg)[64 * j + lane]; xr[64 * j] = (f32x4){v[j].x * rs * g.x, v[j].y * rs * g.y, v[j].z * rs * g.z, v[j].w * rs * g.w}; } }
}

typedef short bf16x8 __attribute__((ext_vector_type(8)));
__device__ __forceinline__ f32x4 mfma16(bf16x8 xa, bf16x8 yb, f32x4 c) { return __builtin_amdgcn_mfma_f32_16x16x32_bf16(xa, yb, c, 0, 0, 0); }
__device__ __forceinline__ bf16x8 ldfrag(const LAS bf16* img, int ld, int row0, int k0, int lane) { return *(const LAS bf16x8*)(img + (row0 + (lane & 15)) * ld + k0 + (lane >> 4) * 8); }
__device__ __forceinline__ void unpack8(const v4u& p, float (&f)[8]) { f[0] = bflo(p.x); f[1] = bfhi(p.x); f[2] = bflo(p.y); f[3] = bfhi(p.y); f[4] = bflo(p.z); f[5] = bfhi(p.z); f[6] = bflo(p.w); f[7] = bfhi(p.w); }

__device__ __forceinline__ void phase_ret_mfma(const Args& a, LAS unsigned char* lds, int tid, int lane, int wave, int bid, int G) {
    unsigned char* ws = a.ws; const bf16* P = (const bf16*)(ws + WS_P); const float* rot = (const float*)(ws + WS_ROT); bf16* OB = (bf16*)(ws + WS_OB);
    constexpr int LQ = 136, LT = 72;
    LAS bf16* Qs = (LAS bf16*)lds;
    LAS bf16* Ks = Qs + 64 * LQ;
    LAS bf16* KT = Ks + 64 * LQ;
    LAS bf16* VT = KT + 128 * LT;
    LAS bf16* Sc = VT + 32 * LT;
    LAS bf16* ST = Sc + 64 * LT;
    LAS float* gp = (LAS float*)(ST + 32 * LQ);
    const int q4 = lane >> 4, l16 = lane & 15;
    for (int u = bid; u < 256; u += G) {
        const int b = u >> 6, h = (u >> 3) & 7, vs = u & 7;
        __syncthreads();
        const float lg = log1pf(-exp2f(-5.0f - (float)h));
        if (tid < 65) gp[tid] = expf((float)tid * lg);
        for (int i = tid; i < 32 * LQ / 2; i += NTHR) ((LAS unsigned*)ST)[i] = 0u;
        f32x4 st[2] = {{0.f, 0.f, 0.f, 0.f}, {0.f, 0.f, 0.f, 0.f}};
        const int si = tid >> 3, d0 = (tid & 7) * 8, e0 = (tid & 7) * 4;
        const bf16* prow = P + (size_t)(b * SEQ + si) * NP;
        v4u qlo = *(const v4u*)(prow + P_RQ + h * 128 + d0), qhi = *(const v4u*)(prow + P_RQ + h * 128 + 64 + d0);
        v4u klo = *(const v4u*)(prow + P_RK + h * 128 + d0), khi = *(const v4u*)(prow + P_RK + h * 128 + 64 + d0);
        v2u vv = *(const v2u*)(prow + P_RV + h * 256 + vs * 32 + e0);
        f32x4 rt[4];
#pragma unroll
        for (int c = 0; c < 4; ++c) rt[c] = *(const f32x4*)(rot + ((size_t)si * 64 + d0) * 2 + c * 4);
        __syncthreads();
        const float chunk_decay = gp[64];
        for (int n = 0; n < SEQ / 64; ++n) {
            { float ql[8], qh[8], kl[8], kh[8]; unpack8(qlo, ql); unpack8(qhi, qh); unpack8(klo, kl); unpack8(khi, kh);
              float oql[8], oqh[8], okl[8], okh[8]; const float kd = gp[63 - si];
#pragma unroll
              for (int j = 0; j < 8; ++j) { const float c = rt[j >> 1][(j & 1) * 2], s = rt[j >> 1][(j & 1) * 2 + 1];
                  oql[j] = ql[j] * c - qh[j] * s; oqh[j] = ql[j] * s + qh[j] * c;
                  okl[j] = (kl[j] * c - kh[j] * s) * 0.08838834764831845f; okh[j] = (kl[j] * s + kh[j] * c) * 0.08838834764831845f; }
              v4u w; w.x = pk2(oql[0], oql[1]); w.y = pk2(oql[2], oql[3]); w.z = pk2(oql[4], oql[5]); w.w = pk2(oql[6], oql[7]); *(LAS v4u*)(Qs + si * LQ + d0) = w;
              w.x = pk2(oqh[0], oqh[1]); w.y = pk2(oqh[2], oqh[3]); w.z = pk2(oqh[4], oqh[5]); w.w = pk2(oqh[6], oqh[7]); *(LAS v4u*)(Qs + si * LQ + 64 + d0) = w;
              w.x = pk2(okl[0], okl[1]); w.y = pk2(okl[2], okl[3]); w.z = pk2(okl[4], okl[5]); w.w = pk2(okl[6], okl[7]); *(LAS v4u*)(Ks + si * LQ + d0) = w;
              w.x = pk2(okh[0], okh[1]); w.y = pk2(okh[2], okh[3]); w.z = pk2(okh[4], okh[5]); w.w = pk2(okh[6], okh[7]); *(LAS v4u*)(Ks + si * LQ + 64 + d0) = w;
#pragma unroll
              for (int j = 0; j < 8; ++j) { KT[(d0 + j) * LT + si] = (bf16)f2bf(okl[j] * kd); KT[(64 + d0 + j) * LT + si] = (bf16)f2bf(okh[j] * kd); }
              VT[(e0 + 0) * LT + si] = (bf16)(vv.x & 0xffffu); VT[(e0 + 1) * LT + si] = (bf16)(vv.x >> 16); VT[(e0 + 2) * LT + si] = (bf16)(vv.y & 0xffffu); VT[(e0 + 3) * LT + si] = (bf16)(vv.y >> 16); }
            __syncthreads();
            if (n + 1 < SEQ / 64) { const bf16* pr = prow + (size_t)(n + 1) * 64 * NP;
                qlo = *(const v4u*)(pr + P_RQ + h * 128 + d0); qhi = *(const v4u*)(pr + P_RQ + h * 128 + 64 + d0);
                klo = *(const v4u*)(pr + P_RK + h * 128 + d0); khi = *(const v4u*)(pr + P_RK + h * 128 + 64 + d0);
                vv = *(const v2u*)(pr + P_RV + h * 256 + vs * 32 + e0);
#pragma unroll
                for (int c = 0; c < 4; ++c) rt[c] = *(const f32x4*)(rot + ((size_t)((n + 1) * 64 + si) * 64 + d0) * 2 + c * 4); }
            { const int i0 = (wave >> 1) * 16;
#pragma unroll
              for (int jt = 0; jt < 2; ++jt) { const int j0 = ((wave & 1) * 2 + jt) * 16; f32x4 acc = {0.f, 0.f, 0.f, 0.f};
#pragma unroll
                  for (int ks = 0; ks < 4; ++ks) acc = mfma16(ldfrag(Ks, LQ, j0, ks * 32, lane), ldfrag(Qs, LQ, i0, ks * 32, lane), acc);
                  const int i = i0 + l16, jb = j0 + 4 * q4; float sv[4];
#pragma unroll
                  for (int r = 0; r < 4; ++r) { const int j = jb + r; const int dist = i > j ? i - j : j - i; sv[r] = acc[r] * gp[dist]; }
                  v2u w; w.x = pk2(sv[0], sv[1]); w.y = pk2(sv[2], sv[3]); *(LAS v2u*)(Sc + i * LT + jb) = w; } }
            const int oi0 = (wave >> 1) * 16, oe0 = (wave & 1) * 16;
            f32x4 ointer = {0.f, 0.f, 0.f, 0.f};
#pragma unroll
            for (int ks = 0; ks < 4; ++ks) ointer = mfma16(ldfrag(ST, LQ, oe0, ks * 32, lane), ldfrag(Qs, LQ, oi0, ks * 32, lane), ointer);
#pragma unroll
            for (int et = 0; et < 2; ++et) { f32x4 acc = st[et] * chunk_decay;
#pragma unroll
                for (int ks = 0; ks < 2; ++ks) acc = mfma16(ldfrag(KT, LT, wave * 16, ks * 32, lane), ldfrag(VT, LT, et * 16, ks * 32, lane), acc);
                st[et] = acc; }
            __syncthreads();
            { f32x4 ointra = {0.f, 0.f, 0.f, 0.f};
#pragma unroll
              for (int ks = 0; ks < 2; ++ks) ointra = mfma16(ldfrag(VT, LT, oe0, ks * 32, lane), ldfrag(Sc, LT, oi0, ks * 32, lane), ointra);
              const int i = oi0 + l16; const float qd = gp[i + 1];
              v2u w; w.x = pk2(ointra[0] + qd * ointer[0], ointra[1] + qd * ointer[1]); w.y = pk2(ointra[2] + qd * ointer[2], ointra[3] + qd * ointer[3]);
              *(v2u*)(OB + (size_t)(b * SEQ + n * 64 + i) * RET_VW + h * 256 + vs * 32 + oe0 + 4 * q4) = w; }
#pragma unroll
            for (int et = 0; et < 2; ++et) { v2u w; w.x = pk2(st[et][0], st[et][1]); w.y = pk2(st[et][2], st[et][3]); *(LAS v2u*)(ST + (et * 16 + l16) * LQ + wave * 16 + 4 * q4) = w; }
            __syncthreads();
        }
    }
}

constexpr int NPHASE = 14;
__global__ void __launch_bounds__(NTHR, 2) mega_fwd(Args args) {
    extern __shared__ __attribute__((aligned(16))) unsigned char lds_raw[];
    LAS unsigned char* lds = (LAS unsigned char*)lds_raw;
    const int tid = threadIdx.x, lane = tid & 63, wave = __builtin_amdgcn_readfirstlane(tid >> 6), bid = blockIdx.x, G = gridDim.x;
    unsigned char* ws = args.ws; unsigned* ctl = (unsigned*)(ws + WS_CTL);
    volatile LAS unsigned* MISC = (volatile LAS unsigned*)(lds + MISC_OFF);
    for (int u = tid; u < (LDS_BYTES - RING_BYTES) / 4; u += NTHR) ((LAS unsigned*)(lds + RING_BYTES))[u] = 0u;
    __syncthreads();
    const int lo = args.ph_lo, hi = args.ph_hi;
    const bool multi = (hi - lo) > 1;
    XcdBarrier bar; bar.bar = ctl + CW_BAR; bar.x = 0; bar.st = nullptr;
    if (multi) bar = xcd_barrier_post(ctl + CW_BAR, MISC + 8);
#ifndef PH_MASK
#define PH_MASK 0x3fff
#endif
#define IN(k) (((PH_MASK >> (k)) & 1) && lo <= (k) && (k) < hi)
#define SEAM(k) do { if (IN(k) && IN((k) + 1)) xcd_barrier(bar); } while (0)
    bf16* P = (bf16*)(ws + WS_P);

    if (IN(0)) { phase_prologue(args, lds, tid, lane, wave, bid, G); } SEAM(0);
    if (IN(1)) { pg8::Gemm g{(const bf16*)(ws + WS_H1), (const bf16*)(ws + WS_WIN), NTOK, NP, DM}; pg8::StaticOrder S; S.init(NTOK, NP, G, bid);
        EpiP E{P}; pg8::gemm_phase<EpiP, pg8::StaticOrder, true, true>(lds, g, S, E); } SEAM(1);
    if (IN(2)) { phase_rwprep(args, lds, tid, lane, wave, bid, G); } SEAM(2);
    if (IN(3)) { phase_ret_mfma(args, lds, tid, lane, wave, bid, G); } SEAM(3);
    if (IN(4)) { phase_rwrec(args, lane, wave, bid, G); } SEAM(4);
    if (IN(5)) { phase_post(args, lane, wave, bid, G); } SEAM(5);
    if (IN(6)) { pg8::Gemm g{(const bf16*)(ws + WS_OA), (const bf16*)(ws + WS_WUPA), NTOK, DM, 1024}; pg8::StaticOrder S; S.init(NTOK, DM, G, bid);
        EpiUp<0> E{(bf16*)(ws + WS_MERGED), P}; pg8::gemm_phase<EpiUp<0>, pg8::StaticOrder, false, true>(lds, g, S, E); } SEAM(6);
    if (IN(7)) { pg8::Gemm g{(const bf16*)(ws + WS_OB), (const bf16*)(ws + WS_WUPB), NTOK, DM, DM}; pg8::StaticOrder S; S.init(NTOK, DM, G, bid);
        EpiUp<1> E{(bf16*)(ws + WS_MERGED), P}; pg8::gemm_phase<EpiUp<1>, pg8::StaticOrder, false, true>(lds, g, S, E); } SEAM(7);
    if (IN(8)) { pg8::Gemm g{(const bf16*)(ws + WS_MERGED), (const bf16*)(ws + WS_WOUT), NTOK, DM, DM}; pg8::StaticOrder S; S.init(NTOK, DM, G, bid);
        EpiX1 E{args.in[0], args.out}; pg8::gemm_phase<EpiX1, pg8::StaticOrder, false, true>(lds, g, S, E); } SEAM(8);
    if (IN(9)) { phase_router(args, lane, wave, bid, G); } SEAM(9);
    if (IN(10)) { phase_gather(args, lds, tid, lane, wave, bid, G); } SEAM(10);
    if (IN(11)) { pg8::Gemm g{(const bf16*)(ws + WS_XG), (const bf16*)(ws + WS_WGU), MAXSLOT, NEXP * 1024, DM}; MoeOrder<4> S; S.init(ctl, G, bid);
        EpiGU E{(bf16*)(ws + WS_ACT)}; pg8::gemm_phase<EpiGU, MoeOrder<4>, true, true>(lds, g, S, E); } SEAM(11);
    if (IN(12)) { pg8::Gemm g{(const bf16*)(ws + WS_ACT), (const bf16*)(ws + WS_WDN), MAXSLOT, NEXP * 2048, EFF}; MoeOrder<8> S; S.init(ctl, G, bid);
        EpiDn E{(bf16*)(ws + WS_YS)}; pg8::gemm_phase<EpiDn, MoeOrder<8>, true, true>(lds, g, S, E); } SEAM(12);
    if (IN(13)) { phase_final(args, lane, wave, bid, G); }
#undef IN
#undef SEAM
}

#ifndef MK_ONE_LAUNCH
#define MK_ONE_LAUNCH 1
#endif
extern "C" void kernel_launch(void* const* d_in, const int* in_sizes, int n_in, void* d_out, int out_size, void* d_ws, size_t ws_size, hipStream_t stream) {
    static int grid = 0;
    if (grid == 0) {
        if (n_in != 27 || out_size != NTOK * DM || ws_size < WS_END) { fprintf(stderr, "kernel_launch: unexpected shapes (n_in %d out %d ws %zu, need %zu)\n", n_in, out_size, ws_size, (size_t)WS_END); grid = -1; return; }
        int dev = 0, cus = 0, per_cu = 0;
        if (hipGetDevice(&dev) != hipSuccess || hipDeviceGetAttribute(&cus, hipDeviceAttributeMultiprocessorCount, dev) != hipSuccess) { grid = -1; return; }
        if (hipFuncSetAttribute((const void*)mega_fwd, hipFuncAttributeMaxDynamicSharedMemorySize, LDS_BYTES) != hipSuccess) { fprintf(stderr, "kernel_launch: hipFuncSetAttribute failed\n"); grid = -1; return; }
        if (hipOccupancyMaxActiveBlocksPerMultiprocessor(&per_cu, (const void*)mega_fwd, NTHR, LDS_BYTES) != hipSuccess || per_cu < 1) { fprintf(stderr, "kernel_launch: occupancy query says %d\n", per_cu); grid = -1; (void)hipGetLastError(); return; }
        grid = cus;
    }
    if (grid < 0) return;
    (void)in_sizes;
    if (hipMemsetAsync((char*)d_ws + WS_CTL, 0, CTL_ZERO_BYTES, stream) != hipSuccess) return;
    Args a{};
    for (int i = 0; i < 27; ++i) a.in[i] = (const float*)d_in[i];
    a.out = (float*)d_out; a.ws = (unsigned char*)d_ws;
#if MK_ONE_LAUNCH
    a.ph_lo = 0; a.ph_hi = NPHASE;
    hipLaunchKernelGGL(mega_fwd, dim3(grid), dim3(NTHR), LDS_BYTES, stream, a);
#else
    for (int p = 0; p < NPHASE; ++p) { a.ph_lo = p; a.ph_hi = p + 1; hipLaunchKernelGGL(mega_fwd, dim3(grid), dim3(NTHR), LDS_BYTES, stream, a); }
#endif
}
```

```cpp
#include <hip/hip_runtime.h>
#include <cstdio>
#include <cstdint>
namespace pg8 {
#define PG8_LAS __attribute__((address_space(3)))
typedef unsigned short bf16_t;
typedef short bf16x8 __attribute__((ext_vector_type(8)));
typedef float f32x4 __attribute__((ext_vector_type(4)));
typedef unsigned u32x4 __attribute__((ext_vector_type(4)));
constexpr int BM = 256, BK = 64, HALF = 128, HTB = HALF * BK * 2  , STAGE_BYTES = 8 * HTB, NXCD = 8, WGM = 8;

__host__ __device__ __forceinline__ int lds_byte(int r, int c) { const int st = (r >> 4) * 2 + (c >> 5), rr = r & 15, cc = c & 31, ob = rr * 64 + cc * 2; return st * 1024 + (ob ^ (((ob >> 9) & 1) << 5)); }
__host__ __device__ __forceinline__ void stage_rc(int b, int& R, int& C) { const int st = b / 1024, sb = b % 1024, swz = sb ^ (((sb >> 9) & 1) << 5); R = (st >> 1) * 16 + swz / 64; C = (st & 1) * 32 + (swz % 64) / 2; }
__host__ __device__ __forceinline__ int perm32(int rho) { const int n = rho >> 4, i = rho & 15; return 8 * (i >> 2) + 4 * n + (i & 3); }

struct Unit { int pm, pn; };
struct Gemm { const bf16_t* A; const bf16_t* Bt; int M, N, K; };

struct StaticOrder {
    int nM, nN, nwg, G, c;
    __host__ __device__ void init(int M, int N, int G_, int c_) { nM = M / BM; nN = N / BM; nwg = nM * nN; G = G_; c = c_; }
    __host__ __device__ bool next(int i, Unit& u) const {
        const long L = (long)i * G + c; if (L >= nwg) return false;
        int wgid = (int)L; { const int q = nwg / NXCD, r = nwg % NXCD, xcd = wgid % NXCD, off = wgid / NXCD; wgid = (xcd < r ? xcd * (q + 1) : r * (q + 1) + (xcd - r) * q) + off; }
        const int nig = WGM * nN, gid = wgid / nig, fm = gid * WGM, gsz = (nM - fm) < WGM ? (nM - fm) : WGM;
        u.pm = fm + ((wgid % nig) % gsz); u.pn = (wgid % nig) / gsz; return true;
    }
    __device__ __forceinline__ void a_ready(const Unit&) const {}
    __device__ __forceinline__ void done(const Unit&) const {}
};

__device__ __forceinline__ unsigned cvt_pk_bf16(float lo, float hi) { unsigned r; asm volatile("v_cvt_pk_bf16_f32 %0, %1, %2" : "=v"(r) : "v"(lo), "v"(hi)); return r; }
typedef float f32x2 __attribute__((ext_vector_type(2)));
template <class Epi, class Sched, bool ALIGN_EPI = false, bool SP2 = false>
__device__ __forceinline__ void gemm_phase(PG8_LAS unsigned char* lds, const Gemm g, const Sched& S, const Epi& E) {
    const int tid = threadIdx.x, wid = __builtin_amdgcn_readfirstlane(tid >> 6), lane = tid & 63, wr = wid >> 2, wc = wid & 3, fr = lane & 15, fq = lane >> 4;
    const int K = g.K, nt = K / BK;
    unsigned voffA[2], voffB[2];
#pragma unroll
    for (int i = 0; i < 2; ++i) { int R, C; stage_rc(tid * 16 + i * 8192, R, C); const int Rb = Epi::PERM ? ((R & ~31) + perm32(R & 31)) : R;
        voffA[i] = (unsigned)(R * K + C) * 2u; voffB[i] = (unsigned)(Rb * K + C) * 2u; }
    const size_t kstep = (size_t)(BK * 2);
    const size_t hstep = (size_t)HALF * K * 2;
    const size_t tstep = 2 * hstep;
    const unsigned ldsw = (unsigned)wid * 1024u;
    const int aoff = lds_byte(wr * 64 + fr, fq * 8), boff = lds_byte(wc * 32 + fr, fq * 8);
#define PG8_SA(b, h) (((b) * 2 + (h)) * HTB)
#define PG8_SB(b, h) ((4 + (b) * 2 + (h)) * HTB)
#define PG8_STAGE(bufoff, gbase, voff) do { _Pragma("unroll") for (int _i = 0; _i < 2; ++_i) \
        __builtin_amdgcn_global_load_lds((const unsigned*)((const char*)(gbase) + (voff)[_i]), (PG8_LAS unsigned*)(lds + (bufoff) + ldsw + _i * 8192), 16, 0, 0); } while (0)
#define PG8_LDA(dst, b, h) do { _Pragma("unroll") for (int m = 0; m < 4; ++m) _Pragma("unroll") for (int k = 0; k < 2; ++k) dst[m][k] = *(const PG8_LAS bf16x8*)(lds + PG8_SA(b, h) + aoff + m * 2048 + k * 1024); } while (0)
#define PG8_LDB(dst, b, h) do { _Pragma("unroll") for (int n = 0; n < 2; ++n) _Pragma("unroll") for (int k = 0; k < 2; ++k) dst[n][k] = *(const PG8_LAS bf16x8*)(lds + PG8_SB(b, h) + boff + n * 2048 + k * 1024); } while (0)
#define PG8_MMA(ai, bj, At, Bt) do { __builtin_amdgcn_s_setprio(1); _Pragma("unroll") for (int m = 0; m < 4; ++m) _Pragma("unroll") for (int n = 0; n < 2; ++n) _Pragma("unroll") for (int k = 0; k < 2; ++k) \
        acc[ai][bj][m][n] = __builtin_amdgcn_mfma_f32_16x16x32_bf16(Bt[n][k], At[m][k], acc[ai][bj][m][n], 0, 0, 0); __builtin_amdgcn_s_setprio(0); } while (0)
#define PG8_WAIT_V(n) asm volatile("s_waitcnt vmcnt(" #n ")" ::: "memory")
#define PG8_WAIT_L(n) asm volatile("s_waitcnt lgkmcnt(" #n ")" ::: "memory")
#define PG8_BAR __builtin_amdgcn_s_barrier()
#define PG8_SCHED __builtin_amdgcn_sched_barrier(0)
    Unit cur, nxt; int ui = 0;
    if (!S.next(0, cur)) return;
    f32x4 acc[2][2][4][2];
#pragma unroll
    for (int a = 0; a < 2; ++a)
#pragma unroll
        for (int b = 0; b < 2; ++b)
#pragma unroll
            for (int m = 0; m < 4; ++m)
#pragma unroll
                for (int n = 0; n < 2; ++n) acc[a][b][m][n] = (f32x4){0.f, 0.f, 0.f, 0.f};
    bf16x8 At[4][2], B0[2][2], B1[2][2];
    const char* cA = (const char*)g.A + (size_t)cur.pm * tstep; const char* cB = (const char*)g.Bt + (size_t)cur.pn * tstep;
    S.a_ready(cur);
    if constexpr (SP2) {
        PG8_STAGE(PG8_SB(0, 0), cB, voffB); PG8_STAGE(PG8_SB(0, 1), cB + hstep, voffB); PG8_STAGE(PG8_SA(0, 0), cA, voffA); PG8_STAGE(PG8_SA(0, 1), cA + hstep, voffA);
        if (wr == 1) PG8_BAR;
        PG8_WAIT_V(2); PG8_BAR;
        PG8_STAGE(PG8_SB(1, 0), cB + kstep, voffB); PG8_STAGE(PG8_SA(1, 0), cA + kstep, voffA); PG8_STAGE(PG8_SB(1, 1), cB + hstep + kstep, voffB);
        PG8_WAIT_V(6); PG8_BAR;
    } else {
        PG8_STAGE(PG8_SB(0, 0), cB, voffB); PG8_STAGE(PG8_SA(0, 0), cA, voffA); PG8_STAGE(PG8_SB(0, 1), cB + hstep, voffB); PG8_STAGE(PG8_SA(0, 1), cA + hstep, voffA);
        if (wr == 1) PG8_BAR;
        PG8_WAIT_V(4); PG8_BAR;
        PG8_STAGE(PG8_SB(1, 0), cB + kstep, voffB); PG8_STAGE(PG8_SA(1, 0), cA + kstep, voffA); PG8_STAGE(PG8_SB(1, 1), cB + hstep + kstep, voffB);
        PG8_WAIT_V(6); PG8_BAR;
    }
    for (;;) {
        const bool has_next = S.next(ui + 1, nxt);
        const char* nA = has_next ? (const char*)g.A + (size_t)nxt.pm * tstep : cA; const char* nB = has_next ? (const char*)g.Bt + (size_t)nxt.pn * tstep : cB;
        for (int t = 0; t < nt; t += 2) {
            const bool last = (t == nt - 2);
            const char* a1 = cA + (size_t)(t + 1) * kstep;
            const char* a2 = last ? nA : cA + (size_t)(t + 2) * kstep; const char* b2 = last ? nB : cB + (size_t)(t + 2) * kstep;
            const char* a3 = a2 + kstep; const char* b3 = b2 + kstep;
            if (last && has_next) S.a_ready(nxt);
            if constexpr (SP2) {
            PG8_LDB(B0, 0, 0); PG8_LDB(B1, 0, 1); PG8_SCHED; PG8_LDA(At, 0, 0); PG8_STAGE(PG8_SA(1, 1), a1 + hstep, voffA);
            PG8_WAIT_V(8); PG8_WAIT_L(0); PG8_BAR; PG8_MMA(0, 0, At, B0); PG8_MMA(0, 1, At, B1); PG8_BAR; PG8_SCHED;
            PG8_LDA(At, 0, 1); PG8_STAGE(PG8_SB(0, 0), b2, voffB); PG8_STAGE(PG8_SB(0, 1), b2 + hstep, voffB); PG8_STAGE(PG8_SA(0, 0), a2, voffA);
            PG8_WAIT_V(8); PG8_WAIT_L(0); PG8_BAR; PG8_MMA(1, 0, At, B0); PG8_MMA(1, 1, At, B1); PG8_BAR; PG8_SCHED;
            PG8_LDB(B0, 1, 0); PG8_LDB(B1, 1, 1); PG8_SCHED; PG8_LDA(At, 1, 0); PG8_STAGE(PG8_SA(0, 1), a2 + hstep, voffA);
            PG8_WAIT_V(8); PG8_WAIT_L(0); PG8_BAR; PG8_MMA(0, 0, At, B0); PG8_MMA(0, 1, At, B1); PG8_BAR; PG8_SCHED;
            PG8_LDA(At, 1, 1); PG8_STAGE(PG8_SB(1, 0), b3, voffB); PG8_STAGE(PG8_SB(1, 1), b3 + hstep, voffB); PG8_STAGE(PG8_SA(1, 0), a3, voffA);
            PG8_WAIT_V(8); PG8_WAIT_L(0); PG8_BAR; PG8_MMA(1, 0, At, B0); PG8_MMA(1, 1, At, B1); PG8_BAR; PG8_SCHED;
            } else {
            PG8_LDB(B0, 0, 0); PG8_SCHED; PG8_LDA(At, 0, 0); PG8_STAGE(PG8_SA(1, 1), a1 + hstep, voffA);
            PG8_WAIT_L(8); PG8_BAR; PG8_WAIT_L(0); PG8_MMA(0, 0, At, B0); PG8_BAR; PG8_SCHED;
            PG8_LDB(B1, 0, 1); PG8_STAGE(PG8_SB(0, 0), b2, voffB);
            PG8_BAR; PG8_WAIT_L(0); PG8_MMA(0, 1, At, B1); PG8_BAR;
            PG8_LDA(At, 0, 1); PG8_STAGE(PG8_SA(0, 0), a2, voffA);
            PG8_BAR; PG8_WAIT_L(0); PG8_MMA(1, 0, At, B0); PG8_BAR; PG8_SCHED;
            PG8_STAGE(PG8_SB(0, 1), b2 + hstep, voffB);
            PG8_WAIT_V(6); PG8_BAR; PG8_MMA(1, 1, At, B1); PG8_BAR;
            PG8_LDB(B0, 1, 0); PG8_SCHED; PG8_LDA(At, 1, 0); PG8_STAGE(PG8_SA(0, 1), a2 + hstep, voffA);
            PG8_WAIT_L(8); PG8_BAR; PG8_WAIT_L(0); PG8_MMA(0, 0, At, B0); PG8_BAR; PG8_SCHED;
            PG8_LDB(B1, 1, 1); PG8_STAGE(PG8_SB(1, 0), b3, voffB);
            PG8_BAR; PG8_WAIT_L(0); PG8_MMA(0, 1, At, B1); PG8_BAR;
            PG8_LDA(At, 1, 1); PG8_STAGE(PG8_SA(1, 0), a3, voffA);
            PG8_BAR; PG8_WAIT_L(0); PG8_MMA(1, 0, At, B0); PG8_BAR; PG8_SCHED;
            PG8_STAGE(PG8_SB(1, 1), b3 + hstep, voffB);
            PG8_WAIT_V(6); PG8_BAR; PG8_MMA(1, 1, At, B1); PG8_BAR;
            }
        }
        if constexpr (ALIGN_EPI) { if (wr == 0) PG8_BAR; }
        if constexpr (!Epi::AFTER_DRAIN) { E(acc, cur, wr, wc, fr, fq); S.done(cur); }
        if (!has_next) break;
#pragma unroll
        for (int a = 0; a < 2; ++a)
#pragma unroll
            for (int b = 0; b < 2; ++b)
#pragma unroll
                for (int m = 0; m < 4; ++m)
#pragma unroll
                    for (int n = 0; n < 2; ++n) acc[a][b][m][n] = (f32x4){0.f, 0.f, 0.f, 0.f};
        cur = nxt; cA = nA; cB = nB; ++ui;
        if constexpr (ALIGN_EPI) { if (wr == 1) PG8_BAR; }
    }
    PG8_WAIT_V(0);
    if constexpr (!ALIGN_EPI) { if (wr == 0) PG8_BAR; }
    PG8_BAR;
    if constexpr (Epi::AFTER_DRAIN) { E.fused(acc, cur, wr, wc, fr, fq, lds, wid, lane); S.done(cur); }
#undef PG8_SA
#undef PG8_SB
#undef PG8_STAGE
#undef PG8_LDA
#undef PG8_LDB
#undef PG8_MMA
#undef PG8_WAIT_V
#undef PG8_WAIT_L
#undef PG8_BAR
#undef PG8_SCHED
}
}

#define GAS __attribute__((address_space(1)))
#define LAS __attribute__((address_space(3)))
typedef unsigned short bf16;
typedef unsigned v4u __attribute__((ext_vector_type(4)));
typedef unsigned v2u __attribute__((ext_vector_type(2)));
typedef float f32x4 __attribute__((ext_vector_type(4)));
typedef GAS unsigned gu32;
#define RLX_AGENT __ATOMIC_RELAXED, __HIP_MEMORY_SCOPE_AGENT
#define LDS_WAIT() asm volatile("s_waitcnt lgkmcnt(0)" ::: "memory")
#define VM_WAIT() asm volatile("s_waitcnt vmcnt(0)" ::: "memory")

constexpr int NTOK = 8192, SEQ = 2048, DM = 2048, NP = 13824, NWAVES = 8, NTHR = 512;
constexpr int RW_W = 1024, RW_H = 16, RW_N = 64;
constexpr int P_XW = 3072, P_XA = 3168, P_XG = 3264;
constexpr int P_RQ = 3584, P_RK = 4608, P_RV = 5632, P_RG = 7680, P_GA = 9728, P_GB = 11776;
constexpr int RET_H = 8, RET_DK = 128, RET_DV = 256, RET_VW = 2048;
constexpr int NEXP = 32, EFF = 512, MAXT = 96, MAXSLOT = MAXT * 256;

constexpr size_t MiB = 1u << 20;
constexpr size_t WS_CTL = 0, CTL_ZERO_BYTES = 256 * 1024;
constexpr size_t WS_ROT = 1 * MiB;
constexpr size_t WS_TOKE = 2 * MiB;
constexpr size_t WS_TOKW = WS_TOKE + 65536;
constexpr size_t WS_TOKP = WS_TOKW + 65536;
constexpr size_t WS_TOKS = WS_TOKP + 65536;
constexpr size_t WS_BONUS = WS_TOKS + 65536;
constexpr size_t WS_WUPA = 3 * MiB, WS_WUPB = 7 * MiB, WS_WOUT = 15 * MiB;
constexpr size_t WS_WGU = 23 * MiB, WS_WDN = 151 * MiB;
constexpr size_t WS_P = 215 * MiB;
constexpr size_t WS_RA = 431 * MiB;
constexpr size_t WS_WIN = WS_RA, WS_H1 = WS_RA + 54 * MiB;
constexpr size_t WS_OA = WS_RA, WS_OB = WS_RA + 16 * MiB;
constexpr size_t WS_RB = 517 * MiB;
constexpr size_t WS_RWE = WS_RB, WS_RWA = WS_RB + 16 * MiB, WS_RWB = WS_RB + 32 * MiB, WS_MERGED = WS_RB;
constexpr size_t WS_END = 565 * MiB;
constexpr size_t WS_H2 = WS_P, WS_XG = WS_P + 32 * MiB, WS_YS = WS_XG, WS_ACT = WS_XG + 96 * MiB;
constexpr int CW_BAR = 1024;
constexpr int CW_CNT = 8192;
constexpr int CW_NT = 8256;
constexpr int CW_TE = 8320;
constexpr int CW_PS = 8448;

constexpr int RING_BYTES = 131072, MISC_OFF = RING_BYTES + 320, LDS_BYTES = 147456;

struct Args { const float* in[27]; float* out; unsigned char* ws; int ph_lo, ph_hi; };

__device__ __forceinline__ float bf2f(unsigned short b) { return __uint_as_float(((unsigned)b) << 16); }
__device__ __forceinline__ float bflo(unsigned u) { return __uint_as_float(u << 16); }
__device__ __forceinline__ float bfhi(unsigned u) { return __uint_as_float(u & 0xffff0000u); }
__device__ __forceinline__ unsigned f2bf(float f) { unsigned u = __float_as_uint(f); return (u + 0x7fffu + ((u >> 16) & 1u)) >> 16; }
__device__ __forceinline__ unsigned pk2(float lo, float hi) { return f2bf(lo) | (f2bf(hi) << 16); }
__device__ __forceinline__ float sigmoidf_(float x) { return 1.0f / (1.0f + __expf(-x)); }
__device__ __forceinline__ float wave_sum(float v) {
#pragma unroll
    for (int o = 1; o < 64; o <<= 1) v += __shfl_xor(v, o);
    return v;
}

struct EpiP {
    static constexpr bool PERM = true, AFTER_DRAIN = false;
    bf16* O;
    __device__ __forceinline__ void operator()(const pg8::f32x4 (&acc)[2][2][4][2], const pg8::Unit& u, int wr, int wc, int fr, int fq) const {
        const int row0 = u.pm * 256 + wr * 64 + fr, col0 = u.pn * 256 + wc * 32 + 8 * fq;
        const int mode = u.pn >= 38 ? 2 : (u.pn >= 30 ? 1 : 0);
#pragma unroll
        for (int ai = 0; ai < 2; ++ai)
#pragma unroll
            for (int m = 0; m < 4; ++m) { bf16* rowp = O + (size_t)(row0 + ai * 128 + m * 16) * NP + col0;
#pragma unroll
                for (int bj = 0; bj < 2; ++bj) { pg8::f32x4 v0 = acc[ai][bj][m][0], v1 = acc[ai][bj][m][1];
                    if (mode) {
#pragma unroll
                        for (int j = 0; j < 4; ++j) { const float s0 = sigmoidf_(v0[j]), s1 = sigmoidf_(v1[j]); v0[j] = mode == 2 ? s0 : v0[j] * s0; v1[j] = mode == 2 ? s1 : v1[j] * s1; } }
                    pg8::u32x4 w; w.x = pg8::cvt_pk_bf16(v0[0], v0[1]); w.y = pg8::cvt_pk_bf16(v0[2], v0[3]); w.z = pg8::cvt_pk_bf16(v1[0], v1[1]); w.w = pg8::cvt_pk_bf16(v1[2], v1[3]);
                    *(pg8::u32x4*)(rowp + bj * 128) = w; } }
    }
};
template <int MODE> struct EpiUp {
    static constexpr bool PERM = true, AFTER_DRAIN = false;
    bf16* O; const bf16* P;
    __device__ __forceinline__ void operator()(const pg8::f32x4 (&acc)[2][2][4][2], const pg8::Unit& u, int wr, int wc, int fr, int fq) const {
        const int row0 = u.pm * 256 + wr * 64 + fr, col0 = u.pn * 256 + wc * 32 + 8 * fq;
#pragma unroll
        for (int ai = 0; ai < 2; ++ai)
#pragma unroll
            for (int m = 0; m < 4; ++m) { const int row = row0 + ai * 128 + m * 16; bf16* rowp = O + (size_t)row * DM + col0; const bf16* gp = P + (size_t)row * NP + (MODE ? P_GB : P_GA) + col0;
#pragma unroll
                for (int bj = 0; bj < 2; ++bj) { const pg8::f32x4 v0 = acc[ai][bj][m][0], v1 = acc[ai][bj][m][1];
                    const pg8::u32x4 g = *(const pg8::u32x4*)(gp + bj * 128);
                    float o[8] = { v0[0] * bflo(g.x), v0[1] * bfhi(g.x), v0[2] * bflo(g.y), v0[3] * bfhi(g.y), v1[0] * bflo(g.z), v1[1] * bfhi(g.z), v1[2] * bflo(g.w), v1[3] * bfhi(g.w) };
                    if (MODE) { const pg8::u32x4 p = *(const pg8::u32x4*)(rowp + bj * 128);
                        o[0] += bflo(p.x); o[1] += bfhi(p.x); o[2] += bflo(p.y); o[3] += bfhi(p.y); o[4] += bflo(p.z); o[5] += bfhi(p.z); o[6] += bflo(p.w); o[7] += bfhi(p.w); }
                    pg8::u32x4 w; w.x = pg8::cvt_pk_bf16(o[0], o[1]); w.y = pg8::cvt_pk_bf16(o[2], o[3]); w.z = pg8::cvt_pk_bf16(o[4], o[5]); w.w = pg8::cvt_pk_bf16(o[6], o[7]);
                    *(pg8::u32x4*)(rowp + bj * 128) = w; } }
    }
};
struct EpiX1 {
    static constexpr bool PERM = false, AFTER_DRAIN = false;
    const float* X; float* O;
    __device__ __forceinline__ void operator()(const pg8::f32x4 (&acc)[2][2][4][2], const pg8::Unit& u, int wr, int wc, int fr, int fq) const {
        const int row0 = u.pm * 256 + wr * 64 + fr, col0 = u.pn * 256 + wc * 32 + 4 * fq;
#pragma unroll
        for (int ai = 0; ai < 2; ++ai)
#pragma unroll
            for (int m = 0; m < 4; ++m) { const size_t off = (size_t)(row0 + ai * 128 + m * 16) * DM + col0;
#pragma unroll
                for (int bj = 0; bj < 2; ++bj)
#pragma unroll
                    for (int n = 0; n < 2; ++n) { const pg8::f32x4 xv = *(const pg8::f32x4*)(X + off + bj * 128 + n * 16); *(pg8::f32x4*)(O + off + bj * 128 + n * 16) = xv + acc[ai][bj][m][n]; } }
    }
};
struct EpiGU {
    static constexpr bool PERM = true, AFTER_DRAIN = false;
    bf16* O;
    __device__ __forceinline__ void operator()(const pg8::f32x4 (&acc)[2][2][4][2], const pg8::Unit& u, int wr, int wc, int fr, int fq) const {
        const int row0 = u.pm * 256 + wr * 64 + fr, col0 = (u.pn & 3) * 128 + wc * 32 + 8 * fq;
#pragma unroll
        for (int ai = 0; ai < 2; ++ai)
#pragma unroll
            for (int m = 0; m < 4; ++m) { bf16* rowp = O + (size_t)(row0 + ai * 128 + m * 16) * EFF + col0;
                const pg8::f32x4 g0 = acc[ai][0][m][0], g1 = acc[ai][0][m][1], u0 = acc[ai][1][m][0], u1 = acc[ai][1][m][1];
                float o[8];
#pragma unroll
                for (int j = 0; j < 4; ++j) { o[j] = g0[j] * sigmoidf_(g0[j]) * u0[j]; o[4 + j] = g1[j] * sigmoidf_(g1[j]) * u1[j]; }
                pg8::u32x4 w; w.x = pg8::cvt_pk_bf16(o[0], o[1]); w.y = pg8::cvt_pk_bf16(o[2], o[3]); w.z = pg8::cvt_pk_bf16(o[4], o[5]); w.w = pg8::cvt_pk_bf16(o[6], o[7]);
                *(pg8::u32x4*)rowp = w; }
    }
};
struct EpiDn {
    static constexpr bool PERM = true, AFTER_DRAIN = false;
    bf16* O;
    __device__ __forceinline__ void operator()(const pg8::f32x4 (&acc)[2][2][4][2], const pg8::Unit& u, int wr, int wc, int fr, int fq) const {
        const int row0 = u.pm * 256 + wr * 64 + fr, col0 = (u.pn & 7) * 256 + wc * 32 + 8 * fq;
#pragma unroll
        for (int ai = 0; ai < 2; ++ai)
#pragma unroll
            for (int m = 0; m < 4; ++m) { bf16* rowp = O + (size_t)(row0 + ai * 128 + m * 16) * DM + col0;
#pragma unroll
                for (int bj = 0; bj < 2; ++bj) { const pg8::f32x4 v0 = acc[ai][bj][m][0], v1 = acc[ai][bj][m][1];
                    pg8::u32x4 w; w.x = pg8::cvt_pk_bf16(v0[0], v0[1]); w.y = pg8::cvt_pk_bf16(v0[2], v0[3]); w.z = pg8::cvt_pk_bf16(v1[0], v1[1]); w.w = pg8::cvt_pk_bf16(v1[2], v1[3]);
                    *(pg8::u32x4*)(rowp + bj * 128) = w; } }
    }
};
template <int NB> struct MoeOrder {
    const unsigned* ctl; int G, c, nunits;
    __device__ __forceinline__ void init(const unsigned* ctl_, int G_, int c_) { ctl = ctl_; G = G_; c = c_; nunits = (int)ctl_[CW_NT] * NB; }
    __device__ __forceinline__ bool next(int i, pg8::Unit& u) const {
        const int L = i * G + c; if (L >= nunits) return false;
        u.pm = L / NB; u.pn = (int)ctl[CW_TE + u.pm] * NB + (L % NB); return true;
    }
    __device__ __forceinline__ void a_ready(const pg8::Unit&) const {}
    __device__ __forceinline__ void done(const pg8::Unit&) const {}
};
#define XB_TMO      128
#define XB_XCNT(j)  (256  + 64 * (j))
#define XB_XSUB(j)  (1280 + 64 * (j))
#define XB_XGEN(j)  (2304 + 64 * (j))
#define XB_TOP      3328
#define XB_TOPGEN   3392
#define XCD_BAR_WORDS 3456
#define XB_SPIN_CAP (1u << 18)

__device__ __forceinline__ unsigned xb_ld(unsigned* p)              { return __hip_atomic_load(p, __ATOMIC_RELAXED, __HIP_MEMORY_SCOPE_AGENT); }
__device__ __forceinline__ unsigned xb_add(unsigned* p, unsigned v) { return __hip_atomic_fetch_add(p, v, __ATOMIC_RELAXED, __HIP_MEMORY_SCOPE_AGENT); }
__device__ __forceinline__ unsigned xb_xcc_id() { return (unsigned)__builtin_amdgcn_s_getreg((3 << 11) | 20) & 0xFu; }
#define XB_SPIN(cond, bar) do { unsigned _sp = 0; while (cond) { __builtin_amdgcn_s_sleep(1); \
    if ((++_sp & 255u) == 0u) { if (xb_ld(&(bar)[XB_TMO])) break; if (_sp > XB_SPIN_CAP) { atomicAdd(&(bar)[XB_TMO], 1u); break; } } } } while (0)

struct XcdBarrier {
    unsigned* bar; unsigned x;
    volatile LAS unsigned* st;
};

__device__ __forceinline__ XcdBarrier xcd_barrier_post(unsigned* bar, volatile LAS unsigned* st) {
    XcdBarrier b; b.bar = bar; b.x = xb_xcc_id(); b.st = st;
    if (threadIdx.x == 0) (void)xb_add(&bar[XB_XCNT(b.x)], 1u);
    return b;
}
__device__ __forceinline__ void xcd_barrier_complete(unsigned* bar, unsigned x, unsigned& nloc, unsigned& nx) {
    const unsigned G = gridDim.x * gridDim.y * gridDim.z;
    unsigned sum, cnt, mine, sp = 0u;
    for (;;) {
        sum = 0u; cnt = 0u; mine = 0u;
#pragma unroll
        for (unsigned j = 0; j < 16; ++j) { const unsigned c = xb_ld(&bar[XB_XCNT(j)]); sum += c; cnt += (c > 0u) ? 1u : 0u; mine = (j == x) ? c : mine; }
        if (sum == G) break;
        __builtin_amdgcn_s_sleep(1);
        if ((++sp & 255u) == 0u) { if (xb_ld(&bar[XB_TMO])) break; if (sp > XB_SPIN_CAP) { atomicAdd(&bar[XB_TMO], 1u); break; } }
    }
    nloc = mine > 0u ? mine : 1u; nx = cnt > 0u ? cnt : 1u;
}

__device__ __forceinline__ void xcd_barrier(const XcdBarrier& b) {
    asm volatile("s_waitcnt vmcnt(0)" ::: "memory");
    __syncthreads();
    if (threadIdx.x == 0) {
        unsigned* bar = b.bar;
        __builtin_amdgcn_s_waitcnt(0);
        unsigned nloc = b.st[0], nx = b.st[1];
        if (nloc == 0u) { xcd_barrier_complete(bar, b.x, nloc, nx); b.st[0] = nloc; b.st[1] = nx; }
        const unsigned old = xb_add(&bar[XB_XSUB(b.x)], 1u);
        const unsigned gen = old / nloc;
        if (old + 1u == (gen + 1u) * nloc) {
            __builtin_amdgcn_fence(__ATOMIC_RELEASE, "agent");
            asm volatile("s_waitcnt vmcnt(0)" ::: "memory");
            const unsigned og = xb_add(&bar[XB_TOP], 1u);
            const unsigned tg = og / nx;
            if (og + 1u == (tg + 1u) * nx) xb_add(&bar[XB_TOPGEN], 1u);
            else XB_SPIN(xb_ld(&bar[XB_TOPGEN]) == tg, bar);
            __builtin_amdgcn_fence(__ATOMIC_ACQUIRE, "agent");
            xb_add(&bar[XB_XGEN(b.x)], 1u);
            asm volatile("s_waitcnt vmcnt(0)" ::: "memory");
        } else {
            XB_SPIN(xb_ld(&bar[XB_XGEN(b.x)]) == gen, bar);
            __builtin_amdgcn_fence(__ATOMIC_ACQUIRE, "agent");
            asm volatile("s_waitcnt vmcnt(0)" ::: "memory");
        }
    }
    __syncthreads();
}

__device__ __forceinline__ void tr_item(const float* W, int ldw, int k0, int n0, bf16* WT, int K, size_t drow0, LAS float* scr, int lane) {
#pragma unroll 8
    for (int i = 0; i < 32; ++i) { const int kk = 2 * i + (lane >> 5); scr[kk * 33 + (lane & 31)] = W[(size_t)(k0 + kk) * ldw + n0 + (lane & 31)]; }
    LDS_WAIT(); asm volatile("" ::: "memory");
    const int c = lane & 7;
#pragma unroll
    for (int j = 0; j < 4; ++j) { const int n = (lane >> 3) + 8 * j; const LAS float* s = scr + (8 * c) * 33 + n;
        v4u o; o.x = pk2(s[0 * 33], s[1 * 33]); o.y = pk2(s[2 * 33], s[3 * 33]); o.z = pk2(s[4 * 33], s[5 * 33]); o.w = pk2(s[6 * 33], s[7 * 33]);
        *(v4u*)(WT + (drow0 + n) * (size_t)K + k0 + 8 * c) = o; }
    LDS_WAIT(); asm volatile("" ::: "memory");
}
__device__ __forceinline__ void phase_prologue(const Args& a, LAS unsigned char* lds, int tid, int lane, int wave, int bid, int G) {
    unsigned char* ws = a.ws;
    LAS float* scr = (LAS float*)(lds + wave * 16384);
    const int gw = bid * NWAVES + wave, NGW = G * NWAVES;
    constexpr int I_IN = 32 * 430, I_UA = 16 * 64, I_UB = 32 * 64, I_WO = 32 * 64, I_EG = 32 * 32 * 16, I_ED = 32 * 8 * 64;
    constexpr int NITEMS = I_IN + I_UA + I_UB + I_WO + 2 * I_EG + I_ED;
    for (int it = gw; it < NITEMS; it += NGW) {
        int r = it;
        if (r < I_IN) { const int kb = r / 430, nb = r % 430, n0 = nb * 32; tr_item(a.in[2], 13760, kb * 64, n0, (bf16*)(ws + WS_WIN), 2048, (size_t)(n0 + (n0 >= 3520 ? 64 : 0)), scr, lane); continue; } r -= I_IN;
        if (r < I_UA) { const int kb = r / 64, nb = r % 64; tr_item(a.in[15], 2048, kb * 64, nb * 32, (bf16*)(ws + WS_WUPA), 1024, (size_t)(nb * 32), scr, lane); continue; } r -= I_UA;
        if (r < I_UB) { const int kb = r / 64, nb = r % 64; tr_item(a.in[16], 2048, kb * 64, nb * 32, (bf16*)(ws + WS_WUPB), 2048, (size_t)(nb * 32), scr, lane); continue; } r -= I_UB;
        if (r < I_WO) { const int kb = r / 64, nb = r % 64; tr_item(a.in[17], 2048, kb * 64, nb * 32, (bf16*)(ws + WS_WOUT), 2048, (size_t)(nb * 32), scr, lane); continue; } r -= I_WO;
        if (r < 2 * I_EG) { const int half = r / I_EG; const int q = r % I_EG; const int e = q / 512, kb = (q % 512) / 16, nb = q % 16, n0 = nb * 32;
            const float* W = a.in[23 + half] + (size_t)e * 2048 * 512;
            tr_item(W, 512, kb * 64, n0, (bf16*)(ws + WS_WGU), 2048, (size_t)e * 1024 + (n0 >> 7) * 256 + half * 128 + (n0 & 127), scr, lane); continue; } r -= 2 * I_EG;
        { const int e = r / 512, kb = (r % 512) / 64, nb = r % 64; const float* W = a.in[25] + (size_t)e * 512 * 2048;
            tr_item(W, 2048, kb * 64, nb * 32, (bf16*)(ws + WS_WDN), 512, (size_t)e * 2048 + nb * 32, scr, lane); }
    }
    { v4u* z = (v4u*)(ws + WS_WIN + (size_t)3520 * 2048 * 2); const int n16 = 64 * 2048 * 2 / 16;
      for (int i = bid * NTHR + tid; i < n16; i += G * NTHR) z[i] = (v4u){0u, 0u, 0u, 0u}; }
    { bf16* W2T = (bf16*)(ws + WS_RB + 16 * MiB); bf16* A2T = W2T + 1024 * 96; bf16* G2T = A2T + 1024 * 96;
      for (int i = bid * NTHR + tid; i < 1024 * 96; i += G * NTHR) { const int ch = i / 96, j = i % 96; W2T[i] = (bf16)f2bf(a.in[5][j * 1024 + ch]); A2T[i] = (bf16)f2bf(a.in[7][j * 1024 + ch]); }
      for (int i = bid * NTHR + tid; i < 1024 * 256; i += G * NTHR) { const int ch = i >> 8, j = i & 255; G2T[i] = (bf16)f2bf(a.in[8][j * 1024 + ch]); } }
    { float2* rot = (float2*)(ws + WS_ROT);
      for (int i = bid * NTHR + tid; i < SEQ * 64; i += G * NTHR) { const int pos = i >> 6, d = i & 63;
          const float inv = exp2f(-(float)d * (13.287712379549449f / 64.0f)); const float ang = (float)pos * inv;
          double rev = (double)ang * 0.15915494309189535; rev -= __builtin_rint(rev); const float rf = (float)rev;
          rot[i] = make_float2(__builtin_amdgcn_cosf(rf), __builtin_amdgcn_sinf(rf)); } }
    { const float* g1 = a.in[1]; bf16* H1 = (bf16*)(ws + WS_H1);
      for (int m = gw; m < NTOK; m += NGW) { const f32x4* xr = (const f32x4*)(a.in[0] + (size_t)m * DM) + lane; f32x4 v[8]; float s = 0.f;
#pragma unroll
          for (int j = 0; j < 8; ++j) { v[j] = xr[64 * j]; s += (v[j].x * v[j].x + v[j].y * v[j].y) + (v[j].z * v[j].z + v[j].w * v[j].w); }
          const float rs = rsqrtf(wave_sum(s) * (1.0f / DM) + 1e-6f);
          v2u* o8 = (v2u*)(H1 + (size_t)m * DM) + lane;
#pragma unroll
          for (int j = 0; j < 8; ++j) { const f32x4 g = ((const f32x4*)g1)[64 * j + lane]; v2u o; o.x = pk2(v[j].x * rs * g.x, v[j].y * rs * g.y); o.y = pk2(v[j].z * rs * g.z, v[j].w * rs * g.w); o8[64 * j] = o; } } }
}

__device__ __forceinline__ float shiftp(const bf16* P, int t, int col, float mu, bool first) {
    const float cur = bf2f(P[(size_t)t * NP + col]); const float prev = first ? 0.f : bf2f(P[(size_t)(t - 1) * NP + col]);
    return cur + (prev - cur) * mu;
}
__device__ __forceinline__ void phase_rwprep(const Args& a, LAS unsigned char* lds, int tid, int lane, int wave, int bid, int G) {
    unsigned char* ws = a.ws; const bf16* P = (const bf16*)(ws + WS_P);
    LAS float* xs = (LAS float*)lds;
    const float* mu = a.in[3]; const float* w0 = a.in[4]; const float* w2 = a.in[5]; const float* a0 = a.in[6]; const float* a2 = a.in[7]; const float* g2 = a.in[8];
    const float* k_k = a.in[9]; const float* k_a = a.in[10]; const float* r_k = a.in[11];
    bf16* RR = (bf16*)a.out; bf16* RK = RR + (size_t)NTOK * RW_W; bf16* RV = RK + (size_t)NTOK * RW_W; bf16* RG = RV + (size_t)NTOK * RW_W;
    bf16* RE = (bf16*)(ws + WS_RWE); bf16* RA = (bf16*)(ws + WS_RWA); bf16* RB = (bf16*)(ws + WS_RWB); float* BON = (float*)(ws + WS_BONUS);
    for (int u = bid; u < NTOK / 8; u += G) {
        const int t0 = u * 8;
        __syncthreads();
        for (int i = tid; i < 448 * 8; i += NTHR) { const int j = i >> 3, tt = i & 7, t = t0 + tt; const int col = P_XW + j;
            float v = shiftp(P, t, col, mu[col], (t & (SEQ - 1)) == 0);
            if (j < 96) v = tanhf(v); else if (j >= 192) v = sigmoidf_(v);
            xs[i] = v; }
        __syncthreads();
        float aw[2][8], aa[2][8], ag[2][8];
#pragma unroll
        for (int c = 0; c < 2; ++c)
#pragma unroll
            for (int tt = 0; tt < 8; ++tt) { aw[c][tt] = 0.f; aa[c][tt] = 0.f; ag[c][tt] = 0.f; }
        for (int j = 0; j < 96; ++j) { const float wa = w2[j * RW_W + tid], wb = w2[j * RW_W + tid + 512]; const f32x4 x0 = *(const LAS f32x4*)(xs + j * 8), x1 = *(const LAS f32x4*)(xs + j * 8 + 4);
#pragma unroll
            for (int tt = 0; tt < 4; ++tt) { aw[0][tt] += x0[tt] * wa; aw[1][tt] += x0[tt] * wb; aw[0][4 + tt] += x1[tt] * wa; aw[1][4 + tt] += x1[tt] * wb; } }
        for (int j = 0; j < 96; ++j) { const float wa = a2[j * RW_W + tid], wb = a2[j * RW_W + tid + 512]; const f32x4 x0 = *(const LAS f32x4*)(xs + (96 + j) * 8), x1 = *(const LAS f32x4*)(xs + (96 + j) * 8 + 4);
#pragma unroll
            for (int tt = 0; tt < 4; ++tt) { aa[0][tt] += x0[tt] * wa; aa[1][tt] += x0[tt] * wb; aa[0][4 + tt] += x1[tt] * wa; aa[1][4 + tt] += x1[tt] * wb; } }
        for (int j = 0; j < 256; ++j) { const float wa = g2[j * RW_W + tid], wb = g2[j * RW_W + tid + 512]; const f32x4 x0 = *(const LAS f32x4*)(xs + (192 + j) * 8), x1 = *(const LAS f32x4*)(xs + (192 + j) * 8 + 4);
#pragma unroll
            for (int tt = 0; tt < 4; ++tt) { ag[0][tt] += x0[tt] * wa; ag[1][tt] += x0[tt] * wb; ag[0][4 + tt] += x1[tt] * wa; ag[1][4 + tt] += x1[tt] * wb; } }
#pragma unroll
        for (int c = 0; c < 2; ++c) { const int ch = tid + c * 512; const int head = ch >> 6;
            const float mur = mu[ch], muk = mu[1024 + ch], muv = mu[2048 + ch], w0c = w0[ch], a0c = a0[ch], kkc = k_k[ch], kac = k_a[ch], rkc = r_k[ch];
#pragma unroll
            for (int tt = 0; tt < 8; ++tt) { const int t = t0 + tt; const bool first = (t & (SEQ - 1)) == 0;
                const float r = shiftp(P, t, ch, mur, first), k = shiftp(P, t, 1024 + ch, muk, first), v = shiftp(P, t, 2048 + ch, muv, first);
                const float e = sigmoidf_(w0c + aw[c][tt]) * 0.6065306597126334f;
                const float av = sigmoidf_(a0c + aa[c][tt]);
                float kk = k * kkc; const float ss = wave_sum(kk * kk); kk *= rsqrtf(fmaxf(ss, 1e-24f));
                const float kp = k * (1.0f + (av - 1.0f) * kac);
                const float bs = wave_sum(r * kp * rkc);
                const size_t o = (size_t)t * RW_W + ch;
                RR[o] = (bf16)f2bf(r); RK[o] = (bf16)f2bf(kp); RV[o] = (bf16)f2bf(v); RG[o] = (bf16)f2bf(ag[c][tt]);
                RE[o] = (bf16)f2bf(e); RA[o] = (bf16)f2bf(-kk); RB[o] = (bf16)f2bf(kk * av);
                if (lane == 0) BON[t * RW_H + head] = bs; } }
    }
}

__device__ __forceinline__ void unpack16(const v4u& p0, const v4u& p1, float (&f)[16]) {
    f[0] = bflo(p0.x); f[1] = bfhi(p0.x); f[2] = bflo(p0.y); f[3] = bfhi(p0.y); f[4] = bflo(p0.z); f[5] = bfhi(p0.z); f[6] = bflo(p0.w); f[7] = bfhi(p0.w);
    f[8] = bflo(p1.x); f[9] = bfhi(p1.x); f[10] = bflo(p1.y); f[11] = bfhi(p1.y); f[12] = bflo(p1.z); f[13] = bfhi(p1.z); f[14] = bflo(p1.w); f[15] = bfhi(p1.w);
}
__device__ __forceinline__ void phase_rwrec(const Args& a, int lane, int wave, int bid, int G) {
    if (wave != 0) return;
    unsigned char* ws = a.ws;
    const bf16* RR = (const bf16*)a.out; const bf16* RK = RR + (size_t)NTOK * RW_W; const bf16* RV = RK + (size_t)NTOK * RW_W;
    const bf16* RE = (const bf16*)(ws + WS_RWE); const bf16* RA = (const bf16*)(ws + WS_RWA); const bf16* RB = (const bf16*)(ws + WS_RWB);
    bf16* Y = (bf16*)(ws + WS_OA);
    for (int u = bid; u < 256; u += G) {
        const int b = u >> 6, h = (u >> 2) & 15, sl = u & 3, row = lane >> 2, kq = lane & 3, iv = sl * 16 + row;
        float S[16];
#pragma unroll
        for (int k = 0; k < 16; ++k) S[k] = 0.f;
        size_t base = (size_t)(b * SEQ) * RW_W + h * 64;
        const v4u* pr = (const v4u*)(RR + base + kq * 16); const v4u* pe = (const v4u*)(RE + base + kq * 16); const v4u* pk = (const v4u*)(RK + base + kq * 16);
        const v4u* pa = (const v4u*)(RA + base + kq * 16); const v4u* pb = (const v4u*)(RB + base + kq * 16);
        v4u nr0 = pr[0], nr1 = pr[1], ne0 = pe[0], ne1 = pe[1], nk0 = pk[0], nk1 = pk[1], na0 = pa[0], na1 = pa[1], nb0 = pb[0], nb1 = pb[1];
        unsigned short nv = RV[base + iv];
        for (int t = 0; t < SEQ; ++t) {
            const v4u r0 = nr0, r1 = nr1, e0 = ne0, e1 = ne1, k0 = nk0, k1 = nk1, a0 = na0, a1 = na1, b0 = nb0, b1 = nb1; const float v = bf2f(nv);
            if (t + 1 < SEQ) { const int q = (t + 1) * (RW_W / 8);
                nr0 = pr[q]; nr1 = pr[q + 1]; ne0 = pe[q]; ne1 = pe[q + 1]; nk0 = pk[q]; nk1 = pk[q + 1]; na0 = pa[q]; na1 = pa[q + 1]; nb0 = pb[q]; nb1 = pb[q + 1];
                nv = RV[base + (size_t)(t + 1) * RW_W + iv]; }
            float fr[16], fe[16], fk[16], fa[16], fb[16];
            unpack16(r0, r1, fr); unpack16(e0, e1, fe); unpack16(k0, k1, fk); unpack16(a0, a1, fa); unpack16(b0, b1, fb);
            float sa = 0.f;
#pragma unroll
            for (int k = 0; k < 16; ++k) sa += S[k] * fa[k];
            sa += __shfl_xor(sa, 1); sa += __shfl_xor(sa, 2);
            float y = 0.f;
#pragma unroll
            for (int k = 0; k < 16; ++k) { const float w = __expf(-fe[k]); S[k] = S[k] * w + (sa * fb[k] + v * fk[k]); y += S[k] * fr[k]; }
            y += __shfl_xor(y, 1); y += __shfl_xor(y, 2);
            if (kq == 0) Y[base + (size_t)t * RW_W + iv] = (bf16)f2bf(y);
        }
    }
}

__device__ __forceinline__ void phase_ret(const Args& a, LAS unsigned char* lds, int tid, int bid, int G) {
    unsigned char* ws = a.ws; const bf16* P = (const bf16*)(ws + WS_P); const float2* rot = (const float2*)(ws + WS_ROT); bf16* OB = (bf16*)(ws + WS_OB);
    LAS float* Qs = (LAS float*)lds;
    LAS float* Ks = Qs + 64 * 129;
    LAS float* Vs = Ks + 64 * 129;
    LAS float* Sc = Vs + 64 * 32;
    LAS float* St = Sc + 64 * 65;
    LAS float* gp = St + 128 * 32;
    for (int u = bid; u < 256; u += G) {
        const int b = u >> 6, h = (u >> 3) & 7, vs = u & 7;
        __syncthreads();
        const float lg = log1pf(-exp2f(-5.0f - (float)h));
        if (tid < 65) gp[tid] = expf((float)tid * lg);
        for (int i = tid; i < 128 * 32; i += NTHR) St[i] = 0.f;
        for (int n = 0; n < SEQ / 64; ++n) {
            __syncthreads();
            for (int idx = tid; idx < 64 * 64; idx += NTHR) { const int i = idx >> 6, d = idx & 63, pos = n * 64 + i; const size_t t = (size_t)(b * SEQ + pos);
                const float2 cs = rot[pos * 64 + d];
                const float q1 = bf2f(P[t * NP + P_RQ + h * 128 + d]), q2 = bf2f(P[t * NP + P_RQ + h * 128 + 64 + d]);
                const float k1 = bf2f(P[t * NP + P_RK + h * 128 + d]) * 0.08838834764831845f, k2 = bf2f(P[t * NP + P_RK + h * 128 + 64 + d]) * 0.08838834764831845f;
                Qs[i * 129 + d] = q1 * cs.x - q2 * cs.y; Qs[i * 129 + 64 + d] = q1 * cs.y + q2 * cs.x;
                Ks[i * 129 + d] = k1 * cs.x - k2 * cs.y; Ks[i * 129 + 64 + d] = k1 * cs.y + k2 * cs.x; }
            for (int idx = tid; idx < 64 * 32; idx += NTHR) { const int j = idx >> 5, e = idx & 31; const size_t t = (size_t)(b * SEQ + n * 64 + j);
                Vs[idx] = bf2f(P[t * NP + P_RV + h * 256 + vs * 32 + e]); }
            __syncthreads();
            { const int i = tid >> 3, jb = tid & 7; float s[8];
#pragma unroll
              for (int jj = 0; jj < 8; ++jj) s[jj] = 0.f;
              for (int d = 0; d < 128; ++d) { const float q = Qs[i * 129 + d];
#pragma unroll
                  for (int jj = 0; jj < 8; ++jj) s[jj] += q * Ks[(jb + 8 * jj) * 129 + d]; }
#pragma unroll
              for (int jj = 0; jj < 8; ++jj) { const int j = jb + 8 * jj; const int dist = i > j ? i - j : j - i; Sc[i * 65 + j] = s[jj] * gp[dist]; } }
            __syncthreads();
            { const int e = tid & 31, ib = tid >> 5; float o1[4], o2[4];
#pragma unroll
              for (int ii = 0; ii < 4; ++ii) { o1[ii] = 0.f; o2[ii] = 0.f; }
              for (int j = 0; j < 64; ++j) { const float v = Vs[j * 32 + e];
#pragma unroll
                  for (int ii = 0; ii < 4; ++ii) o1[ii] += Sc[(ib + 16 * ii) * 65 + j] * v; }
              for (int d = 0; d < 128; ++d) { const float s = St[d * 32 + e];
#pragma unroll
                  for (int ii = 0; ii < 4; ++ii) o2[ii] += Qs[(ib + 16 * ii) * 129 + d] * s; }
#pragma unroll
              for (int ii = 0; ii < 4; ++ii) { const int i = ib + 16 * ii; const size_t t = (size_t)(b * SEQ + n * 64 + i);
                  OB[t * RET_VW + h * 256 + vs * 32 + e] = (bf16)f2bf(o1[ii] + gp[i + 1] * o2[ii]); } }
            __syncthreads();
            { const int e = tid & 31, db = tid >> 5; float s[8];
#pragma unroll
              for (int dd = 0; dd < 8; ++dd) s[dd] = 0.f;
              for (int j = 0; j < 64; ++j) { const float v = Vs[j * 32 + e] * gp[63 - j];
#pragma unroll
                  for (int dd = 0; dd < 8; ++dd) s[dd] += Ks[j * 129 + db + 16 * dd] * v; }
#pragma unroll
              for (int dd = 0; dd < 8; ++dd) { const int d = db + 16 * dd; St[d * 32 + e] = St[d * 32 + e] * gp[64] + s[dd]; } }
        }
    }
}

__device__ __forceinline__ void phase_post(const Args& a, int lane, int wave, int bid, int G) {
    unsigned char* ws = a.ws; const bf16* P = (const bf16*)(ws + WS_P);
    const int gw = bid * NWAVES + wave, NGW = G * NWAVES;
    { bf16* Y = (bf16*)(ws + WS_OA); const bf16* RR = (const bf16*)a.out; const bf16* RV = RR + (size_t)2 * NTOK * RW_W; const bf16* RG = RR + (size_t)3 * NTOK * RW_W;
      const float* BON = (const float*)(ws + WS_BONUS); const float* lg = a.in[12]; const float* lb = a.in[13];
      for (int it = gw; it < NTOK * RW_H; it += NGW) { const int t = it >> 4, h = it & 15; const size_t o = (size_t)t * RW_W + h * 64 + lane;
          const float y = bf2f(Y[o]); const float mean = wave_sum(y) * (1.0f / 64.0f); const float dy = y - mean; const float var = wave_sum(dy * dy) * (1.0f / 64.0f);
          float yn = dy * rsqrtf(var + 64e-5f) * lg[h * 64 + lane] + lb[h * 64 + lane];
          yn += BON[it] * bf2f(RV[o]);
          Y[o] = (bf16)f2bf(yn * bf2f(RG[o])); } }
    { bf16* OB = (bf16*)(ws + WS_OB); const float* ng = a.in[14];
      for (int it = gw; it < NTOK * RET_H; it += NGW) { const int t = it >> 3, h = it & 7; const size_t o = (size_t)t * RET_VW + h * 256 + lane * 4;
          const v2u raw = *(const v2u*)(OB + o); const float v0 = bflo(raw.x), v1 = bfhi(raw.x), v2 = bflo(raw.y), v3 = bfhi(raw.y);
          const float rs = rsqrtf(wave_sum((v0 * v0 + v1 * v1) + (v2 * v2 + v3 * v3)) * (1.0f / 256.0f) + 1e-6f);
          const v2u gr = *(const v2u*)(P + (size_t)t * NP + P_RG + h * 256 + lane * 4); const f32x4 g = *(const f32x4*)(ng + h * 256 + lane * 4);
          v2u w; w.x = pk2(v0 * rs * g.x * bflo(gr.x), v1 * rs * g.y * bfhi(gr.x)); w.y = pk2(v2 * rs * g.z * bflo(gr.y), v3 * rs * g.w * bfhi(gr.y));
          *(v2u*)(OB + o) = w; } }
}

__device__ __forceinline__ void phase_retpost(const Args& a, int lane, int wave, int bid, int G) {
    unsigned char* ws = a.ws; const bf16* P = (const bf16*)(ws + WS_P);
    const int gw = bid * NWAVES + wave, NGW = G * NWAVES;
    bf16* OB = (bf16*)(ws + WS_OB); const float* ng = a.in[14];
    for (int it = gw; it < NTOK * RET_H; it += NGW) { const int t = it >> 3, h = it & 7; const size_t o = (size_t)t * RET_VW + h * 256 + lane * 4;
        const v2u raw = *(const v2u*)(OB + o); const float v0 = bflo(raw.x), v1 = bfhi(raw.x), v2 = bflo(raw.y), v3 = bfhi(raw.y);
        const float rs = rsqrtf(wave_sum((v0 * v0 + v1 * v1) + (v2 * v2 + v3 * v3)) * (1.0f / 256.0f) + 1e-6f);
        const v2u gr = *(const v2u*)(P + (size_t)t * NP + P_RG + h * 256 + lane * 4); const f32x4 g = *(const f32x4*)(ng + h * 256 + lane * 4);
        v2u w; w.x = pk2(v0 * rs * g.x * bflo(gr.x), v1 * rs * g.y * bfhi(gr.x)); w.y = pk2(v2 * rs * g.z * bflo(gr.y), v3 * rs * g.w * bfhi(gr.y));
        *(v2u*)(OB + o) = w; }
}

__device__ __forceinline__ void phase_router(const Args& a, int lane, int wave, int bid, int G) {
    unsigned char* ws = a.ws; const float* X1 = a.out; bf16* H2 = (bf16*)(ws + WS_H2);
    const float* g2 = a.in[18]; const float* wg = a.in[19]; const float* bg = a.in[20]; const float* we = a.in[21]; const float* be = a.in[22];
    unsigned* ctl = (unsigned*)(ws + WS_CTL); int* TE = (int*)(ws + WS_TOKE); float* TW = (float*)(ws + WS_TOKW); int* TP = (int*)(ws + WS_TOKP);
    const int gw = bid * NWAVES + wave, NGW = G * NWAVES;
    for (int t = gw; t < NTOK; t += NGW) {
        const f32x4* xr = (const f32x4*)(X1 + (size_t)t * DM) + lane; float s = 0.f;
#pragma unroll
        for (int j = 0; j < 8; ++j) { const f32x4 x = xr[64 * j]; s += (x.x * x.x + x.y * x.y) + (x.z * x.z + x.w * x.w); }
        const float rs = rsqrtf(wave_sum(s) * (1.0f / DM) + 1e-6f);
        float lgt[36];
#pragma unroll
        for (int q = 0; q < 36; ++q) lgt[q] = 0.f;
        v2u* o8 = (v2u*)(H2 + (size_t)t * DM) + lane;
#pragma unroll 1
        for (int j = 0; j < 8; ++j) { const f32x4 x = xr[64 * j]; const f32x4 g = ((const f32x4*)g2)[64 * j + lane]; const f32x4 hv = {x.x * rs * g.x, x.y * rs * g.y, x.z * rs * g.z, x.w * rs * g.w};
            v2u o; o.x = pk2(hv.x, hv.y); o.y = pk2(hv.z, hv.w); o8[64 * j] = o;
            const int col = 256 * j + 4 * lane;
#pragma unroll
            for (int c = 0; c < 4; ++c) { const float hc = hv[c]; const f32x4 w4 = *(const f32x4*)(wg + (size_t)(col + c) * 4);
                lgt[0] += hc * w4.x; lgt[1] += hc * w4.y; lgt[2] += hc * w4.z; lgt[3] += hc * w4.w;
#pragma unroll
                for (int q = 0; q < 8; ++q) { const f32x4 e4 = *(const f32x4*)(we + (size_t)(col + c) * 32 + 4 * q);
                    lgt[4 + 4 * q] += hc * e4.x; lgt[5 + 4 * q] += hc * e4.y; lgt[6 + 4 * q] += hc * e4.z; lgt[7 + 4 * q] += hc * e4.w; } }
            asm volatile("" ::: "memory"); }
#pragma unroll
        for (int q = 0; q < 36; ++q) lgt[q] = wave_sum(lgt[q]);
        float gl[4];
#pragma unroll
        for (int q = 0; q < 4; ++q) gl[q] = lgt[q] + bg[q];
        int gs = 0; float gm = gl[0];
#pragma unroll
        for (int q = 1; q < 4; ++q) if (gl[q] > gm) { gm = gl[q]; gs = q; }
        float den = 0.f;
#pragma unroll
        for (int q = 0; q < 4; ++q) den += expf(gl[q] - gm);
        const float gwt = 1.0f / den;
        float el[8];
#pragma unroll
        for (int q = 0; q < 8; ++q) { float x = 0.f;
#pragma unroll
            for (int gq = 0; gq < 4; ++gq) x = (gs == gq) ? lgt[4 + gq * 8 + q] + be[gq * 8 + q] : x;
            el[q] = x; }
        int i0 = 0; float m0 = el[0];
#pragma unroll
        for (int q = 1; q < 8; ++q) if (el[q] > m0) { m0 = el[q]; i0 = q; }
        int i1 = -1; float m1 = -3.0e38f;
#pragma unroll
        for (int q = 0; q < 8; ++q) if (q != i0 && el[q] > m1) { m1 = el[q]; i1 = q; }
        const float e1 = expf(m1 - m0); const float w0 = gwt / (1.0f + e1), w1 = gwt * e1 / (1.0f + e1);
        if (lane == 0) { const int ex0 = gs * 8 + i0, ex1 = gs * 8 + i1;
            const unsigned p0 = __hip_atomic_fetch_add(ctl + CW_CNT + ex0, 1u, RLX_AGENT), p1 = __hip_atomic_fetch_add(ctl + CW_CNT + ex1, 1u, RLX_AGENT);
            TE[2 * t] = ex0; TE[2 * t + 1] = ex1; TW[2 * t] = w0; TW[2 * t + 1] = w1; TP[2 * t] = (int)p0; TP[2 * t + 1] = (int)p1; }
    }
}

__device__ __forceinline__ void phase_gather(const Args& a, LAS unsigned char* lds, int tid, int lane, int wave, int bid, int G) {
    unsigned char* ws = a.ws; unsigned* ctl = (unsigned*)(ws + WS_CTL); const bf16* H2 = (const bf16*)(ws + WS_H2); bf16* XG = (bf16*)(ws + WS_XG);
    const int* TE = (const int*)(ws + WS_TOKE); const int* TP = (const int*)(ws + WS_TOKP); int* TS = (int*)(ws + WS_TOKS);
    LAS int* ps = (LAS int*)lds;
    __syncthreads();
    if (tid == 0) { int acc = 0, nt = 0;
        for (int e = 0; e < NEXP; ++e) { const int c = (int)__hip_atomic_load(ctl + CW_CNT + e, RLX_AGENT); ps[e] = acc; ps[64 + e] = c; const int tl = (c + 255) >> 8;
            if (bid == 0) for (int q = 0; q < tl; ++q) ctl[CW_TE + nt + q] = (unsigned)e;
            nt += tl; acc += tl * 256; }
        ps[32] = acc; if (bid == 0) ctl[CW_NT] = (unsigned)nt; }
    __syncthreads();
    const int gw = bid * NWAVES + wave, NGW = G * NWAVES;
    for (int it = gw; it < NTOK * 2; it += NGW) { const int t = it >> 1; const int e = TE[it]; const int slot = ps[e] + TP[it];
        const v4u* src = (const v4u*)(H2 + (size_t)t * DM) + lane; v4u* dst = (v4u*)(XG + (size_t)slot * DM) + lane;
#pragma unroll
        for (int j = 0; j < 4; ++j) dst[64 * j] = src[64 * j];
        if (lane == 0) TS[it] = slot; }
    for (int e = 0; e < NEXP; ++e) { const int c = ps[64 + e], base = ps[e] + c, npad = ps[e + 1] - base;
        for (int r = gw; r < npad; r += NGW) { v4u* dst = (v4u*)(XG + (size_t)(base + r) * DM) + lane;
#pragma unroll
            for (int j = 0; j < 4; ++j) dst[64 * j] = (v4u){0u, 0u, 0u, 0u}; } }
}

__device__ __forceinline__ void phase_final(const Args& a, int lane, int wave, int bid, int G) {
    unsigned char* ws = a.ws; float* X1 = a.out; const bf16* YS = (const bf16*)(ws + WS_YS); const int* TS = (const int*)(ws + WS_TOKS); const float* TW = (const float*)(ws + WS_TOKW); const float* fg = a.in[26];
    const int gw = bid * NWAVES + wave, NGW = G * NWAVES;
    for (int t = gw; t < NTOK; t += NGW) { const int s0 = TS[2 * t], s1 = TS[2 * t + 1]; const float w0 = TW[2 * t], w1 = TW[2 * t + 1];
        f32x4* xr = (f32x4*)(X1 + (size_t)t * DM) + lane; const v2u* y0 = (const v2u*)(YS + (size_t)s0 * DM) + lane; const v2u* y1 = (const v2u*)(YS + (size_t)s1 * DM) + lane;
        f32x4 v[8]; float s = 0.f;
#pragma unroll
        for (int j = 0; j < 8; ++j) { const f32x4 x = xr[64 * j]; const v2u a0 = y0[64 * j], a1 = y1[64 * j];
            v[j].x = x.x + w0 * bflo(a0.x) + w1 * bflo(a1.x); v[j].y = x.y + w0 * bfhi(a0.x) + w1 * bfhi(a1.x); v[j].z = x.z + w0 * bflo(a0.y) + w1 * bflo(a1.y); v[j].w = x.w + w0 * bfhi(a0.y) + w1 * bfhi(a1.y);
            s += (v[j].x * v[j].x + v[j].y * v[j].y) + (v[j].z * v[j].z + v[j].w * v[j].w); }
        const float rs = rsqrtf(wave_sum(s) * (1.0f / DM) + 1e-6f);
#pragma unroll
        for (int j = 0; j < 8; ++j) { const f32x4 g = ((const f32x4*)fg)[64 * j + lane]; xr[64 * j] = (f32x4){v[j].x * rs * g.x, v[j].y * rs * g.y, v[j].z * rs * g.z, v[j].w * rs * g.w}; } }
}

typedef __bf16 bf2_t __attribute__((ext_vector_type(2)));
typedef float f2_t __attribute__((ext_vector_type(2)));
__device__ __forceinline__ unsigned cvt2(float a, float b) { const f2_t v = {a, b}; const bf2_t r = __builtin_convertvector(v, bf2_t); return __builtin_bit_cast(unsigned, r); }
typedef short bf16x8 __attribute__((ext_vector_type(8)));
__device__ __forceinline__ f32x4 mfma16(bf16x8 xa, bf16x8 yb, f32x4 c) { return __builtin_amdgcn_mfma_f32_16x16x32_bf16(xa, yb, c, 0, 0, 0); }
__device__ __forceinline__ bf16x8 ldfrag(const LAS bf16* img, int ld, int row0, int k0, int lane) { return *(const LAS bf16x8*)(img + (row0 + (lane & 15)) * ld + k0 + (lane >> 4) * 8); }
__device__ __forceinline__ void unpack8(const v4u& p, float (&f)[8]) { f[0] = bflo(p.x); f[1] = bfhi(p.x); f[2] = bflo(p.y); f[3] = bfhi(p.y); f[4] = bflo(p.z); f[5] = bfhi(p.z); f[6] = bflo(p.w); f[7] = bfhi(p.w); }

__device__ __forceinline__ void phase_ret_mfma(const Args& a, LAS unsigned char* lds, int tid, int lane, int wave, int bid, int G) {
    unsigned char* ws = a.ws; const bf16* P = (const bf16*)(ws + WS_P); const float* rot = (const float*)(ws + WS_ROT); bf16* OB = (bf16*)(ws + WS_OB);
    constexpr int LQ = 136, LT = 72;
    LAS bf16* Qs = (LAS bf16*)lds;
    LAS bf16* Ks = Qs + 64 * LQ;
    LAS bf16* KT = Ks + 64 * LQ;
    LAS bf16* VT = KT + 128 * LT;
    LAS bf16* Sc = VT + 32 * LT;
    LAS bf16* ST = Sc + 64 * LT;
    LAS float* gp = (LAS float*)(ST + 32 * LQ);
    const int q4 = lane >> 4, l16 = lane & 15;
    for (int u = bid; u < 256; u += G) {
        const int b = u >> 6, h = (u >> 3) & 7, vs = u & 7;
        __syncthreads();
        const float lg = log1pf(-exp2f(-5.0f - (float)h));
        if (tid < 65) gp[tid] = expf((float)tid * lg);
        for (int i = tid; i < 32 * LQ / 2; i += NTHR) ((LAS unsigned*)ST)[i] = 0u;
        f32x4 st[2] = {{0.f, 0.f, 0.f, 0.f}, {0.f, 0.f, 0.f, 0.f}};
        const int si = tid >> 3, d0 = (tid & 7) * 8, e0 = (tid & 7) * 4;
        const bf16* prow = P + (size_t)(b * SEQ + si) * NP;
        v4u qlo = *(const v4u*)(prow + P_RQ + h * 128 + d0), qhi = *(const v4u*)(prow + P_RQ + h * 128 + 64 + d0);
        v4u klo = *(const v4u*)(prow + P_RK + h * 128 + d0), khi = *(const v4u*)(prow + P_RK + h * 128 + 64 + d0);
        v2u vv = *(const v2u*)(prow + P_RV + h * 256 + vs * 32 + e0);
        f32x4 rt[4];
#pragma unroll
        for (int c = 0; c < 4; ++c) rt[c] = *(const f32x4*)(rot + ((size_t)si * 64 + d0) * 2 + c * 4);
        __syncthreads();
        const float chunk_decay = gp[64];
        for (int n = 0; n < SEQ / 64; ++n) {
            { float ql[8], qh[8], kl[8], kh[8]; unpack8(qlo, ql); unpack8(qhi, qh); unpack8(klo, kl); unpack8(khi, kh);
              float oql[8], oqh[8], okl[8], okh[8]; const float kd = gp[63 - si];
#pragma unroll
              for (int j = 0; j < 8; ++j) { const float c = rt[j >> 1][(j & 1) * 2], s = rt[j >> 1][(j & 1) * 2 + 1];
                  oql[j] = ql[j] * c - qh[j] * s; oqh[j] = ql[j] * s + qh[j] * c;
                  okl[j] = (kl[j] * c - kh[j] * s) * 0.08838834764831845f; okh[j] = (kl[j] * s + kh[j] * c) * 0.08838834764831845f; }
              v4u w; w.x = pk2(oql[0], oql[1]); w.y = pk2(oql[2], oql[3]); w.z = pk2(oql[4], oql[5]); w.w = pk2(oql[6], oql[7]); *(LAS v4u*)(Qs + si * LQ + d0) = w;
              w.x = pk2(oqh[0], oqh[1]); w.y = pk2(oqh[2], oqh[3]); w.z = pk2(oqh[4], oqh[5]); w.w = pk2(oqh[6], oqh[7]); *(LAS v4u*)(Qs + si * LQ + 64 + d0) = w;
              w.x = pk2(okl[0], okl[1]); w.y = pk2(okl[2], okl[3]); w.z = pk2(okl[4], okl[5]); w.w = pk2(okl[6], okl[7]); *(LAS v4u*)(Ks + si * LQ + d0) = w;
              w.x = pk2(okh[0], okh[1]); w.y = pk2(okh[2], okh[3]); w.z = pk2(okh[4], okh[5]); w.w = pk2(okh[6], okh[7]); *(LAS v4u*)(Ks + si * LQ + 64 + d0) = w;
#pragma unroll
              for (int j = 0; j < 8; ++j) { KT[(d0 + j) * LT + si] = (bf16)f2bf(okl[j] * kd); KT[(64 + d0 + j) * LT + si] = (bf16)f2bf(okh[j] * kd); }
              VT[(e0 + 0) * LT + si] = (bf16)(vv.x & 0xffffu); VT[(e0 + 1) * LT + si] = (bf16)(vv.x >> 16); VT[(e0 + 2) * LT + si] = (bf16)(vv.y & 0xffffu); VT[(e0 + 3) * LT + si] = (bf16)(vv.y >> 16); }
            __syncthreads();
            if (n + 1 < SEQ / 64) { const bf16* pr = prow + (size_t)(n + 1) * 64 * NP;
                qlo = *(const v4u*)(pr + P_RQ + h * 128 + d0); qhi = *(const v4u*)(pr + P_RQ + h * 128 + 64 + d0);
                klo = *(const v4u*)(pr + P_RK + h * 128 + d0); khi = *(const v4u*)(pr + P_RK + h * 128 + 64 + d0);
                vv = *(const v2u*)(pr + P_RV + h * 256 + vs * 32 + e0);
#pragma unroll
                for (int c = 0; c < 4; ++c) rt[c] = *(const f32x4*)(rot + ((size_t)((n + 1) * 64 + si) * 64 + d0) * 2 + c * 4); }
            { const int i0 = (wave >> 1) * 16;
#pragma unroll
              for (int jt = 0; jt < 2; ++jt) { const int j0 = ((wave & 1) * 2 + jt) * 16; f32x4 acc = {0.f, 0.f, 0.f, 0.f};
#pragma unroll
                  for (int ks = 0; ks < 4; ++ks) acc = mfma16(ldfrag(Ks, LQ, j0, ks * 32, lane), ldfrag(Qs, LQ, i0, ks * 32, lane), acc);
                  const int i = i0 + l16, jb = j0 + 4 * q4; float sv[4];
#pragma unroll
                  for (int r = 0; r < 4; ++r) { const int j = jb + r; const int dist = i > j ? i - j : j - i; sv[r] = acc[r] * gp[dist]; }
                  v2u w; w.x = pk2(sv[0], sv[1]); w.y = pk2(sv[2], sv[3]); *(LAS v2u*)(Sc + i * LT + jb) = w; } }
            const int oi0 = (wave >> 1) * 16, oe0 = (wave & 1) * 16;
            f32x4 ointer = {0.f, 0.f, 0.f, 0.f};
#pragma unroll
            for (int ks = 0; ks < 4; ++ks) ointer = mfma16(ldfrag(ST, LQ, oe0, ks * 32, lane), ldfrag(Qs, LQ, oi0, ks * 32, lane), ointer);
#pragma unroll
            for (int et = 0; et < 2; ++et) { f32x4 acc = st[et] * chunk_decay;
#pragma unroll
                for (int ks = 0; ks < 2; ++ks) acc = mfma16(ldfrag(KT, LT, wave * 16, ks * 32, lane), ldfrag(VT, LT, et * 16, ks * 32, lane), acc);
                st[et] = acc; }
            __syncthreads();
            { f32x4 ointra = {0.f, 0.f, 0.f, 0.f};
#pragma unroll
              for (int ks = 0; ks < 2; ++ks) ointra = mfma16(ldfrag(VT, LT, oe0, ks * 32, lane), ldfrag(Sc, LT, oi0, ks * 32, lane), ointra);
              const int i = oi0 + l16; const float qd = gp[i + 1];
              v2u w; w.x = pk2(ointra[0] + qd * ointer[0], ointra[1] + qd * ointer[1]); w.y = pk2(ointra[2] + qd * ointer[2], ointra[3] + qd * ointer[3]);
              *(v2u*)(OB + (size_t)(b * SEQ + n * 64 + i) * RET_VW + h * 256 + vs * 32 + oe0 + 4 * q4) = w; }
#pragma unroll
            for (int et = 0; et < 2; ++et) { v2u w; w.x = pk2(st[et][0], st[et][1]); w.y = pk2(st[et][2], st[et][3]); *(LAS v2u*)(ST + (et * 16 + l16) * LQ + wave * 16 + 4 * q4) = w; }
            __syncthreads();
        }
    }
}

constexpr int LT = 72, SLOT = 64 * LT;
constexpr size_t RW_GS = 0, RW_GY = 16 * MiB, RW_YS = 32 * MiB, RW_SS = 48 * MiB;
constexpr size_t WS_H0 = WS_RB;
constexpr size_t WS_W2T = WS_RB + 16 * MiB, WS_A2T = WS_W2T + 196608, WS_G2T = WS_A2T + 196608;

__device__ __forceinline__ f32x4 tile2(const LAS bf16* X, int x0, const LAS bf16* Y, int y0, int lane, f32x4 acc) {
    acc = mfma16(ldfrag(X, LT, x0, 0, lane), ldfrag(Y, LT, y0, 0, lane), acc);
    acc = mfma16(ldfrag(X, LT, x0, 32, lane), ldfrag(Y, LT, y0, 32, lane), acc);
    return acc;
}
__device__ __forceinline__ v2u pack4(f32x4 v) { v2u w; w.x = cvt2(v[0], v[1]); w.y = cvt2(v[2], v[3]); return w; }
__device__ __forceinline__ f32x4 unpack4(v2u w) { return (f32x4){bflo(w.x), bfhi(w.x), bflo(w.y), bfhi(w.y)}; }
__device__ __forceinline__ void st4(LAS bf16* img, int yrow, int xcol, f32x4 v) { *(LAS v2u*)(img + yrow * LT + xcol) = pack4(v); }
__device__ __forceinline__ f32x4 ld4(const LAS bf16* img, int yrow, int xcol) { return unpack4(*(const LAS v2u*)(img + yrow * LT + xcol)); }
__device__ __forceinline__ v4u pack8(const float (&f)[8]) { v4u w; w.x = cvt2(f[0], f[1]); w.y = cvt2(f[2], f[3]); w.z = cvt2(f[4], f[5]); w.w = cvt2(f[6], f[7]); return w; }
__device__ __forceinline__ void shift8(const bf16* P, size_t tg, int col, bool first, const float* mu, float (&o)[8]) {
    const v4u cur = *(const v4u*)(P + tg * NP + col); v4u prv = {0u, 0u, 0u, 0u}; if (!first) prv = *(const v4u*)(P + (tg - 1) * NP + col);
    const f32x4 m0 = *(const f32x4*)(mu + col), m1 = *(const f32x4*)(mu + col + 4);
    float c[8], p[8]; unpack8(cur, c); unpack8(prv, p);
#pragma unroll
    for (int j = 0; j < 8; ++j) o[j] = c[j] + (p[j] - c[j]) * (j < 4 ? m0[j] : m1[j - 4]);
}

__device__ __forceinline__ void phase_rwA(const Args& a, LAS unsigned char* lds, int tid, int lane, int wave, int bid, int G) {
    unsigned char* ws = a.ws; const bf16* P = (const bf16*)(ws + WS_P);
    const float* mu = a.in[3]; const float* w0 = a.in[4]; const float* a0 = a.in[6]; const float* k_k = a.in[9]; const float* k_a = a.in[10]; const float* r_k = a.in[11];
    const bf16* W2T = (const bf16*)(ws + WS_W2T); const bf16* A2T = (const bf16*)(ws + WS_A2T);
    bf16* GS = (bf16*)((unsigned char*)a.out + RW_GS); bf16* GY = (bf16*)((unsigned char*)a.out + RW_GY); bf16* YS = (bf16*)((unsigned char*)a.out + RW_YS); bf16* SS = (bf16*)((unsigned char*)a.out + RW_SS);
    float* BON = (float*)(ws + WS_BONUS);
    LAS bf16* img = (LAS bf16*)lds;
    LAS bf16 *s0 = img, *s1 = img + SLOT, *s2 = img + 2 * SLOT, *s3 = img + 3 * SLOT, *s4 = img + 4 * SLOT, *s5 = img + 5 * SLOT, *s6 = img + 6 * SLOT, *s7 = img + 7 * SLOT;
    LAS bf16 *s8 = img + 8 * SLOT, *s9 = img + 9 * SLOT, *s10 = img + 10 * SLOT, *s11 = img + 11 * SLOT, *s12 = img + 12 * SLOT, *s13 = img + 13 * SLOT;
    LAS float* WL = (LAS float*)s8;  LAS float* AL = (LAS float*)s10;
    LAS float* SEG = (LAS float*)(lds + RING_BYTES + 1024);
    LAS float* GC = SEG + 512;
    LAS float* DIAG = GC + 64;
    const int q4 = lane >> 4, l16 = lane & 15;
    const int yt = wave >> 1, xb = (wave & 1) * 2, y0 = yt * 16;
    const int st_ = tid >> 3, c0 = (tid & 7) * 8;
    for (int u = bid; u < 2048; u += G) {
        const int b = u >> 9, h = (u >> 5) & 15, c = u & 31;
        const size_t t0g = (size_t)b * SEQ + c * 64;
        { const int tl = y0 + l16; const size_t tg = t0g + tl; const bool firstl = (c == 0 && tl == 0);
          bf16x8 fw[3], fa[3];
#pragma unroll
          for (int ks = 0; ks < 3; ++ks) { float x[8];
              shift8(P, tg, P_XW + ks * 32 + q4 * 8, firstl, mu, x);
#pragma unroll
              for (int j = 0; j < 8; ++j) x[j] = tanhf(x[j]);
              fw[ks] = __builtin_bit_cast(bf16x8, pack8(x));
              shift8(P, tg, P_XA + ks * 32 + q4 * 8, firstl, mu, x);
              fa[ks] = __builtin_bit_cast(bf16x8, pack8(x)); }
#pragma unroll
          for (int xi = 0; xi < 2; ++xi) { const int ch0 = (xb + xi) * 16; f32x4 accw = {0.f, 0.f, 0.f, 0.f}, acca = {0.f, 0.f, 0.f, 0.f};
#pragma unroll
              for (int ks = 0; ks < 3; ++ks) { const size_t wo = (size_t)(h * 64 + ch0 + l16) * 96 + ks * 32 + q4 * 8;
                  accw = mfma16(*(const bf16x8*)(W2T + wo), fw[ks], accw); acca = mfma16(*(const bf16x8*)(A2T + wo), fa[ks], acca); }
              *(LAS f32x4*)(WL + tl * 68 + ch0 + 4 * q4) = accw; *(LAS f32x4*)(AL + tl * 68 + ch0 + 4 * q4) = acca; } }
        float rr[8], kp[8], vv[8], av[8], bv[8], ee[8];
        { const size_t tg = t0g + st_; const bool first = (c == 0 && st_ == 0);
          shift8(P, tg, h * 64 + c0, first, mu, rr); shift8(P, tg, 1024 + h * 64 + c0, first, mu, kp); shift8(P, tg, 2048 + h * 64 + c0, first, mu, vv); }
        __syncthreads();
        { const int chg = h * 64 + c0; float wl[8], al[8];
          { const f32x4 t0 = *(const LAS f32x4*)(WL + st_ * 68 + c0), t1 = *(const LAS f32x4*)(WL + st_ * 68 + c0 + 4), u0 = *(const LAS f32x4*)(AL + st_ * 68 + c0), u1 = *(const LAS f32x4*)(AL + st_ * 68 + c0 + 4);
#pragma unroll
            for (int j = 0; j < 4; ++j) { wl[j] = t0[j]; wl[4 + j] = t1[j]; al[j] = u0[j]; al[4 + j] = u1[j]; } }
          float ss = 0.f, bon = 0.f, kk[8], as[8];
#pragma unroll
          for (int j = 0; j < 8; ++j) { ee[j] = sigmoidf_(w0[chg + j] + wl[j]) * 0.6065306597126334f; as[j] = sigmoidf_(a0[chg + j] + al[j]); kk[j] = kp[j] * k_k[chg + j]; ss += kk[j] * kk[j]; }
          ss += __shfl_xor(ss, 1); ss += __shfl_xor(ss, 2); ss += __shfl_xor(ss, 4);
          const float rn = rsqrtf(fmaxf(ss, 1e-24f));
#pragma unroll
          for (int j = 0; j < 8; ++j) { const float kn = kk[j] * rn; kp[j] = kp[j] * (1.0f + (as[j] - 1.0f) * k_a[chg + j]); av[j] = -kn; bv[j] = kn * as[j]; bon += rr[j] * kp[j] * r_k[chg + j]; }
          bon += __shfl_xor(bon, 1); bon += __shfl_xor(bon, 2); bon += __shfl_xor(bon, 4);
          if ((tid & 7) == 0) BON[(t0g + st_) * RW_H + h] = bon;
          *(LAS f32x4*)(WL + st_ * 68 + c0) = (f32x4){ee[0], ee[1], ee[2], ee[3]}; *(LAS f32x4*)(WL + st_ * 68 + c0 + 4) = (f32x4){ee[4], ee[5], ee[6], ee[7]}; }
        __syncthreads();
        { const int ch = tid & 63, seg = tid >> 6; float x[8], run = 0.f;
#pragma unroll
          for (int i = 0; i < 8; ++i) { run += WL[(seg * 8 + i) * 68 + ch]; x[i] = run; }
          SEG[seg * 64 + ch] = run;
          __syncthreads();
          float off = 0.f;
#pragma unroll
          for (int s = 0; s < 8; ++s) off += (s < seg) ? SEG[s * 64 + ch] : 0.f;
#pragma unroll
          for (int i = 0; i < 8; ++i) WL[(seg * 8 + i) * 68 + ch] = x[i] + off; }
        __syncthreads();
        { float cs[8], cC[8];
          { const f32x4 t0 = *(const LAS f32x4*)(WL + st_ * 68 + c0), t1 = *(const LAS f32x4*)(WL + st_ * 68 + c0 + 4), u0 = *(const LAS f32x4*)(WL + 63 * 68 + c0), u1 = *(const LAS f32x4*)(WL + 63 * 68 + c0 + 4);
#pragma unroll
            for (int j = 0; j < 4; ++j) { cs[j] = t0[j]; cs[4 + j] = t1[j]; cC[j] = u0[j]; cC[4 + j] = u1[j]; } }
          float At[8], Rt[8], Bt[8], Kt[8], Bh[8], Kh[8];
#pragma unroll
          for (int j = 0; j < 8; ++j) { const float gi = __expf(cs[j]), gt = __expf(-cs[j]), gh = __expf(cs[j] - cC[j]);
              At[j] = av[j] * __expf(ee[j] - cs[j]); Rt[j] = rr[j] * gt; Bt[j] = bv[j] * gi; Kt[j] = kp[j] * gi; Bh[j] = bv[j] * gh; Kh[j] = kp[j] * gh; }
          *(LAS v4u*)(s0 + st_ * LT + c0) = pack8(At); *(LAS v4u*)(s1 + st_ * LT + c0) = pack8(Rt); *(LAS v4u*)(s2 + st_ * LT + c0) = pack8(Bt); *(LAS v4u*)(s3 + st_ * LT + c0) = pack8(Kt);
#pragma unroll
          for (int j = 0; j < 8; ++j) { s4[(c0 + j) * LT + st_] = (bf16)f2bf(At[j]); s5[(c0 + j) * LT + st_] = (bf16)f2bf(Bh[j]); s6[(c0 + j) * LT + st_] = (bf16)f2bf(Kh[j]); s7[(c0 + j) * LT + st_] = (bf16)f2bf(vv[j]); }
          if (st_ == 63) {
#pragma unroll
              for (int j = 0; j < 8; ++j) GC[c0 + j] = __expf(-cC[j]); }
          for (int i = tid; i < 2 * SLOT * 2 / 16; i += NTHR) ((LAS v4u*)s12)[i] = (v4u){0u, 0u, 0u, 0u}; }
        __syncthreads();
        f32x4 lrk[2];
#pragma unroll
        for (int xi = 0; xi < 2; ++xi) { const int xt = xb + xi, x0 = xt * 16; const int yr = y0 + l16, xc = x0 + 4 * q4; const f32x4 z = {0.f, 0.f, 0.f, 0.f};
            f32x4 acc = tile2(s2, x0, s0, y0, lane, z);
#pragma unroll
            for (int r = 0; r < 4; ++r) acc[r] = (xc + r < yr) ? acc[r] : 0.f;
            if (yt == xt) *(LAS f32x4*)(DIAG + (yt * 16 + l16) * 16 + 4 * q4) = acc;
            st4(s8, yr, xc, ((yt == 1 && xt == 0) || (yt == 3 && xt == 2)) ? acc : z);
            st4(s9, yr, xc, (yt >= 2 && xt <= 1) ? acc : z);
            acc = tile2(s0, x0, s3, y0, lane, z);
#pragma unroll
            for (int r = 0; r < 4; ++r) acc[r] = (yr < xc + r) ? acc[r] : 0.f;
            st4(s10, yr, xc, acc);
            acc = tile2(s2, x0, s1, y0, lane, z);
#pragma unroll
            for (int r = 0; r < 4; ++r) acc[r] = (xc + r <= yr) ? acc[r] : 0.f;
            st4(s11, yr, xc, acc);
            acc = tile2(s3, x0, s1, y0, lane, z);
#pragma unroll
            for (int r = 0; r < 4; ++r) acc[r] = (xc + r <= yr) ? acc[r] : 0.f;
            lrk[xi] = acc; }
        __syncthreads();
        if (wave == 0) { const LAS float* Lb = DIAG + q4 * 256; float x[16];
#pragma unroll
            for (int r = 0; r < 16; ++r) { float s = (r == l16) ? 1.0f : 0.0f;
#pragma unroll
                for (int j = 0; j < r; ++j) s += Lb[r * 16 + j] * x[j];
                x[r] = s; }
#pragma unroll
            for (int r = 0; r < 16; ++r) s12[(q4 * 16 + r) * LT + q4 * 16 + l16] = (bf16)f2bf(x[r]);
            { float lo[8], hi[8];
#pragma unroll
              for (int r = 0; r < 8; ++r) { lo[r] = x[r]; hi[r] = x[8 + r]; }
              *(LAS v4u*)(s13 + (q4 * 16 + l16) * LT + q4 * 16) = pack8(lo); *(LAS v4u*)(s13 + (q4 * 16 + l16) * LT + q4 * 16 + 8) = pack8(hi); } }
        __syncthreads();
        const f32x4 z4 = {0.f, 0.f, 0.f, 0.f};
#pragma unroll
        for (int xi = 0; xi < 2; ++xi) { const int x0 = (xb + xi) * 16; st4(s0, y0 + l16, x0 + 4 * q4, tile2(s8, x0, s13, y0, lane, z4)); }
        __syncthreads();
#pragma unroll
        for (int xi = 0; xi < 2; ++xi) { const int x0 = (xb + xi) * 16, yr = y0 + l16, xc = x0 + 4 * q4;
            st4(s2, yr, xc, tile2(s0, x0, s12, y0, lane, ld4(s12, yr, xc)));
            st4(s3, yr, xc, tile2(s12, x0, s0, y0, lane, ld4(s13, yr, xc))); }
        __syncthreads();
#pragma unroll
        for (int xi = 0; xi < 2; ++xi) { const int x0 = (xb + xi) * 16; st4(s0, y0 + l16, x0 + 4 * q4, tile2(s9, x0, s3, y0, lane, z4)); }
        __syncthreads();
#pragma unroll
        for (int xi = 0; xi < 2; ++xi) { const int x0 = (xb + xi) * 16, yr = y0 + l16, xc = x0 + 4 * q4; st4(s12, yr, xc, tile2(s0, x0, s2, y0, lane, ld4(s2, yr, xc))); }
        __syncthreads();
#pragma unroll
        for (int xi = 0; xi < 2; ++xi) { const int x0 = (xb + xi) * 16, yr = y0 + l16, xc = x0 + 4 * q4;
            st4(s13, yr, xc, tile2(s12, x0, s4, y0, lane, z4));
            st4(s0, yr, xc, tile2(s12, x0, s10, y0, lane, z4)); }
        __syncthreads();
#pragma unroll
        for (int xi = 0; xi < 2; ++xi) { const int xt = xb + xi, x0 = xt * 16, yr = y0 + l16, xc = x0 + 4 * q4;
            f32x4 acc = tile2(s13, x0, s11, y0, lane, ld4(s1, yr, xc));
            *(v2u*)(GY + (size_t)u * 4096 + yr * 64 + xc) = pack4(acc);
            st4(s2, yr, xc, tile2(s0, x0, s11, y0, lane, lrk[xi]));
            acc = tile2(s13, x0, s5, y0, lane, z4);
#pragma unroll
            for (int r = 0; r < 4; ++r) acc[r] += (xc + r == yr) ? GC[yr] : 0.f;
            *(v2u*)(GS + (size_t)u * 4096 + yr * 64 + xc) = pack4(acc);
            st4(s3, yr, xc, tile2(s0, x0, s5, y0, lane, ld4(s6, yr, xc))); }
        __syncthreads();
#pragma unroll
        for (int xi = 0; xi < 2; ++xi) { const int x0 = (xb + xi) * 16, yr = y0 + l16, xc = x0 + 4 * q4;
            *(v2u*)(YS + (size_t)u * 4096 + yr * 64 + xc) = pack4(tile2(s7, x0, s2, y0, lane, z4));
            *(v2u*)(SS + (size_t)u * 4096 + yr * 64 + xc) = pack4(tile2(s3, x0, s7, y0, lane, z4)); }
        __syncthreads();
    }
}

struct RwBRegs { v2u g[4][2][2]; v2u s[4]; };
__device__ __forceinline__ void rwB_load(RwBRegs& R, const bf16* GS, const bf16* SS, size_t u, int vg, int l16, int q4) {
#pragma unroll
    for (int mt = 0; mt < 4; ++mt) {
#pragma unroll
        for (int s = 0; s < 2; ++s) { const bf16* p = GS + u * 4096 + (mt * 16 + l16) * 64 + 32 * s + 4 * q4; R.g[mt][s][0] = *(const v2u*)p; R.g[mt][s][1] = *(const v2u*)(p + 16); }
        R.s[mt] = *(const v2u*)(SS + u * 4096 + (vg * 16 + l16) * 64 + mt * 16 + 4 * q4); }
}
__device__ __forceinline__ void phase_rwB(const Args& a, int lane, int wave, int bid, int G) {
    if (wave != 0) return;
    unsigned char* ws = a.ws; const bf16* GS = (const bf16*)((const unsigned char*)a.out + RW_GS); const bf16* SS = (const bf16*)((const unsigned char*)a.out + RW_SS); bf16* H0 = (bf16*)(ws + WS_H0);
    const int q4 = lane >> 4, l16 = lane & 15;
    for (int ch = bid; ch < 256; ch += G) {
        const int bh = ch >> 2, vg = ch & 3; const size_t u0 = (size_t)bh * 32;
        f32x4 H[4];
#pragma unroll
        for (int mt = 0; mt < 4; ++mt) H[mt] = (f32x4){0.f, 0.f, 0.f, 0.f};
        RwBRegs nxt; rwB_load(nxt, GS, SS, u0, vg, l16, q4);
        for (int c = 0; c < 32; ++c) {
            const RwBRegs cur = nxt;
            if (c + 1 < 32) rwB_load(nxt, GS, SS, u0 + c + 1, vg, l16, q4);
            v4u hf[2];
#pragma unroll
            for (int s = 0; s < 2; ++s) { const v2u lo = pack4(H[2 * s]), hi = pack4(H[2 * s + 1]); hf[s] = (v4u){lo.x, lo.y, hi.x, hi.y};
                bf16* hp = H0 + (u0 + c) * 4096 + (vg * 16 + l16) * 64 + 32 * s + 4 * q4; *(v2u*)hp = lo; *(v2u*)(hp + 16) = hi; }
#pragma unroll
            for (int mt = 0; mt < 4; ++mt) { f32x4 acc = unpack4(cur.s[mt]);
#pragma unroll
                for (int s = 0; s < 2; ++s) { const v4u af = {cur.g[mt][s][0].x, cur.g[mt][s][0].y, cur.g[mt][s][1].x, cur.g[mt][s][1].y};
                    acc = mfma16(__builtin_bit_cast(bf16x8, af), __builtin_bit_cast(bf16x8, hf[s]), acc); }
                H[mt] = acc; }
        }
    }
}

__device__ __forceinline__ void phase_rwC(const Args& a, int lane, int wave, int bid, int G) {
    unsigned char* ws = a.ws; const bf16* P = (const bf16*)(ws + WS_P);
    const bf16* GY = (const bf16*)((const unsigned char*)a.out + RW_GY); const bf16* YS = (const bf16*)((const unsigned char*)a.out + RW_YS); const bf16* H0 = (const bf16*)(ws + WS_H0);
    const bf16* G2T = (const bf16*)(ws + WS_G2T); const float* BON = (const float*)(ws + WS_BONUS); const float* mu = a.in[3]; const float* lg = a.in[12]; const float* lb = a.in[13];
    bf16* OA = (bf16*)(ws + WS_OA);
    const int q4 = lane >> 4, l16 = lane & 15; const int gw = bid * NWAVES + wave, NGW = G * NWAVES;
    for (int task = gw; task < 8192; task += NGW) {
        const int u = task >> 2, tt = task & 3; const int b = u >> 9, h = (u >> 5) & 15, c = u & 31;
        const int tl = tt * 16 + l16; const size_t tg = (size_t)b * SEQ + c * 64 + tl; const bool first = (c == 0 && tl == 0);
        f32x4 y[4], g[4];
        { const bf16x8 yf0 = *(const bf16x8*)(GY + (size_t)u * 4096 + tl * 64 + q4 * 8), yf1 = *(const bf16x8*)(GY + (size_t)u * 4096 + tl * 64 + 32 + q4 * 8);
#pragma unroll
          for (int vt = 0; vt < 4; ++vt) { f32x4 acc = unpack4(*(const v2u*)(YS + (size_t)u * 4096 + tl * 64 + vt * 16 + 4 * q4));
              const bf16* hp = H0 + (size_t)u * 4096 + (vt * 16 + l16) * 64 + q4 * 8;
              acc = mfma16(*(const bf16x8*)hp, yf0, acc); acc = mfma16(*(const bf16x8*)(hp + 32), yf1, acc); y[vt] = acc; } }
#pragma unroll
        for (int vt = 0; vt < 4; ++vt) g[vt] = (f32x4){0.f, 0.f, 0.f, 0.f};
#pragma unroll
        for (int ks = 0; ks < 8; ++ks) { float x[8]; shift8(P, tg, P_XG + ks * 32 + q4 * 8, first, mu, x);
#pragma unroll
            for (int j = 0; j < 8; ++j) x[j] = sigmoidf_(x[j]);
            const bf16x8 gf = __builtin_bit_cast(bf16x8, pack8(x));
#pragma unroll
            for (int vt = 0; vt < 4; ++vt) g[vt] = mfma16(*(const bf16x8*)(G2T + (size_t)(h * 64 + vt * 16 + l16) * 256 + ks * 32 + q4 * 8), gf, g[vt]); }
        float s = 0.f;
#pragma unroll
        for (int vt = 0; vt < 4; ++vt) s += (y[vt][0] + y[vt][1]) + (y[vt][2] + y[vt][3]);
        s += __shfl_xor(s, 16); s += __shfl_xor(s, 32);
        const float mean = s * (1.0f / 64.0f); float q = 0.f;
#pragma unroll
        for (int vt = 0; vt < 4; ++vt)
#pragma unroll
            for (int r = 0; r < 4; ++r) { const float d = y[vt][r] - mean; q += d * d; }
        q += __shfl_xor(q, 16); q += __shfl_xor(q, 32);
        const float rstd = rsqrtf(q * (1.0f / 64.0f) + 64e-5f); const float bon = BON[tg * RW_H + h];
#pragma unroll
        for (int vt = 0; vt < 4; ++vt) { const int chn = h * 64 + vt * 16 + 4 * q4;
            const v2u cur = *(const v2u*)(P + tg * NP + 2048 + chn); v2u prv = {0u, 0u}; if (!first) prv = *(const v2u*)(P + (tg - 1) * NP + 2048 + chn);
            const f32x4 cv = unpack4(cur), pv = unpack4(prv), m4 = *(const f32x4*)(mu + 2048 + chn), lg4 = *(const f32x4*)(lg + chn), lb4 = *(const f32x4*)(lb + chn);
            f32x4 o;
#pragma unroll
            for (int r = 0; r < 4; ++r) { const float vsh = cv[r] + (pv[r] - cv[r]) * m4[r]; o[r] = ((y[vt][r] - mean) * rstd * lg4[r] + lb4[r] + bon * vsh) * g[vt][r]; }
            *(v2u*)(OA + tg * RW_W + chn) = pack4(o); }
    }
}

constexpr int NPHASE = 14;
__global__ void __launch_bounds__(NTHR, 2) mega_fwd(Args args) {
    extern __shared__ __attribute__((aligned(16))) unsigned char lds_raw[];
    LAS unsigned char* lds = (LAS unsigned char*)lds_raw;
    const int tid = threadIdx.x, lane = tid & 63, wave = __builtin_amdgcn_readfirstlane(tid >> 6), bid = blockIdx.x, G = gridDim.x;
    unsigned char* ws = args.ws; unsigned* ctl = (unsigned*)(ws + WS_CTL);
    volatile LAS unsigned* MISC = (volatile LAS unsigned*)(lds + MISC_OFF);
    for (int u = tid; u < (LDS_BYTES - RING_BYTES) / 4; u += NTHR) ((LAS unsigned*)(lds + RING_BYTES))[u] = 0u;
    __syncthreads();
    const int lo = args.ph_lo, hi = args.ph_hi;
    const bool multi = (hi - lo) > 1;
    XcdBarrier bar; bar.bar = ctl + CW_BAR; bar.x = 0; bar.st = nullptr;
    if (multi) bar = xcd_barrier_post(ctl + CW_BAR, MISC + 8);
#ifndef PH_MASK
#define PH_MASK 0x3fff
#endif
#define IN(k) (((PH_MASK >> (k)) & 1) && lo <= (k) && (k) < hi)
#define SEAM(k) do { if (IN(k) && IN((k) + 1)) xcd_barrier(bar); } while (0)
    bf16* P = (bf16*)(ws + WS_P);

    if (IN(0)) { phase_prologue(args, lds, tid, lane, wave, bid, G); } SEAM(0);
    if (IN(1)) { pg8::Gemm g{(const bf16*)(ws + WS_H1), (const bf16*)(ws + WS_WIN), NTOK, NP, DM}; pg8::StaticOrder S; S.init(NTOK, NP, G, bid);
        EpiP E{P}; pg8::gemm_phase<EpiP, pg8::StaticOrder, true, true>(lds, g, S, E); } SEAM(1);
    if (IN(2)) { phase_rwA(args, lds, tid, lane, wave, bid, G); }
    if (IN(3)) { phase_ret_mfma(args, lds, tid, lane, wave, bid, G); } SEAM(3);
    if (IN(4)) { phase_rwB(args, lane, wave, bid, G); } SEAM(4);
    if (IN(5)) { phase_rwC(args, lane, wave, bid, G); phase_retpost(args, lane, wave, bid, G); } SEAM(5);
    if (IN(6)) { pg8::Gemm g{(const bf16*)(ws + WS_OA), (const bf16*)(ws + WS_WUPA), NTOK, DM, 1024}; pg8::StaticOrder S; S.init(NTOK, DM, G, bid);
        EpiUp<0> E{(bf16*)(ws + WS_MERGED), P}; pg8::gemm_phase<EpiUp<0>, pg8::StaticOrder, false, true>(lds, g, S, E); } SEAM(6);
    if (IN(7)) { pg8::Gemm g{(const bf16*)(ws + WS_OB), (const bf16*)(ws + WS_WUPB), NTOK, DM, DM}; pg8::StaticOrder S; S.init(NTOK, DM, G, bid);
        EpiUp<1> E{(bf16*)(ws + WS_MERGED), P}; pg8::gemm_phase<EpiUp<1>, pg8::StaticOrder, false, true>(lds, g, S, E); } SEAM(7);
    if (IN(8)) { pg8::Gemm g{(const bf16*)(ws + WS_MERGED), (const bf16*)(ws + WS_WOUT), NTOK, DM, DM}; pg8::StaticOrder S; S.init(NTOK, DM, G, bid);
        EpiX1 E{args.in[0], args.out}; pg8::gemm_phase<EpiX1, pg8::StaticOrder, false, true>(lds, g, S, E); } SEAM(8);
    if (IN(9)) { phase_router(args, lane, wave, bid, G); } SEAM(9);
    if (IN(10)) { phase_gather(args, lds, tid, lane, wave, bid, G); } SEAM(10);
    if (IN(11)) { pg8::Gemm g{(const bf16*)(ws + WS_XG), (const bf16*)(ws + WS_WGU), MAXSLOT, NEXP * 1024, DM}; MoeOrder<4> S; S.init(ctl, G, bid);
        EpiGU E{(bf16*)(ws + WS_ACT)}; pg8::gemm_phase<EpiGU, MoeOrder<4>, true, true>(lds, g, S, E); } SEAM(11);
    if (IN(12)) { pg8::Gemm g{(const bf16*)(ws + WS_ACT), (const bf16*)(ws + WS_WDN), MAXSLOT, NEXP * 2048, EFF}; MoeOrder<8> S; S.init(ctl, G, bid);
        EpiDn E{(bf16*)(ws + WS_YS)}; pg8::gemm_phase<EpiDn, MoeOrder<8>, true, true>(lds, g, S, E); } SEAM(12);
    if (IN(13)) { phase_final(args, lane, wave, bid, G); }
#undef IN
#undef SEAM
}

#ifndef MK_ONE_LAUNCH
#define MK_ONE_LAUNCH 1
#endif
extern "C" void kernel_launch(void* const* d_in, const int* in_sizes, int n_in, void* d_out, int out_size, void* d_ws, size_t ws_size, hipStream_t stream) {
    static int grid = 0;
    if (grid == 0) {
        if (n_in != 27 || out_size != NTOK * DM || ws_size < WS_END) { fprintf(stderr, "kernel_launch: unexpected shapes (n_in %d out %d ws %zu, need %zu)\n", n_in, out_size, ws_size, (size_t)WS_END); grid = -1; return; }
        int dev = 0, cus = 0, per_cu = 0;
        if (hipGetDevice(&dev) != hipSuccess || hipDeviceGetAttribute(&cus, hipDeviceAttributeMultiprocessorCount, dev) != hipSuccess) { grid = -1; return; }
        if (hipFuncSetAttribute((const void*)mega_fwd, hipFuncAttributeMaxDynamicSharedMemorySize, LDS_BYTES) != hipSuccess) { fprintf(stderr, "kernel_launch: hipFuncSetAttribute failed\n"); grid = -1; return; }
        if (hipOccupancyMaxActiveBlocksPerMultiprocessor(&per_cu, (const void*)mega_fwd, NTHR, LDS_BYTES) != hipSuccess || per_cu < 1) { fprintf(stderr, "kernel_launch: occupancy query says %d\n", per_cu); grid = -1; (void)hipGetLastError(); return; }
        grid = cus;
    }
    if (grid < 0) return;
    (void)in_sizes;
    if (hipMemsetAsync((char*)d_ws + WS_CTL, 0, CTL_ZERO_BYTES, stream) != hipSuccess) return;
    Args a{};
    for (int i = 0; i < 27; ++i) a.in[i] = (const float*)d_in[i];
    a.out = (float*)d_out; a.ws = (unsigned char*)d_ws;
#if MK_ONE_LAUNCH
    a.ph_lo = 0; a.ph_hi = NPHASE;
    hipLaunchKernelGGL(mega_fwd, dim3(grid), dim3(NTHR), LDS_BYTES, stream, a);
#else
    for (int p = 0; p < NPHASE; ++p) { a.ph_lo = p; a.ph_hi = p + 1; hipLaunchKernelGGL(mega_fwd, dim3(grid), dim3(NTHR), LDS_BYTES, stream, a); }
#endif
}
```

```cpp
#include <hip/hip_runtime.h>
#include <cstdio>
#include <cstdint>
namespace pg8 {
#define PG8_LAS __attribute__((address_space(3)))
typedef unsigned short bf16_t;
typedef short bf16x8 __attribute__((ext_vector_type(8)));
typedef float f32x4 __attribute__((ext_vector_type(4)));
typedef unsigned u32x4 __attribute__((ext_vector_type(4)));
constexpr int BM = 256, BK = 64, HALF = 128, HTB = HALF * BK * 2  , STAGE_BYTES = 8 * HTB, NXCD = 8, WGM = 8;

__host__ __device__ __forceinline__ int lds_byte(int r, int c) { const int st = (r >> 4) * 2 + (c >> 5), rr = r & 15, cc = c & 31, ob = rr * 64 + cc * 2; return st * 1024 + (ob ^ (((ob >> 9) & 1) << 5)); }
__host__ __device__ __forceinline__ void stage_rc(int b, int& R, int& C) { const int st = b / 1024, sb = b % 1024, swz = sb ^ (((sb >> 9) & 1) << 5); R = (st >> 1) * 16 + swz / 64; C = (st & 1) * 32 + (swz % 64) / 2; }
__host__ __device__ __forceinline__ int perm32(int rho) { const int n = rho >> 4, i = rho & 15; return 8 * (i >> 2) + 4 * n + (i & 3); }

struct Unit { int pm, pn; };
struct Gemm { const bf16_t* A; const bf16_t* Bt; int M, N, K; };

struct StaticOrder {
    int nM, nN, nwg, G, c;
    __host__ __device__ void init(int M, int N, int G_, int c_) { nM = M / BM; nN = N / BM; nwg = nM * nN; G = G_; c = c_; }
    __host__ __device__ bool next(int i, Unit& u) const {
        const long L = (long)i * G + c; if (L >= nwg) return false;
        int wgid = (int)L; { const int q = nwg / NXCD, r = nwg % NXCD, xcd = wgid % NXCD, off = wgid / NXCD; wgid = (xcd < r ? xcd * (q + 1) : r * (q + 1) + (xcd - r) * q) + off; }
        const int nig = WGM * nN, gid = wgid / nig, fm = gid * WGM, gsz = (nM - fm) < WGM ? (nM - fm) : WGM;
        u.pm = fm + ((wgid % nig) % gsz); u.pn = (wgid % nig) / gsz; return true;
    }
    __device__ __forceinline__ void a_ready(const Unit&) const {}
    __device__ __forceinline__ void done(const Unit&) const {}
};

__device__ __forceinline__ unsigned cvt_pk_bf16(float lo, float hi) { unsigned r; asm volatile("v_cvt_pk_bf16_f32 %0, %1, %2" : "=v"(r) : "v"(lo), "v"(hi)); return r; }
typedef float f32x2 __attribute__((ext_vector_type(2)));
template <class Epi, class Sched, bool ALIGN_EPI = false, bool SP2 = false>
__device__ __forceinline__ void gemm_phase(PG8_LAS unsigned char* lds, const Gemm g, const Sched& S, const Epi& E) {
    const int tid = threadIdx.x, wid = __builtin_amdgcn_readfirstlane(tid >> 6), lane = tid & 63, wr = wid >> 2, wc = wid & 3, fr = lane & 15, fq = lane >> 4;
    const int K = g.K, nt = K / BK;
    unsigned voffA[2], voffB[2];
#pragma unroll
    for (int i = 0; i < 2; ++i) { int R, C; stage_rc(tid * 16 + i * 8192, R, C); const int Rb = Epi::PERM ? ((R & ~31) + perm32(R & 31)) : R;
        voffA[i] = (unsigned)(R * K + C) * 2u; voffB[i] = (unsigned)(Rb * K + C) * 2u; }
    const size_t kstep = (size_t)(BK * 2);
    const size_t hstep = (size_t)HALF * K * 2;
    const size_t tstep = 2 * hstep;
    const unsigned ldsw = (unsigned)wid * 1024u;
    const int aoff = lds_byte(wr * 64 + fr, fq * 8), boff = lds_byte(wc * 32 + fr, fq * 8);
#define PG8_SA(b, h) (((b) * 2 + (h)) * HTB)
#define PG8_SB(b, h) ((4 + (b) * 2 + (h)) * HTB)
#define PG8_STAGE(bufoff, gbase, voff) do { _Pragma("unroll") for (int _i = 0; _i < 2; ++_i) \
        __builtin_amdgcn_global_load_lds((const unsigned*)((const char*)(gbase) + (voff)[_i]), (PG8_LAS unsigned*)(lds + (bufoff) + ldsw + _i * 8192), 16, 0, 0); } while (0)
#define PG8_LDA(dst, b, h) do { _Pragma("unroll") for (int m = 0; m < 4; ++m) _Pragma("unroll") for (int k = 0; k < 2; ++k) dst[m][k] = *(const PG8_LAS bf16x8*)(lds + PG8_SA(b, h) + aoff + m * 2048 + k * 1024); } while (0)
#define PG8_LDB(dst, b, h) do { _Pragma("unroll") for (int n = 0; n < 2; ++n) _Pragma("unroll") for (int k = 0; k < 2; ++k) dst[n][k] = *(const PG8_LAS bf16x8*)(lds + PG8_SB(b, h) + boff + n * 2048 + k * 1024); } while (0)
#define PG8_MMA(ai, bj, At, Bt) do { __builtin_amdgcn_s_setprio(1); _Pragma("unroll") for (int m = 0; m < 4; ++m) _Pragma("unroll") for (int n = 0; n < 2; ++n) _Pragma("unroll") for (int k = 0; k < 2; ++k) \
        acc[ai][bj][m][n] = __builtin_amdgcn_mfma_f32_16x16x32_bf16(Bt[n][k], At[m][k], acc[ai][bj][m][n], 0, 0, 0); __builtin_amdgcn_s_setprio(0); } while (0)
#define PG8_WAIT_V(n) asm volatile("s_waitcnt vmcnt(" #n ")" ::: "memory")
#define PG8_WAIT_L(n) asm volatile("s_waitcnt lgkmcnt(" #n ")" ::: "memory")
#define PG8_BAR __builtin_amdgcn_s_barrier()
#define PG8_SCHED __builtin_amdgcn_sched_barrier(0)
    Unit cur, nxt; int ui = 0;
    if (!S.next(0, cur)) return;
    f32x4 acc[2][2][4][2];
#pragma unroll
    for (int a = 0; a < 2; ++a)
#pragma unroll
        for (int b = 0; b < 2; ++b)
#pragma unroll
            for (int m = 0; m < 4; ++m)
#pragma unroll
                for (int n = 0; n < 2; ++n) acc[a][b][m][n] = (f32x4){0.f, 0.f, 0.f, 0.f};
    bf16x8 At[4][2], B0[2][2], B1[2][2];
    const char* cA = (const char*)g.A + (size_t)cur.pm * tstep; const char* cB = (const char*)g.Bt + (size_t)cur.pn * tstep;
    S.a_ready(cur);
    if constexpr (SP2) {
        PG8_STAGE(PG8_SB(0, 0), cB, voffB); PG8_STAGE(PG8_SB(0, 1), cB + hstep, voffB); PG8_STAGE(PG8_SA(0, 0), cA, voffA); PG8_STAGE(PG8_SA(0, 1), cA + hstep, voffA);
        if (wr == 1) PG8_BAR;
        PG8_WAIT_V(2); PG8_BAR;
        PG8_STAGE(PG8_SB(1, 0), cB + kstep, voffB); PG8_STAGE(PG8_SA(1, 0), cA + kstep, voffA); PG8_STAGE(PG8_SB(1, 1), cB + hstep + kstep, voffB);
        PG8_WAIT_V(6); PG8_BAR;
    } else {
        PG8_STAGE(PG8_SB(0, 0), cB, voffB); PG8_STAGE(PG8_SA(0, 0), cA, voffA); PG8_STAGE(PG8_SB(0, 1), cB + hstep, voffB); PG8_STAGE(PG8_SA(0, 1), cA + hstep, voffA);
        if (wr == 1) PG8_BAR;
        PG8_WAIT_V(4); PG8_BAR;
        PG8_STAGE(PG8_SB(1, 0), cB + kstep, voffB); PG8_STAGE(PG8_SA(1, 0), cA + kstep, voffA); PG8_STAGE(PG8_SB(1, 1), cB + hstep + kstep, voffB);
        PG8_WAIT_V(6); PG8_BAR;
    }
    for (;;) {
        const bool has_next = S.next(ui + 1, nxt);
        const char* nA = has_next ? (const char*)g.A + (size_t)nxt.pm * tstep : cA; const char* nB = has_next ? (const char*)g.Bt + (size_t)nxt.pn * tstep : cB;
        for (int t = 0; t < nt; t += 2) {
            const bool last = (t == nt - 2);
            const char* a1 = cA + (size_t)(t + 1) * kstep;
            const char* a2 = last ? nA : cA + (size_t)(t + 2) * kstep; const char* b2 = last ? nB : cB + (size_t)(t + 2) * kstep;
            const char* a3 = a2 + kstep; const char* b3 = b2 + kstep;
            if (last && has_next) S.a_ready(nxt);
            if constexpr (SP2) {
            PG8_LDB(B0, 0, 0); PG8_LDB(B1, 0, 1); PG8_SCHED; PG8_LDA(At, 0, 0); PG8_STAGE(PG8_SA(1, 1), a1 + hstep, voffA);
            PG8_WAIT_V(8); PG8_WAIT_L(0); PG8_BAR; PG8_MMA(0, 0, At, B0); PG8_MMA(0, 1, At, B1); PG8_BAR; PG8_SCHED;
            PG8_LDA(At, 0, 1); PG8_STAGE(PG8_SB(0, 0), b2, voffB); PG8_STAGE(PG8_SB(0, 1), b2 + hstep, voffB); PG8_STAGE(PG8_SA(0, 0), a2, voffA);
            PG8_WAIT_V(8); PG8_WAIT_L(0); PG8_BAR; PG8_MMA(1, 0, At, B0); PG8_MMA(1, 1, At, B1); PG8_BAR; PG8_SCHED;
            PG8_LDB(B0, 1, 0); PG8_LDB(B1, 1, 1); PG8_SCHED; PG8_LDA(At, 1, 0); PG8_STAGE(PG8_SA(0, 1), a2 + hstep, voffA);
            PG8_WAIT_V(8); PG8_WAIT_L(0); PG8_BAR; PG8_MMA(0, 0, At, B0); PG8_MMA(0, 1, At, B1); PG8_BAR; PG8_SCHED;
            PG8_LDA(At, 1, 1); PG8_STAGE(PG8_SB(1, 0), b3, voffB); PG8_STAGE(PG8_SB(1, 1), b3 + hstep, voffB); PG8_STAGE(PG8_SA(1, 0), a3, voffA);
            PG8_WAIT_V(8); PG8_WAIT_L(0); PG8_BAR; PG8_MMA(1, 0, At, B0); PG8_MMA(1, 1, At, B1); PG8_BAR; PG8_SCHED;
            } else {
            PG8_LDB(B0, 0, 0); PG8_SCHED; PG8_LDA(At, 0, 0); PG8_STAGE(PG8_SA(1, 1), a1 + hstep, voffA);
            PG8_WAIT_L(8); PG8_BAR; PG8_WAIT_L(0); PG8_MMA(0, 0, At, B0); PG8_BAR; PG8_SCHED;
            PG8_LDB(B1, 0, 1); PG8_STAGE(PG8_SB(0, 0), b2, voffB);
            PG8_BAR; PG8_WAIT_L(0); PG8_MMA(0, 1, At, B1); PG8_BAR;
            PG8_LDA(At, 0, 1); PG8_STAGE(PG8_SA(0, 0), a2, voffA);
            PG8_BAR; PG8_WAIT_L(0); PG8_MMA(1, 0, At, B0); PG8_BAR; PG8_SCHED;
            PG8_STAGE(PG8_SB(0, 1), b2 + hstep, voffB);
            PG8_WAIT_V(6); PG8_BAR; PG8_MMA(1, 1, At, B1); PG8_BAR;
            PG8_LDB(B0, 1, 0); PG8_SCHED; PG8_LDA(At, 1, 0); PG8_STAGE(PG8_SA(0, 1), a2 + hstep, voffA);
            PG8_WAIT_L(8); PG8_BAR; PG8_WAIT_L(0); PG8_MMA(0, 0, At, B0); PG8_BAR; PG8_SCHED;
            PG8_LDB(B1, 1, 1); PG8_STAGE(PG8_SB(1, 0), b3, voffB);
            PG8_BAR; PG8_WAIT_L(0); PG8_MMA(0, 1, At, B1); PG8_BAR;
            PG8_LDA(At, 1, 1); PG8_STAGE(PG8_SA(1, 0), a3, voffA);
            PG8_BAR; PG8_WAIT_L(0); PG8_MMA(1, 0, At, B0); PG8_BAR; PG8_SCHED;
            PG8_STAGE(PG8_SB(1, 1), b3 + hstep, voffB);
            PG8_WAIT_V(6); PG8_BAR; PG8_MMA(1, 1, At, B1); PG8_BAR;
            }
        }
        if constexpr (ALIGN_EPI) { if (wr == 0) PG8_BAR; }
        if constexpr (!Epi::AFTER_DRAIN) { E(acc, cur, wr, wc, fr, fq); S.done(cur); }
        if (!has_next) break;
#pragma unroll
        for (int a = 0; a < 2; ++a)
#pragma unroll
            for (int b = 0; b < 2; ++b)
#pragma unroll
                for (int m = 0; m < 4; ++m)
#pragma unroll
                    for (int n = 0; n < 2; ++n) acc[a][b][m][n] = (f32x4){0.f, 0.f, 0.f, 0.f};
        cur = nxt; cA = nA; cB = nB; ++ui;
        if constexpr (ALIGN_EPI) { if (wr == 1) PG8_BAR; }
    }
    PG8_WAIT_V(0);
    if constexpr (!ALIGN_EPI) { if (wr == 0) PG8_BAR; }
    PG8_BAR;
    if constexpr (Epi::AFTER_DRAIN) { E.fused(acc, cur, wr, wc, fr, fq, lds, wid, lane); S.done(cur); }
#undef PG8_SA
#undef PG8_SB
#undef PG8_STAGE
#undef PG8_LDA
#undef PG8_LDB
#undef PG8_MMA
#undef PG8_WAIT_V
#undef PG8_WAIT_L
#undef PG8_BAR
#undef PG8_SCHED
}
}

#define GAS __attribute__((address_space(1)))
#define LAS __attribute__((address_space(3)))
typedef unsigned short bf16;
typedef unsigned v4u __attribute__((ext_vector_type(4)));
typedef unsigned v2u __attribute__((ext_vector_type(2)));
typedef float f32x4 __attribute__((ext_vector_type(4)));
typedef GAS unsigned gu32;
#define RLX_AGENT __ATOMIC_RELAXED, __HIP_MEMORY_SCOPE_AGENT
#define LDS_WAIT() asm volatile("s_waitcnt lgkmcnt(0)" ::: "memory")
#define VM_WAIT() asm volatile("s_waitcnt vmcnt(0)" ::: "memory")

constexpr int NTOK = 8192, SEQ = 2048, DM = 2048, NP = 13824, NWAVES = 8, NTHR = 512;
constexpr int RW_W = 1024, RW_H = 16, RW_N = 64;
constexpr int P_XW = 3072, P_XA = 3168, P_XG = 3264;
constexpr int P_RQ = 3584, P_RK = 4608, P_RV = 5632, P_RG = 7680, P_GA = 9728, P_GB = 11776;
constexpr int RET_H = 8, RET_DK = 128, RET_DV = 256, RET_VW = 2048;
constexpr int NEXP = 32, EFF = 512, MAXT = 96, MAXSLOT = MAXT * 256;

constexpr size_t MiB = 1u << 20;
constexpr size_t WS_CTL = 0, CTL_ZERO_BYTES = 256 * 1024;
constexpr size_t WS_ROT = 1 * MiB;
constexpr size_t WS_TOKE = 2 * MiB;
constexpr size_t WS_TOKW = WS_TOKE + 65536;
constexpr size_t WS_TOKP = WS_TOKW + 65536;
constexpr size_t WS_TOKS = WS_TOKP + 65536;
constexpr size_t WS_BONUS = WS_TOKS + 65536;
constexpr size_t WS_WUPA = 3 * MiB, WS_WUPB = 7 * MiB, WS_WOUT = 15 * MiB;
constexpr size_t WS_WGU = 23 * MiB, WS_WDN = 151 * MiB;
constexpr size_t WS_P = 215 * MiB;
constexpr size_t WS_RA = 431 * MiB;
constexpr size_t WS_WIN = WS_RA, WS_H1 = WS_RA + 54 * MiB;
constexpr size_t WS_OA = WS_RA, WS_OB = WS_RA + 16 * MiB;
constexpr size_t WS_RB = 517 * MiB;
constexpr size_t WS_RWE = WS_RB, WS_RWA = WS_RB + 16 * MiB, WS_RWB = WS_RB + 32 * MiB, WS_MERGED = WS_RB;
constexpr size_t WS_END = 565 * MiB;
constexpr size_t WS_H2 = WS_P, WS_XG = WS_P + 32 * MiB, WS_YS = WS_XG, WS_ACT = WS_XG + 96 * MiB;
constexpr int CW_BAR = 1024;
constexpr int CW_CNT = 8192;
constexpr int CW_NT = 8256;
constexpr int CW_TE = 8320;
constexpr int CW_PS = 8448;

constexpr int RING_BYTES = 131072, MISC_OFF = RING_BYTES + 320, LDS_BYTES = 147456;

struct Args { const float* in[27]; float* out; unsigned char* ws; int ph_lo, ph_hi; };

__device__ __forceinline__ float bf2f(unsigned short b) { return __uint_as_float(((unsigned)b) << 16); }
__device__ __forceinline__ float bflo(unsigned u) { return __uint_as_float(u << 16); }
__device__ __forceinline__ float bfhi(unsigned u) { return __uint_as_float(u & 0xffff0000u); }
__device__ __forceinline__ unsigned f2bf(float f) { unsigned u = __float_as_uint(f); return (u + 0x7fffu + ((u >> 16) & 1u)) >> 16; }
__device__ __forceinline__ unsigned pk2(float lo, float hi) { return f2bf(lo) | (f2bf(hi) << 16); }
__device__ __forceinline__ float sigmoidf_(float x) { return 1.0f / (1.0f + __expf(-x)); }
__device__ __forceinline__ float wave_sum(float v) {
#pragma unroll
    for (int o = 1; o < 64; o <<= 1) v += __shfl_xor(v, o);
    return v;
}

struct EpiP {
    static constexpr bool PERM = true, AFTER_DRAIN = false;
    bf16* O;
    __device__ __forceinline__ void operator()(const pg8::f32x4 (&acc)[2][2][4][2], const pg8::Unit& u, int wr, int wc, int fr, int fq) const {
        const int row0 = u.pm * 256 + wr * 64 + fr, col0 = u.pn * 256 + wc * 32 + 8 * fq;
        const int mode = u.pn >= 38 ? 2 : (u.pn >= 30 ? 1 : 0);
#pragma unroll
        for (int ai = 0; ai < 2; ++ai)
#pragma unroll
            for (int m = 0; m < 4; ++m) { bf16* rowp = O + (size_t)(row0 + ai * 128 + m * 16) * NP + col0;
#pragma unroll
                for (int bj = 0; bj < 2; ++bj) { pg8::f32x4 v0 = acc[ai][bj][m][0], v1 = acc[ai][bj][m][1];
                    if (mode) {
#pragma unroll
                        for (int j = 0; j < 4; ++j) { const float s0 = sigmoidf_(v0[j]), s1 = sigmoidf_(v1[j]); v0[j] = mode == 2 ? s0 : v0[j] * s0; v1[j] = mode == 2 ? s1 : v1[j] * s1; } }
                    pg8::u32x4 w; w.x = pg8::cvt_pk_bf16(v0[0], v0[1]); w.y = pg8::cvt_pk_bf16(v0[2], v0[3]); w.z = pg8::cvt_pk_bf16(v1[0], v1[1]); w.w = pg8::cvt_pk_bf16(v1[2], v1[3]);
                    *(pg8::u32x4*)(rowp + bj * 128) = w; } }
    }
};
template <int MODE> struct EpiUp {
    static constexpr bool PERM = true, AFTER_DRAIN = false;
    bf16* O; const bf16* P;
    __device__ __forceinline__ void operator()(const pg8::f32x4 (&acc)[2][2][4][2], const pg8::Unit& u, int wr, int wc, int fr, int fq) const {
        const int row0 = u.pm * 256 + wr * 64 + fr, col0 = u.pn * 256 + wc * 32 + 8 * fq;
#pragma unroll
        for (int ai = 0; ai < 2; ++ai)
#pragma unroll
            for (int m = 0; m < 4; ++m) { const int row = row0 + ai * 128 + m * 16; bf16* rowp = O + (size_t)row * DM + col0; const bf16* gp = P + (size_t)row * NP + (MODE ? P_GB : P_GA) + col0;
#pragma unroll
                for (int bj = 0; bj < 2; ++bj) { const pg8::f32x4 v0 = acc[ai][bj][m][0], v1 = acc[ai][bj][m][1];
                    const pg8::u32x4 g = *(const pg8::u32x4*)(gp + bj * 128);
                    float o[8] = { v0[0] * bflo(g.x), v0[1] * bfhi(g.x), v0[2] * bflo(g.y), v0[3] * bfhi(g.y), v1[0] * bflo(g.z), v1[1] * bfhi(g.z), v1[2] * bflo(g.w), v1[3] * bfhi(g.w) };
                    if (MODE) { const pg8::u32x4 p = *(const pg8::u32x4*)(rowp + bj * 128);
                        o[0] += bflo(p.x); o[1] += bfhi(p.x); o[2] += bflo(p.y); o[3] += bfhi(p.y); o[4] += bflo(p.z); o[5] += bfhi(p.z); o[6] += bflo(p.w); o[7] += bfhi(p.w); }
                    pg8::u32x4 w; w.x = pg8::cvt_pk_bf16(o[0], o[1]); w.y = pg8::cvt_pk_bf16(o[2], o[3]); w.z = pg8::cvt_pk_bf16(o[4], o[5]); w.w = pg8::cvt_pk_bf16(o[6], o[7]);
                    *(pg8::u32x4*)(rowp + bj * 128) = w; } }
    }
};
struct EpiX1 {
    static constexpr bool PERM = false, AFTER_DRAIN = false;
    const float* X; float* O;
    __device__ __forceinline__ void operator()(const pg8::f32x4 (&acc)[2][2][4][2], const pg8::Unit& u, int wr, int wc, int fr, int fq) const {
        const int row0 = u.pm * 256 + wr * 64 + fr, col0 = u.pn * 256 + wc * 32 + 4 * fq;
#pragma unroll
        for (int ai = 0; ai < 2; ++ai)
#pragma unroll
            for (int m = 0; m < 4; ++m) { const size_t off = (size_t)(row0 + ai * 128 + m * 16) * DM + col0;
#pragma unroll
                for (int bj = 0; bj < 2; ++bj)
#pragma unroll
                    for (int n = 0; n < 2; ++n) { const pg8::f32x4 xv = *(const pg8::f32x4*)(X + off + bj * 128 + n * 16); *(pg8::f32x4*)(O + off + bj * 128 + n * 16) = xv + acc[ai][bj][m][n]; } }
    }
};
struct EpiGU {
    static constexpr bool PERM = true, AFTER_DRAIN = false;
    bf16* O;
    __device__ __forceinline__ void operator()(const pg8::f32x4 (&acc)[2][2][4][2], const pg8::Unit& u, int wr, int wc, int fr, int fq) const {
        const int row0 = u.pm * 256 + wr * 64 + fr, col0 = (u.pn & 3) * 128 + wc * 32 + 8 * fq;
#pragma unroll
        for (int ai = 0; ai < 2; ++ai)
#pragma unroll
            for (int m = 0; m < 4; ++m) { bf16* rowp = O + (size_t)(row0 + ai * 128 + m * 16) * EFF + col0;
                const pg8::f32x4 g0 = acc[ai][0][m][0], g1 = acc[ai][0][m][1], u0 = acc[ai][1][m][0], u1 = acc[ai][1][m][1];
                float o[8];
#pragma unroll
                for (int j = 0; j < 4; ++j) { o[j] = g0[j] * sigmoidf_(g0[j]) * u0[j]; o[4 + j] = g1[j] * sigmoidf_(g1[j]) * u1[j]; }
                pg8::u32x4 w; w.x = pg8::cvt_pk_bf16(o[0], o[1]); w.y = pg8::cvt_pk_bf16(o[2], o[3]); w.z = pg8::cvt_pk_bf16(o[4], o[5]); w.w = pg8::cvt_pk_bf16(o[6], o[7]);
                *(pg8::u32x4*)rowp = w; }
    }
};
struct EpiDn {
    static constexpr bool PERM = true, AFTER_DRAIN = false;
    bf16* O;
    __device__ __forceinline__ void operator()(const pg8::f32x4 (&acc)[2][2][4][2], const pg8::Unit& u, int wr, int wc, int fr, int fq) const {
        const int row0 = u.pm * 256 + wr * 64 + fr, col0 = (u.pn & 7) * 256 + wc * 32 + 8 * fq;
#pragma unroll
        for (int ai = 0; ai < 2; ++ai)
#pragma unroll
            for (int m = 0; m < 4; ++m) { bf16* rowp = O + (size_t)(row0 + ai * 128 + m * 16) * DM + col0;
#pragma unroll
                for (int bj = 0; bj < 2; ++bj) { const pg8::f32x4 v0 = acc[ai][bj][m][0], v1 = acc[ai][bj][m][1];
                    pg8::u32x4 w; w.x = pg8::cvt_pk_bf16(v0[0], v0[1]); w.y = pg8::cvt_pk_bf16(v0[2], v0[3]); w.z = pg8::cvt_pk_bf16(v1[0], v1[1]); w.w = pg8::cvt_pk_bf16(v1[2], v1[3]);
                    *(pg8::u32x4*)(rowp + bj * 128) = w; } }
    }
};
template <int NB> struct MoeOrder {
    const unsigned* ctl; int G, c, nunits;
    __device__ __forceinline__ void init(const unsigned* ctl_, int G_, int c_) { ctl = ctl_; G = G_; c = c_; nunits = (int)ctl_[CW_NT] * NB; }
    __device__ __forceinline__ bool next(int i, pg8::Unit& u) const {
        const int L = i * G + c; if (L >= nunits) return false;
        u.pm = L / NB; u.pn = (int)ctl[CW_TE + u.pm] * NB + (L % NB); return true;
    }
    __device__ __forceinline__ void a_ready(const pg8::Unit&) const {}
    __device__ __forceinline__ void done(const pg8::Unit&) const {}
};
#define XB_TMO      128
#define XB_XCNT(j)  (256  + 64 * (j))
#define XB_XSUB(j)  (1280 + 64 * (j))
#define XB_XGEN(j)  (2304 + 64 * (j))
#define XB_TOP      3328
#define XB_TOPGEN   3392
#define XCD_BAR_WORDS 3456
#define XB_SPIN_CAP (1u << 18)

__device__ __forceinline__ unsigned xb_ld(unsigned* p)              { return __hip_atomic_load(p, __ATOMIC_RELAXED, __HIP_MEMORY_SCOPE_AGENT); }
__device__ __forceinline__ unsigned xb_add(unsigned* p, unsigned v) { return __hip_atomic_fetch_add(p, v, __ATOMIC_RELAXED, __HIP_MEMORY_SCOPE_AGENT); }
__device__ __forceinline__ unsigned xb_xcc_id() { return (unsigned)__builtin_amdgcn_s_getreg((3 << 11) | 20) & 0xFu; }
#define XB_SPIN(cond, bar) do { unsigned _sp = 0; while (cond) { __builtin_amdgcn_s_sleep(1); \
    if ((++_sp & 255u) == 0u) { if (xb_ld(&(bar)[XB_TMO])) break; if (_sp > XB_SPIN_CAP) { atomicAdd(&(bar)[XB_TMO], 1u); break; } } } } while (0)

struct XcdBarrier {
    unsigned* bar; unsigned x;
    volatile LAS unsigned* st;
};

__device__ __forceinline__ XcdBarrier xcd_barrier_post(unsigned* bar, volatile LAS unsigned* st) {
    XcdBarrier b; b.bar = bar; b.x = xb_xcc_id(); b.st = st;
    if (threadIdx.x == 0) (void)xb_add(&bar[XB_XCNT(b.x)], 1u);
    return b;
}
__device__ __forceinline__ void xcd_barrier_complete(unsigned* bar, unsigned x, unsigned& nloc, unsigned& nx) {
    const unsigned G = gridDim.x * gridDim.y * gridDim.z;
    unsigned sum, cnt, mine, sp = 0u;
    for (;;) {
        sum = 0u; cnt = 0u; mine = 0u;
#pragma unroll
        for (unsigned j = 0; j < 16; ++j) { const unsigned c = xb_ld(&bar[XB_XCNT(j)]); sum += c; cnt += (c > 0u) ? 1u : 0u; mine = (j == x) ? c : mine; }
        if (sum == G) break;
        __builtin_amdgcn_s_sleep(1);
        if ((++sp & 255u) == 0u) { if (xb_ld(&bar[XB_TMO])) break; if (sp > XB_SPIN_CAP) { atomicAdd(&bar[XB_TMO], 1u); break; } }
    }
    nloc = mine > 0u ? mine : 1u; nx = cnt > 0u ? cnt : 1u;
}

__device__ __forceinline__ void xcd_barrier(const XcdBarrier& b) {
    asm volatile("s_waitcnt vmcnt(0)" ::: "memory");
    __syncthreads();
    if (threadIdx.x == 0) {
        unsigned* bar = b.bar;
        __builtin_amdgcn_s_waitcnt(0);
        unsigned nloc = b.st[0], nx = b.st[1];
        if (nloc == 0u) { xcd_barrier_complete(bar, b.x, nloc, nx); b.st[0] = nloc; b.st[1] = nx; }
        const unsigned old = xb_add(&bar[XB_XSUB(b.x)], 1u);
        const unsigned gen = old / nloc;
        if (old + 1u == (gen + 1u) * nloc) {
            __builtin_amdgcn_fence(__ATOMIC_RELEASE, "agent");
            asm volatile("s_waitcnt vmcnt(0)" ::: "memory");
            const unsigned og = xb_add(&bar[XB_TOP], 1u);
            const unsigned tg = og / nx;
            if (og + 1u == (tg + 1u) * nx) xb_add(&bar[XB_TOPGEN], 1u);
            else XB_SPIN(xb_ld(&bar[XB_TOPGEN]) == tg, bar);
            __builtin_amdgcn_fence(__ATOMIC_ACQUIRE, "agent");
            xb_add(&bar[XB_XGEN(b.x)], 1u);
            asm volatile("s_waitcnt vmcnt(0)" ::: "memory");
        } else {
            XB_SPIN(xb_ld(&bar[XB_XGEN(b.x)]) == gen, bar);
            __builtin_amdgcn_fence(__ATOMIC_ACQUIRE, "agent");
            asm volatile("s_waitcnt vmcnt(0)" ::: "memory");
        }
    }
    __syncthreads();
}

__device__ __forceinline__ void tr_item(const float* W, int ldw, int k0, int n0, bf16* WT, int K, size_t drow0, LAS float* scr, int lane) {
#pragma unroll 8
    for (int i = 0; i < 32; ++i) { const int kk = 2 * i + (lane >> 5); scr[kk * 33 + (lane & 31)] = W[(size_t)(k0 + kk) * ldw + n0 + (lane & 31)]; }
    LDS_WAIT(); asm volatile("" ::: "memory");
    const int c = lane & 7;
#pragma unroll
    for (int j = 0; j < 4; ++j) { const int n = (lane >> 3) + 8 * j; const LAS float* s = scr + (8 * c) * 33 + n;
        v4u o; o.x = pk2(s[0 * 33], s[1 * 33]); o.y = pk2(s[2 * 33], s[3 * 33]); o.z = pk2(s[4 * 33], s[5 * 33]); o.w = pk2(s[6 * 33], s[7 * 33]);
        *(v4u*)(WT + (drow0 + n) * (size_t)K + k0 + 8 * c) = o; }
    LDS_WAIT(); asm volatile("" ::: "memory");
}
__device__ __forceinline__ void phase_prologue(const Args& a, LAS unsigned char* lds, int tid, int lane, int wave, int bid, int G) {
    unsigned char* ws = a.ws;
    LAS float* scr = (LAS float*)(lds + wave * 16384);
    const int gw = bid * NWAVES + wave, NGW = G * NWAVES;
    constexpr int I_IN = 32 * 430, I_UA = 16 * 64, I_UB = 32 * 64, I_WO = 32 * 64, I_EG = 32 * 32 * 16, I_ED = 32 * 8 * 64;
    constexpr int NITEMS = I_IN + I_UA + I_UB + I_WO + 2 * I_EG + I_ED;
    for (int it = gw; it < NITEMS; it += NGW) {
        int r = it;
        if (r < I_IN) { const int kb = r / 430, nb = r % 430, n0 = nb * 32; tr_item(a.in[2], 13760, kb * 64, n0, (bf16*)(ws + WS_WIN), 2048, (size_t)(n0 + (n0 >= 3520 ? 64 : 0)), scr, lane); continue; } r -= I_IN;
        if (r < I_UA) { const int kb = r / 64, nb = r % 64; tr_item(a.in[15], 2048, kb * 64, nb * 32, (bf16*)(ws + WS_WUPA), 1024, (size_t)(nb * 32), scr, lane); continue; } r -= I_UA;
        if (r < I_UB) { const int kb = r / 64, nb = r % 64; tr_item(a.in[16], 2048, kb * 64, nb * 32, (bf16*)(ws + WS_WUPB), 2048, (size_t)(nb * 32), scr, lane); continue; } r -= I_UB;
        if (r < I_WO) { const int kb = r / 64, nb = r % 64; tr_item(a.in[17], 2048, kb * 64, nb * 32, (bf16*)(ws + WS_WOUT), 2048, (size_t)(nb * 32), scr, lane); continue; } r -= I_WO;
        if (r < 2 * I_EG) { const int half = r / I_EG; const int q = r % I_EG; const int e = q / 512, kb = (q % 512) / 16, nb = q % 16, n0 = nb * 32;
            const float* W = a.in[23 + half] + (size_t)e * 2048 * 512;
            tr_item(W, 512, kb * 64, n0, (bf16*)(ws + WS_WGU), 2048, (size_t)e * 1024 + (n0 >> 7) * 256 + half * 128 + (n0 & 127), scr, lane); continue; } r -= 2 * I_EG;
        { const int e = r / 512, kb = (r % 512) / 64, nb = r % 64; const float* W = a.in[25] + (size_t)e * 512 * 2048;
            tr_item(W, 2048, kb * 64, nb * 32, (bf16*)(ws + WS_WDN), 512, (size_t)e * 2048 + nb * 32, scr, lane); }
    }
    { v4u* z = (v4u*)(ws + WS_WIN + (size_t)3520 * 2048 * 2); const int n16 = 64 * 2048 * 2 / 16;
      for (int i = bid * NTHR + tid; i < n16; i += G * NTHR) z[i] = (v4u){0u, 0u, 0u, 0u}; }
    { bf16* W2T = (bf16*)(ws + WS_RB + 16 * MiB); bf16* A2T = W2T + 1024 * 96; bf16* G2T = A2T + 1024 * 96;
      for (int i = bid * NTHR + tid; i < 1024 * 96; i += G * NTHR) { const int ch = i / 96, j = i % 96; W2T[i] = (bf16)f2bf(a.in[5][j * 1024 + ch]); A2T[i] = (bf16)f2bf(a.in[7][j * 1024 + ch]); }
      for (int i = bid * NTHR + tid; i < 1024 * 256; i += G * NTHR) { const int ch = i >> 8, j = i & 255; G2T[i] = (bf16)f2bf(a.in[8][j * 1024 + ch]); } }
    { float* WTG = (float*)(ws + 262144); const float* g2n = a.in[18];
      for (int i = bid * NTHR + tid; i < 48 * DM; i += G * NTHR) { const int o = i >> 11, d = i & (DM - 1);
          float w = 0.f; if (o < 4) w = a.in[19][d * 4 + o]; else if (o < 36) w = a.in[21][d * 32 + (o - 4)];
          WTG[i] = w * g2n[d]; } }
    { float2* rot = (float2*)(ws + WS_ROT);
      for (int i = bid * NTHR + tid; i < SEQ * 64; i += G * NTHR) { const int pos = i >> 6, d = i & 63;
          const float inv = exp2f(-(float)d * (13.287712379549449f / 64.0f)); const float ang = (float)pos * inv;
          double rev = (double)ang * 0.15915494309189535; rev -= __builtin_rint(rev); const float rf = (float)rev;
          rot[i] = make_float2(__builtin_amdgcn_cosf(rf), __builtin_amdgcn_sinf(rf)); } }
    { const float* g1 = a.in[1]; bf16* H1 = (bf16*)(ws + WS_H1);
      for (int m = gw; m < NTOK; m += NGW) { const f32x4* xr = (const f32x4*)(a.in[0] + (size_t)m * DM) + lane; f32x4 v[8]; float s = 0.f;
#pragma unroll
          for (int j = 0; j < 8; ++j) { v[j] = xr[64 * j]; s += (v[j].x * v[j].x + v[j].y * v[j].y) + (v[j].z * v[j].z + v[j].w * v[j].w); }
          const float rs = rsqrtf(wave_sum(s) * (1.0f / DM) + 1e-6f);
          v2u* o8 = (v2u*)(H1 + (size_t)m * DM) + lane;
#pragma unroll
          for (int j = 0; j < 8; ++j) { const f32x4 g = ((const f32x4*)g1)[64 * j + lane]; v2u o; o.x = pk2(v[j].x * rs * g.x, v[j].y * rs * g.y); o.y = pk2(v[j].z * rs * g.z, v[j].w * rs * g.w); o8[64 * j] = o; } } }
}

__device__ __forceinline__ float shiftp(const bf16* P, int t, int col, float mu, bool first) {
    const float cur = bf2f(P[(size_t)t * NP + col]); const float prev = first ? 0.f : bf2f(P[(size_t)(t - 1) * NP + col]);
    return cur + (prev - cur) * mu;
}
__device__ __forceinline__ void phase_rwprep(const Args& a, LAS unsigned char* lds, int tid, int lane, int wave, int bid, int G) {
    unsigned char* ws = a.ws; const bf16* P = (const bf16*)(ws + WS_P);
    LAS float* xs = (LAS float*)lds;
    const float* mu = a.in[3]; const float* w0 = a.in[4]; const float* w2 = a.in[5]; const float* a0 = a.in[6]; const float* a2 = a.in[7]; const float* g2 = a.in[8];
    const float* k_k = a.in[9]; const float* k_a = a.in[10]; const float* r_k = a.in[11];
    bf16* RR = (bf16*)a.out; bf16* RK = RR + (size_t)NTOK * RW_W; bf16* RV = RK + (size_t)NTOK * RW_W; bf16* RG = RV + (size_t)NTOK * RW_W;
    bf16* RE = (bf16*)(ws + WS_RWE); bf16* RA = (bf16*)(ws + WS_RWA); bf16* RB = (bf16*)(ws + WS_RWB); float* BON = (float*)(ws + WS_BONUS);
    for (int u = bid; u < NTOK / 8; u += G) {
        const int t0 = u * 8;
        __syncthreads();
        for (int i = tid; i < 448 * 8; i += NTHR) { const int j = i >> 3, tt = i & 7, t = t0 + tt; const int col = P_XW + j;
            float v = shiftp(P, t, col, mu[col], (t & (SEQ - 1)) == 0);
            if (j < 96) v = tanhf(v); else if (j >= 192) v = sigmoidf_(v);
            xs[i] = v; }
        __syncthreads();
        float aw[2][8], aa[2][8], ag[2][8];
#pragma unroll
        for (int c = 0; c < 2; ++c)
#pragma unroll
            for (int tt = 0; tt < 8; ++tt) { aw[c][tt] = 0.f; aa[c][tt] = 0.f; ag[c][tt] = 0.f; }
        for (int j = 0; j < 96; ++j) { const float wa = w2[j * RW_W + tid], wb = w2[j * RW_W + tid + 512]; const f32x4 x0 = *(const LAS f32x4*)(xs + j * 8), x1 = *(const LAS f32x4*)(xs + j * 8 + 4);
#pragma unroll
            for (int tt = 0; tt < 4; ++tt) { aw[0][tt] += x0[tt] * wa; aw[1][tt] += x0[tt] * wb; aw[0][4 + tt] += x1[tt] * wa; aw[1][4 + tt] += x1[tt] * wb; } }
        for (int j = 0; j < 96; ++j) { const float wa = a2[j * RW_W + tid], wb = a2[j * RW_W + tid + 512]; const f32x4 x0 = *(const LAS f32x4*)(xs + (96 + j) * 8), x1 = *(const LAS f32x4*)(xs + (96 + j) * 8 + 4);
#pragma unroll
            for (int tt = 0; tt < 4; ++tt) { aa[0][tt] += x0[tt] * wa; aa[1][tt] += x0[tt] * wb; aa[0][4 + tt] += x1[tt] * wa; aa[1][4 + tt] += x1[tt] * wb; } }
        for (int j = 0; j < 256; ++j) { const float wa = g2[j * RW_W + tid], wb = g2[j * RW_W + tid + 512]; const f32x4 x0 = *(const LAS f32x4*)(xs + (192 + j) * 8), x1 = *(const LAS f32x4*)(xs + (192 + j) * 8 + 4);
#pragma unroll
            for (int tt = 0; tt < 4; ++tt) { ag[0][tt] += x0[tt] * wa; ag[1][tt] += x0[tt] * wb; ag[0][4 + tt] += x1[tt] * wa; ag[1][4 + tt] += x1[tt] * wb; } }
#pragma unroll
        for (int c = 0; c < 2; ++c) { const int ch = tid + c * 512; const int head = ch >> 6;
            const float mur = mu[ch], muk = mu[1024 + ch], muv = mu[2048 + ch], w0c = w0[ch], a0c = a0[ch], kkc = k_k[ch], kac = k_a[ch], rkc = r_k[ch];
#pragma unroll
            for (int tt = 0; tt < 8; ++tt) { const int t = t0 + tt; const bool first = (t & (SEQ - 1)) == 0;
                const float r = shiftp(P, t, ch, mur, first), k = shiftp(P, t, 1024 + ch, muk, first), v = shiftp(P, t, 2048 + ch, muv, first);
                const float e = sigmoidf_(w0c + aw[c][tt]) * 0.6065306597126334f;
                const float av = sigmoidf_(a0c + aa[c][tt]);
                float kk = k * kkc; const float ss = wave_sum(kk * kk); kk *= rsqrtf(fmaxf(ss, 1e-24f));
                const float kp = k * (1.0f + (av - 1.0f) * kac);
                const float bs = wave_sum(r * kp * rkc);
                const size_t o = (size_t)t * RW_W + ch;
                RR[o] = (bf16)f2bf(r); RK[o] = (bf16)f2bf(kp); RV[o] = (bf16)f2bf(v); RG[o] = (bf16)f2bf(ag[c][tt]);
                RE[o] = (bf16)f2bf(e); RA[o] = (bf16)f2bf(-kk); RB[o] = (bf16)f2bf(kk * av);
                if (lane == 0) BON[t * RW_H + head] = bs; } }
    }
}

__device__ __forceinline__ void unpack16(const v4u& p0, const v4u& p1, float (&f)[16]) {
    f[0] = bflo(p0.x); f[1] = bfhi(p0.x); f[2] = bflo(p0.y); f[3] = bfhi(p0.y); f[4] = bflo(p0.z); f[5] = bfhi(p0.z); f[6] = bflo(p0.w); f[7] = bfhi(p0.w);
    f[8] = bflo(p1.x); f[9] = bfhi(p1.x); f[10] = bflo(p1.y); f[11] = bfhi(p1.y); f[12] = bflo(p1.z); f[13] = bfhi(p1.z); f[14] = bflo(p1.w); f[15] = bfhi(p1.w);
}
__device__ __forceinline__ void phase_rwrec(const Args& a, int lane, int wave, int bid, int G) {
    if (wave != 0) return;
    unsigned char* ws = a.ws;
    const bf16* RR = (const bf16*)a.out; const bf16* RK = RR + (size_t)NTOK * RW_W; const bf16* RV = RK + (size_t)NTOK * RW_W;
    const bf16* RE = (const bf16*)(ws + WS_RWE); const bf16* RA = (const bf16*)(ws + WS_RWA); const bf16* RB = (const bf16*)(ws + WS_RWB);
    bf16* Y = (bf16*)(ws + WS_OA);
    for (int u = bid; u < 256; u += G) {
        const int b = u >> 6, h = (u >> 2) & 15, sl = u & 3, row = lane >> 2, kq = lane & 3, iv = sl * 16 + row;
        float S[16];
#pragma unroll
        for (int k = 0; k < 16; ++k) S[k] = 0.f;
        size_t base = (size_t)(b * SEQ) * RW_W + h * 64;
        const v4u* pr = (const v4u*)(RR + base + kq * 16); const v4u* pe = (const v4u*)(RE + base + kq * 16); const v4u* pk = (const v4u*)(RK + base + kq * 16);
        const v4u* pa = (const v4u*)(RA + base + kq * 16); const v4u* pb = (const v4u*)(RB + base + kq * 16);
        v4u nr0 = pr[0], nr1 = pr[1], ne0 = pe[0], ne1 = pe[1], nk0 = pk[0], nk1 = pk[1], na0 = pa[0], na1 = pa[1], nb0 = pb[0], nb1 = pb[1];
        unsigned short nv = RV[base + iv];
        for (int t = 0; t < SEQ; ++t) {
            const v4u r0 = nr0, r1 = nr1, e0 = ne0, e1 = ne1, k0 = nk0, k1 = nk1, a0 = na0, a1 = na1, b0 = nb0, b1 = nb1; const float v = bf2f(nv);
            if (t + 1 < SEQ) { const int q = (t + 1) * (RW_W / 8);
                nr0 = pr[q]; nr1 = pr[q + 1]; ne0 = pe[q]; ne1 = pe[q + 1]; nk0 = pk[q]; nk1 = pk[q + 1]; na0 = pa[q]; na1 = pa[q + 1]; nb0 = pb[q]; nb1 = pb[q + 1];
                nv = RV[base + (size_t)(t + 1) * RW_W + iv]; }
            float fr[16], fe[16], fk[16], fa[16], fb[16];
            unpack16(r0, r1, fr); unpack16(e0, e1, fe); unpack16(k0, k1, fk); unpack16(a0, a1, fa); unpack16(b0, b1, fb);
            float sa = 0.f;
#pragma unroll
            for (int k = 0; k < 16; ++k) sa += S[k] * fa[k];
            sa += __shfl_xor(sa, 1); sa += __shfl_xor(sa, 2);
            float y = 0.f;
#pragma unroll
            for (int k = 0; k < 16; ++k) { const float w = __expf(-fe[k]); S[k] = S[k] * w + (sa * fb[k] + v * fk[k]); y += S[k] * fr[k]; }
            y += __shfl_xor(y, 1); y += __shfl_xor(y, 2);
            if (kq == 0) Y[base + (size_t)t * RW_W + iv] = (bf16)f2bf(y);
        }
    }
}

__device__ __forceinline__ void phase_ret(const Args& a, LAS unsigned char* lds, int tid, int bid, int G) {
    unsigned char* ws = a.ws; const bf16* P = (const bf16*)(ws + WS_P); const float2* rot = (const float2*)(ws + WS_ROT); bf16* OB = (bf16*)(ws + WS_OB);
    LAS float* Qs = (LAS float*)lds;
    LAS float* Ks = Qs + 64 * 129;
    LAS float* Vs = Ks + 64 * 129;
    LAS float* Sc = Vs + 64 * 32;
    LAS float* St = Sc + 64 * 65;
    LAS float* gp = St + 128 * 32;
    for (int u = bid; u < 256; u += G) {
        const int b = u >> 6, h = (u >> 3) & 7, vs = u & 7;
        __syncthreads();
        const float lg = log1pf(-exp2f(-5.0f - (float)h));
        if (tid < 65) gp[tid] = expf((float)tid * lg);
        for (int i = tid; i < 128 * 32; i += NTHR) St[i] = 0.f;
        for (int n = 0; n < SEQ / 64; ++n) {
            __syncthreads();
            for (int idx = tid; idx < 64 * 64; idx += NTHR) { const int i = idx >> 6, d = idx & 63, pos = n * 64 + i; const size_t t = (size_t)(b * SEQ + pos);
                const float2 cs = rot[pos * 64 + d];
                const float q1 = bf2f(P[t * NP + P_RQ + h * 128 + d]), q2 = bf2f(P[t * NP + P_RQ + h * 128 + 64 + d]);
                const float k1 = bf2f(P[t * NP + P_RK + h * 128 + d]) * 0.08838834764831845f, k2 = bf2f(P[t * NP + P_RK + h * 128 + 64 + d]) * 0.08838834764831845f;
                Qs[i * 129 + d] = q1 * cs.x - q2 * cs.y; Qs[i * 129 + 64 + d] = q1 * cs.y + q2 * cs.x;
                Ks[i * 129 + d] = k1 * cs.x - k2 * cs.y; Ks[i * 129 + 64 + d] = k1 * cs.y + k2 * cs.x; }
            for (int idx = tid; idx < 64 * 32; idx += NTHR) { const int j = idx >> 5, e = idx & 31; const size_t t = (size_t)(b * SEQ + n * 64 + j);
                Vs[idx] = bf2f(P[t * NP + P_RV + h * 256 + vs * 32 + e]); }
            __syncthreads();
            { const int i = tid >> 3, jb = tid & 7; float s[8];
#pragma unroll
              for (int jj = 0; jj < 8; ++jj) s[jj] = 0.f;
              for (int d = 0; d < 128; ++d) { const float q = Qs[i * 129 + d];
#pragma unroll
                  for (int jj = 0; jj < 8; ++jj) s[jj] += q * Ks[(jb + 8 * jj) * 129 + d]; }
#pragma unroll
              for (int jj = 0; jj < 8; ++jj) { const int j = jb + 8 * jj; const int dist = i > j ? i - j : j - i; Sc[i * 65 + j] = s[jj] * gp[dist]; } }
            __syncthreads();
            { const int e = tid & 31, ib = tid >> 5; float o1[4], o2[4];
#pragma unroll
              for (int ii = 0; ii < 4; ++ii) { o1[ii] = 0.f; o2[ii] = 0.f; }
              for (int j = 0; j < 64; ++j) { const float v = Vs[j * 32 + e];
#pragma unroll
                  for (int ii = 0; ii < 4; ++ii) o1[ii] += Sc[(ib + 16 * ii) * 65 + j] * v; }
              for (int d = 0; d < 128; ++d) { const float s = St[d * 32 + e];
#pragma unroll
                  for (int ii = 0; ii < 4; ++ii) o2[ii] += Qs[(ib + 16 * ii) * 129 + d] * s; }
#pragma unroll
              for (int ii = 0; ii < 4; ++ii) { const int i = ib + 16 * ii; const size_t t = (size_t)(b * SEQ + n * 64 + i);
                  OB[t * RET_VW + h * 256 + vs * 32 + e] = (bf16)f2bf(o1[ii] + gp[i + 1] * o2[ii]); } }
            __syncthreads();
            { const int e = tid & 31, db = tid >> 5; float s[8];
#pragma unroll
              for (int dd = 0; dd < 8; ++dd) s[dd] = 0.f;
              for (int j = 0; j < 64; ++j) { const float v = Vs[j * 32 + e] * gp[63 - j];
#pragma unroll
                  for (int dd = 0; dd < 8; ++dd) s[dd] += Ks[j * 129 + db + 16 * dd] * v; }
#pragma unroll
              for (int dd = 0; dd < 8; ++dd) { const int d = db + 16 * dd; St[d * 32 + e] = St[d * 32 + e] * gp[64] + s[dd]; } }
        }
    }
}

__device__ __forceinline__ void phase_post(const Args& a, int lane, int wave, int bid, int G) {
    unsigned char* ws = a.ws; const bf16* P = (const bf16*)(ws + WS_P);
    const int gw = bid * NWAVES + wave, NGW = G * NWAVES;
    { bf16* Y = (bf16*)(ws + WS_OA); const bf16* RR = (const bf16*)a.out; const bf16* RV = RR + (size_t)2 * NTOK * RW_W; const bf16* RG = RR + (size_t)3 * NTOK * RW_W;
      const float* BON = (const float*)(ws + WS_BONUS); const float* lg = a.in[12]; const float* lb = a.in[13];
      for (int it = gw; it < NTOK * RW_H; it += NGW) { const int t = it >> 4, h = it & 15; const size_t o = (size_t)t * RW_W + h * 64 + lane;
          const float y = bf2f(Y[o]); const float mean = wave_sum(y) * (1.0f / 64.0f); const float dy = y - mean; const float var = wave_sum(dy * dy) * (1.0f / 64.0f);
          float yn = dy * rsqrtf(var + 64e-5f) * lg[h * 64 + lane] + lb[h * 64 + lane];
          yn += BON[it] * bf2f(RV[o]);
          Y[o] = (bf16)f2bf(yn * bf2f(RG[o])); } }
    { bf16* OB = (bf16*)(ws + WS_OB); const float* ng = a.in[14];
      for (int it = gw; it < NTOK * RET_H; it += NGW) { const int t = it >> 3, h = it & 7; const size_t o = (size_t)t * RET_VW + h * 256 + lane * 4;
          const v2u raw = *(const v2u*)(OB + o); const float v0 = bflo(raw.x), v1 = bfhi(raw.x), v2 = bflo(raw.y), v3 = bfhi(raw.y);
          const float rs = rsqrtf(wave_sum((v0 * v0 + v1 * v1) + (v2 * v2 + v3 * v3)) * (1.0f / 256.0f) + 1e-6f);
          const v2u gr = *(const v2u*)(P + (size_t)t * NP + P_RG + h * 256 + lane * 4); const f32x4 g = *(const f32x4*)(ng + h * 256 + lane * 4);
          v2u w; w.x = pk2(v0 * rs * g.x * bflo(gr.x), v1 * rs * g.y * bfhi(gr.x)); w.y = pk2(v2 * rs * g.z * bflo(gr.y), v3 * rs * g.w * bfhi(gr.y));
          *(v2u*)(OB + o) = w; } }
}

__device__ __forceinline__ void phase_retpost(const Args& a, int lane, int wave, int bid, int G) {
    unsigned char* ws = a.ws; const bf16* P = (const bf16*)(ws + WS_P);
    const int gw = bid * NWAVES + wave, NGW = G * NWAVES;
    bf16* OB = (bf16*)(ws + WS_OB); const float* ng = a.in[14];
    for (int it = gw; it < NTOK * RET_H; it += NGW) { const int t = it >> 3, h = it & 7; const size_t o = (size_t)t * RET_VW + h * 256 + lane * 4;
        const v2u raw = *(const v2u*)(OB + o); const float v0 = bflo(raw.x), v1 = bfhi(raw.x), v2 = bflo(raw.y), v3 = bfhi(raw.y);
        const float rs = rsqrtf(wave_sum((v0 * v0 + v1 * v1) + (v2 * v2 + v3 * v3)) * (1.0f / 256.0f) + 1e-6f);
        const v2u gr = *(const v2u*)(P + (size_t)t * NP + P_RG + h * 256 + lane * 4); const f32x4 g = *(const f32x4*)(ng + h * 256 + lane * 4);
        v2u w; w.x = pk2(v0 * rs * g.x * bflo(gr.x), v1 * rs * g.y * bfhi(gr.x)); w.y = pk2(v2 * rs * g.z * bflo(gr.y), v3 * rs * g.w * bfhi(gr.y));
        *(v2u*)(OB + o) = w; }
}

__device__ __forceinline__ void phase_router(const Args& a, int lane, int wave, int bid, int G) {
    unsigned char* ws = a.ws; const float* X1 = a.out; bf16* H2 = (bf16*)(ws + WS_H2);
    const float* g2 = a.in[18]; const float* wg = a.in[19]; const float* bg = a.in[20]; const float* we = a.in[21]; const float* be = a.in[22];
    unsigned* ctl = (unsigned*)(ws + WS_CTL); int* TE = (int*)(ws + WS_TOKE); float* TW = (float*)(ws + WS_TOKW); int* TP = (int*)(ws + WS_TOKP);
    const int gw = bid * NWAVES + wave, NGW = G * NWAVES;
    for (int t = gw; t < NTOK; t += NGW) {
        const f32x4* xr = (const f32x4*)(X1 + (size_t)t * DM) + lane; float s = 0.f;
#pragma unroll
        for (int j = 0; j < 8; ++j) { const f32x4 x = xr[64 * j]; s += (x.x * x.x + x.y * x.y) + (x.z * x.z + x.w * x.w); }
        const float rs = rsqrtf(wave_sum(s) * (1.0f / DM) + 1e-6f);
        float lgt[36];
#pragma unroll
        for (int q = 0; q < 36; ++q) lgt[q] = 0.f;
        v2u* o8 = (v2u*)(H2 + (size_t)t * DM) + lane;
#pragma unroll 1
        for (int j = 0; j < 8; ++j) { const f32x4 x = xr[64 * j]; const f32x4 g = ((const f32x4*)g2)[64 * j + lane]; const f32x4 hv = {x.x * rs * g.x, x.y * rs * g.y, x.z * rs * g.z, x.w * rs * g.w};
            v2u o; o.x = pk2(hv.x, hv.y); o.y = pk2(hv.z, hv.w); o8[64 * j] = o;
            const int col = 256 * j + 4 * lane;
#pragma unroll
            for (int c = 0; c < 4; ++c) { const float hc = hv[c]; const f32x4 w4 = *(const f32x4*)(wg + (size_t)(col + c) * 4);
                lgt[0] += hc * w4.x; lgt[1] += hc * w4.y; lgt[2] += hc * w4.z; lgt[3] += hc * w4.w;
#pragma unroll
                for (int q = 0; q < 8; ++q) { const f32x4 e4 = *(const f32x4*)(we + (size_t)(col + c) * 32 + 4 * q);
                    lgt[4 + 4 * q] += hc * e4.x; lgt[5 + 4 * q] += hc * e4.y; lgt[6 + 4 * q] += hc * e4.z; lgt[7 + 4 * q] += hc * e4.w; } }
            asm volatile("" ::: "memory"); }
#pragma unroll
        for (int q = 0; q < 36; ++q) lgt[q] = wave_sum(lgt[q]);
        float gl[4];
#pragma unroll
        for (int q = 0; q < 4; ++q) gl[q] = lgt[q] + bg[q];
        int gs = 0; float gm = gl[0];
#pragma unroll
        for (int q = 1; q < 4; ++q) if (gl[q] > gm) { gm = gl[q]; gs = q; }
        float den = 0.f;
#pragma unroll
        for (int q = 0; q < 4; ++q) den += expf(gl[q] - gm);
        const float gwt = 1.0f / den;
        float el[8];
#pragma unroll
        for (int q = 0; q < 8; ++q) { float x = 0.f;
#pragma unroll
            for (int gq = 0; gq < 4; ++gq) x = (gs == gq) ? lgt[4 + gq * 8 + q] + be[gq * 8 + q] : x;
            el[q] = x; }
        int i0 = 0; float m0 = el[0];
#pragma unroll
        for (int q = 1; q < 8; ++q) if (el[q] > m0) { m0 = el[q]; i0 = q; }
        int i1 = -1; float m1 = -3.0e38f;
#pragma unroll
        for (int q = 0; q < 8; ++q) if (q != i0 && el[q] > m1) { m1 = el[q]; i1 = q; }
        const float e1 = expf(m1 - m0); const float w0 = gwt / (1.0f + e1), w1 = gwt * e1 / (1.0f + e1);
        if (lane == 0) { const int ex0 = gs * 8 + i0, ex1 = gs * 8 + i1;
            const unsigned p0 = __hip_atomic_fetch_add(ctl + CW_CNT + ex0, 1u, RLX_AGENT), p1 = __hip_atomic_fetch_add(ctl + CW_CNT + ex1, 1u, RLX_AGENT);
            TE[2 * t] = ex0; TE[2 * t + 1] = ex1; TW[2 * t] = w0; TW[2 * t + 1] = w1; TP[2 * t] = (int)p0; TP[2 * t + 1] = (int)p1; }
    }
}

__device__ __forceinline__ void phase_gather(const Args& a, LAS unsigned char* lds, int tid, int lane, int wave, int bid, int G) {
    unsigned char* ws = a.ws; unsigned* ctl = (unsigned*)(ws + WS_CTL); const bf16* H2 = (const bf16*)(ws + WS_H2); bf16* XG = (bf16*)(ws + WS_XG);
    const int* TE = (const int*)(ws + WS_TOKE); const int* TP = (const int*)(ws + WS_TOKP); int* TS = (int*)(ws + WS_TOKS);
    LAS int* ps = (LAS int*)lds;
    __syncthreads();
    if (tid == 0) { int acc = 0, nt = 0;
        for (int e = 0; e < NEXP; ++e) { const int c = (int)__hip_atomic_load(ctl + CW_CNT + e, RLX_AGENT); ps[e] = acc; ps[64 + e] = c; const int tl = (c + 255) >> 8;
            if (bid == 0) for (int q = 0; q < tl; ++q) ctl[CW_TE + nt + q] = (unsigned)e;
            nt += tl; acc += tl * 256; }
        ps[32] = acc; if (bid == 0) ctl[CW_NT] = (unsigned)nt; }
    __syncthreads();
    const int gw = bid * NWAVES + wave, NGW = G * NWAVES;
    for (int it = gw; it < NTOK * 2; it += NGW) { const int t = it >> 1; const int e = TE[it]; const int slot = ps[e] + TP[it];
        const v4u* src = (const v4u*)(H2 + (size_t)t * DM) + lane; v4u* dst = (v4u*)(XG + (size_t)slot * DM) + lane;
#pragma unroll
        for (int j = 0; j < 4; ++j) dst[64 * j] = src[64 * j];
        if (lane == 0) TS[it] = slot; }
    for (int e = 0; e < NEXP; ++e) { const int c = ps[64 + e], base = ps[e] + c, npad = ps[e + 1] - base;
        for (int r = gw; r < npad; r += NGW) { v4u* dst = (v4u*)(XG + (size_t)(base + r) * DM) + lane;
#pragma unroll
            for (int j = 0; j < 4; ++j) dst[64 * j] = (v4u){0u, 0u, 0u, 0u}; } }
}

__device__ __forceinline__ void phase_final(const Args& a, int lane, int wave, int bid, int G) {
    unsigned char* ws = a.ws; float* X1 = a.out; const bf16* YS = (const bf16*)(ws + WS_YS); const int* TS = (const int*)(ws + WS_TOKS); const float* TW = (const float*)(ws + WS_TOKW); const float* fg = a.in[26];
    const int gw = bid * NWAVES + wave, NGW = G * NWAVES;
    for (int t = gw; t < NTOK; t += NGW) { const int s0 = TS[2 * t], s1 = TS[2 * t + 1]; const float w0 = TW[2 * t], w1 = TW[2 * t + 1];
        f32x4* xr = (f32x4*)(X1 + (size_t)t * DM) + lane; const v2u* y0 = (const v2u*)(YS + (size_t)s0 * DM) + lane; const v2u* y1 = (const v2u*)(YS + (size_t)s1 * DM) + lane;
        f32x4 v[8]; float s = 0.f;
#pragma unroll
        for (int j = 0; j < 8; ++j) { const f32x4 x = xr[64 * j]; const v2u a0 = y0[64 * j], a1 = y1[64 * j];
            v[j].x = x.x + w0 * bflo(a0.x) + w1 * bflo(a1.x); v[j].y = x.y + w0 * bfhi(a0.x) + w1 * bfhi(a1.x); v[j].z = x.z + w0 * bflo(a0.y) + w1 * bflo(a1.y); v[j].w = x.w + w0 * bfhi(a0.y) + w1 * bfhi(a1.y);
            s += (v[j].x * v[j].x + v[j].y * v[j].y) + (v[j].z * v[j].z + v[j].w * v[j].w); }
        const float rs = rsqrtf(wave_sum(s) * (1.0f / DM) + 1e-6f);
#pragma unroll
        for (int j = 0; j < 8; ++j) { const f32x4 g = ((const f32x4*)fg)[64 * j + lane]; xr[64 * j] = (f32x4){v[j].x * rs * g.x, v[j].y * rs * g.y, v[j].z * rs * g.z, v[j].w * rs * g.w}; } }
}

typedef __bf16 bf2_t __attribute__((ext_vector_type(2)));
typedef float f2_t __attribute__((ext_vector_type(2)));
__device__ __forceinline__ unsigned cvt2(float a, float b) { const f2_t v = {a, b}; const bf2_t r = __builtin_convertvector(v, bf2_t); return __builtin_bit_cast(unsigned, r); }
typedef short bf16x8 __attribute__((ext_vector_type(8)));
__device__ __forceinline__ f32x4 mfma16(bf16x8 xa, bf16x8 yb, f32x4 c) { return __builtin_amdgcn_mfma_f32_16x16x32_bf16(xa, yb, c, 0, 0, 0); }
__device__ __forceinline__ bf16x8 ldfrag(const LAS bf16* img, int ld, int row0, int k0, int lane) { return *(const LAS bf16x8*)(img + (row0 + (lane & 15)) * ld + k0 + (lane >> 4) * 8); }
__device__ __forceinline__ void unpack8(const v4u& p, float (&f)[8]) { f[0] = bflo(p.x); f[1] = bfhi(p.x); f[2] = bflo(p.y); f[3] = bfhi(p.y); f[4] = bflo(p.z); f[5] = bfhi(p.z); f[6] = bflo(p.w); f[7] = bfhi(p.w); }

__device__ __forceinline__ void phase_ret_mfma(const Args& a, LAS unsigned char* lds, int tid, int lane, int wave, int bid, int G) {
    unsigned char* ws = a.ws; const bf16* P = (const bf16*)(ws + WS_P); const float* rot = (const float*)(ws + WS_ROT); bf16* OB = (bf16*)(ws + WS_OB);
    constexpr int LQ = 136, LT = 72;
    LAS bf16* Qs = (LAS bf16*)lds;
    LAS bf16* Ks = Qs + 64 * LQ;
    LAS bf16* KT = Ks + 64 * LQ;
    LAS bf16* VT = KT + 128 * LT;
    LAS bf16* Sc = VT + 32 * LT;
    LAS bf16* ST = Sc + 64 * LT;
    LAS float* gp = (LAS float*)(ST + 32 * LQ);
    const int q4 = lane >> 4, l16 = lane & 15;
    for (int u = bid; u < 256; u += G) {
        const int b = u >> 6, h = (u >> 3) & 7, vs = u & 7;
        __syncthreads();
        const float lg = log1pf(-exp2f(-5.0f - (float)h));
        if (tid < 65) gp[tid] = expf((float)tid * lg);
        for (int i = tid; i < 32 * LQ / 2; i += NTHR) ((LAS unsigned*)ST)[i] = 0u;
        f32x4 st[2] = {{0.f, 0.f, 0.f, 0.f}, {0.f, 0.f, 0.f, 0.f}};
        const int si = tid >> 3, d0 = (tid & 7) * 8, e0 = (tid & 7) * 4;
        const bf16* prow = P + (size_t)(b * SEQ + si) * NP;
        v4u qlo = *(const v4u*)(prow + P_RQ + h * 128 + d0), qhi = *(const v4u*)(prow + P_RQ + h * 128 + 64 + d0);
        v4u klo = *(const v4u*)(prow + P_RK + h * 128 + d0), khi = *(const v4u*)(prow + P_RK + h * 128 + 64 + d0);
        v2u vv = *(const v2u*)(prow + P_RV + h * 256 + vs * 32 + e0);
        f32x4 rt[4];
#pragma unroll
        for (int c = 0; c < 4; ++c) rt[c] = *(const f32x4*)(rot + ((size_t)si * 64 + d0) * 2 + c * 4);
        __syncthreads();
        const float chunk_decay = gp[64];
        for (int n = 0; n < SEQ / 64; ++n) {
            { float ql[8], qh[8], kl[8], kh[8]; unpack8(qlo, ql); unpack8(qhi, qh); unpack8(klo, kl); unpack8(khi, kh);
              float oql[8], oqh[8], okl[8], okh[8]; const float kd = gp[63 - si];
#pragma unroll
              for (int j = 0; j < 8; ++j) { const float c = rt[j >> 1][(j & 1) * 2], s = rt[j >> 1][(j & 1) * 2 + 1];
                  oql[j] = ql[j] * c - qh[j] * s; oqh[j] = ql[j] * s + qh[j] * c;
                  okl[j] = (kl[j] * c - kh[j] * s) * 0.08838834764831845f; okh[j] = (kl[j] * s + kh[j] * c) * 0.08838834764831845f; }
              v4u w; w.x = pk2(oql[0], oql[1]); w.y = pk2(oql[2], oql[3]); w.z = pk2(oql[4], oql[5]); w.w = pk2(oql[6], oql[7]); *(LAS v4u*)(Qs + si * LQ + d0) = w;
              w.x = pk2(oqh[0], oqh[1]); w.y = pk2(oqh[2], oqh[3]); w.z = pk2(oqh[4], oqh[5]); w.w = pk2(oqh[6], oqh[7]); *(LAS v4u*)(Qs + si * LQ + 64 + d0) = w;
              w.x = pk2(okl[0], okl[1]); w.y = pk2(okl[2], okl[3]); w.z = pk2(okl[4], okl[5]); w.w = pk2(okl[6], okl[7]); *(LAS v4u*)(Ks + si * LQ + d0) = w;
              w.x = pk2(okh[0], okh[1]); w.y = pk2(okh[2], okh[3]); w.z = pk2(okh[4], okh[5]); w.w = pk2(okh[6], okh[7]); *(LAS v4u*)(Ks + si * LQ + 64 + d0) = w;
#pragma unroll
              for (int j = 0; j < 8; ++j) { KT[(d0 + j) * LT + si] = (bf16)f2bf(okl[j] * kd); KT[(64 + d0 + j) * LT + si] = (bf16)f2bf(okh[j] * kd); }
              VT[(e0 + 0) * LT + si] = (bf16)(vv.x & 0xffffu); VT[(e0 + 1) * LT + si] = (bf16)(vv.x >> 16); VT[(e0 + 2) * LT + si] = (bf16)(vv.y & 0xffffu); VT[(e0 + 3) * LT + si] = (bf16)(vv.y >> 16); }
            __syncthreads();
            if (n + 1 < SEQ / 64) { const bf16* pr = prow + (size_t)(n + 1) * 64 * NP;
                qlo = *(const v4u*)(pr + P_RQ + h * 128 + d0); qhi = *(const v4u*)(pr + P_RQ + h * 128 + 64 + d0);
                klo = *(const v4u*)(pr + P_RK + h * 128 + d0); khi = *(const v4u*)(pr + P_RK + h * 128 + 64 + d0);
                vv = *(const v2u*)(pr + P_RV + h * 256 + vs * 32 + e0);
#pragma unroll
                for (int c = 0; c < 4; ++c) rt[c] = *(const f32x4*)(rot + ((size_t)((n + 1) * 64 + si) * 64 + d0) * 2 + c * 4); }
            { const int i0 = (wave >> 1) * 16;
#pragma unroll
              for (int jt = 0; jt < 2; ++jt) { const int j0 = ((wave & 1) * 2 + jt) * 16; f32x4 acc = {0.f, 0.f, 0.f, 0.f};
#pragma unroll
                  for (int ks = 0; ks < 4; ++ks) acc = mfma16(ldfrag(Ks, LQ, j0, ks * 32, lane), ldfrag(Qs, LQ, i0, ks * 32, lane), acc);
                  const int i = i0 + l16, jb = j0 + 4 * q4; float sv[4];
#pragma unroll
                  for (int r = 0; r < 4; ++r) { const int j = jb + r; const int dist = i > j ? i - j : j - i; sv[r] = acc[r] * gp[dist]; }
                  v2u w; w.x = pk2(sv[0], sv[1]); w.y = pk2(sv[2], sv[3]); *(LAS v2u*)(Sc + i * LT + jb) = w; } }
            const int oi0 = (wave >> 1) * 16, oe0 = (wave & 1) * 16;
            f32x4 ointer = {0.f, 0.f, 0.f, 0.f};
#pragma unroll
            for (int ks = 0; ks < 4; ++ks) ointer = mfma16(ldfrag(ST, LQ, oe0, ks * 32, lane), ldfrag(Qs, LQ, oi0, ks * 32, lane), ointer);
#pragma unroll
            for (int et = 0; et < 2; ++et) { f32x4 acc = st[et] * chunk_decay;
#pragma unroll
                for (int ks = 0; ks < 2; ++ks) acc = mfma16(ldfrag(KT, LT, wave * 16, ks * 32, lane), ldfrag(VT, LT, et * 16, ks * 32, lane), acc);
                st[et] = acc; }
            __syncthreads();
            { f32x4 ointra = {0.f, 0.f, 0.f, 0.f};
#pragma unroll
              for (int ks = 0; ks < 2; ++ks) ointra = mfma16(ldfrag(VT, LT, oe0, ks * 32, lane), ldfrag(Sc, LT, oi0, ks * 32, lane), ointra);
              const int i = oi0 + l16; const float qd = gp[i + 1];
              v2u w; w.x = pk2(ointra[0] + qd * ointer[0], ointra[1] + qd * ointer[1]); w.y = pk2(ointra[2] + qd * ointer[2], ointra[3] + qd * ointer[3]);
              *(v2u*)(OB + (size_t)(b * SEQ + n * 64 + i) * RET_VW + h * 256 + vs * 32 + oe0 + 4 * q4) = w; }
#pragma unroll
            for (int et = 0; et < 2; ++et) { v2u w; w.x = pk2(st[et][0], st[et][1]); w.y = pk2(st[et][2], st[et][3]); *(LAS v2u*)(ST + (et * 16 + l16) * LQ + wave * 16 + 4 * q4) = w; }
            __syncthreads();
        }
    }
}

constexpr int LT = 72, SLOT = 64 * LT;
constexpr size_t RW_GS = 0, RW_GY = 16 * MiB, RW_YS = 32 * MiB, RW_SS = 48 * MiB;
constexpr size_t WS_H0 = WS_RB;
constexpr size_t WS_W2T = WS_RB + 16 * MiB, WS_A2T = WS_W2T + 196608, WS_G2T = WS_A2T + 196608;

__device__ __forceinline__ f32x4 tile2(const LAS bf16* X, int x0, const LAS bf16* Y, int y0, int lane, f32x4 acc) {
    acc = mfma16(ldfrag(X, LT, x0, 0, lane), ldfrag(Y, LT, y0, 0, lane), acc);
    acc = mfma16(ldfrag(X, LT, x0, 32, lane), ldfrag(Y, LT, y0, 32, lane), acc);
    return acc;
}
__device__ __forceinline__ v2u pack4(f32x4 v) { v2u w; w.x = cvt2(v[0], v[1]); w.y = cvt2(v[2], v[3]); return w; }
__device__ __forceinline__ f32x4 unpack4(v2u w) { return (f32x4){bflo(w.x), bfhi(w.x), bflo(w.y), bfhi(w.y)}; }
__device__ __forceinline__ void st4(LAS bf16* img, int yrow, int xcol, f32x4 v) { *(LAS v2u*)(img + yrow * LT + xcol) = pack4(v); }
__device__ __forceinline__ f32x4 ld4(const LAS bf16* img, int yrow, int xcol) { return unpack4(*(const LAS v2u*)(img + yrow * LT + xcol)); }
__device__ __forceinline__ v4u pack8(const float (&f)[8]) { v4u w; w.x = cvt2(f[0], f[1]); w.y = cvt2(f[2], f[3]); w.z = cvt2(f[4], f[5]); w.w = cvt2(f[6], f[7]); return w; }
__device__ __forceinline__ void shift8(const bf16* P, size_t tg, int col, bool first, const float* mu, float (&o)[8]) {
    const v4u cur = *(const v4u*)(P + tg * NP + col); v4u prv = {0u, 0u, 0u, 0u}; if (!first) prv = *(const v4u*)(P + (tg - 1) * NP + col);
    const f32x4 m0 = *(const f32x4*)(mu + col), m1 = *(const f32x4*)(mu + col + 4);
    float c[8], p[8]; unpack8(cur, c); unpack8(prv, p);
#pragma unroll
    for (int j = 0; j < 8; ++j) o[j] = c[j] + (p[j] - c[j]) * (j < 4 ? m0[j] : m1[j - 4]);
}

__device__ __forceinline__ void phase_rwA(const Args& a, LAS unsigned char* lds, int tid, int lane, int wave, int bid, int G) {
    unsigned char* ws = a.ws; const bf16* P = (const bf16*)(ws + WS_P);
    const float* mu = a.in[3]; const float* w0 = a.in[4]; const float* a0 = a.in[6]; const float* k_k = a.in[9]; const float* k_a = a.in[10]; const float* r_k = a.in[11];
    const bf16* W2T = (const bf16*)(ws + WS_W2T); const bf16* A2T = (const bf16*)(ws + WS_A2T);
    bf16* GS = (bf16*)((unsigned char*)a.out + RW_GS); bf16* GY = (bf16*)((unsigned char*)a.out + RW_GY); bf16* YS = (bf16*)((unsigned char*)a.out + RW_YS); bf16* SS = (bf16*)((unsigned char*)a.out + RW_SS);
    float* BON = (float*)(ws + WS_BONUS);
    LAS bf16* img = (LAS bf16*)lds;
    LAS bf16 *s0 = img, *s1 = img + SLOT, *s2 = img + 2 * SLOT, *s3 = img + 3 * SLOT, *s4 = img + 4 * SLOT, *s5 = img + 5 * SLOT, *s6 = img + 6 * SLOT, *s7 = img + 7 * SLOT;
    LAS bf16 *s8 = img + 8 * SLOT, *s9 = img + 9 * SLOT, *s10 = img + 10 * SLOT, *s11 = img + 11 * SLOT, *s12 = img + 12 * SLOT, *s13 = img + 13 * SLOT;
    LAS float* WL = (LAS float*)s8;  LAS float* AL = (LAS float*)s10;
    LAS float* SEG = (LAS float*)(lds + RING_BYTES + 1024);
    LAS float* GC = SEG + 512;
    LAS float* DIAG = GC + 64;
    const int q4 = lane >> 4, l16 = lane & 15;
    const int yt = wave >> 1, xb = (wave & 1) * 2, y0 = yt * 16;
    const int st_ = tid >> 3, c0 = (tid & 7) * 8;
    for (int u = bid; u < 2048; u += G) {
        const int b = u >> 9, h = (u >> 5) & 15, c = u & 31;
        const size_t t0g = (size_t)b * SEQ + c * 64;
        { const int tl = y0 + l16; const size_t tg = t0g + tl; const bool firstl = (c == 0 && tl == 0);
          bf16x8 fw[3], fa[3];
#pragma unroll
          for (int ks = 0; ks < 3; ++ks) { float x[8];
              shift8(P, tg, P_XW + ks * 32 + q4 * 8, firstl, mu, x);
#pragma unroll
              for (int j = 0; j < 8; ++j) x[j] = tanhf(x[j]);
              fw[ks] = __builtin_bit_cast(bf16x8, pack8(x));
              shift8(P, tg, P_XA + ks * 32 + q4 * 8, firstl, mu, x);
              fa[ks] = __builtin_bit_cast(bf16x8, pack8(x)); }
#pragma unroll
          for (int xi = 0; xi < 2; ++xi) { const int ch0 = (xb + xi) * 16; f32x4 accw = {0.f, 0.f, 0.f, 0.f}, acca = {0.f, 0.f, 0.f, 0.f};
#pragma unroll
              for (int ks = 0; ks < 3; ++ks) { const size_t wo = (size_t)(h * 64 + ch0 + l16) * 96 + ks * 32 + q4 * 8;
                  accw = mfma16(*(const bf16x8*)(W2T + wo), fw[ks], accw); acca = mfma16(*(const bf16x8*)(A2T + wo), fa[ks], acca); }
              *(LAS f32x4*)(WL + tl * 68 + ch0 + 4 * q4) = accw; *(LAS f32x4*)(AL + tl * 68 + ch0 + 4 * q4) = acca; } }
        float rr[8], kp[8], vv[8], av[8], bv[8], ee[8];
        { const size_t tg = t0g + st_; const bool first = (c == 0 && st_ == 0);
          shift8(P, tg, h * 64 + c0, first, mu, rr); shift8(P, tg, 1024 + h * 64 + c0, first, mu, kp); shift8(P, tg, 2048 + h * 64 + c0, first, mu, vv); }
        __syncthreads();
        { const int chg = h * 64 + c0; float wl[8], al[8];
          { const f32x4 t0 = *(const LAS f32x4*)(WL + st_ * 68 + c0), t1 = *(const LAS f32x4*)(WL + st_ * 68 + c0 + 4), u0 = *(const LAS f32x4*)(AL + st_ * 68 + c0), u1 = *(const LAS f32x4*)(AL + st_ * 68 + c0 + 4);
#pragma unroll
            for (int j = 0; j < 4; ++j) { wl[j] = t0[j]; wl[4 + j] = t1[j]; al[j] = u0[j]; al[4 + j] = u1[j]; } }
          float ss = 0.f, bon = 0.f, kk[8], as[8];
#pragma unroll
          for (int j = 0; j < 8; ++j) { ee[j] = sigmoidf_(w0[chg + j] + wl[j]) * 0.6065306597126334f; as[j] = sigmoidf_(a0[chg + j] + al[j]); kk[j] = kp[j] * k_k[chg + j]; ss += kk[j] * kk[j]; }
          ss += __shfl_xor(ss, 1); ss += __shfl_xor(ss, 2); ss += __shfl_xor(ss, 4);
          const float rn = rsqrtf(fmaxf(ss, 1e-24f));
#pragma unroll
          for (int j = 0; j < 8; ++j) { const float kn = kk[j] * rn; kp[j] = kp[j] * (1.0f + (as[j] - 1.0f) * k_a[chg + j]); av[j] = -kn; bv[j] = kn * as[j]; bon += rr[j] * kp[j] * r_k[chg + j]; }
          bon += __shfl_xor(bon, 1); bon += __shfl_xor(bon, 2); bon += __shfl_xor(bon, 4);
          if ((tid & 7) == 0) BON[(t0g + st_) * RW_H + h] = bon;
          *(LAS f32x4*)(WL + st_ * 68 + c0) = (f32x4){ee[0], ee[1], ee[2], ee[3]}; *(LAS f32x4*)(WL + st_ * 68 + c0 + 4) = (f32x4){ee[4], ee[5], ee[6], ee[7]}; }
        __syncthreads();
        { const int ch = tid & 63, seg = tid >> 6; float x[8], run = 0.f;
#pragma unroll
          for (int i = 0; i < 8; ++i) { run += WL[(seg * 8 + i) * 68 + ch]; x[i] = run; }
          SEG[seg * 64 + ch] = run;
          __syncthreads();
          float off = 0.f;
#pragma unroll
          for (int s = 0; s < 8; ++s) off += (s < seg) ? SEG[s * 64 + ch] : 0.f;
#pragma unroll
          for (int i = 0; i < 8; ++i) WL[(seg * 8 + i) * 68 + ch] = x[i] + off; }
        __syncthreads();
        { float cs[8], cC[8];
          { const f32x4 t0 = *(const LAS f32x4*)(WL + st_ * 68 + c0), t1 = *(const LAS f32x4*)(WL + st_ * 68 + c0 + 4), u0 = *(const LAS f32x4*)(WL + 63 * 68 + c0), u1 = *(const LAS f32x4*)(WL + 63 * 68 + c0 + 4);
#pragma unroll
            for (int j = 0; j < 4; ++j) { cs[j] = t0[j]; cs[4 + j] = t1[j]; cC[j] = u0[j]; cC[4 + j] = u1[j]; } }
          float At[8], Rt[8], Bt[8], Kt[8], Bh[8], Kh[8];
#pragma unroll
          for (int j = 0; j < 8; ++j) { const float gi = __expf(cs[j]), gt = __expf(-cs[j]), gh = __expf(cs[j] - cC[j]);
              At[j] = av[j] * __expf(ee[j] - cs[j]); Rt[j] = rr[j] * gt; Bt[j] = bv[j] * gi; Kt[j] = kp[j] * gi; Bh[j] = bv[j] * gh; Kh[j] = kp[j] * gh; }
          *(LAS v4u*)(s0 + st_ * LT + c0) = pack8(At); *(LAS v4u*)(s1 + st_ * LT + c0) = pack8(Rt); *(LAS v4u*)(s2 + st_ * LT + c0) = pack8(Bt); *(LAS v4u*)(s3 + st_ * LT + c0) = pack8(Kt);
#pragma unroll
          for (int j = 0; j < 8; ++j) { s4[(c0 + j) * LT + st_] = (bf16)f2bf(At[j]); s5[(c0 + j) * LT + st_] = (bf16)f2bf(Bh[j]); s6[(c0 + j) * LT + st_] = (bf16)f2bf(Kh[j]); s7[(c0 + j) * LT + st_] = (bf16)f2bf(vv[j]); }
          if (st_ == 63) {
#pragma unroll
              for (int j = 0; j < 8; ++j) GC[c0 + j] = __expf(-cC[j]); }
          for (int i = tid; i < 2 * SLOT * 2 / 16; i += NTHR) ((LAS v4u*)s12)[i] = (v4u){0u, 0u, 0u, 0u}; }
        __syncthreads();
        f32x4 lrk[2];
#pragma unroll
        for (int xi = 0; xi < 2; ++xi) { const int xt = xb + xi, x0 = xt * 16; const int yr = y0 + l16, xc = x0 + 4 * q4; const f32x4 z = {0.f, 0.f, 0.f, 0.f};
            f32x4 acc = tile2(s2, x0, s0, y0, lane, z);
#pragma unroll
            for (int r = 0; r < 4; ++r) acc[r] = (xc + r < yr) ? acc[r] : 0.f;
            if (yt == xt) *(LAS f32x4*)(DIAG + (yt * 16 + l16) * 16 + 4 * q4) = acc;
            st4(s8, yr, xc, ((yt == 1 && xt == 0) || (yt == 3 && xt == 2)) ? acc : z);
            st4(s9, yr, xc, (yt >= 2 && xt <= 1) ? acc : z);
            acc = tile2(s0, x0, s3, y0, lane, z);
#pragma unroll
            for (int r = 0; r < 4; ++r) acc[r] = (yr < xc + r) ? acc[r] : 0.f;
            st4(s10, yr, xc, acc);
            acc = tile2(s2, x0, s1, y0, lane, z);
#pragma unroll
            for (int r = 0; r < 4; ++r) acc[r] = (xc + r <= yr) ? acc[r] : 0.f;
            st4(s11, yr, xc, acc);
            acc = tile2(s3, x0, s1, y0, lane, z);
#pragma unroll
            for (int r = 0; r < 4; ++r) acc[r] = (xc + r <= yr) ? acc[r] : 0.f;
            lrk[xi] = acc; }
        __syncthreads();
        if (wave == 0) { const LAS float* Lb = DIAG + q4 * 256; float x[16];
#pragma unroll
            for (int r = 0; r < 16; ++r) { float s = (r == l16) ? 1.0f : 0.0f;
#pragma unroll
                for (int j = 0; j < r; ++j) s += Lb[r * 16 + j] * x[j];
                x[r] = s; }
#pragma unroll
            for (int r = 0; r < 16; ++r) s12[(q4 * 16 + r) * LT + q4 * 16 + l16] = (bf16)f2bf(x[r]);
            { float lo[8], hi[8];
#pragma unroll
              for (int r = 0; r < 8; ++r) { lo[r] = x[r]; hi[r] = x[8 + r]; }
              *(LAS v4u*)(s13 + (q4 * 16 + l16) * LT + q4 * 16) = pack8(lo); *(LAS v4u*)(s13 + (q4 * 16 + l16) * LT + q4 * 16 + 8) = pack8(hi); } }
        __syncthreads();
        const f32x4 z4 = {0.f, 0.f, 0.f, 0.f};
#pragma unroll
        for (int xi = 0; xi < 2; ++xi) { const int x0 = (xb + xi) * 16; st4(s0, y0 + l16, x0 + 4 * q4, tile2(s8, x0, s13, y0, lane, z4)); }
        __syncthreads();
#pragma unroll
        for (int xi = 0; xi < 2; ++xi) { const int x0 = (xb + xi) * 16, yr = y0 + l16, xc = x0 + 4 * q4;
            st4(s2, yr, xc, tile2(s0, x0, s12, y0, lane, ld4(s12, yr, xc)));
            st4(s3, yr, xc, tile2(s12, x0, s0, y0, lane, ld4(s13, yr, xc))); }
        __syncthreads();
#pragma unroll
        for (int xi = 0; xi < 2; ++xi) { const int x0 = (xb + xi) * 16; st4(s0, y0 + l16, x0 + 4 * q4, tile2(s9, x0, s3, y0, lane, z4)); }
        __syncthreads();
#pragma unroll
        for (int xi = 0; xi < 2; ++xi) { const int x0 = (xb + xi) * 16, yr = y0 + l16, xc = x0 + 4 * q4; st4(s12, yr, xc, tile2(s0, x0, s2, y0, lane, ld4(s2, yr, xc))); }
        __syncthreads();
#pragma unroll
        for (int xi = 0; xi < 2; ++xi) { const int x0 = (xb + xi) * 16, yr = y0 + l16, xc = x0 + 4 * q4;
            st4(s13, yr, xc, tile2(s12, x0, s4, y0, lane, z4));
            st4(s0, yr, xc, tile2(s12, x0, s10, y0, lane, z4)); }
        __syncthreads();
#pragma unroll
        for (int xi = 0; xi < 2; ++xi) { const int xt = xb + xi, x0 = xt * 16, yr = y0 + l16, xc = x0 + 4 * q4;
            f32x4 acc = tile2(s13, x0, s11, y0, lane, ld4(s1, yr, xc));
            *(v2u*)(GY + (size_t)u * 4096 + yr * 64 + xc) = pack4(acc);
            st4(s2, yr, xc, tile2(s0, x0, s11, y0, lane, lrk[xi]));
            acc = tile2(s13, x0, s5, y0, lane, z4);
#pragma unroll
            for (int r = 0; r < 4; ++r) acc[r] += (xc + r == yr) ? GC[yr] : 0.f;
            *(v2u*)(GS + (size_t)u * 4096 + yr * 64 + xc) = pack4(acc);
            st4(s3, yr, xc, tile2(s0, x0, s5, y0, lane, ld4(s6, yr, xc))); }
        __syncthreads();
#pragma unroll
        for (int xi = 0; xi < 2; ++xi) { const int x0 = (xb + xi) * 16, yr = y0 + l16, xc = x0 + 4 * q4;
            *(v2u*)(YS + (size_t)u * 4096 + yr * 64 + xc) = pack4(tile2(s7, x0, s2, y0, lane, z4));
            *(v2u*)(SS + (size_t)u * 4096 + yr * 64 + xc) = pack4(tile2(s3, x0, s7, y0, lane, z4)); }
        __syncthreads();
    }
}

struct RwBRegs { v2u g[4][2][2]; v2u s[4]; };
__device__ __forceinline__ void rwB_load(RwBRegs& R, const bf16* GS, const bf16* SS, size_t u, int vg, int l16, int q4) {
#pragma unroll
    for (int mt = 0; mt < 4; ++mt) {
#pragma unroll
        for (int s = 0; s < 2; ++s) { const bf16* p = GS + u * 4096 + (mt * 16 + l16) * 64 + 32 * s + 4 * q4; R.g[mt][s][0] = *(const v2u*)p; R.g[mt][s][1] = *(const v2u*)(p + 16); }
        R.s[mt] = *(const v2u*)(SS + u * 4096 + (vg * 16 + l16) * 64 + mt * 16 + 4 * q4); }
}
__device__ __forceinline__ void phase_rwB(const Args& a, int lane, int wave, int bid, int G) {
    if (wave != 0) return;
    unsigned char* ws = a.ws; const bf16* GS = (const bf16*)((const unsigned char*)a.out + RW_GS); const bf16* SS = (const bf16*)((const unsigned char*)a.out + RW_SS); bf16* H0 = (bf16*)(ws + WS_H0);
    const int q4 = lane >> 4, l16 = lane & 15;
    for (int ch = bid; ch < 256; ch += G) {
        const int bh = ch >> 2, vg = ch & 3; const size_t u0 = (size_t)bh * 32;
        f32x4 H[4];
#pragma unroll
        for (int mt = 0; mt < 4; ++mt) H[mt] = (f32x4){0.f, 0.f, 0.f, 0.f};
        RwBRegs nxt; rwB_load(nxt, GS, SS, u0, vg, l16, q4);
        for (int c = 0; c < 32; ++c) {
            const RwBRegs cur = nxt;
            if (c + 1 < 32) rwB_load(nxt, GS, SS, u0 + c + 1, vg, l16, q4);
            v4u hf[2];
#pragma unroll
            for (int s = 0; s < 2; ++s) { const v2u lo = pack4(H[2 * s]), hi = pack4(H[2 * s + 1]); hf[s] = (v4u){lo.x, lo.y, hi.x, hi.y};
                bf16* hp = H0 + (u0 + c) * 4096 + (vg * 16 + l16) * 64 + 32 * s + 4 * q4; *(v2u*)hp = lo; *(v2u*)(hp + 16) = hi; }
#pragma unroll
            for (int mt = 0; mt < 4; ++mt) { f32x4 acc = unpack4(cur.s[mt]);
#pragma unroll
                for (int s = 0; s < 2; ++s) { const v4u af = {cur.g[mt][s][0].x, cur.g[mt][s][0].y, cur.g[mt][s][1].x, cur.g[mt][s][1].y};
                    acc = mfma16(__builtin_bit_cast(bf16x8, af), __builtin_bit_cast(bf16x8, hf[s]), acc); }
                H[mt] = acc; }
        }
    }
}

__device__ __forceinline__ void phase_rwC(const Args& a, int lane, int wave, int bid, int G) {
    unsigned char* ws = a.ws; const bf16* P = (const bf16*)(ws + WS_P);
    const bf16* GY = (const bf16*)((const unsigned char*)a.out + RW_GY); const bf16* YS = (const bf16*)((const unsigned char*)a.out + RW_YS); const bf16* H0 = (const bf16*)(ws + WS_H0);
    const bf16* G2T = (const bf16*)(ws + WS_G2T); const float* BON = (const float*)(ws + WS_BONUS); const float* mu = a.in[3]; const float* lg = a.in[12]; const float* lb = a.in[13];
    bf16* OA = (bf16*)(ws + WS_OA);
    const int q4 = lane >> 4, l16 = lane & 15; const int gw = bid * NWAVES + wave, NGW = G * NWAVES;
    for (int task = gw; task < 8192; task += NGW) {
        const int u = task >> 2, tt = task & 3; const int b = u >> 9, h = (u >> 5) & 15, c = u & 31;
        const int tl = tt * 16 + l16; const size_t tg = (size_t)b * SEQ + c * 64 + tl; const bool first = (c == 0 && tl == 0);
        f32x4 y[4], g[4];
        { const bf16x8 yf0 = *(const bf16x8*)(GY + (size_t)u * 4096 + tl * 64 + q4 * 8), yf1 = *(const bf16x8*)(GY + (size_t)u * 4096 + tl * 64 + 32 + q4 * 8);
#pragma unroll
          for (int vt = 0; vt < 4; ++vt) { f32x4 acc = unpack4(*(const v2u*)(YS + (size_t)u * 4096 + tl * 64 + vt * 16 + 4 * q4));
              const bf16* hp = H0 + (size_t)u * 4096 + (vt * 16 + l16) * 64 + q4 * 8;
              acc = mfma16(*(const bf16x8*)hp, yf0, acc); acc = mfma16(*(const bf16x8*)(hp + 32), yf1, acc); y[vt] = acc; } }
#pragma unroll
        for (int vt = 0; vt < 4; ++vt) g[vt] = (f32x4){0.f, 0.f, 0.f, 0.f};
#pragma unroll
        for (int ks = 0; ks < 8; ++ks) { float x[8]; shift8(P, tg, P_XG + ks * 32 + q4 * 8, first, mu, x);
#pragma unroll
            for (int j = 0; j < 8; ++j) x[j] = sigmoidf_(x[j]);
            const bf16x8 gf = __builtin_bit_cast(bf16x8, pack8(x));
#pragma unroll
            for (int vt = 0; vt < 4; ++vt) g[vt] = mfma16(*(const bf16x8*)(G2T + (size_t)(h * 64 + vt * 16 + l16) * 256 + ks * 32 + q4 * 8), gf, g[vt]); }
        float s = 0.f;
#pragma unroll
        for (int vt = 0; vt < 4; ++vt) s += (y[vt][0] + y[vt][1]) + (y[vt][2] + y[vt][3]);
        s += __shfl_xor(s, 16); s += __shfl_xor(s, 32);
        const float mean = s * (1.0f / 64.0f); float q = 0.f;
#pragma unroll
        for (int vt = 0; vt < 4; ++vt)
#pragma unroll
            for (int r = 0; r < 4; ++r) { const float d = y[vt][r] - mean; q += d * d; }
        q += __shfl_xor(q, 16); q += __shfl_xor(q, 32);
        const float rstd = rsqrtf(q * (1.0f / 64.0f) + 64e-5f); const float bon = BON[tg * RW_H + h];
#pragma unroll
        for (int vt = 0; vt < 4; ++vt) { const int chn = h * 64 + vt * 16 + 4 * q4;
            const v2u cur = *(const v2u*)(P + tg * NP + 2048 + chn); v2u prv = {0u, 0u}; if (!first) prv = *(const v2u*)(P + (tg - 1) * NP + 2048 + chn);
            const f32x4 cv = unpack4(cur), pv = unpack4(prv), m4 = *(const f32x4*)(mu + 2048 + chn), lg4 = *(const f32x4*)(lg + chn), lb4 = *(const f32x4*)(lb + chn);
            f32x4 o;
#pragma unroll
            for (int r = 0; r < 4; ++r) { const float vsh = cv[r] + (pv[r] - cv[r]) * m4[r]; o[r] = ((y[vt][r] - mean) * rstd * lg4[r] + lb4[r] + bon * vsh) * g[vt][r]; }
            *(v2u*)(OA + tg * RW_W + chn) = pack4(o); }
    }
}

constexpr size_t WS_WTG = 262144;
constexpr size_t WS_RS = WS_WTG + 393216;
static_assert(WS_RS + 32768 <= WS_ROT, "small tables fit below the rotary table");
__device__ __forceinline__ void phase_router2(const Args& a, LAS unsigned char* lds, int tid, int lane, int wave, int bid, int G) {
    unsigned char* ws = a.ws; const float* X1 = a.out; const float* WTG = (const float*)(ws + WS_WTG); float* RS = (float*)(ws + WS_RS);
    const float* bg = a.in[20]; const float* be = a.in[22];
    unsigned* ctl = (unsigned*)(ws + WS_CTL); int* TE = (int*)(ws + WS_TOKE); float* TW = (float*)(ws + WS_TOKW); int* TP = (int*)(ws + WS_TOKP);
    LAS float* part = (LAS float*)lds;
    const int q4 = lane >> 4, l16 = lane & 15, tile = wave >> 2, kq = wave & 3;
    for (int tp = bid; tp < NTOK / 32; tp += G) {
        const int t0 = tp * 32 + tile * 16;
        __syncthreads();
        f32x4 acc[3] = {{0.f, 0.f, 0.f, 0.f}, {0.f, 0.f, 0.f, 0.f}, {0.f, 0.f, 0.f, 0.f}}; float ssq = 0.f;
        const float* xp = X1 + (size_t)(t0 + l16) * DM + kq * 512 + 4 * q4; const float* wp = WTG + (size_t)l16 * DM + kq * 512 + 4 * q4;
#pragma unroll 4
        for (int g = 0; g < 32; ++g) { const f32x4 xv = *(const f32x4*)(xp + 16 * g);
            const f32x4 w0 = *(const f32x4*)(wp + 16 * g), w1 = *(const f32x4*)(wp + 16 * DM + 16 * g), w2 = *(const f32x4*)(wp + 32 * DM + 16 * g);
            ssq += (xv[0] * xv[0] + xv[1] * xv[1]) + (xv[2] * xv[2] + xv[3] * xv[3]);
#pragma unroll
            for (int j = 0; j < 4; ++j) { acc[0] = __builtin_amdgcn_mfma_f32_16x16x4f32(w0[j], xv[j], acc[0], 0, 0, 0); acc[1] = __builtin_amdgcn_mfma_f32_16x16x4f32(w1[j], xv[j], acc[1], 0, 0, 0);
                acc[2] = __builtin_amdgcn_mfma_f32_16x16x4f32(w2[j], xv[j], acc[2], 0, 0, 0); } }
        ssq += __shfl_xor(ssq, 16); ssq += __shfl_xor(ssq, 32);
        LAS float* pr = part + ((tile * 4 + kq) * 16 + l16) * 52;
#pragma unroll
        for (int ot = 0; ot < 3; ++ot) *(LAS f32x4*)(pr + ot * 16 + 4 * q4) = acc[ot];
        if (q4 == 0) pr[48] = ssq;
        __syncthreads();
        if (tid < 32) { const int tl = tid >> 4, tk = tid & 15, t = tp * 32 + tl * 16 + tk;
            const LAS float* p0 = part + ((tl * 4 + 0) * 16 + tk) * 52; const int ks = 16 * 52;
            const float sq = (p0[48] + p0[ks + 48]) + (p0[2 * ks + 48] + p0[3 * ks + 48]); const float rs = rsqrtf(sq * (1.0f / DM) + 1e-6f);
            float gl[4];
#pragma unroll
            for (int q = 0; q < 4; ++q) gl[q] = ((p0[q] + p0[ks + q]) + (p0[2 * ks + q] + p0[3 * ks + q])) * rs + bg[q];
            int gs = 0; float gm = gl[0];
#pragma unroll
            for (int q = 1; q < 4; ++q) if (gl[q] > gm) { gm = gl[q]; gs = q; }
            float den = 0.f;
#pragma unroll
            for (int q = 0; q < 4; ++q) den += expf(gl[q] - gm);
            const float gwt = 1.0f / den;
            float el[8];
#pragma unroll
            for (int q = 0; q < 8; ++q) { const int o = 4 + gs * 8 + q; el[q] = ((p0[o] + p0[ks + o]) + (p0[2 * ks + o] + p0[3 * ks + o])) * rs + be[gs * 8 + q]; }
            int i0 = 0; float m0 = el[0];
#pragma unroll
            for (int q = 1; q < 8; ++q) if (el[q] > m0) { m0 = el[q]; i0 = q; }
            int i1 = -1; float m1 = -3.0e38f;
#pragma unroll
            for (int q = 0; q < 8; ++q) if (q != i0 && el[q] > m1) { m1 = el[q]; i1 = q; }
            const float e1 = expf(m1 - m0); const float w0 = gwt / (1.0f + e1), w1 = gwt * e1 / (1.0f + e1);
            const int ex0 = gs * 8 + i0, ex1 = gs * 8 + i1;
            const unsigned c0 = __hip_atomic_fetch_add(ctl + CW_CNT + ex0, 1u, RLX_AGENT), c1 = __hip_atomic_fetch_add(ctl + CW_CNT + ex1, 1u, RLX_AGENT);
            TE[2 * t] = ex0; TE[2 * t + 1] = ex1; TW[2 * t] = w0; TW[2 * t + 1] = w1; TP[2 * t] = (int)c0; TP[2 * t + 1] = (int)c1; RS[t] = rs; }
    }
}

__device__ __forceinline__ void phase_gather2(const Args& a, LAS unsigned char* lds, int tid, int lane, int wave, int bid, int G) {
    unsigned char* ws = a.ws; unsigned* ctl = (unsigned*)(ws + WS_CTL); const float* X1 = a.out; bf16* XG = (bf16*)(ws + WS_XG); const float* RS = (const float*)(ws + WS_RS); const float* g2 = a.in[18];
    const int* TE = (const int*)(ws + WS_TOKE); const int* TP = (const int*)(ws + WS_TOKP); int* TS = (int*)(ws + WS_TOKS);
    LAS int* ps = (LAS int*)lds;
    __syncthreads();
    if (tid == 0) { int acc = 0, nt = 0;
        for (int e = 0; e < NEXP; ++e) { const int c = (int)__hip_atomic_load(ctl + CW_CNT + e, RLX_AGENT); ps[e] = acc; ps[64 + e] = c; const int tl = (c + 255) >> 8;
            if (bid == 0) for (int q = 0; q < tl; ++q) ctl[CW_TE + nt + q] = (unsigned)e;
            nt += tl; acc += tl * 256; }
        ps[32] = acc; if (bid == 0) ctl[CW_NT] = (unsigned)nt; }
    __syncthreads();
    const int gw = bid * NWAVES + wave, NGW = G * NWAVES;
    for (int t = gw; t < NTOK; t += NGW) { const int s0 = ps[TE[2 * t]] + TP[2 * t], s1 = ps[TE[2 * t + 1]] + TP[2 * t + 1]; const float rs = RS[t];
        const f32x4* xr = (const f32x4*)(X1 + (size_t)t * DM) + lane; v2u* d0 = (v2u*)(XG + (size_t)s0 * DM) + lane; v2u* d1 = (v2u*)(XG + (size_t)s1 * DM) + lane;
#pragma unroll
        for (int j = 0; j < 8; ++j) { const f32x4 x = xr[64 * j]; const f32x4 g = ((const f32x4*)g2)[64 * j + lane];
            v2u o; o.x = cvt2(x.x * rs * g.x, x.y * rs * g.y); o.y = cvt2(x.z * rs * g.z, x.w * rs * g.w); d0[64 * j] = o; d1[64 * j] = o; }
        if (lane == 0) { TS[2 * t] = s0; TS[2 * t + 1] = s1; } }
    for (int e = 0; e < NEXP; ++e) { const int c = ps[64 + e], base = ps[e] + c, npad = ps[e + 1] - base;
        for (int r = gw; r < npad; r += NGW) { v4u* dst = (v4u*)(XG + (size_t)(base + r) * DM) + lane;
#pragma unroll
            for (int j = 0; j < 4; ++j) dst[64 * j] = (v4u){0u, 0u, 0u, 0u}; } }
}

constexpr int NPHASE = 14;
__global__ void __launch_bounds__(NTHR, 2) mega_fwd(Args args) {
    extern __shared__ __attribute__((aligned(16))) unsigned char lds_raw[];
    LAS unsigned char* lds = (LAS unsigned char*)lds_raw;
    const int tid = threadIdx.x, lane = tid & 63, wave = __builtin_amdgcn_readfirstlane(tid >> 6), bid = blockIdx.x, G = gridDim.x;
    unsigned char* ws = args.ws; unsigned* ctl = (unsigned*)(ws + WS_CTL);
    volatile LAS unsigned* MISC = (volatile LAS unsigned*)(lds + MISC_OFF);
    for (int u = tid; u < (LDS_BYTES - RING_BYTES) / 4; u += NTHR) ((LAS unsigned*)(lds + RING_BYTES))[u] = 0u;
    __syncthreads();
    const int lo = args.ph_lo, hi = args.ph_hi;
    const bool multi = (hi - lo) > 1;
    XcdBarrier bar; bar.bar = ctl + CW_BAR; bar.x = 0; bar.st = nullptr;
    if (multi) bar = xcd_barrier_post(ctl + CW_BAR, MISC + 8);
#ifndef PH_MASK
#define PH_MASK 0x3fff
#endif
#define IN(k) (((PH_MASK >> (k)) & 1) && lo <= (k) && (k) < hi)
#define SEAM(k) do { if (IN(k) && IN((k) + 1)) xcd_barrier(bar); } while (0)
    bf16* P = (bf16*)(ws + WS_P);

#ifndef PH_REP
#define PH_REP 0
#endif
#define REP(k) ((PH_REP >> (k)) & 1)
#define P0_BODY { phase_prologue(args, lds, tid, lane, wave, bid, G); }
#define P1_BODY { pg8::Gemm g{(const bf16*)(ws + WS_H1), (const bf16*)(ws + WS_WIN), NTOK, NP, DM}; pg8::StaticOrder S; S.init(NTOK, NP, G, bid); EpiP E{P}; pg8::gemm_phase<EpiP, pg8::StaticOrder, true, true>(lds, g, S, E); }
#define P2_BODY { phase_rwA(args, lds, tid, lane, wave, bid, G); }
#define P3_BODY { phase_ret_mfma(args, lds, tid, lane, wave, bid, G); }
#define P4_BODY { phase_rwB(args, lane, wave, bid, G); }
#define P6_BODY { pg8::Gemm g{(const bf16*)(ws + WS_OA), (const bf16*)(ws + WS_WUPA), NTOK, DM, 1024}; pg8::StaticOrder S; S.init(NTOK, DM, G, bid); EpiUp<0> E{(bf16*)(ws + WS_MERGED), P}; pg8::gemm_phase<EpiUp<0>, pg8::StaticOrder, false, true>(lds, g, S, E); }
#define P7_BODY { pg8::Gemm g{(const bf16*)(ws + WS_OB), (const bf16*)(ws + WS_WUPB), NTOK, DM, DM}; pg8::StaticOrder S; S.init(NTOK, DM, G, bid); EpiUp<1> E{(bf16*)(ws + WS_MERGED), P}; pg8::gemm_phase<EpiUp<1>, pg8::StaticOrder, false, true>(lds, g, S, E); }
#define P8_BODY { pg8::Gemm g{(const bf16*)(ws + WS_MERGED), (const bf16*)(ws + WS_WOUT), NTOK, DM, DM}; pg8::StaticOrder S; S.init(NTOK, DM, G, bid); EpiX1 E{args.in[0], args.out}; pg8::gemm_phase<EpiX1, pg8::StaticOrder, false, true>(lds, g, S, E); }
#define P10_BODY { phase_gather2(args, lds, tid, lane, wave, bid, G); }
#define P11_BODY { pg8::Gemm g{(const bf16*)(ws + WS_XG), (const bf16*)(ws + WS_WGU), MAXSLOT, NEXP * 1024, DM}; MoeOrder<4> S; S.init(ctl, G, bid); EpiGU E{(bf16*)(ws + WS_ACT)}; pg8::gemm_phase<EpiGU, MoeOrder<4>, true, true>(lds, g, S, E); }
#define P12_BODY { pg8::Gemm g{(const bf16*)(ws + WS_ACT), (const bf16*)(ws + WS_WDN), MAXSLOT, NEXP * 2048, EFF}; MoeOrder<8> S; S.init(ctl, G, bid); EpiDn E{(bf16*)(ws + WS_YS)}; pg8::gemm_phase<EpiDn, MoeOrder<8>, true, true>(lds, g, S, E); }
    if (IN(0)) { P0_BODY if (REP(0)) { xcd_barrier(bar); P0_BODY } } SEAM(0);
    if (IN(1)) { P1_BODY if (REP(1)) { xcd_barrier(bar); P1_BODY } } SEAM(1);
    if (IN(2)) { P2_BODY if (REP(2)) { P2_BODY } }
    if (IN(3)) { P3_BODY if (REP(3)) { P3_BODY } } SEAM(3);
    if (IN(4)) { P4_BODY if (REP(4)) { xcd_barrier(bar); P4_BODY } } SEAM(4);
    if (IN(5)) { phase_rwC(args, lane, wave, bid, G); if (REP(5)) { phase_rwC(args, lane, wave, bid, G); } phase_retpost(args, lane, wave, bid, G); } SEAM(5);
    if (IN(6)) P6_BODY
    if (IN(7)) P7_BODY
    SEAM(7);
    if (IN(8)) { P8_BODY if (REP(6)) { xcd_barrier(bar); P6_BODY xcd_barrier(bar); P7_BODY xcd_barrier(bar); P8_BODY } } SEAM(8);
    if (IN(9)) { phase_router2(args, lds, tid, lane, wave, bid, G); } SEAM(9);
    if (IN(10)) P10_BODY
    SEAM(10);
    if (IN(11)) P11_BODY
    SEAM(11);
    if (IN(12)) { P12_BODY if (REP(10)) { xcd_barrier(bar); P10_BODY xcd_barrier(bar); P11_BODY xcd_barrier(bar); P12_BODY } } SEAM(12);
    if (IN(13)) { phase_final(args, lane, wave, bid, G); }
#undef IN
#undef SEAM
}

#ifndef MK_ONE_LAUNCH
#define MK_ONE_LAUNCH 1
#endif
extern "C" void kernel_launch(void* const* d_in, const int* in_sizes, int n_in, void* d_out, int out_size, void* d_ws, size_t ws_size, hipStream_t stream) {
    static int grid = 0;
    if (grid == 0) {
        if (n_in != 27 || out_size != NTOK * DM || ws_size < WS_END) { fprintf(stderr, "kernel_launch: unexpected shapes (n_in %d out %d ws %zu, need %zu)\n", n_in, out_size, ws_size, (size_t)WS_END); grid = -1; return; }
        int dev = 0, cus = 0, per_cu = 0;
        if (hipGetDevice(&dev) != hipSuccess || hipDeviceGetAttribute(&cus, hipDeviceAttributeMultiprocessorCount, dev) != hipSuccess) { grid = -1; return; }
        if (hipFuncSetAttribute((const void*)mega_fwd, hipFuncAttributeMaxDynamicSharedMemorySize, LDS_BYTES) != hipSuccess) { fprintf(stderr, "kernel_launch: hipFuncSetAttribute failed\n"); grid = -1; return; }
        if (hipOccupancyMaxActiveBlocksPerMultiprocessor(&per_cu, (const void*)mega_fwd, NTHR, LDS_BYTES) != hipSuccess || per_cu < 1) { fprintf(stderr, "kernel_launch: occupancy query says %d\n", per_cu); grid = -1; (void)hipGetLastError(); return; }
        grid = cus;
    }
    if (grid < 0) return;
    (void)in_sizes;
    if (hipMemsetAsync((char*)d_ws + WS_CTL, 0, CTL_ZERO_BYTES, stream) != hipSuccess) return;
    Args a{};
    for (int i = 0; i < 27; ++i) a.in[i] = (const float*)d_in[i];
    a.out = (float*)d_out; a.ws = (unsigned char*)d_ws;
#if MK_ONE_LAUNCH
    a.ph_lo = 0; a.ph_hi = NPHASE;
    hipLaunchKernelGGL(mega_fwd, dim3(grid), dim3(NTHR), LDS_BYTES, stream, a);
#else
    for (int p = 0; p < NPHASE; ++p) { a.ph_lo = p; a.ph_hi = p + 1; hipLaunchKernelGGL(mega_fwd, dim3(grid), dim3(NTHR), LDS_BYTES, stream, a); }
#endif
}
```

```cpp
#include <hip/hip_runtime.h>
#include <cstdio>
#include <cstdint>
namespace pg8 {
#define PG8_LAS __attribute__((address_space(3)))
typedef unsigned short bf16_t;
typedef short bf16x8 __attribute__((ext_vector_type(8)));
typedef float f32x4 __attribute__((ext_vector_type(4)));
typedef unsigned u32x4 __attribute__((ext_vector_type(4)));
constexpr int BM = 256, BK = 64, HALF = 128, HTB = HALF * BK * 2  , STAGE_BYTES = 8 * HTB, NXCD = 8, WGM = 8;

__host__ __device__ __forceinline__ int lds_byte(int r, int c) { const int st = (r >> 4) * 2 + (c >> 5), rr = r & 15, cc = c & 31, ob = rr * 64 + cc * 2; return st * 1024 + (ob ^ (((ob >> 9) & 1) << 5)); }
__host__ __device__ __forceinline__ void stage_rc(int b, int& R, int& C) { const int st = b / 1024, sb = b % 1024, swz = sb ^ (((sb >> 9) & 1) << 5); R = (st >> 1) * 16 + swz / 64; C = (st & 1) * 32 + (swz % 64) / 2; }
__host__ __device__ __forceinline__ int perm32(int rho) { const int n = rho >> 4, i = rho & 15; return 8 * (i >> 2) + 4 * n + (i & 3); }

struct Unit { int pm, pn; };
struct Gemm { const bf16_t* A; const bf16_t* Bt; int M, N, K; };

struct StaticOrder {
    int nM, nN, nwg, G, c;
    __host__ __device__ void init(int M, int N, int G_, int c_) { nM = M / BM; nN = N / BM; nwg = nM * nN; G = G_; c = c_; }
    __host__ __device__ bool next(int i, Unit& u) const {
        const long L = (long)i * G + c; if (L >= nwg) return false;
        int wgid = (int)L; { const int q = nwg / NXCD, r = nwg % NXCD, xcd = wgid % NXCD, off = wgid / NXCD; wgid = (xcd < r ? xcd * (q + 1) : r * (q + 1) + (xcd - r) * q) + off; }
        const int nig = WGM * nN, gid = wgid / nig, fm = gid * WGM, gsz = (nM - fm) < WGM ? (nM - fm) : WGM;
        u.pm = fm + ((wgid % nig) % gsz); u.pn = (wgid % nig) / gsz; return true;
    }
    __device__ __forceinline__ void a_ready(const Unit&) const {}
    __device__ __forceinline__ void done(const Unit&) const {}
};

__device__ __forceinline__ unsigned cvt_pk_bf16(float lo, float hi) { unsigned r; asm volatile("v_cvt_pk_bf16_f32 %0, %1, %2" : "=v"(r) : "v"(lo), "v"(hi)); return r; }
typedef float f32x2 __attribute__((ext_vector_type(2)));
template <class Epi, class Sched, bool ALIGN_EPI = false, bool SP2 = false>
__device__ __forceinline__ void gemm_phase(PG8_LAS unsigned char* lds, const Gemm g, const Sched& S, const Epi& E) {
    const int tid = threadIdx.x, wid = __builtin_amdgcn_readfirstlane(tid >> 6), lane = tid & 63, wr = wid >> 2, wc = wid & 3, fr = lane & 15, fq = lane >> 4;
    const int K = g.K, nt = K / BK;
    unsigned voffA[2], voffB[2];
#pragma unroll
    for (int i = 0; i < 2; ++i) { int R, C; stage_rc(tid * 16 + i * 8192, R, C); const int Rb = Epi::PERM ? ((R & ~31) + perm32(R & 31)) : R;
        voffA[i] = (unsigned)(R * K + C) * 2u; voffB[i] = (unsigned)(Rb * K + C) * 2u; }
    const size_t kstep = (size_t)(BK * 2);
    const size_t hstep = (size_t)HALF * K * 2;
    const size_t tstep = 2 * hstep;
    const unsigned ldsw = (unsigned)wid * 1024u;
    const int aoff = lds_byte(wr * 64 + fr, fq * 8), boff = lds_byte(wc * 32 + fr, fq * 8);
#define PG8_SA(b, h) (((b) * 2 + (h)) * HTB)
#define PG8_SB(b, h) ((4 + (b) * 2 + (h)) * HTB)
#define PG8_STAGE(bufoff, gbase, voff) do { _Pragma("unroll") for (int _i = 0; _i < 2; ++_i) \
        __builtin_amdgcn_global_load_lds((const unsigned*)((const char*)(gbase) + (voff)[_i]), (PG8_LAS unsigned*)(lds + (bufoff) + ldsw + _i * 8192), 16, 0, 0); } while (0)
#define PG8_LDA(dst, b, h) do { _Pragma("unroll") for (int m = 0; m < 4; ++m) _Pragma("unroll") for (int k = 0; k < 2; ++k) dst[m][k] = *(const PG8_LAS bf16x8*)(lds + PG8_SA(b, h) + aoff + m * 2048 + k * 1024); } while (0)
#define PG8_LDB(dst, b, h) do { _Pragma("unroll") for (int n = 0; n < 2; ++n) _Pragma("unroll") for (int k = 0; k < 2; ++k) dst[n][k] = *(const PG8_LAS bf16x8*)(lds + PG8_SB(b, h) + boff + n * 2048 + k * 1024); } while (0)
#define PG8_MMA(ai, bj, At, Bt) do { __builtin_amdgcn_s_setprio(1); _Pragma("unroll") for (int m = 0; m < 4; ++m) _Pragma("unroll") for (int n = 0; n < 2; ++n) _Pragma("unroll") for (int k = 0; k < 2; ++k) \
        acc[ai][bj][m][n] = __builtin_amdgcn_mfma_f32_16x16x32_bf16(Bt[n][k], At[m][k], acc[ai][bj][m][n], 0, 0, 0); __builtin_amdgcn_s_setprio(0); } while (0)
#define PG8_WAIT_V(n) asm volatile("s_waitcnt vmcnt(" #n ")" ::: "memory")
#define PG8_WAIT_L(n) asm volatile("s_waitcnt lgkmcnt(" #n ")" ::: "memory")
#define PG8_BAR __builtin_amdgcn_s_barrier()
#define PG8_SCHED __builtin_amdgcn_sched_barrier(0)
    Unit cur, nxt; int ui = 0;
    if (!S.next(0, cur)) return;
    f32x4 acc[2][2][4][2];
#pragma unroll
    for (int a = 0; a < 2; ++a)
#pragma unroll
        for (int b = 0; b < 2; ++b)
#pragma unroll
            for (int m = 0; m < 4; ++m)
#pragma unroll
                for (int n = 0; n < 2; ++n) acc[a][b][m][n] = (f32x4){0.f, 0.f, 0.f, 0.f};
    bf16x8 At[4][2], B0[2][2], B1[2][2];
    const char* cA = (const char*)g.A + (size_t)cur.pm * tstep; const char* cB = (const char*)g.Bt + (size_t)cur.pn * tstep;
    S.a_ready(cur);
    if constexpr (SP2) {
        PG8_STAGE(PG8_SB(0, 0), cB, voffB); PG8_STAGE(PG8_SB(0, 1), cB + hstep, voffB); PG8_STAGE(PG8_SA(0, 0), cA, voffA); PG8_STAGE(PG8_SA(0, 1), cA + hstep, voffA);
        if (wr == 1) PG8_BAR;
        PG8_WAIT_V(2); PG8_BAR;
        PG8_STAGE(PG8_SB(1, 0), cB + kstep, voffB); PG8_STAGE(PG8_SA(1, 0), cA + kstep, voffA); PG8_STAGE(PG8_SB(1, 1), cB + hstep + kstep, voffB);
        PG8_WAIT_V(6); PG8_BAR;
    } else {
        PG8_STAGE(PG8_SB(0, 0), cB, voffB); PG8_STAGE(PG8_SA(0, 0), cA, voffA); PG8_STAGE(PG8_SB(0, 1), cB + hstep, voffB); PG8_STAGE(PG8_SA(0, 1), cA + hstep, voffA);
        if (wr == 1) PG8_BAR;
        PG8_WAIT_V(4); PG8_BAR;
        PG8_STAGE(PG8_SB(1, 0), cB + kstep, voffB); PG8_STAGE(PG8_SA(1, 0), cA + kstep, voffA); PG8_STAGE(PG8_SB(1, 1), cB + hstep + kstep, voffB);
        PG8_WAIT_V(6); PG8_BAR;
    }
    for (;;) {
        const bool has_next = S.next(ui + 1, nxt);
        const char* nA = has_next ? (const char*)g.A + (size_t)nxt.pm * tstep : cA; const char* nB = has_next ? (const char*)g.Bt + (size_t)nxt.pn * tstep : cB;
        for (int t = 0; t < nt; t += 2) {
            const bool last = (t == nt - 2);
            const char* a1 = cA + (size_t)(t + 1) * kstep;
            const char* a2 = last ? nA : cA + (size_t)(t + 2) * kstep; const char* b2 = last ? nB : cB + (size_t)(t + 2) * kstep;
            const char* a3 = a2 + kstep; const char* b3 = b2 + kstep;
            if (last && has_next) S.a_ready(nxt);
            if constexpr (SP2) {
            PG8_LDB(B0, 0, 0); PG8_LDB(B1, 0, 1); PG8_SCHED; PG8_LDA(At, 0, 0); PG8_STAGE(PG8_SA(1, 1), a1 + hstep, voffA);
            PG8_WAIT_V(8); PG8_WAIT_L(0); PG8_BAR; PG8_MMA(0, 0, At, B0); PG8_MMA(0, 1, At, B1); PG8_BAR; PG8_SCHED;
            PG8_LDA(At, 0, 1); PG8_STAGE(PG8_SB(0, 0), b2, voffB); PG8_STAGE(PG8_SB(0, 1), b2 + hstep, voffB); PG8_STAGE(PG8_SA(0, 0), a2, voffA);
            PG8_WAIT_V(8); PG8_WAIT_L(0); PG8_BAR; PG8_MMA(1, 0, At, B0); PG8_MMA(1, 1, At, B1); PG8_BAR; PG8_SCHED;
            PG8_LDB(B0, 1, 0); PG8_LDB(B1, 1, 1); PG8_SCHED; PG8_LDA(At, 1, 0); PG8_STAGE(PG8_SA(0, 1), a2 + hstep, voffA);
            PG8_WAIT_V(8); PG8_WAIT_L(0); PG8_BAR; PG8_MMA(0, 0, At, B0); PG8_MMA(0, 1, At, B1); PG8_BAR; PG8_SCHED;
            PG8_LDA(At, 1, 1); PG8_STAGE(PG8_SB(1, 0), b3, voffB); PG8_STAGE(PG8_SB(1, 1), b3 + hstep, voffB); PG8_STAGE(PG8_SA(1, 0), a3, voffA);
            PG8_WAIT_V(8); PG8_WAIT_L(0); PG8_BAR; PG8_MMA(1, 0, At, B0); PG8_MMA(1, 1, At, B1); PG8_BAR; PG8_SCHED;
            } else {
            PG8_LDB(B0, 0, 0); PG8_SCHED; PG8_LDA(At, 0, 0); PG8_STAGE(PG8_SA(1, 1), a1 + hstep, voffA);
            PG8_WAIT_L(8); PG8_BAR; PG8_WAIT_L(0); PG8_MMA(0, 0, At, B0); PG8_BAR; PG8_SCHED;
            PG8_LDB(B1, 0, 1); PG8_STAGE(PG8_SB(0, 0), b2, voffB);
            PG8_BAR; PG8_WAIT_L(0); PG8_MMA(0, 1, At, B1); PG8_BAR;
            PG8_LDA(At, 0, 1); PG8_STAGE(PG8_SA(0, 0), a2, voffA);
            PG8_BAR; PG8_WAIT_L(0); PG8_MMA(1, 0, At, B0); PG8_BAR; PG8_SCHED;
            PG8_STAGE(PG8_SB(0, 1), b2 + hstep, voffB);
            PG8_WAIT_V(6); PG8_BAR; PG8_MMA(1, 1, At, B1); PG8_BAR;
            PG8_LDB(B0, 1, 0); PG8_SCHED; PG8_LDA(At, 1, 0); PG8_STAGE(PG8_SA(0, 1), a2 + hstep, voffA);
            PG8_WAIT_L(8); PG8_BAR; PG8_WAIT_L(0); PG8_MMA(0, 0, At, B0); PG8_BAR; PG8_SCHED;
            PG8_LDB(B1, 1, 1); PG8_STAGE(PG8_SB(1, 0), b3, voffB);
            PG8_BAR; PG8_WAIT_L(0); PG8_MMA(0, 1, At, B1); PG8_BAR;
            PG8_LDA(At, 1, 1); PG8_STAGE(PG8_SA(1, 0), a3, voffA);
            PG8_BAR; PG8_WAIT_L(0); PG8_MMA(1, 0, At, B0); PG8_BAR; PG8_SCHED;
            PG8_STAGE(PG8_SB(1, 1), b3 + hstep, voffB);
            PG8_WAIT_V(6); PG8_BAR; PG8_MMA(1, 1, At, B1); PG8_BAR;
            }
        }
        if constexpr (ALIGN_EPI) { if (wr == 0) PG8_BAR; }
        if constexpr (!Epi::AFTER_DRAIN) { E(acc, cur, wr, wc, fr, fq); S.done(cur); }
        if (!has_next) break;
#pragma unroll
        for (int a = 0; a < 2; ++a)
#pragma unroll
            for (int b = 0; b < 2; ++b)
#pragma unroll
                for (int m = 0; m < 4; ++m)
#pragma unroll
                    for (int n = 0; n < 2; ++n) acc[a][b][m][n] = (f32x4){0.f, 0.f, 0.f, 0.f};
        cur = nxt; cA = nA; cB = nB; ++ui;
        if constexpr (ALIGN_EPI) { if (wr == 1) PG8_BAR; }
    }
    PG8_WAIT_V(0);
    if constexpr (!ALIGN_EPI) { if (wr == 0) PG8_BAR; }
    PG8_BAR;
    if constexpr (Epi::AFTER_DRAIN) { E.fused(acc, cur, wr, wc, fr, fq, lds, wid, lane); S.done(cur); }
#undef PG8_SA
#undef PG8_SB
#undef PG8_STAGE
#undef PG8_LDA
#undef PG8_LDB
#undef PG8_MMA
#undef PG8_WAIT_V
#undef PG8_WAIT_L
#undef PG8_BAR
#undef PG8_SCHED
}
}

#define GAS __attribute__((address_space(1)))
#define LAS __attribute__((address_space(3)))
typedef unsigned short bf16;
typedef unsigned v4u __attribute__((ext_vector_type(4)));
typedef unsigned v2u __attribute__((ext_vector_type(2)));
typedef float f32x4 __attribute__((ext_vector_type(4)));
typedef GAS unsigned gu32;
#define RLX_AGENT __ATOMIC_RELAXED, __HIP_MEMORY_SCOPE_AGENT
#define LDS_WAIT() asm volatile("s_waitcnt lgkmcnt(0)" ::: "memory")
#define VM_WAIT() asm volatile("s_waitcnt vmcnt(0)" ::: "memory")

constexpr int NTOK = 8192, SEQ = 2048, DM = 2048, NP = 13824, NWAVES = 8, NTHR = 512;
constexpr int RW_W = 1024, RW_H = 16, RW_N = 64;
constexpr int P_XW = 3072, P_XA = 3168, P_XG = 3264;
constexpr int P_RQ = 3584, P_RK = 4608, P_RV = 5632, P_RG = 7680, P_GA = 9728, P_GB = 11776;
constexpr int RET_H = 8, RET_DK = 128, RET_DV = 256, RET_VW = 2048;
constexpr int NEXP = 32, EFF = 512, MAXT = 96, MAXSLOT = MAXT * 256;

constexpr size_t MiB = 1u << 20;
constexpr size_t WS_CTL = 0, CTL_ZERO_BYTES = 256 * 1024;
constexpr size_t WS_ROT = 1 * MiB;
constexpr size_t WS_TOKE = 2 * MiB;
constexpr size_t WS_TOKW = WS_TOKE + 65536;
constexpr size_t WS_TOKP = WS_TOKW + 65536;
constexpr size_t WS_TOKS = WS_TOKP + 65536;
constexpr size_t WS_BONUS = WS_TOKS + 65536;
constexpr size_t WS_WUPA = 3 * MiB, WS_WUPB = 7 * MiB, WS_WOUT = 15 * MiB;
constexpr size_t WS_WGU = 23 * MiB, WS_WDN = 151 * MiB;
constexpr size_t WS_P = 215 * MiB;
constexpr size_t WS_RA = 431 * MiB;
constexpr size_t WS_WIN = WS_RA, WS_H1 = WS_RA + 54 * MiB;
constexpr size_t WS_OA = WS_RA, WS_OB = WS_RA + 16 * MiB;
constexpr size_t WS_RB = 517 * MiB;
constexpr size_t WS_RWE = WS_RB, WS_RWA = WS_RB + 16 * MiB, WS_RWB = WS_RB + 32 * MiB, WS_MERGED = WS_RB;
constexpr size_t WS_END = 565 * MiB;
constexpr size_t WS_H2 = WS_P, WS_XG = WS_P + 32 * MiB, WS_YS = WS_XG, WS_ACT = WS_XG + 96 * MiB;
constexpr int CW_BAR = 1024;
constexpr int CW_CNT = 8192;
constexpr int CW_NT = 8256;
constexpr int CW_TE = 8320;
constexpr int CW_PS = 8448;

constexpr int RING_BYTES = 131072, MISC_OFF = RING_BYTES + 320, LDS_BYTES = 147456;

struct Args { const float* in[27]; float* out; unsigned char* ws; int ph_lo, ph_hi; };

__device__ __forceinline__ float bf2f(unsigned short b) { return __uint_as_float(((unsigned)b) << 16); }
__device__ __forceinline__ float bflo(unsigned u) { return __uint_as_float(u << 16); }
__device__ __forceinline__ float bfhi(unsigned u) { return __uint_as_float(u & 0xffff0000u); }
__device__ __forceinline__ unsigned f2bf(float f) { unsigned u = __float_as_uint(f); return (u + 0x7fffu + ((u >> 16) & 1u)) >> 16; }
__device__ __forceinline__ unsigned pk2(float lo, float hi) { return f2bf(lo) | (f2bf(hi) << 16); }
__device__ __forceinline__ float sigmoidf_(float x) { return 1.0f / (1.0f + __expf(-x)); }
__device__ __forceinline__ float wave_sum(float v) {
#pragma unroll
    for (int o = 1; o < 64; o <<= 1) v += __shfl_xor(v, o);
    return v;
}

struct EpiP {
    static constexpr bool PERM = true, AFTER_DRAIN = false;
    bf16* O;
    __device__ __forceinline__ void operator()(const pg8::f32x4 (&acc)[2][2][4][2], const pg8::Unit& u, int wr, int wc, int fr, int fq) const {
        const int row0 = u.pm * 256 + wr * 64 + fr, col0 = u.pn * 256 + wc * 32 + 8 * fq;
        const int mode = u.pn >= 38 ? 2 : (u.pn >= 30 ? 1 : 0);
#pragma unroll
        for (int ai = 0; ai < 2; ++ai)
#pragma unroll
            for (int m = 0; m < 4; ++m) { bf16* rowp = O + (size_t)(row0 + ai * 128 + m * 16) * NP + col0;
#pragma unroll
                for (int bj = 0; bj < 2; ++bj) { pg8::f32x4 v0 = acc[ai][bj][m][0], v1 = acc[ai][bj][m][1];
                    if (mode) {
#pragma unroll
                        for (int j = 0; j < 4; ++j) { const float s0 = sigmoidf_(v0[j]), s1 = sigmoidf_(v1[j]); v0[j] = mode == 2 ? s0 : v0[j] * s0; v1[j] = mode == 2 ? s1 : v1[j] * s1; } }
                    pg8::u32x4 w; w.x = pg8::cvt_pk_bf16(v0[0], v0[1]); w.y = pg8::cvt_pk_bf16(v0[2], v0[3]); w.z = pg8::cvt_pk_bf16(v1[0], v1[1]); w.w = pg8::cvt_pk_bf16(v1[2], v1[3]);
                    *(pg8::u32x4*)(rowp + bj * 128) = w; } }
    }
};
template <int MODE> struct EpiUp {
    static constexpr bool PERM = true, AFTER_DRAIN = false;
    bf16* O; const bf16* P;
    __device__ __forceinline__ void operator()(const pg8::f32x4 (&acc)[2][2][4][2], const pg8::Unit& u, int wr, int wc, int fr, int fq) const {
        const int row0 = u.pm * 256 + wr * 64 + fr, col0 = u.pn * 256 + wc * 32 + 8 * fq;
#pragma unroll
        for (int ai = 0; ai < 2; ++ai)
#pragma unroll
            for (int m = 0; m < 4; ++m) { const int row = row0 + ai * 128 + m * 16; bf16* rowp = O + (size_t)row * DM + col0; const bf16* gp = P + (size_t)row * NP + (MODE ? P_GB : P_GA) + col0;
#pragma unroll
                for (int bj = 0; bj < 2; ++bj) { const pg8::f32x4 v0 = acc[ai][bj][m][0], v1 = acc[ai][bj][m][1];
                    const pg8::u32x4 g = *(const pg8::u32x4*)(gp + bj * 128);
                    float o[8] = { v0[0] * bflo(g.x), v0[1] * bfhi(g.x), v0[2] * bflo(g.y), v0[3] * bfhi(g.y), v1[0] * bflo(g.z), v1[1] * bfhi(g.z), v1[2] * bflo(g.w), v1[3] * bfhi(g.w) };
                    if (MODE) { const pg8::u32x4 p = *(const pg8::u32x4*)(rowp + bj * 128);
                        o[0] += bflo(p.x); o[1] += bfhi(p.x); o[2] += bflo(p.y); o[3] += bfhi(p.y); o[4] += bflo(p.z); o[5] += bfhi(p.z); o[6] += bflo(p.w); o[7] += bfhi(p.w); }
                    pg8::u32x4 w; w.x = pg8::cvt_pk_bf16(o[0], o[1]); w.y = pg8::cvt_pk_bf16(o[2], o[3]); w.z = pg8::cvt_pk_bf16(o[4], o[5]); w.w = pg8::cvt_pk_bf16(o[6], o[7]);
                    *(pg8::u32x4*)(rowp + bj * 128) = w; } }
    }
};
struct EpiX1 {
    static constexpr bool PERM = false, AFTER_DRAIN = false;
    const float* X; float* O;
    __device__ __forceinline__ void operator()(const pg8::f32x4 (&acc)[2][2][4][2], const pg8::Unit& u, int wr, int wc, int fr, int fq) const {
        const int row0 = u.pm * 256 + wr * 64 + fr, col0 = u.pn * 256 + wc * 32 + 4 * fq;
#pragma unroll
        for (int ai = 0; ai < 2; ++ai)
#pragma unroll
            for (int m = 0; m < 4; ++m) { const size_t off = (size_t)(row0 + ai * 128 + m * 16) * DM + col0;
#pragma unroll
                for (int bj = 0; bj < 2; ++bj)
#pragma unroll
                    for (int n = 0; n < 2; ++n) { const pg8::f32x4 xv = *(const pg8::f32x4*)(X + off + bj * 128 + n * 16); *(pg8::f32x4*)(O + off + bj * 128 + n * 16) = xv + acc[ai][bj][m][n]; } }
    }
};
struct EpiGU {
    static constexpr bool PERM = true, AFTER_DRAIN = false;
    bf16* O;
    __device__ __forceinline__ void operator()(const pg8::f32x4 (&acc)[2][2][4][2], const pg8::Unit& u, int wr, int wc, int fr, int fq) const {
        const int row0 = u.pm * 256 + wr * 64 + fr, col0 = (u.pn & 3) * 128 + wc * 32 + 8 * fq;
#pragma unroll
        for (int ai = 0; ai < 2; ++ai)
#pragma unroll
            for (int m = 0; m < 4; ++m) { bf16* rowp = O + (size_t)(row0 + ai * 128 + m * 16) * EFF + col0;
                const pg8::f32x4 g0 = acc[ai][0][m][0], g1 = acc[ai][0][m][1], u0 = acc[ai][1][m][0], u1 = acc[ai][1][m][1];
                float o[8];
#pragma unroll
                for (int j = 0; j < 4; ++j) { o[j] = g0[j] * sigmoidf_(g0[j]) * u0[j]; o[4 + j] = g1[j] * sigmoidf_(g1[j]) * u1[j]; }
                pg8::u32x4 w; w.x = pg8::cvt_pk_bf16(o[0], o[1]); w.y = pg8::cvt_pk_bf16(o[2], o[3]); w.z = pg8::cvt_pk_bf16(o[4], o[5]); w.w = pg8::cvt_pk_bf16(o[6], o[7]);
                *(pg8::u32x4*)rowp = w; }
    }
};
struct EpiDn {
    static constexpr bool PERM = true, AFTER_DRAIN = false;
    bf16* O;
    __device__ __forceinline__ void operator()(const pg8::f32x4 (&acc)[2][2][4][2], const pg8::Unit& u, int wr, int wc, int fr, int fq) const {
        const int row0 = u.pm * 256 + wr * 64 + fr, col0 = (u.pn & 7) * 256 + wc * 32 + 8 * fq;
#pragma unroll
        for (int ai = 0; ai < 2; ++ai)
#pragma unroll
            for (int m = 0; m < 4; ++m) { bf16* rowp = O + (size_t)(row0 + ai * 128 + m * 16) * DM + col0;
#pragma unroll
                for (int bj = 0; bj < 2; ++bj) { const pg8::f32x4 v0 = acc[ai][bj][m][0], v1 = acc[ai][bj][m][1];
                    pg8::u32x4 w; w.x = pg8::cvt_pk_bf16(v0[0], v0[1]); w.y = pg8::cvt_pk_bf16(v0[2], v0[3]); w.z = pg8::cvt_pk_bf16(v1[0], v1[1]); w.w = pg8::cvt_pk_bf16(v1[2], v1[3]);
                    *(pg8::u32x4*)(rowp + bj * 128) = w; } }
    }
};
template <int NB> struct MoeOrder {
    const unsigned* ctl; int G, c, nunits;
    __device__ __forceinline__ void init(const unsigned* ctl_, int G_, int c_) { ctl = ctl_; G = G_; c = c_; nunits = (int)ctl_[CW_NT] * NB; }
    __device__ __forceinline__ bool next(int i, pg8::Unit& u) const {
        const int L = i * G + c; if (L >= nunits) return false;
        u.pm = L / NB; u.pn = (int)ctl[CW_TE + u.pm] * NB + (L % NB); return true;
    }
    __device__ __forceinline__ void a_ready(const pg8::Unit&) const {}
    __device__ __forceinline__ void done(const pg8::Unit&) const {}
};
#define XB_TMO      128
#define XB_XCNT(j)  (256  + 64 * (j))
#define XB_XSUB(j)  (1280 + 64 * (j))
#define XB_XGEN(j)  (2304 + 64 * (j))
#define XB_TOP      3328
#define XB_TOPGEN   3392
#define XCD_BAR_WORDS 3456
#define XB_SPIN_CAP (1u << 18)

__device__ __forceinline__ unsigned xb_ld(unsigned* p)              { return __hip_atomic_load(p, __ATOMIC_RELAXED, __HIP_MEMORY_SCOPE_AGENT); }
__device__ __forceinline__ unsigned xb_add(unsigned* p, unsigned v) { return __hip_atomic_fetch_add(p, v, __ATOMIC_RELAXED, __HIP_MEMORY_SCOPE_AGENT); }
__device__ __forceinline__ unsigned xb_xcc_id() { return (unsigned)__builtin_amdgcn_s_getreg((3 << 11) | 20) & 0xFu; }
#define XB_SPIN(cond, bar) do { unsigned _sp = 0; while (cond) { __builtin_amdgcn_s_sleep(1); \
    if ((++_sp & 255u) == 0u) { if (xb_ld(&(bar)[XB_TMO])) break; if (_sp > XB_SPIN_CAP) { atomicAdd(&(bar)[XB_TMO], 1u); break; } } } } while (0)

struct XcdBarrier {
    unsigned* bar; unsigned x;
    volatile LAS unsigned* st;
};

__device__ __forceinline__ XcdBarrier xcd_barrier_post(unsigned* bar, volatile LAS unsigned* st) {
    XcdBarrier b; b.bar = bar; b.x = xb_xcc_id(); b.st = st;
    if (threadIdx.x == 0) (void)xb_add(&bar[XB_XCNT(b.x)], 1u);
    return b;
}
__device__ __forceinline__ void xcd_barrier_complete(unsigned* bar, unsigned x, unsigned& nloc, unsigned& nx) {
    const unsigned G = gridDim.x * gridDim.y * gridDim.z;
    unsigned sum, cnt, mine, sp = 0u;
    for (;;) {
        sum = 0u; cnt = 0u; mine = 0u;
#pragma unroll
        for (unsigned j = 0; j < 16; ++j) { const unsigned c = xb_ld(&bar[XB_XCNT(j)]); sum += c; cnt += (c > 0u) ? 1u : 0u; mine = (j == x) ? c : mine; }
        if (sum == G) break;
        __builtin_amdgcn_s_sleep(1);
        if ((++sp & 255u) == 0u) { if (xb_ld(&bar[XB_TMO])) break; if (sp > XB_SPIN_CAP) { atomicAdd(&bar[XB_TMO], 1u); break; } }
    }
    nloc = mine > 0u ? mine : 1u; nx = cnt > 0u ? cnt : 1u;
}

__device__ __forceinline__ void xcd_barrier(const XcdBarrier& b) {
    asm volatile("s_waitcnt vmcnt(0)" ::: "memory");
    __syncthreads();
    if (threadIdx.x == 0) {
        unsigned* bar = b.bar;
        __builtin_amdgcn_s_waitcnt(0);
        unsigned nloc = b.st[0], nx = b.st[1];
        if (nloc == 0u) { xcd_barrier_complete(bar, b.x, nloc, nx); b.st[0] = nloc; b.st[1] = nx; }
        const unsigned old = xb_add(&bar[XB_XSUB(b.x)], 1u);
        const unsigned gen = old / nloc;
        if (old + 1u == (gen + 1u) * nloc) {
            __builtin_amdgcn_fence(__ATOMIC_RELEASE, "agent");
            asm volatile("s_waitcnt vmcnt(0)" ::: "memory");
            const unsigned og = xb_add(&bar[XB_TOP], 1u);
            const unsigned tg = og / nx;
            if (og + 1u == (tg + 1u) * nx) xb_add(&bar[XB_TOPGEN], 1u);
            else XB_SPIN(xb_ld(&bar[XB_TOPGEN]) == tg, bar);
            __builtin_amdgcn_fence(__ATOMIC_ACQUIRE, "agent");
            xb_add(&bar[XB_XGEN(b.x)], 1u);
            asm volatile("s_waitcnt vmcnt(0)" ::: "memory");
        } else {
            XB_SPIN(xb_ld(&bar[XB_XGEN(b.x)]) == gen, bar);
            __builtin_amdgcn_fence(__ATOMIC_ACQUIRE, "agent");
            asm volatile("s_waitcnt vmcnt(0)" ::: "memory");
        }
    }
    __syncthreads();
}

__device__ __forceinline__ void tr_item(const float* W, int ldw, int k0, int n0, bf16* WT, int K, size_t drow0, LAS float* scr, int lane) {
#pragma unroll 8
    for (int i = 0; i < 32; ++i) { const int kk = 2 * i + (lane >> 5); scr[kk * 33 + (lane & 31)] = W[(size_t)(k0 + kk) * ldw + n0 + (lane & 31)]; }
    LDS_WAIT(); asm volatile("" ::: "memory");
    const int c = lane & 7;
#pragma unroll
    for (int j = 0; j < 4; ++j) { const int n = (lane >> 3) + 8 * j; const LAS float* s = scr + (8 * c) * 33 + n;
        v4u o; o.x = pk2(s[0 * 33], s[1 * 33]); o.y = pk2(s[2 * 33], s[3 * 33]); o.z = pk2(s[4 * 33], s[5 * 33]); o.w = pk2(s[6 * 33], s[7 * 33]);
        *(v4u*)(WT + (drow0 + n) * (size_t)K + k0 + 8 * c) = o; }
    LDS_WAIT(); asm volatile("" ::: "memory");
}
__device__ __forceinline__ void phase_prologue(const Args& a, LAS unsigned char* lds, int tid, int lane, int wave, int bid, int G) {
    unsigned char* ws = a.ws;
    LAS float* scr = (LAS float*)(lds + wave * 16384);
    const int gw = bid * NWAVES + wave, NGW = G * NWAVES;
    constexpr int I_IN = 32 * 430, I_UA = 16 * 64, I_UB = 32 * 64, I_WO = 32 * 64, I_EG = 32 * 32 * 16, I_ED = 32 * 8 * 64;
    constexpr int NITEMS = I_IN + I_UA + I_UB + I_WO + 2 * I_EG + I_ED;
    for (int it = gw; it < NITEMS; it += NGW) {
        int r = it;
        if (r < I_IN) { const int kb = r / 430, nb = r % 430, n0 = nb * 32; tr_item(a.in[2], 13760, kb * 64, n0, (bf16*)(ws + WS_WIN), 2048, (size_t)(n0 + (n0 >= 3520 ? 64 : 0)), scr, lane); continue; } r -= I_IN;
        if (r < I_UA) { const int kb = r / 64, nb = r % 64; tr_item(a.in[15], 2048, kb * 64, nb * 32, (bf16*)(ws + WS_WUPA), 1024, (size_t)(nb * 32), scr, lane); continue; } r -= I_UA;
        if (r < I_UB) { const int kb = r / 64, nb = r % 64; tr_item(a.in[16], 2048, kb * 64, nb * 32, (bf16*)(ws + WS_WUPB), 2048, (size_t)(nb * 32), scr, lane); continue; } r -= I_UB;
        if (r < I_WO) { const int kb = r / 64, nb = r % 64; tr_item(a.in[17], 2048, kb * 64, nb * 32, (bf16*)(ws + WS_WOUT), 2048, (size_t)(nb * 32), scr, lane); continue; } r -= I_WO;
        if (r < 2 * I_EG) { const int half = r / I_EG; const int q = r % I_EG; const int e = q / 512, kb = (q % 512) / 16, nb = q % 16, n0 = nb * 32;
            const float* W = a.in[23 + half] + (size_t)e * 2048 * 512;
            tr_item(W, 512, kb * 64, n0, (bf16*)(ws + WS_WGU), 2048, (size_t)e * 1024 + (n0 >> 7) * 256 + half * 128 + (n0 & 127), scr, lane); continue; } r -= 2 * I_EG;
        { const int e = r / 512, kb = (r % 512) / 64, nb = r % 64; const float* W = a.in[25] + (size_t)e * 512 * 2048;
            tr_item(W, 2048, kb * 64, nb * 32, (bf16*)(ws + WS_WDN), 512, (size_t)e * 2048 + nb * 32, scr, lane); }
    }
    { v4u* z = (v4u*)(ws + WS_WIN + (size_t)3520 * 2048 * 2); const int n16 = 64 * 2048 * 2 / 16;
      for (int i = bid * NTHR + tid; i < n16; i += G * NTHR) z[i] = (v4u){0u, 0u, 0u, 0u}; }
    { bf16* W2T = (bf16*)(ws + WS_RB + 16 * MiB); bf16* A2T = W2T + 1024 * 96; bf16* G2T = A2T + 1024 * 96;
      for (int i = bid * NTHR + tid; i < 1024 * 96; i += G * NTHR) { const int ch = i / 96, j = i % 96; W2T[i] = (bf16)f2bf(a.in[5][j * 1024 + ch]); A2T[i] = (bf16)f2bf(a.in[7][j * 1024 + ch]); }
      for (int i = bid * NTHR + tid; i < 1024 * 256; i += G * NTHR) { const int ch = i >> 8, j = i & 255; G2T[i] = (bf16)f2bf(a.in[8][j * 1024 + ch]); } }
    { float* WTG = (float*)(ws + 262144); const float* g2n = a.in[18];
      for (int i = bid * NTHR + tid; i < 48 * DM; i += G * NTHR) { const int o = i >> 11, d = i & (DM - 1);
          float w = 0.f; if (o < 4) w = a.in[19][d * 4 + o]; else if (o < 36) w = a.in[21][d * 32 + (o - 4)];
          WTG[i] = w * g2n[d]; } }
    { float2* rot = (float2*)(ws + WS_ROT);
      for (int i = bid * NTHR + tid; i < SEQ * 64; i += G * NTHR) { const int pos = i >> 6, d = i & 63;
          const float inv = exp2f(-(float)d * (13.287712379549449f / 64.0f)); const float ang = (float)pos * inv;
          double rev = (double)ang * 0.15915494309189535; rev -= __builtin_rint(rev); const float rf = (float)rev;
          rot[i] = make_float2(__builtin_amdgcn_cosf(rf), __builtin_amdgcn_sinf(rf)); } }
    { const float* g1 = a.in[1]; bf16* H1 = (bf16*)(ws + WS_H1);
      for (int m = gw; m < NTOK; m += NGW) { const f32x4* xr = (const f32x4*)(a.in[0] + (size_t)m * DM) + lane; f32x4 v[8]; float s = 0.f;
#pragma unroll
          for (int j = 0; j < 8; ++j) { v[j] = xr[64 * j]; s += (v[j].x * v[j].x + v[j].y * v[j].y) + (v[j].z * v[j].z + v[j].w * v[j].w); }
          const float rs = rsqrtf(wave_sum(s) * (1.0f / DM) + 1e-6f);
          v2u* o8 = (v2u*)(H1 + (size_t)m * DM) + lane;
#pragma unroll
          for (int j = 0; j < 8; ++j) { const f32x4 g = ((const f32x4*)g1)[64 * j + lane]; v2u o; o.x = pk2(v[j].x * rs * g.x, v[j].y * rs * g.y); o.y = pk2(v[j].z * rs * g.z, v[j].w * rs * g.w); o8[64 * j] = o; } } }
}

__device__ __forceinline__ float shiftp(const bf16* P, int t, int col, float mu, bool first) {
    const float cur = bf2f(P[(size_t)t * NP + col]); const float prev = first ? 0.f : bf2f(P[(size_t)(t - 1) * NP + col]);
    return cur + (prev - cur) * mu;
}
__device__ __forceinline__ void phase_rwprep(const Args& a, LAS unsigned char* lds, int tid, int lane, int wave, int bid, int G) {
    unsigned char* ws = a.ws; const bf16* P = (const bf16*)(ws + WS_P);
    LAS float* xs = (LAS float*)lds;
    const float* mu = a.in[3]; const float* w0 = a.in[4]; const float* w2 = a.in[5]; const float* a0 = a.in[6]; const float* a2 = a.in[7]; const float* g2 = a.in[8];
    const float* k_k = a.in[9]; const float* k_a = a.in[10]; const float* r_k = a.in[11];
    bf16* RR = (bf16*)a.out; bf16* RK = RR + (size_t)NTOK * RW_W; bf16* RV = RK + (size_t)NTOK * RW_W; bf16* RG = RV + (size_t)NTOK * RW_W;
    bf16* RE = (bf16*)(ws + WS_RWE); bf16* RA = (bf16*)(ws + WS_RWA); bf16* RB = (bf16*)(ws + WS_RWB); float* BON = (float*)(ws + WS_BONUS);
    for (int u = bid; u < NTOK / 8; u += G) {
        const int t0 = u * 8;
        __syncthreads();
        for (int i = tid; i < 448 * 8; i += NTHR) { const int j = i >> 3, tt = i & 7, t = t0 + tt; const int col = P_XW + j;
            float v = shiftp(P, t, col, mu[col], (t & (SEQ - 1)) == 0);
            if (j < 96) v = tanhf(v); else if (j >= 192) v = sigmoidf_(v);
            xs[i] = v; }
        __syncthreads();
        float aw[2][8], aa[2][8], ag[2][8];
#pragma unroll
        for (int c = 0; c < 2; ++c)
#pragma unroll
            for (int tt = 0; tt < 8; ++tt) { aw[c][tt] = 0.f; aa[c][tt] = 0.f; ag[c][tt] = 0.f; }
        for (int j = 0; j < 96; ++j) { const float wa = w2[j * RW_W + tid], wb = w2[j * RW_W + tid + 512]; const f32x4 x0 = *(const LAS f32x4*)(xs + j * 8), x1 = *(const LAS f32x4*)(xs + j * 8 + 4);
#pragma unroll
            for (int tt = 0; tt < 4; ++tt) { aw[0][tt] += x0[tt] * wa; aw[1][tt] += x0[tt] * wb; aw[0][4 + tt] += x1[tt] * wa; aw[1][4 + tt] += x1[tt] * wb; } }
        for (int j = 0; j < 96; ++j) { const float wa = a2[j * RW_W + tid], wb = a2[j * RW_W + tid + 512]; const f32x4 x0 = *(const LAS f32x4*)(xs + (96 + j) * 8), x1 = *(const LAS f32x4*)(xs + (96 + j) * 8 + 4);
#pragma unroll
            for (int tt = 0; tt < 4; ++tt) { aa[0][tt] += x0[tt] * wa; aa[1][tt] += x0[tt] * wb; aa[0][4 + tt] += x1[tt] * wa; aa[1][4 + tt] += x1[tt] * wb; } }
        for (int j = 0; j < 256; ++j) { const float wa = g2[j * RW_W + tid], wb = g2[j * RW_W + tid + 512]; const f32x4 x0 = *(const LAS f32x4*)(xs + (192 + j) * 8), x1 = *(const LAS f32x4*)(xs + (192 + j) * 8 + 4);
#pragma unroll
            for (int tt = 0; tt < 4; ++tt) { ag[0][tt] += x0[tt] * wa; ag[1][tt] += x0[tt] * wb; ag[0][4 + tt] += x1[tt] * wa; ag[1][4 + tt] += x1[tt] * wb; } }
#pragma unroll
        for (int c = 0; c < 2; ++c) { const int ch = tid + c * 512; const int head = ch >> 6;
            const float mur = mu[ch], muk = mu[1024 + ch], muv = mu[2048 + ch], w0c = w0[ch], a0c = a0[ch], kkc = k_k[ch], kac = k_a[ch], rkc = r_k[ch];
#pragma unroll
            for (int tt = 0; tt < 8; ++tt) { const int t = t0 + tt; const bool first = (t & (SEQ - 1)) == 0;
                const float r = shiftp(P, t, ch, mur, first), k = shiftp(P, t, 1024 + ch, muk, first), v = shiftp(P, t, 2048 + ch, muv, first);
                const float e = sigmoidf_(w0c + aw[c][tt]) * 0.6065306597126334f;
                const float av = sigmoidf_(a0c + aa[c][tt]);
                float kk = k * kkc; const float ss = wave_sum(kk * kk); kk *= rsqrtf(fmaxf(ss, 1e-24f));
                const float kp = k * (1.0f + (av - 1.0f) * kac);
                const float bs = wave_sum(r * kp * rkc);
                const size_t o = (size_t)t * RW_W + ch;
                RR[o] = (bf16)f2bf(r); RK[o] = (bf16)f2bf(kp); RV[o] = (bf16)f2bf(v); RG[o] = (bf16)f2bf(ag[c][tt]);
                RE[o] = (bf16)f2bf(e); RA[o] = (bf16)f2bf(-kk); RB[o] = (bf16)f2bf(kk * av);
                if (lane == 0) BON[t * RW_H + head] = bs; } }
    }
}

__device__ __forceinline__ void unpack16(const v4u& p0, const v4u& p1, float (&f)[16]) {
    f[0] = bflo(p0.x); f[1] = bfhi(p0.x); f[2] = bflo(p0.y); f[3] = bfhi(p0.y); f[4] = bflo(p0.z); f[5] = bfhi(p0.z); f[6] = bflo(p0.w); f[7] = bfhi(p0.w);
    f[8] = bflo(p1.x); f[9] = bfhi(p1.x); f[10] = bflo(p1.y); f[11] = bfhi(p1.y); f[12] = bflo(p1.z); f[13] = bfhi(p1.z); f[14] = bflo(p1.w); f[15] = bfhi(p1.w);
}
__device__ __forceinline__ void phase_rwrec(const Args& a, int lane, int wave, int bid, int G) {
    if (wave != 0) return;
    unsigned char* ws = a.ws;
    const bf16* RR = (const bf16*)a.out; const bf16* RK = RR + (size_t)NTOK * RW_W; const bf16* RV = RK + (size_t)NTOK * RW_W;
    const bf16* RE = (const bf16*)(ws + WS_RWE); const bf16* RA = (const bf16*)(ws + WS_RWA); const bf16* RB = (const bf16*)(ws + WS_RWB);
    bf16* Y = (bf16*)(ws + WS_OA);
    for (int u = bid; u < 256; u += G) {
        const int b = u >> 6, h = (u >> 2) & 15, sl = u & 3, row = lane >> 2, kq = lane & 3, iv = sl * 16 + row;
        float S[16];
#pragma unroll
        for (int k = 0; k < 16; ++k) S[k] = 0.f;
        size_t base = (size_t)(b * SEQ) * RW_W + h * 64;
        const v4u* pr = (const v4u*)(RR + base + kq * 16); const v4u* pe = (const v4u*)(RE + base + kq * 16); const v4u* pk = (const v4u*)(RK + base + kq * 16);
        const v4u* pa = (const v4u*)(RA + base + kq * 16); const v4u* pb = (const v4u*)(RB + base + kq * 16);
        v4u nr0 = pr[0], nr1 = pr[1], ne0 = pe[0], ne1 = pe[1], nk0 = pk[0], nk1 = pk[1], na0 = pa[0], na1 = pa[1], nb0 = pb[0], nb1 = pb[1];
        unsigned short nv = RV[base + iv];
        for (int t = 0; t < SEQ; ++t) {
            const v4u r0 = nr0, r1 = nr1, e0 = ne0, e1 = ne1, k0 = nk0, k1 = nk1, a0 = na0, a1 = na1, b0 = nb0, b1 = nb1; const float v = bf2f(nv);
            if (t + 1 < SEQ) { const int q = (t + 1) * (RW_W / 8);
                nr0 = pr[q]; nr1 = pr[q + 1]; ne0 = pe[q]; ne1 = pe[q + 1]; nk0 = pk[q]; nk1 = pk[q + 1]; na0 = pa[q]; na1 = pa[q + 1]; nb0 = pb[q]; nb1 = pb[q + 1];
                nv = RV[base + (size_t)(t + 1) * RW_W + iv]; }
            float fr[16], fe[16], fk[16], fa[16], fb[16];
            unpack16(r0, r1, fr); unpack16(e0, e1, fe); unpack16(k0, k1, fk); unpack16(a0, a1, fa); unpack16(b0, b1, fb);
            float sa = 0.f;
#pragma unroll
            for (int k = 0; k < 16; ++k) sa += S[k] * fa[k];
            sa += __shfl_xor(sa, 1); sa += __shfl_xor(sa, 2);
            float y = 0.f;
#pragma unroll
            for (int k = 0; k < 16; ++k) { const float w = __expf(-fe[k]); S[k] = S[k] * w + (sa * fb[k] + v * fk[k]); y += S[k] * fr[k]; }
            y += __shfl_xor(y, 1); y += __shfl_xor(y, 2);
            if (kq == 0) Y[base + (size_t)t * RW_W + iv] = (bf16)f2bf(y);
        }
    }
}

__device__ __forceinline__ void phase_ret(const Args& a, LAS unsigned char* lds, int tid, int bid, int G) {
    unsigned char* ws = a.ws; const bf16* P = (const bf16*)(ws + WS_P); const float2* rot = (const float2*)(ws + WS_ROT); bf16* OB = (bf16*)(ws + WS_OB);
    LAS float* Qs = (LAS float*)lds;
    LAS float* Ks = Qs + 64 * 129;
    LAS float* Vs = Ks + 64 * 129;
    LAS float* Sc = Vs + 64 * 32;
    LAS float* St = Sc + 64 * 65;
    LAS float* gp = St + 128 * 32;
    for (int u = bid; u < 256; u += G) {
        const int b = u >> 6, h = (u >> 3) & 7, vs = u & 7;
        __syncthreads();
        const float lg = log1pf(-exp2f(-5.0f - (float)h));
        if (tid < 65) gp[tid] = expf((float)tid * lg);
        for (int i = tid; i < 128 * 32; i += NTHR) St[i] = 0.f;
        for (int n = 0; n < SEQ / 64; ++n) {
            __syncthreads();
            for (int idx = tid; idx < 64 * 64; idx += NTHR) { const int i = idx >> 6, d = idx & 63, pos = n * 64 + i; const size_t t = (size_t)(b * SEQ + pos);
                const float2 cs = rot[pos * 64 + d];
                const float q1 = bf2f(P[t * NP + P_RQ + h * 128 + d]), q2 = bf2f(P[t * NP + P_RQ + h * 128 + 64 + d]);
                const float k1 = bf2f(P[t * NP + P_RK + h * 128 + d]) * 0.08838834764831845f, k2 = bf2f(P[t * NP + P_RK + h * 128 + 64 + d]) * 0.08838834764831845f;
                Qs[i * 129 + d] = q1 * cs.x - q2 * cs.y; Qs[i * 129 + 64 + d] = q1 * cs.y + q2 * cs.x;
                Ks[i * 129 + d] = k1 * cs.x - k2 * cs.y; Ks[i * 129 + 64 + d] = k1 * cs.y + k2 * cs.x; }
            for (int idx = tid; idx < 64 * 32; idx += NTHR) { const int j = idx >> 5, e = idx & 31; const size_t t = (size_t)(b * SEQ + n * 64 + j);
                Vs[idx] = bf2f(P[t * NP + P_RV + h * 256 + vs * 32 + e]); }
            __syncthreads();
            { const int i = tid >> 3, jb = tid & 7; float s[8];
#pragma unroll
              for (int jj = 0; jj < 8; ++jj) s[jj] = 0.f;
              for (int d = 0; d < 128; ++d) { const float q = Qs[i * 129 + d];
#pragma unroll
                  for (int jj = 0; jj < 8; ++jj) s[jj] += q * Ks[(jb + 8 * jj) * 129 + d]; }
#pragma unroll
              for (int jj = 0; jj < 8; ++jj) { const int j = jb + 8 * jj; const int dist = i > j ? i - j : j - i; Sc[i * 65 + j] = s[jj] * gp[dist]; } }
            __syncthreads();
            { const int e = tid & 31, ib = tid >> 5; float o1[4], o2[4];
#pragma unroll
              for (int ii = 0; ii < 4; ++ii) { o1[ii] = 0.f; o2[ii] = 0.f; }
              for (int j = 0; j < 64; ++j) { const float v = Vs[j * 32 + e];
#pragma unroll
                  for (int ii = 0; ii < 4; ++ii) o1[ii] += Sc[(ib + 16 * ii) * 65 + j] * v; }
              for (int d = 0; d < 128; ++d) { const float s = St[d * 32 + e];
#pragma unroll
                  for (int ii = 0; ii < 4; ++ii) o2[ii] += Qs[(ib + 16 * ii) * 129 + d] * s; }
#pragma unroll
              for (int ii = 0; ii < 4; ++ii) { const int i = ib + 16 * ii; const size_t t = (size_t)(b * SEQ + n * 64 + i);
                  OB[t * RET_VW + h * 256 + vs * 32 + e] = (bf16)f2bf(o1[ii] + gp[i + 1] * o2[ii]); } }
            __syncthreads();
            { const int e = tid & 31, db = tid >> 5; float s[8];
#pragma unroll
              for (int dd = 0; dd < 8; ++dd) s[dd] = 0.f;
              for (int j = 0; j < 64; ++j) { const float v = Vs[j * 32 + e] * gp[63 - j];
#pragma unroll
                  for (int dd = 0; dd < 8; ++dd) s[dd] += Ks[j * 129 + db + 16 * dd] * v; }
#pragma unroll
              for (int dd = 0; dd < 8; ++dd) { const int d = db + 16 * dd; St[d * 32 + e] = St[d * 32 + e] * gp[64] + s[dd]; } }
        }
    }
}

__device__ __forceinline__ void phase_post(const Args& a, int lane, int wave, int bid, int G) {
    unsigned char* ws = a.ws; const bf16* P = (const bf16*)(ws + WS_P);
    const int gw = bid * NWAVES + wave, NGW = G * NWAVES;
    { bf16* Y = (bf16*)(ws + WS_OA); const bf16* RR = (const bf16*)a.out; const bf16* RV = RR + (size_t)2 * NTOK * RW_W; const bf16* RG = RR + (size_t)3 * NTOK * RW_W;
      const float* BON = (const float*)(ws + WS_BONUS); const float* lg = a.in[12]; const float* lb = a.in[13];
      for (int it = gw; it < NTOK * RW_H; it += NGW) { const int t = it >> 4, h = it & 15; const size_t o = (size_t)t * RW_W + h * 64 + lane;
          const float y = bf2f(Y[o]); const float mean = wave_sum(y) * (1.0f / 64.0f); const float dy = y - mean; const float var = wave_sum(dy * dy) * (1.0f / 64.0f);
          float yn = dy * rsqrtf(var + 64e-5f) * lg[h * 64 + lane] + lb[h * 64 + lane];
          yn += BON[it] * bf2f(RV[o]);
          Y[o] = (bf16)f2bf(yn * bf2f(RG[o])); } }
    { bf16* OB = (bf16*)(ws + WS_OB); const float* ng = a.in[14];
      for (int it = gw; it < NTOK * RET_H; it += NGW) { const int t = it >> 3, h = it & 7; const size_t o = (size_t)t * RET_VW + h * 256 + lane * 4;
          const v2u raw = *(const v2u*)(OB + o); const float v0 = bflo(raw.x), v1 = bfhi(raw.x), v2 = bflo(raw.y), v3 = bfhi(raw.y);
          const float rs = rsqrtf(wave_sum((v0 * v0 + v1 * v1) + (v2 * v2 + v3 * v3)) * (1.0f / 256.0f) + 1e-6f);
          const v2u gr = *(const v2u*)(P + (size_t)t * NP + P_RG + h * 256 + lane * 4); const f32x4 g = *(const f32x4*)(ng + h * 256 + lane * 4);
          v2u w; w.x = pk2(v0 * rs * g.x * bflo(gr.x), v1 * rs * g.y * bfhi(gr.x)); w.y = pk2(v2 * rs * g.z * bflo(gr.y), v3 * rs * g.w * bfhi(gr.y));
          *(v2u*)(OB + o) = w; } }
}

__device__ __forceinline__ void phase_retpost(const Args& a, int lane, int wave, int bid, int G) {
    unsigned char* ws = a.ws; const bf16* P = (const bf16*)(ws + WS_P);
    const int gw = bid * NWAVES + wave, NGW = G * NWAVES;
    bf16* OB = (bf16*)(ws + WS_OB); const float* ng = a.in[14];
    for (int it = gw; it < NTOK * RET_H; it += NGW) { const int t = it >> 3, h = it & 7; const size_t o = (size_t)t * RET_VW + h * 256 + lane * 4;
        const v2u raw = *(const v2u*)(OB + o); const float v0 = bflo(raw.x), v1 = bfhi(raw.x), v2 = bflo(raw.y), v3 = bfhi(raw.y);
        const float rs = rsqrtf(wave_sum((v0 * v0 + v1 * v1) + (v2 * v2 + v3 * v3)) * (1.0f / 256.0f) + 1e-6f);
        const v2u gr = *(const v2u*)(P + (size_t)t * NP + P_RG + h * 256 + lane * 4); const f32x4 g = *(const f32x4*)(ng + h * 256 + lane * 4);
        v2u w; w.x = pk2(v0 * rs * g.x * bflo(gr.x), v1 * rs * g.y * bfhi(gr.x)); w.y = pk2(v2 * rs * g.z * bflo(gr.y), v3 * rs * g.w * bfhi(gr.y));
        *(v2u*)(OB + o) = w; }
}

__device__ __forceinline__ void phase_router(const Args& a, int lane, int wave, int bid, int G) {
    unsigned char* ws = a.ws; const float* X1 = a.out; bf16* H2 = (bf16*)(ws + WS_H2);
    const float* g2 = a.in[18]; const float* wg = a.in[19]; const float* bg = a.in[20]; const float* we = a.in[21]; const float* be = a.in[22];
    unsigned* ctl = (unsigned*)(ws + WS_CTL); int* TE = (int*)(ws + WS_TOKE); float* TW = (float*)(ws + WS_TOKW); int* TP = (int*)(ws + WS_TOKP);
    const int gw = bid * NWAVES + wave, NGW = G * NWAVES;
    for (int t = gw; t < NTOK; t += NGW) {
        const f32x4* xr = (const f32x4*)(X1 + (size_t)t * DM) + lane; float s = 0.f;
#pragma unroll
        for (int j = 0; j < 8; ++j) { const f32x4 x = xr[64 * j]; s += (x.x * x.x + x.y * x.y) + (x.z * x.z + x.w * x.w); }
        const float rs = rsqrtf(wave_sum(s) * (1.0f / DM) + 1e-6f);
        float lgt[36];
#pragma unroll
        for (int q = 0; q < 36; ++q) lgt[q] = 0.f;
        v2u* o8 = (v2u*)(H2 + (size_t)t * DM) + lane;
#pragma unroll 1
        for (int j = 0; j < 8; ++j) { const f32x4 x = xr[64 * j]; const f32x4 g = ((const f32x4*)g2)[64 * j + lane]; const f32x4 hv = {x.x * rs * g.x, x.y * rs * g.y, x.z * rs * g.z, x.w * rs * g.w};
            v2u o; o.x = pk2(hv.x, hv.y); o.y = pk2(hv.z, hv.w); o8[64 * j] = o;
            const int col = 256 * j + 4 * lane;
#pragma unroll
            for (int c = 0; c < 4; ++c) { const float hc = hv[c]; const f32x4 w4 = *(const f32x4*)(wg + (size_t)(col + c) * 4);
                lgt[0] += hc * w4.x; lgt[1] += hc * w4.y; lgt[2] += hc * w4.z; lgt[3] += hc * w4.w;
#pragma unroll
                for (int q = 0; q < 8; ++q) { const f32x4 e4 = *(const f32x4*)(we + (size_t)(col + c) * 32 + 4 * q);
                    lgt[4 + 4 * q] += hc * e4.x; lgt[5 + 4 * q] += hc * e4.y; lgt[6 + 4 * q] += hc * e4.z; lgt[7 + 4 * q] += hc * e4.w; } }
            asm volatile("" ::: "memory"); }
#pragma unroll
        for (int q = 0; q < 36; ++q) lgt[q] = wave_sum(lgt[q]);
        float gl[4];
#pragma unroll
        for (int q = 0; q < 4; ++q) gl[q] = lgt[q] + bg[q];
        int gs = 0; float gm = gl[0];
#pragma unroll
        for (int q = 1; q < 4; ++q) if (gl[q] > gm) { gm = gl[q]; gs = q; }
        float den = 0.f;
#pragma unroll
        for (int q = 0; q < 4; ++q) den += expf(gl[q] - gm);
        const float gwt = 1.0f / den;
        float el[8];
#pragma unroll
        for (int q = 0; q < 8; ++q) { float x = 0.f;
#pragma unroll
            for (int gq = 0; gq < 4; ++gq) x = (gs == gq) ? lgt[4 + gq * 8 + q] + be[gq * 8 + q] : x;
            el[q] = x; }
        int i0 = 0; float m0 = el[0];
#pragma unroll
        for (int q = 1; q < 8; ++q) if (el[q] > m0) { m0 = el[q]; i0 = q; }
        int i1 = -1; float m1 = -3.0e38f;
#pragma unroll
        for (int q = 0; q < 8; ++q) if (q != i0 && el[q] > m1) { m1 = el[q]; i1 = q; }
        const float e1 = expf(m1 - m0); const float w0 = gwt / (1.0f + e1), w1 = gwt * e1 / (1.0f + e1);
        if (lane == 0) { const int ex0 = gs * 8 + i0, ex1 = gs * 8 + i1;
            const unsigned p0 = __hip_atomic_fetch_add(ctl + CW_CNT + ex0, 1u, RLX_AGENT), p1 = __hip_atomic_fetch_add(ctl + CW_CNT + ex1, 1u, RLX_AGENT);
            TE[2 * t] = ex0; TE[2 * t + 1] = ex1; TW[2 * t] = w0; TW[2 * t + 1] = w1; TP[2 * t] = (int)p0; TP[2 * t + 1] = (int)p1; }
    }
}

__device__ __forceinline__ void phase_gather(const Args& a, LAS unsigned char* lds, int tid, int lane, int wave, int bid, int G) {
    unsigned char* ws = a.ws; unsigned* ctl = (unsigned*)(ws + WS_CTL); const bf16* H2 = (const bf16*)(ws + WS_H2); bf16* XG = (bf16*)(ws + WS_XG);
    const int* TE = (const int*)(ws + WS_TOKE); const int* TP = (const int*)(ws + WS_TOKP); int* TS = (int*)(ws + WS_TOKS);
    LAS int* ps = (LAS int*)lds;
    __syncthreads();
    if (tid == 0) { int acc = 0, nt = 0;
        for (int e = 0; e < NEXP; ++e) { const int c = (int)__hip_atomic_load(ctl + CW_CNT + e, RLX_AGENT); ps[e] = acc; ps[64 + e] = c; const int tl = (c + 255) >> 8;
            if (bid == 0) for (int q = 0; q < tl; ++q) ctl[CW_TE + nt + q] = (unsigned)e;
            nt += tl; acc += tl * 256; }
        ps[32] = acc; if (bid == 0) ctl[CW_NT] = (unsigned)nt; }
    __syncthreads();
    const int gw = bid * NWAVES + wave, NGW = G * NWAVES;
    for (int it = gw; it < NTOK * 2; it += NGW) { const int t = it >> 1; const int e = TE[it]; const int slot = ps[e] + TP[it];
        const v4u* src = (const v4u*)(H2 + (size_t)t * DM) + lane; v4u* dst = (v4u*)(XG + (size_t)slot * DM) + lane;
#pragma unroll
        for (int j = 0; j < 4; ++j) dst[64 * j] = src[64 * j];
        if (lane == 0) TS[it] = slot; }
    for (int e = 0; e < NEXP; ++e) { const int c = ps[64 + e], base = ps[e] + c, npad = ps[e + 1] - base;
        for (int r = gw; r < npad; r += NGW) { v4u* dst = (v4u*)(XG + (size_t)(base + r) * DM) + lane;
#pragma unroll
            for (int j = 0; j < 4; ++j) dst[64 * j] = (v4u){0u, 0u, 0u, 0u}; } }
}

__device__ __forceinline__ void phase_final(const Args& a, int lane, int wave, int bid, int G) {
    unsigned char* ws = a.ws; float* X1 = a.out; const bf16* YS = (const bf16*)(ws + WS_YS); const int* TS = (const int*)(ws + WS_TOKS); const float* TW = (const float*)(ws + WS_TOKW); const float* fg = a.in[26];
    const int gw = bid * NWAVES + wave, NGW = G * NWAVES;
    for (int t = gw; t < NTOK; t += NGW) { const int s0 = TS[2 * t], s1 = TS[2 * t + 1]; const float w0 = TW[2 * t], w1 = TW[2 * t + 1];
        f32x4* xr = (f32x4*)(X1 + (size_t)t * DM) + lane; const v2u* y0 = (const v2u*)(YS + (size_t)s0 * DM) + lane; const v2u* y1 = (const v2u*)(YS + (size_t)s1 * DM) + lane;
        f32x4 v[8]; float s = 0.f;
#pragma unroll
        for (int j = 0; j < 8; ++j) { const f32x4 x = xr[64 * j]; const v2u a0 = y0[64 * j], a1 = y1[64 * j];
            v[j].x = x.x + w0 * bflo(a0.x) + w1 * bflo(a1.x); v[j].y = x.y + w0 * bfhi(a0.x) + w1 * bfhi(a1.x); v[j].z = x.z + w0 * bflo(a0.y) + w1 * bflo(a1.y); v[j].w = x.w + w0 * bfhi(a0.y) + w1 * bfhi(a1.y);
            s += (v[j].x * v[j].x + v[j].y * v[j].y) + (v[j].z * v[j].z + v[j].w * v[j].w); }
        const float rs = rsqrtf(wave_sum(s) * (1.0f / DM) + 1e-6f);
#pragma unroll
        for (int j = 0; j < 8; ++j) { const f32x4 g = ((const f32x4*)fg)[64 * j + lane]; xr[64 * j] = (f32x4){v[j].x * rs * g.x, v[j].y * rs * g.y, v[j].z * rs * g.z, v[j].w * rs * g.w}; } }
}

#define LDS_BARRIER() do { asm volatile("s_waitcnt lgkmcnt(0)" ::: "memory"); __builtin_amdgcn_s_barrier(); asm volatile("" ::: "memory"); } while (0)
typedef __bf16 bf2_t __attribute__((ext_vector_type(2)));
typedef float f2_t __attribute__((ext_vector_type(2)));
__device__ __forceinline__ unsigned cvt2(float a, float b) { const f2_t v = {a, b}; const bf2_t r = __builtin_convertvector(v, bf2_t); return __builtin_bit_cast(unsigned, r); }
typedef short bf16x8 __attribute__((ext_vector_type(8)));
__device__ __forceinline__ f32x4 mfma16(bf16x8 xa, bf16x8 yb, f32x4 c) { return __builtin_amdgcn_mfma_f32_16x16x32_bf16(xa, yb, c, 0, 0, 0); }
__device__ __forceinline__ bf16x8 ldfrag(const LAS bf16* img, int ld, int row0, int k0, int lane) { return *(const LAS bf16x8*)(img + (row0 + (lane & 15)) * ld + k0 + (lane >> 4) * 8); }
typedef short s16x4 __attribute__((ext_vector_type(4)));
__device__ __forceinline__ bf16x8 ldfrag_tr(const LAS bf16* img, int ld, int k0, int c0, int lane) {
    const int q = lane >> 4, i = lane & 15;
    LAS bf16* p = (LAS bf16*)img + (k0 + 8 * q + (i >> 2)) * ld + c0 + 4 * (i & 3);
    const s16x4 lo = __builtin_amdgcn_ds_read_tr16_b64_v4i16((LAS s16x4*)p);
    const s16x4 hi = __builtin_amdgcn_ds_read_tr16_b64_v4i16((LAS s16x4*)(p + 4 * ld));
    return __builtin_shufflevector(lo, hi, 0, 1, 2, 3, 4, 5, 6, 7);
}
__device__ __forceinline__ void unpack8(const v4u& p, float (&f)[8]) { f[0] = bflo(p.x); f[1] = bfhi(p.x); f[2] = bflo(p.y); f[3] = bfhi(p.y); f[4] = bflo(p.z); f[5] = bfhi(p.z); f[6] = bflo(p.w); f[7] = bfhi(p.w); }

__device__ __forceinline__ void phase_ret_mfma(const Args& a, LAS unsigned char* lds, int tid, int lane, int wave, int bid, int G) {
    unsigned char* ws = a.ws; const bf16* P = (const bf16*)(ws + WS_P); const float* rot = (const float*)(ws + WS_ROT); bf16* OB = (bf16*)(ws + WS_OB);
    constexpr int LQ = 136, LT = 72;
    LAS bf16* Qs = (LAS bf16*)lds;
    LAS bf16* Ks = Qs + 64 * LQ;
    constexpr int LV = 40;
    LAS bf16* Vn = Ks + 64 * LQ;
    LAS bf16* Vd = Vn + 64 * LV;
    LAS bf16* Sc = Vd + 64 * LV;
    LAS bf16* ST = Sc + 64 * LT;
    LAS float* gp = (LAS float*)(ST + 32 * LQ);
    const int q4 = lane >> 4, l16 = lane & 15;
    for (int uu = bid; uu < 256; uu += G) {
        const int u = (((uu & 7) * 4 + (uu >> 6)) << 3) | ((uu >> 3) & 7);
        const int b = u >> 6, h = (u >> 3) & 7, vs = u & 7;
        __syncthreads();
        const float lg = log1pf(-exp2f(-5.0f - (float)h));
        if (tid < 65) gp[tid] = expf((float)tid * lg);
        for (int i = tid; i < 32 * LQ / 2; i += NTHR) ((LAS unsigned*)ST)[i] = 0u;
        f32x4 st[2] = {{0.f, 0.f, 0.f, 0.f}, {0.f, 0.f, 0.f, 0.f}};
        const int si = tid >> 3, d0 = (tid & 7) * 8, e0 = (tid & 7) * 4;
        const bf16* prow = P + (size_t)(b * SEQ + si) * NP;
        v4u qlo = *(const v4u*)(prow + P_RQ + h * 128 + d0), qhi = *(const v4u*)(prow + P_RQ + h * 128 + 64 + d0);
        v4u klo = *(const v4u*)(prow + P_RK + h * 128 + d0), khi = *(const v4u*)(prow + P_RK + h * 128 + 64 + d0);
        v2u vv = *(const v2u*)(prow + P_RV + h * 256 + vs * 32 + e0);
        f32x4 rt[4];
#pragma unroll
        for (int c = 0; c < 4; ++c) rt[c] = *(const f32x4*)(rot + ((size_t)si * 64 + d0) * 2 + c * 4);
        __syncthreads();
        const float chunk_decay = gp[64];
        for (int n = 0; n < SEQ / 64; ++n) {
            { float ql[8], qh[8], kl[8], kh[8]; unpack8(qlo, ql); unpack8(qhi, qh); unpack8(klo, kl); unpack8(khi, kh);
              float oql[8], oqh[8], okl[8], okh[8]; const float kd = gp[63 - si];
#pragma unroll
              for (int j = 0; j < 8; ++j) { const float c = rt[j >> 1][(j & 1) * 2], s = rt[j >> 1][(j & 1) * 2 + 1];
                  oql[j] = ql[j] * c - qh[j] * s; oqh[j] = ql[j] * s + qh[j] * c;
                  okl[j] = (kl[j] * c - kh[j] * s) * 0.08838834764831845f; okh[j] = (kl[j] * s + kh[j] * c) * 0.08838834764831845f; }
              v4u w; w.x = cvt2(oql[0], oql[1]); w.y = cvt2(oql[2], oql[3]); w.z = cvt2(oql[4], oql[5]); w.w = cvt2(oql[6], oql[7]); *(LAS v4u*)(Qs + si * LQ + d0) = w;
              w.x = cvt2(oqh[0], oqh[1]); w.y = cvt2(oqh[2], oqh[3]); w.z = cvt2(oqh[4], oqh[5]); w.w = cvt2(oqh[6], oqh[7]); *(LAS v4u*)(Qs + si * LQ + 64 + d0) = w;
              w.x = cvt2(okl[0], okl[1]); w.y = cvt2(okl[2], okl[3]); w.z = cvt2(okl[4], okl[5]); w.w = cvt2(okl[6], okl[7]); *(LAS v4u*)(Ks + si * LQ + d0) = w;
              w.x = cvt2(okh[0], okh[1]); w.y = cvt2(okh[2], okh[3]); w.z = cvt2(okh[4], okh[5]); w.w = cvt2(okh[6], okh[7]); *(LAS v4u*)(Ks + si * LQ + 64 + d0) = w;
              *(LAS v2u*)(Vn + si * LV + e0) = vv;
              { v2u wd; wd.x = cvt2(bflo(vv.x) * kd, bfhi(vv.x) * kd); wd.y = cvt2(bflo(vv.y) * kd, bfhi(vv.y) * kd); *(LAS v2u*)(Vd + si * LV + e0) = wd; } }
            LDS_BARRIER();
            if (n + 1 < SEQ / 64) { const bf16* pr = prow + (size_t)(n + 1) * 64 * NP;
                qlo = *(const v4u*)(pr + P_RQ + h * 128 + d0); qhi = *(const v4u*)(pr + P_RQ + h * 128 + 64 + d0);
                klo = *(const v4u*)(pr + P_RK + h * 128 + d0); khi = *(const v4u*)(pr + P_RK + h * 128 + 64 + d0);
                vv = *(const v2u*)(pr + P_RV + h * 256 + vs * 32 + e0);
#pragma unroll
                for (int c = 0; c < 4; ++c) rt[c] = *(const f32x4*)(rot + ((size_t)((n + 1) * 64 + si) * 64 + d0) * 2 + c * 4); }
            { const int i0 = (wave >> 1) * 16;
#pragma unroll
              for (int jt = 0; jt < 2; ++jt) { const int j0 = ((wave & 1) * 2 + jt) * 16; f32x4 acc = {0.f, 0.f, 0.f, 0.f};
#pragma unroll
                  for (int ks = 0; ks < 4; ++ks) acc = mfma16(ldfrag(Ks, LQ, j0, ks * 32, lane), ldfrag(Qs, LQ, i0, ks * 32, lane), acc);
                  const int i = i0 + l16, jb = j0 + 4 * q4; float sv[4];
#pragma unroll
                  for (int r = 0; r < 4; ++r) { const int j = jb + r; const int dist = i > j ? i - j : j - i; sv[r] = acc[r] * gp[dist]; }
                  v2u w; w.x = cvt2(sv[0], sv[1]); w.y = cvt2(sv[2], sv[3]); *(LAS v2u*)(Sc + i * LT + jb) = w; } }
            const int oi0 = (wave >> 1) * 16, oe0 = (wave & 1) * 16;
            f32x4 ointer = {0.f, 0.f, 0.f, 0.f};
#pragma unroll
            for (int ks = 0; ks < 4; ++ks) ointer = mfma16(ldfrag(ST, LQ, oe0, ks * 32, lane), ldfrag(Qs, LQ, oi0, ks * 32, lane), ointer);
#pragma unroll
            for (int et = 0; et < 2; ++et) { f32x4 acc = st[et] * chunk_decay;
#pragma unroll
                for (int ks = 0; ks < 2; ++ks) acc = mfma16(ldfrag_tr(Ks, LQ, ks * 32, wave * 16, lane), ldfrag_tr(Vd, LV, ks * 32, et * 16, lane), acc);
                st[et] = acc; }
            LDS_BARRIER();
            { f32x4 ointra = {0.f, 0.f, 0.f, 0.f};
#pragma unroll
              for (int ks = 0; ks < 2; ++ks) ointra = mfma16(ldfrag_tr(Vn, LV, ks * 32, oe0, lane), ldfrag(Sc, LT, oi0, ks * 32, lane), ointra);
              const int i = oi0 + l16; const float qd = gp[i + 1];
              v2u w; w.x = cvt2(ointra[0] + qd * ointer[0], ointra[1] + qd * ointer[1]); w.y = cvt2(ointra[2] + qd * ointer[2], ointra[3] + qd * ointer[3]);
              *(v2u*)(OB + (size_t)(b * SEQ + n * 64 + i) * RET_VW + h * 256 + vs * 32 + oe0 + 4 * q4) = w; }
#pragma unroll
            for (int et = 0; et < 2; ++et) { v2u w; w.x = cvt2(st[et][0], st[et][1]); w.y = cvt2(st[et][2], st[et][3]); *(LAS v2u*)(ST + (et * 16 + l16) * LQ + wave * 16 + 4 * q4) = w; }
            LDS_BARRIER();
        }
    }
}

constexpr int LT = 72, SLOT = 64 * LT;
constexpr size_t RW_GS = 0, RW_GY = 16 * MiB, RW_YS = 32 * MiB, RW_SS = 48 * MiB;
constexpr size_t WS_H0 = WS_RB;
constexpr size_t WS_W2T = WS_RB + 16 * MiB, WS_A2T = WS_W2T + 196608, WS_G2T = WS_A2T + 196608;

__device__ __forceinline__ f32x4 tile2(const LAS bf16* X, int x0, const LAS bf16* Y, int y0, int lane, f32x4 acc) {
    acc = mfma16(ldfrag(X, LT, x0, 0, lane), ldfrag(Y, LT, y0, 0, lane), acc);
    acc = mfma16(ldfrag(X, LT, x0, 32, lane), ldfrag(Y, LT, y0, 32, lane), acc);
    return acc;
}
__device__ __forceinline__ v2u pack4(f32x4 v) { v2u w; w.x = cvt2(v[0], v[1]); w.y = cvt2(v[2], v[3]); return w; }
__device__ __forceinline__ f32x4 unpack4(v2u w) { return (f32x4){bflo(w.x), bfhi(w.x), bflo(w.y), bfhi(w.y)}; }
__device__ __forceinline__ void st4(LAS bf16* img, int yrow, int xcol, f32x4 v) { *(LAS v2u*)(img + yrow * LT + xcol) = pack4(v); }
__device__ __forceinline__ f32x4 ld4(const LAS bf16* img, int yrow, int xcol) { return unpack4(*(const LAS v2u*)(img + yrow * LT + xcol)); }
__device__ __forceinline__ v4u pack8(const float (&f)[8]) { v4u w; w.x = cvt2(f[0], f[1]); w.y = cvt2(f[2], f[3]); w.z = cvt2(f[4], f[5]); w.w = cvt2(f[6], f[7]); return w; }
__device__ __forceinline__ void shift8(const bf16* P, size_t tg, int col, bool first, const float* mu, float (&o)[8]) {
    const v4u cur = *(const v4u*)(P + tg * NP + col); v4u prv = {0u, 0u, 0u, 0u}; if (!first) prv = *(const v4u*)(P + (tg - 1) * NP + col);
    const f32x4 m0 = *(const f32x4*)(mu + col), m1 = *(const f32x4*)(mu + col + 4);
    float c[8], p[8]; unpack8(cur, c); unpack8(prv, p);
#pragma unroll
    for (int j = 0; j < 8; ++j) o[j] = c[j] + (p[j] - c[j]) * (j < 4 ? m0[j] : m1[j - 4]);
}

__device__ __forceinline__ f32x4 tile2_ytr(const LAS bf16* X, int x0, const LAS bf16* Yn, int y0, int lane, f32x4 acc) {
    acc = mfma16(ldfrag(X, LT, x0, 0, lane), ldfrag_tr(Yn, LT, 0, y0, lane), acc);
    acc = mfma16(ldfrag(X, LT, x0, 32, lane), ldfrag_tr(Yn, LT, 32, y0, lane), acc);
    return acc;
}
__device__ __forceinline__ f32x4 tile2_xtr(const LAS bf16* Xn, int x0, const LAS bf16* Y, int y0, int lane, f32x4 acc) {
    acc = mfma16(ldfrag_tr(Xn, LT, 0, x0, lane), ldfrag(Y, LT, y0, 0, lane), acc);
    acc = mfma16(ldfrag_tr(Xn, LT, 32, x0, lane), ldfrag(Y, LT, y0, 32, lane), acc);
    return acc;
}
__device__ __forceinline__ f32x4 ld4_tr(const LAS bf16* img, int r0, int c0, int lane) {
    const int q = lane >> 4, i = lane & 15;
    LAS bf16* p = (LAS bf16*)img + (r0 + 4 * q + (i >> 2)) * LT + c0 + 4 * (i & 3);
    const s16x4 v = __builtin_amdgcn_ds_read_tr16_b64_v4i16((LAS s16x4*)p);
    return (f32x4){bf2f((unsigned short)v[0]), bf2f((unsigned short)v[1]), bf2f((unsigned short)v[2]), bf2f((unsigned short)v[3])};
}
__device__ __forceinline__ float fast_tanh(float x) { const float e = __expf(2.0f * x); return 1.0f - 2.0f / (e + 1.0f); }

__device__ __forceinline__ void phase_rwA(const Args& a, LAS unsigned char* lds, int tid, int lane, int wave, int bid, int G) {
    unsigned char* ws = a.ws; const bf16* P = (const bf16*)(ws + WS_P);
    const float* mu = a.in[3]; const float* w0 = a.in[4]; const float* a0 = a.in[6]; const float* k_k = a.in[9]; const float* k_a = a.in[10]; const float* r_k = a.in[11];
    const bf16* W2T = (const bf16*)(ws + WS_W2T); const bf16* A2T = (const bf16*)(ws + WS_A2T);
    bf16* GS = (bf16*)((unsigned char*)a.out + RW_GS); bf16* GY = (bf16*)((unsigned char*)a.out + RW_GY); bf16* YS = (bf16*)((unsigned char*)a.out + RW_YS); bf16* SS = (bf16*)((unsigned char*)a.out + RW_SS);
    float* BON = (float*)(ws + WS_BONUS);
    LAS bf16* img = (LAS bf16*)lds;
    LAS bf16 *s0 = img, *s1 = img + SLOT, *s2 = img + 2 * SLOT, *s3 = img + 3 * SLOT, *s4 = img + 4 * SLOT, *s5 = img + 5 * SLOT, *s6 = img + 6 * SLOT, *s7 = img + 7 * SLOT;
    LAS bf16 *s8 = img + 8 * SLOT, *s9 = img + 9 * SLOT, *s10 = img + 10 * SLOT, *s11 = img + 11 * SLOT, *s12 = img + 12 * SLOT, *s13 = img + 13 * SLOT;
    LAS float* WL = (LAS float*)s8;  LAS float* AL = (LAS float*)s10;
    LAS float* SEG = (LAS float*)(lds + RING_BYTES + 1024);
    LAS float* GC = SEG + 512;
    LAS float* DIAG = GC + 64;
    const int q4 = lane >> 4, l16 = lane & 15;
    const int yt = wave >> 1, xb = (wave & 1) * 2, y0 = yt * 16;
    const int st_ = tid >> 3, c0 = (tid & 7) * 8;
    const f32x4 z4 = {0.f, 0.f, 0.f, 0.f};
    for (int u = bid; u < 2048; u += G) {
        const int b = u >> 9, h = (u >> 5) & 15, c = u & 31;
        const size_t t0g = (size_t)b * SEQ + c * 64;
        { const int tl = y0 + l16; const size_t tg = t0g + tl; const bool firstl = (c == 0 && tl == 0);
          bf16x8 fw[3], fa[3];
#pragma unroll
          for (int ks = 0; ks < 3; ++ks) { float x[8];
              shift8(P, tg, P_XW + ks * 32 + q4 * 8, firstl, mu, x);
#pragma unroll
              for (int j = 0; j < 8; ++j) x[j] = fast_tanh(x[j]);
              fw[ks] = __builtin_bit_cast(bf16x8, pack8(x));
              shift8(P, tg, P_XA + ks * 32 + q4 * 8, firstl, mu, x);
              fa[ks] = __builtin_bit_cast(bf16x8, pack8(x)); }
#pragma unroll
          for (int xi = 0; xi < 2; ++xi) { const int ch0 = (xb + xi) * 16; f32x4 accw = z4, acca = z4;
#pragma unroll
              for (int ks = 0; ks < 3; ++ks) { const size_t wo = (size_t)(h * 64 + ch0 + l16) * 96 + ks * 32 + q4 * 8;
                  accw = mfma16(*(const bf16x8*)(W2T + wo), fw[ks], accw); acca = mfma16(*(const bf16x8*)(A2T + wo), fa[ks], acca); }
              *(LAS f32x4*)(WL + tl * 68 + ch0 + 4 * q4) = accw; *(LAS f32x4*)(AL + tl * 68 + ch0 + 4 * q4) = acca; } }
        float rr[8], kp[8], vv[8], av[8], bv[8], ee[8];
        { const size_t tg = t0g + st_; const bool first = (c == 0 && st_ == 0);
          shift8(P, tg, h * 64 + c0, first, mu, rr); shift8(P, tg, 1024 + h * 64 + c0, first, mu, kp); shift8(P, tg, 2048 + h * 64 + c0, first, mu, vv); }
        LDS_BARRIER();
        { const int chg = h * 64 + c0; float wl[8], al[8];
          { const f32x4 t0 = *(const LAS f32x4*)(WL + st_ * 68 + c0), t1 = *(const LAS f32x4*)(WL + st_ * 68 + c0 + 4), u0 = *(const LAS f32x4*)(AL + st_ * 68 + c0), u1 = *(const LAS f32x4*)(AL + st_ * 68 + c0 + 4);
#pragma unroll
            for (int j = 0; j < 4; ++j) { wl[j] = t0[j]; wl[4 + j] = t1[j]; al[j] = u0[j]; al[4 + j] = u1[j]; } }
          float ss = 0.f, bon = 0.f, kk[8], as[8];
#pragma unroll
          for (int j = 0; j < 8; ++j) { ee[j] = sigmoidf_(w0[chg + j] + wl[j]) * 0.6065306597126334f; as[j] = sigmoidf_(a0[chg + j] + al[j]); kk[j] = kp[j] * k_k[chg + j]; ss += kk[j] * kk[j]; }
          ss += __shfl_xor(ss, 1); ss += __shfl_xor(ss, 2); ss += __shfl_xor(ss, 4);
          const float rn = rsqrtf(fmaxf(ss, 1e-24f));
#pragma unroll
          for (int j = 0; j < 8; ++j) { const float kn = kk[j] * rn; kp[j] = kp[j] * (1.0f + (as[j] - 1.0f) * k_a[chg + j]); av[j] = -kn; bv[j] = kn * as[j]; bon += rr[j] * kp[j] * r_k[chg + j]; }
          bon += __shfl_xor(bon, 1); bon += __shfl_xor(bon, 2); bon += __shfl_xor(bon, 4);
          if ((tid & 7) == 0) BON[(t0g + st_) * RW_H + h] = bon;
          *(LAS f32x4*)(WL + st_ * 68 + c0) = (f32x4){ee[0], ee[1], ee[2], ee[3]}; *(LAS f32x4*)(WL + st_ * 68 + c0 + 4) = (f32x4){ee[4], ee[5], ee[6], ee[7]}; }
        LDS_BARRIER();
        { const int ch = tid & 63, seg = tid >> 6; float x[8], run = 0.f;
#pragma unroll
          for (int i = 0; i < 8; ++i) { run += WL[(seg * 8 + i) * 68 + ch]; x[i] = run; }
          SEG[seg * 64 + ch] = run;
          LDS_BARRIER();
          float off = 0.f;
#pragma unroll
          for (int s = 0; s < 8; ++s) off += (s < seg) ? SEG[s * 64 + ch] : 0.f;
#pragma unroll
          for (int i = 0; i < 8; ++i) WL[(seg * 8 + i) * 68 + ch] = x[i] + off; }
        LDS_BARRIER();
        { float cs[8], cC[8];
          { const f32x4 t0 = *(const LAS f32x4*)(WL + st_ * 68 + c0), t1 = *(const LAS f32x4*)(WL + st_ * 68 + c0 + 4), u0 = *(const LAS f32x4*)(WL + 63 * 68 + c0), u1 = *(const LAS f32x4*)(WL + 63 * 68 + c0 + 4);
#pragma unroll
            for (int j = 0; j < 4; ++j) { cs[j] = t0[j]; cs[4 + j] = t1[j]; cC[j] = u0[j]; cC[4 + j] = u1[j]; } }
          float At[8], Rt[8], Bt[8], Kt[8], Bh[8], Kh[8];
#pragma unroll
          for (int j = 0; j < 8; ++j) { const float gi = __expf(cs[j]), gt = __expf(-cs[j]), gh = __expf(cs[j] - cC[j]);
              At[j] = av[j] * __expf(ee[j] - cs[j]); Rt[j] = rr[j] * gt; Bt[j] = bv[j] * gi; Kt[j] = kp[j] * gi; Bh[j] = bv[j] * gh; Kh[j] = kp[j] * gh; }
          *(LAS v4u*)(s0 + st_ * LT + c0) = pack8(At); *(LAS v4u*)(s1 + st_ * LT + c0) = pack8(Rt); *(LAS v4u*)(s2 + st_ * LT + c0) = pack8(Bt); *(LAS v4u*)(s3 + st_ * LT + c0) = pack8(Kt);
          *(LAS v4u*)(s4 + st_ * LT + c0) = pack8(Bh); *(LAS v4u*)(s5 + st_ * LT + c0) = pack8(Kh); *(LAS v4u*)(s6 + st_ * LT + c0) = pack8(vv);
          if (st_ == 63) {
#pragma unroll
              for (int j = 0; j < 8; ++j) GC[c0 + j] = __expf(-cC[j]); }
          for (int i = tid; i < 2 * SLOT * 2 / 16; i += NTHR) ((LAS v4u*)s12)[i] = (v4u){0u, 0u, 0u, 0u}; }
        LDS_BARRIER();
#pragma unroll
        for (int xi = 0; xi < 2; ++xi) { const int xt = xb + xi, x0 = xt * 16; const int yr = y0 + l16, xc = x0 + 4 * q4;
            f32x4 acc = tile2(s2, x0, s0, y0, lane, z4);
#pragma unroll
            for (int r = 0; r < 4; ++r) acc[r] = (xc + r < yr) ? acc[r] : 0.f;
            if (yt == xt) *(LAS f32x4*)(DIAG + (yt * 16 + l16) * 16 + 4 * q4) = acc;
            st4(s8, yr, xc, ((yt == 1 && xt == 0) || (yt == 3 && xt == 2)) ? acc : z4);
            st4(s9, yr, xc, (yt >= 2 && xt <= 1) ? acc : z4); }
        LDS_BARRIER();
        if (wave == 0) { const LAS float* Lb = DIAG + q4 * 256; float x[16];
#pragma unroll
            for (int r = 0; r < 16; ++r) { float s = (r == l16) ? 1.0f : 0.0f;
#pragma unroll
                for (int j = 0; j < r; ++j) s += Lb[r * 16 + j] * x[j];
                x[r] = s; }
#pragma unroll
            for (int r = 0; r < 16; ++r) s12[(q4 * 16 + r) * LT + q4 * 16 + l16] = (bf16)f2bf(x[r]);
            { float lo[8], hi[8];
#pragma unroll
              for (int r = 0; r < 8; ++r) { lo[r] = x[r]; hi[r] = x[8 + r]; }
              *(LAS v4u*)(s13 + (q4 * 16 + l16) * LT + q4 * 16) = pack8(lo); *(LAS v4u*)(s13 + (q4 * 16 + l16) * LT + q4 * 16 + 8) = pack8(hi); } }
        else {
            for (int T = wave - 1; T < 48; T += 7) { const int p = T >> 4, ty = (T >> 2) & 3, tx = T & 3; const int yy0 = ty * 16, xx0 = tx * 16, yr = yy0 + l16, xc = xx0 + 4 * q4;
                const LAS bf16* X = p == 0 ? s0 : (p == 1 ? s2 : s3); const LAS bf16* Y = p == 0 ? s3 : s1; LAS bf16* D = p == 0 ? s10 : (p == 1 ? s11 : s7);
                f32x4 acc = tile2(X, xx0, Y, yy0, lane, z4);
#pragma unroll
                for (int r = 0; r < 4; ++r) { const bool keep = p == 0 ? (yr < xc + r) : (xc + r <= yr); acc[r] = keep ? acc[r] : 0.f; }
                st4(D, yr, xc, acc); } }
        LDS_BARRIER();
#pragma unroll
        for (int xi = 0; xi < 2; ++xi) { const int x0 = (xb + xi) * 16; st4(s2, y0 + l16, x0 + 4 * q4, tile2(s8, x0, s13, y0, lane, z4)); }
        LDS_BARRIER();
#pragma unroll
        for (int xi = 0; xi < 2; ++xi) { const int x0 = (xb + xi) * 16, yr = y0 + l16, xc = x0 + 4 * q4;
            st4(s3, yr, xc, tile2(s2, x0, s12, y0, lane, ld4(s12, yr, xc)));
            st4(s8, yr, xc, tile2(s12, x0, s2, y0, lane, ld4(s13, yr, xc))); }
        LDS_BARRIER();
#pragma unroll
        for (int xi = 0; xi < 2; ++xi) { const int x0 = (xb + xi) * 16; st4(s2, y0 + l16, x0 + 4 * q4, tile2(s9, x0, s8, y0, lane, z4)); }
        LDS_BARRIER();
#pragma unroll
        for (int xi = 0; xi < 2; ++xi) { const int x0 = (xb + xi) * 16, yr = y0 + l16, xc = x0 + 4 * q4; st4(s12, yr, xc, tile2(s2, x0, s3, y0, lane, ld4(s3, yr, xc))); }
        LDS_BARRIER();
#pragma unroll
        for (int xi = 0; xi < 2; ++xi) { const int x0 = (xb + xi) * 16, yr = y0 + l16, xc = x0 + 4 * q4;
            st4(s13, yr, xc, tile2_ytr(s12, x0, s0, y0, lane, z4));
            st4(s2, yr, xc, tile2(s12, x0, s10, y0, lane, z4)); }
        LDS_BARRIER();
#pragma unroll
        for (int xi = 0; xi < 2; ++xi) { const int xt = xb + xi, x0 = xt * 16, yr = y0 + l16, xc = x0 + 4 * q4;
            f32x4 acc = tile2(s13, x0, s11, y0, lane, ld4(s1, yr, xc));
            *(v2u*)(GY + (size_t)u * 4096 + yr * 64 + xc) = pack4(acc);
            st4(s3, yr, xc, tile2(s2, x0, s11, y0, lane, ld4(s7, yr, xc)));
            acc = tile2_ytr(s13, x0, s4, y0, lane, z4);
#pragma unroll
            for (int r = 0; r < 4; ++r) acc[r] += (xc + r == yr) ? GC[yr] : 0.f;
            *(v2u*)(GS + (size_t)u * 4096 + yr * 64 + xc) = pack4(acc);
            st4(s8, yr, xc, tile2_ytr(s2, x0, s4, y0, lane, ld4_tr(s5, x0, y0, lane))); }
        LDS_BARRIER();
#pragma unroll
        for (int xi = 0; xi < 2; ++xi) { const int x0 = (xb + xi) * 16, yr = y0 + l16, xc = x0 + 4 * q4;
            *(v2u*)(YS + (size_t)u * 4096 + yr * 64 + xc) = pack4(tile2_xtr(s6, x0, s3, y0, lane, z4));
            *(v2u*)(SS + (size_t)u * 4096 + yr * 64 + xc) = pack4(tile2_ytr(s8, x0, s6, y0, lane, z4)); }
        LDS_BARRIER();
    }
}

struct RwBRegs { v2u g[4][2][2]; v2u s[4]; };
__device__ __forceinline__ void rwB_load(RwBRegs& R, const bf16* GS, const bf16* SS, size_t u, int vg, int l16, int q4) {
#pragma unroll
    for (int mt = 0; mt < 4; ++mt) {
#pragma unroll
        for (int s = 0; s < 2; ++s) { const bf16* p = GS + u * 4096 + (mt * 16 + l16) * 64 + 32 * s + 4 * q4; R.g[mt][s][0] = *(const v2u*)p; R.g[mt][s][1] = *(const v2u*)(p + 16); }
        R.s[mt] = *(const v2u*)(SS + u * 4096 + (vg * 16 + l16) * 64 + mt * 16 + 4 * q4); }
}
__device__ __forceinline__ void phase_rwB(const Args& a, int lane, int wave, int bid, int G) {
    if (wave != 0) return;
    unsigned char* ws = a.ws; const bf16* GS = (const bf16*)((const unsigned char*)a.out + RW_GS); const bf16* SS = (const bf16*)((const unsigned char*)a.out + RW_SS); bf16* H0 = (bf16*)(ws + WS_H0);
    const int q4 = lane >> 4, l16 = lane & 15;
    for (int ch = bid; ch < 256; ch += G) {
        const int bh = ch >> 2, vg = ch & 3; const size_t u0 = (size_t)bh * 32;
        f32x4 H[4];
#pragma unroll
        for (int mt = 0; mt < 4; ++mt) H[mt] = (f32x4){0.f, 0.f, 0.f, 0.f};
        RwBRegs nxt; rwB_load(nxt, GS, SS, u0, vg, l16, q4);
        for (int c = 0; c < 32; ++c) {
            const RwBRegs cur = nxt;
            if (c + 1 < 32) rwB_load(nxt, GS, SS, u0 + c + 1, vg, l16, q4);
            v4u hf[2];
#pragma unroll
            for (int s = 0; s < 2; ++s) { const v2u lo = pack4(H[2 * s]), hi = pack4(H[2 * s + 1]); hf[s] = (v4u){lo.x, lo.y, hi.x, hi.y};
                bf16* hp = H0 + (u0 + c) * 4096 + (vg * 16 + l16) * 64 + 32 * s + 4 * q4; *(v2u*)hp = lo; *(v2u*)(hp + 16) = hi; }
#pragma unroll
            for (int mt = 0; mt < 4; ++mt) { f32x4 acc = unpack4(cur.s[mt]);
#pragma unroll
                for (int s = 0; s < 2; ++s) { const v4u af = {cur.g[mt][s][0].x, cur.g[mt][s][0].y, cur.g[mt][s][1].x, cur.g[mt][s][1].y};
                    acc = mfma16(__builtin_bit_cast(bf16x8, af), __builtin_bit_cast(bf16x8, hf[s]), acc); }
                H[mt] = acc; }
        }
    }
}

__device__ __forceinline__ void phase_rwC(const Args& a, int lane, int wave, int bid, int G) {
    unsigned char* ws = a.ws; const bf16* P = (const bf16*)(ws + WS_P);
    const bf16* GY = (const bf16*)((const unsigned char*)a.out + RW_GY); const bf16* YS = (const bf16*)((const unsigned char*)a.out + RW_YS); const bf16* H0 = (const bf16*)(ws + WS_H0);
    const bf16* G2T = (const bf16*)(ws + WS_G2T); const float* BON = (const float*)(ws + WS_BONUS); const float* mu = a.in[3]; const float* lg = a.in[12]; const float* lb = a.in[13];
    bf16* OA = (bf16*)(ws + WS_OA);
    const int q4 = lane >> 4, l16 = lane & 15; const int gw = bid * NWAVES + wave, NGW = G * NWAVES;
    for (int task = gw; task < 8192; task += NGW) {
        const int u = task >> 2, tt = task & 3; const int b = u >> 9, h = (u >> 5) & 15, c = u & 31;
        const int tl = tt * 16 + l16; const size_t tg = (size_t)b * SEQ + c * 64 + tl; const bool first = (c == 0 && tl == 0);
        f32x4 y[4], g[4];
        { const bf16x8 yf0 = *(const bf16x8*)(GY + (size_t)u * 4096 + tl * 64 + q4 * 8), yf1 = *(const bf16x8*)(GY + (size_t)u * 4096 + tl * 64 + 32 + q4 * 8);
#pragma unroll
          for (int vt = 0; vt < 4; ++vt) { f32x4 acc = unpack4(*(const v2u*)(YS + (size_t)u * 4096 + tl * 64 + vt * 16 + 4 * q4));
              const bf16* hp = H0 + (size_t)u * 4096 + (vt * 16 + l16) * 64 + q4 * 8;
              acc = mfma16(*(const bf16x8*)hp, yf0, acc); acc = mfma16(*(const bf16x8*)(hp + 32), yf1, acc); y[vt] = acc; } }
#pragma unroll
        for (int vt = 0; vt < 4; ++vt) g[vt] = (f32x4){0.f, 0.f, 0.f, 0.f};
#pragma unroll
        for (int ks = 0; ks < 8; ++ks) { float x[8]; shift8(P, tg, P_XG + ks * 32 + q4 * 8, first, mu, x);
#pragma unroll
            for (int j = 0; j < 8; ++j) x[j] = sigmoidf_(x[j]);
            const bf16x8 gf = __builtin_bit_cast(bf16x8, pack8(x));
#pragma unroll
            for (int vt = 0; vt < 4; ++vt) g[vt] = mfma16(*(const bf16x8*)(G2T + (size_t)(h * 64 + vt * 16 + l16) * 256 + ks * 32 + q4 * 8), gf, g[vt]); }
        float s = 0.f;
#pragma unroll
        for (int vt = 0; vt < 4; ++vt) s += (y[vt][0] + y[vt][1]) + (y[vt][2] + y[vt][3]);
        s += __shfl_xor(s, 16); s += __shfl_xor(s, 32);
        const float mean = s * (1.0f / 64.0f); float q = 0.f;
#pragma unroll
        for (int vt = 0; vt < 4; ++vt)
#pragma unroll
            for (int r = 0; r < 4; ++r) { const float d = y[vt][r] - mean; q += d * d; }
        q += __shfl_xor(q, 16); q += __shfl_xor(q, 32);
        const float rstd = rsqrtf(q * (1.0f / 64.0f) + 64e-5f); const float bon = BON[tg * RW_H + h];
#pragma unroll
        for (int vt = 0; vt < 4; ++vt) { const int chn = h * 64 + vt * 16 + 4 * q4;
            const v2u cur = *(const v2u*)(P + tg * NP + 2048 + chn); v2u prv = {0u, 0u}; if (!first) prv = *(const v2u*)(P + (tg - 1) * NP + 2048 + chn);
            const f32x4 cv = unpack4(cur), pv = unpack4(prv), m4 = *(const f32x4*)(mu + 2048 + chn), lg4 = *(const f32x4*)(lg + chn), lb4 = *(const f32x4*)(lb + chn);
            f32x4 o;
#pragma unroll
            for (int r = 0; r < 4; ++r) { const float vsh = cv[r] + (pv[r] - cv[r]) * m4[r]; o[r] = ((y[vt][r] - mean) * rstd * lg4[r] + lb4[r] + bon * vsh) * g[vt][r]; }
            *(v2u*)(OA + tg * RW_W + chn) = pack4(o); }
    }
}

constexpr size_t WS_WTG = 262144;
constexpr size_t WS_RS = WS_WTG + 393216;
static_assert(WS_RS + 32768 <= WS_ROT, "small tables fit below the rotary table");
__device__ __forceinline__ void phase_router2(const Args& a, LAS unsigned char* lds, int tid, int lane, int wave, int bid, int G) {
    unsigned char* ws = a.ws; const float* X1 = a.out; const float* WTG = (const float*)(ws + WS_WTG); float* RS = (float*)(ws + WS_RS);
    const float* bg = a.in[20]; const float* be = a.in[22];
    unsigned* ctl = (unsigned*)(ws + WS_CTL); int* TE = (int*)(ws + WS_TOKE); float* TW = (float*)(ws + WS_TOKW); int* TP = (int*)(ws + WS_TOKP);
    LAS float* part = (LAS float*)lds;
    const int q4 = lane >> 4, l16 = lane & 15, tile = wave >> 2, kq = wave & 3;
    for (int tp = bid; tp < NTOK / 32; tp += G) {
        const int t0 = tp * 32 + tile * 16;
        __syncthreads();
        f32x4 acc[3] = {{0.f, 0.f, 0.f, 0.f}, {0.f, 0.f, 0.f, 0.f}, {0.f, 0.f, 0.f, 0.f}}; float ssq = 0.f;
        const float* xp = X1 + (size_t)(t0 + l16) * DM + kq * 512 + 4 * q4; const float* wp = WTG + (size_t)l16 * DM + kq * 512 + 4 * q4;
#pragma unroll 4
        for (int g = 0; g < 32; ++g) { const f32x4 xv = *(const f32x4*)(xp + 16 * g);
            const f32x4 w0 = *(const f32x4*)(wp + 16 * g), w1 = *(const f32x4*)(wp + 16 * DM + 16 * g), w2 = *(const f32x4*)(wp + 32 * DM + 16 * g);
            ssq += (xv[0] * xv[0] + xv[1] * xv[1]) + (xv[2] * xv[2] + xv[3] * xv[3]);
#pragma unroll
            for (int j = 0; j < 4; ++j) { acc[0] = __builtin_amdgcn_mfma_f32_16x16x4f32(w0[j], xv[j], acc[0], 0, 0, 0); acc[1] = __builtin_amdgcn_mfma_f32_16x16x4f32(w1[j], xv[j], acc[1], 0, 0, 0);
                acc[2] = __builtin_amdgcn_mfma_f32_16x16x4f32(w2[j], xv[j], acc[2], 0, 0, 0); } }
        ssq += __shfl_xor(ssq, 16); ssq += __shfl_xor(ssq, 32);
        LAS float* pr = part + ((tile * 4 + kq) * 16 + l16) * 52;
#pragma unroll
        for (int ot = 0; ot < 3; ++ot) *(LAS f32x4*)(pr + ot * 16 + 4 * q4) = acc[ot];
        if (q4 == 0) pr[48] = ssq;
        __syncthreads();
        if (tid < 32) { const int tl = tid >> 4, tk = tid & 15, t = tp * 32 + tl * 16 + tk;
            const LAS float* p0 = part + ((tl * 4 + 0) * 16 + tk) * 52; const int ks = 16 * 52;
            const float sq = (p0[48] + p0[ks + 48]) + (p0[2 * ks + 48] + p0[3 * ks + 48]); const float rs = rsqrtf(sq * (1.0f / DM) + 1e-6f);
            float gl[4];
#pragma unroll
            for (int q = 0; q < 4; ++q) gl[q] = ((p0[q] + p0[ks + q]) + (p0[2 * ks + q] + p0[3 * ks + q])) * rs + bg[q];
            int gs = 0; float gm = gl[0];
#pragma unroll
            for (int q = 1; q < 4; ++q) if (gl[q] > gm) { gm = gl[q]; gs = q; }
            float den = 0.f;
#pragma unroll
            for (int q = 0; q < 4; ++q) den += expf(gl[q] - gm);
            const float gwt = 1.0f / den;
            float el[8];
#pragma unroll
            for (int q = 0; q < 8; ++q) { const int o = 4 + gs * 8 + q; el[q] = ((p0[o] + p0[ks + o]) + (p0[2 * ks + o] + p0[3 * ks + o])) * rs + be[gs * 8 + q]; }
            int i0 = 0; float m0 = el[0];
#pragma unroll
            for (int q = 1; q < 8; ++q) if (el[q] > m0) { m0 = el[q]; i0 = q; }
            int i1 = -1; float m1 = -3.0e38f;
#pragma unroll
            for (int q = 0; q < 8; ++q) if (q != i0 && el[q] > m1) { m1 = el[q]; i1 = q; }
            const float e1 = expf(m1 - m0); const float w0 = gwt / (1.0f + e1), w1 = gwt * e1 / (1.0f + e1);
            const int ex0 = gs * 8 + i0, ex1 = gs * 8 + i1;
            const unsigned c0 = __hip_atomic_fetch_add(ctl + CW_CNT + ex0, 1u, RLX_AGENT), c1 = __hip_atomic_fetch_add(ctl + CW_CNT + ex1, 1u, RLX_AGENT);
            TE[2 * t] = ex0; TE[2 * t + 1] = ex1; TW[2 * t] = w0; TW[2 * t + 1] = w1; TP[2 * t] = (int)c0; TP[2 * t + 1] = (int)c1; RS[t] = rs; }
    }
}

__device__ __forceinline__ void phase_gather2(const Args& a, LAS unsigned char* lds, int tid, int lane, int wave, int bid, int G) {
    unsigned char* ws = a.ws; unsigned* ctl = (unsigned*)(ws + WS_CTL); const float* X1 = a.out; bf16* XG = (bf16*)(ws + WS_XG); const float* RS = (const float*)(ws + WS_RS); const float* g2 = a.in[18];
    const int* TE = (const int*)(ws + WS_TOKE); const int* TP = (const int*)(ws + WS_TOKP); int* TS = (int*)(ws + WS_TOKS);
    LAS int* ps = (LAS int*)lds;
    __syncthreads();
    if (tid == 0) { int acc = 0, nt = 0;
        for (int e = 0; e < NEXP; ++e) { const int c = (int)__hip_atomic_load(ctl + CW_CNT + e, RLX_AGENT); ps[e] = acc; ps[64 + e] = c; const int tl = (c + 255) >> 8;
            if (bid == 0) for (int q = 0; q < tl; ++q) ctl[CW_TE + nt + q] = (unsigned)e;
            nt += tl; acc += tl * 256; }
        ps[32] = acc; if (bid == 0) ctl[CW_NT] = (unsigned)nt; }
    __syncthreads();
    const int gw = bid * NWAVES + wave, NGW = G * NWAVES;
    for (int t = gw; t < NTOK; t += NGW) { const int s0 = ps[TE[2 * t]] + TP[2 * t], s1 = ps[TE[2 * t + 1]] + TP[2 * t + 1]; const float rs = RS[t];
        const f32x4* xr = (const f32x4*)(X1 + (size_t)t * DM) + lane; v2u* d0 = (v2u*)(XG + (size_t)s0 * DM) + lane; v2u* d1 = (v2u*)(XG + (size_t)s1 * DM) + lane;
#pragma unroll
        for (int j = 0; j < 8; ++j) { const f32x4 x = xr[64 * j]; const f32x4 g = ((const f32x4*)g2)[64 * j + lane];
            v2u o; o.x = cvt2(x.x * rs * g.x, x.y * rs * g.y); o.y = cvt2(x.z * rs * g.z, x.w * rs * g.w); d0[64 * j] = o; d1[64 * j] = o; }
        if (lane == 0) { TS[2 * t] = s0; TS[2 * t + 1] = s1; } }
    for (int e = 0; e < NEXP; ++e) { const int c = ps[64 + e], base = ps[e] + c, npad = ps[e + 1] - base;
        for (int r = gw; r < npad; r += NGW) { v4u* dst = (v4u*)(XG + (size_t)(base + r) * DM) + lane;
#pragma unroll
            for (int j = 0; j < 4; ++j) dst[64 * j] = (v4u){0u, 0u, 0u, 0u}; } }
}

constexpr int NPHASE = 14;
__global__ void __launch_bounds__(NTHR, 2) mega_fwd(Args args) {
    extern __shared__ __attribute__((aligned(16))) unsigned char lds_raw[];
    LAS unsigned char* lds = (LAS unsigned char*)lds_raw;
    const int tid = threadIdx.x, lane = tid & 63, wave = __builtin_amdgcn_readfirstlane(tid >> 6), bid = blockIdx.x, G = gridDim.x;
    unsigned char* ws = args.ws; unsigned* ctl = (unsigned*)(ws + WS_CTL);
    volatile LAS unsigned* MISC = (volatile LAS unsigned*)(lds + MISC_OFF);
    for (int u = tid; u < (LDS_BYTES - RING_BYTES) / 4; u += NTHR) ((LAS unsigned*)(lds + RING_BYTES))[u] = 0u;
    __syncthreads();
    const int lo = args.ph_lo, hi = args.ph_hi;
    const bool multi = (hi - lo) > 1;
    XcdBarrier bar; bar.bar = ctl + CW_BAR; bar.x = 0; bar.st = nullptr;
    if (multi) bar = xcd_barrier_post(ctl + CW_BAR, MISC + 8);
#ifndef PH_MASK
#define PH_MASK 0x3fff
#endif
#define IN(k) (((PH_MASK >> (k)) & 1) && lo <= (k) && (k) < hi)
#define SEAM(k) do { if (IN(k) && IN((k) + 1)) xcd_barrier(bar); } while (0)
    bf16* P = (bf16*)(ws + WS_P);

#ifndef PH_REP
#define PH_REP 0
#endif
#define REP(k) ((PH_REP >> (k)) & 1)
#define P0_BODY { phase_prologue(args, lds, tid, lane, wave, bid, G); }
#define P1_BODY { pg8::Gemm g{(const bf16*)(ws + WS_H1), (const bf16*)(ws + WS_WIN), NTOK, NP, DM}; pg8::StaticOrder S; S.init(NTOK, NP, G, bid); EpiP E{P}; pg8::gemm_phase<EpiP, pg8::StaticOrder, true, true>(lds, g, S, E); }
#define P2_BODY { phase_rwA(args, lds, tid, lane, wave, bid, G); }
#define P3_BODY { phase_ret_mfma(args, lds, tid, lane, wave, bid, G); }
#define P4_BODY { phase_rwB(args, lane, wave, bid, G); }
#define P6_BODY { pg8::Gemm g{(const bf16*)(ws + WS_OA), (const bf16*)(ws + WS_WUPA), NTOK, DM, 1024}; pg8::StaticOrder S; S.init(NTOK, DM, G, bid); EpiUp<0> E{(bf16*)(ws + WS_MERGED), P}; pg8::gemm_phase<EpiUp<0>, pg8::StaticOrder, false, true>(lds, g, S, E); }
#define P7_BODY { pg8::Gemm g{(const bf16*)(ws + WS_OB), (const bf16*)(ws + WS_WUPB), NTOK, DM, DM}; pg8::StaticOrder S; S.init(NTOK, DM, G, bid); EpiUp<1> E{(bf16*)(ws + WS_MERGED), P}; pg8::gemm_phase<EpiUp<1>, pg8::StaticOrder, false, true>(lds, g, S, E); }
#define P8_BODY { pg8::Gemm g{(const bf16*)(ws + WS_MERGED), (const bf16*)(ws + WS_WOUT), NTOK, DM, DM}; pg8::StaticOrder S; S.init(NTOK, DM, G, bid); EpiX1 E{args.in[0], args.out}; pg8::gemm_phase<EpiX1, pg8::StaticOrder, false, true>(lds, g, S, E); }
#define P10_BODY { phase_gather2(args, lds, tid, lane, wave, bid, G); }
#define P11_BODY { pg8::Gemm g{(const bf16*)(ws + WS_XG), (const bf16*)(ws + WS_WGU), MAXSLOT, NEXP * 1024, DM}; MoeOrder<4> S; S.init(ctl, G, bid); EpiGU E{(bf16*)(ws + WS_ACT)}; pg8::gemm_phase<EpiGU, MoeOrder<4>, true, true>(lds, g, S, E); }
#define P12_BODY { pg8::Gemm g{(const bf16*)(ws + WS_ACT), (const bf16*)(ws + WS_WDN), MAXSLOT, NEXP * 2048, EFF}; MoeOrder<8> S; S.init(ctl, G, bid); EpiDn E{(bf16*)(ws + WS_YS)}; pg8::gemm_phase<EpiDn, MoeOrder<8>, true, true>(lds, g, S, E); }
    if (IN(0)) { P0_BODY if (REP(0)) { xcd_barrier(bar); P0_BODY } } SEAM(0);
    if (IN(1)) { P1_BODY if (REP(1)) { xcd_barrier(bar); P1_BODY } } SEAM(1);
    if (IN(2)) { P2_BODY if (REP(2)) { P2_BODY } }
    if (IN(3)) { P3_BODY if (REP(3)) { P3_BODY } } SEAM(3);
    if (IN(4)) { P4_BODY if (REP(4)) { xcd_barrier(bar); P4_BODY } } SEAM(4);
    if (IN(5)) { phase_rwC(args, lane, wave, bid, G); if (REP(5)) { phase_rwC(args, lane, wave, bid, G); } phase_retpost(args, lane, wave, bid, G); } SEAM(5);
    if (IN(6)) P6_BODY
    if (IN(7)) P7_BODY
    SEAM(7);
    if (IN(8)) { P8_BODY if (REP(6)) { xcd_barrier(bar); P6_BODY xcd_barrier(bar); P7_BODY xcd_barrier(bar); P8_BODY } } SEAM(8);
    if (IN(9)) { phase_router2(args, lds, tid, lane, wave, bid, G); } SEAM(9);
    if (IN(10)) P10_BODY
    SEAM(10);
    if (IN(11)) P11_BODY
    SEAM(11);
    if (IN(12)) { P12_BODY if (REP(10)) { xcd_barrier(bar); P10_BODY xcd_barrier(bar); P11_BODY xcd_barrier(bar); P12_BODY } } SEAM(12);
    if (IN(13)) { phase_final(args, lane, wave, bid, G); }
#undef IN
#undef SEAM
}

#ifndef MK_ONE_LAUNCH
#define MK_ONE_LAUNCH 1
#endif
extern "C" void kernel_launch(void* const* d_in, const int* in_sizes, int n_in, void* d_out, int out_size, void* d_ws, size_t ws_size, hipStream_t stream) {
    static int grid = 0;
    if (grid == 0) {
        if (n_in != 27 || out_size != NTOK * DM || ws_size < WS_END) { fprintf(stderr, "kernel_launch: unexpected shapes (n_in %d out %d ws %zu, need %zu)\n", n_in, out_size, ws_size, (size_t)WS_END); grid = -1; return; }
        int dev = 0, cus = 0, per_cu = 0;
        if (hipGetDevice(&dev) != hipSuccess || hipDeviceGetAttribute(&cus, hipDeviceAttributeMultiprocessorCount, dev) != hipSuccess) { grid = -1; return; }
        if (hipFuncSetAttribute((const void*)mega_fwd, hipFuncAttributeMaxDynamicSharedMemorySize, LDS_BYTES) != hipSuccess) { fprintf(stderr, "kernel_launch: hipFuncSetAttribute failed\n"); grid = -1; return; }
        if (hipOccupancyMaxActiveBlocksPerMultiprocessor(&per_cu, (const void*)mega_fwd, NTHR, LDS_BYTES) != hipSuccess || per_cu < 1) { fprintf(stderr, "kernel_launch: occupancy query says %d\n", per_cu); grid = -1; (void)hipGetLastError(); return; }
        grid = cus;
    }
    if (grid < 0) return;
    (void)in_sizes;
    if (hipMemsetAsync((char*)d_ws + WS_CTL, 0, CTL_ZERO_BYTES, stream) != hipSuccess) return;
    Args a{};
    for (int i = 0; i < 27; ++i) a.in[i] = (const float*)d_in[i];
    a.out = (float*)d_out; a.ws = (unsigned char*)d_ws;
#if MK_ONE_LAUNCH
    a.ph_lo = 0; a.ph_hi = NPHASE;
    hipLaunchKernelGGL(mega_fwd, dim3(grid), dim3(NTHR), LDS_BYTES, stream, a);
#else
    for (int p = 0; p < NPHASE; ++p) { a.ph_lo = p; a.ph_hi = p + 1; hipLaunchKernelGGL(mega_fwd, dim3(grid), dim3(NTHR), LDS_BYTES, stream, a); }
#endif
}
```

```cpp
#include <hip/hip_runtime.h>
#include <cstdio>
#include <cstdint>
namespace pg8 {
#define PG8_LAS __attribute__((address_space(3)))
typedef unsigned short bf16_t;
typedef short bf16x8 __attribute__((ext_vector_type(8)));
typedef float f32x4 __attribute__((ext_vector_type(4)));
typedef unsigned u32x4 __attribute__((ext_vector_type(4)));
constexpr int BM = 256, BK = 64, HALF = 128, HTB = HALF * BK * 2  , STAGE_BYTES = 8 * HTB, NXCD = 8, WGM = 8;

__host__ __device__ __forceinline__ int lds_byte(int r, int c) { const int st = (r >> 4) * 2 + (c >> 5), rr = r & 15, cc = c & 31, ob = rr * 64 + cc * 2; return st * 1024 + (ob ^ (((ob >> 9) & 1) << 5)); }
__host__ __device__ __forceinline__ void stage_rc(int b, int& R, int& C) { const int st = b / 1024, sb = b % 1024, swz = sb ^ (((sb >> 9) & 1) << 5); R = (st >> 1) * 16 + swz / 64; C = (st & 1) * 32 + (swz % 64) / 2; }
__host__ __device__ __forceinline__ int perm32(int rho) { const int n = rho >> 4, i = rho & 15; return 8 * (i >> 2) + 4 * n + (i & 3); }

struct Unit { int pm, pn; int hv; };
struct Gemm { const bf16_t* A; const bf16_t* Bt; int M, N, K; const int* rowmap = nullptr; };

struct StaticOrder {
    int nM, nN, nwg, G, c;
    __host__ __device__ void init(int M, int N, int G_, int c_) { nM = M / BM; nN = N / BM; nwg = nM * nN; G = G_; c = c_; }
    __host__ __device__ bool next(int i, Unit& u) const {
        const long L = (long)i * G + c; if (L >= nwg) return false;
        int wgid = (int)L; { const int q = nwg / NXCD, r = nwg % NXCD, xcd = wgid % NXCD, off = wgid / NXCD; wgid = (xcd < r ? xcd * (q + 1) : r * (q + 1) + (xcd - r) * q) + off; }
        const int nig = WGM * nN, gid = wgid / nig, fm = gid * WGM, gsz = (nM - fm) < WGM ? (nM - fm) : WGM;
        u.pm = fm + ((wgid % nig) % gsz); u.pn = (wgid % nig) / gsz; return true;
    }
    __device__ __forceinline__ void a_ready(const Unit&) const {}
    __device__ __forceinline__ void done(const Unit&) const {}
};

__device__ __forceinline__ unsigned cvt_pk_bf16(float lo, float hi) { unsigned r; asm volatile("v_cvt_pk_bf16_f32 %0, %1, %2" : "=v"(r) : "v"(lo), "v"(hi)); return r; }
typedef float f32x2 __attribute__((ext_vector_type(2)));
template <class Epi, class Sched, bool ALIGN_EPI = false, bool SP2 = false, bool GATHER = false, bool HSKIP = false>
__device__ __forceinline__ void gemm_phase(PG8_LAS unsigned char* lds, const Gemm g, const Sched& S, const Epi& E) {
    const int tid = threadIdx.x, wid = __builtin_amdgcn_readfirstlane(tid >> 6), lane = tid & 63, wr = wid >> 2, wc = wid & 3, fr = lane & 15, fq = lane >> 4;
    const int K = g.K, nt = K / BK;
    unsigned voffA[2], voffB[2];
#pragma unroll
    for (int i = 0; i < 2; ++i) { int R, C; stage_rc(tid * 16 + i * 8192, R, C); const int Rb = Epi::PERM ? ((R & ~31) + perm32(R & 31)) : R;
        voffA[i] = (unsigned)(R * K + C) * 2u; voffB[i] = (unsigned)(Rb * K + C) * 2u; }
    const size_t kstep = (size_t)(BK * 2);
    const size_t hstep = (size_t)HALF * K * 2;
    const size_t tstep = 2 * hstep;
    const unsigned ldsw = (unsigned)wid * 1024u;
    const int aoff = lds_byte(wr * 64 + fr, fq * 8), boff = lds_byte(wc * 32 + fr, fq * 8);
#define PG8_SA(b, h) (((b) * 2 + (h)) * HTB)
#define PG8_SB(b, h) ((4 + (b) * 2 + (h)) * HTB)
#define PG8_STAGE(bufoff, gbase, voff) do { _Pragma("unroll") for (int _i = 0; _i < 2; ++_i) \
        __builtin_amdgcn_global_load_lds((const unsigned*)((const char*)(gbase) + (voff)[_i]), (PG8_LAS unsigned*)(lds + (bufoff) + ldsw + _i * 8192), 16, 0, 0); } while (0)
#define PG8_LDA(dst, b, h) do { _Pragma("unroll") for (int m = 0; m < 4; ++m) _Pragma("unroll") for (int k = 0; k < 2; ++k) dst[m][k] = *(const PG8_LAS bf16x8*)(lds + PG8_SA(b, h) + aoff + m * 2048 + k * 1024); } while (0)
#define PG8_LDB(dst, b, h) do { _Pragma("unroll") for (int n = 0; n < 2; ++n) _Pragma("unroll") for (int k = 0; k < 2; ++k) dst[n][k] = *(const PG8_LAS bf16x8*)(lds + PG8_SB(b, h) + boff + n * 2048 + k * 1024); } while (0)
#define PG8_MMA(ai, bj, At, Bt) do { __builtin_amdgcn_s_setprio(1); _Pragma("unroll") for (int m = 0; m < 4; ++m) _Pragma("unroll") for (int n = 0; n < 2; ++n) _Pragma("unroll") for (int k = 0; k < 2; ++k) \
        acc[ai][bj][m][n] = __builtin_amdgcn_mfma_f32_16x16x32_bf16(Bt[n][k], At[m][k], acc[ai][bj][m][n], 0, 0, 0); __builtin_amdgcn_s_setprio(0); } while (0)
#define PG8_WAIT_V(n) asm volatile("s_waitcnt vmcnt(" #n ")" ::: "memory")
#define PG8_WAIT_L(n) asm volatile("s_waitcnt lgkmcnt(" #n ")" ::: "memory")
#define PG8_BAR __builtin_amdgcn_s_barrier()
#define PG8_SCHED __builtin_amdgcn_sched_barrier(0)
    Unit cur, nxt; int ui = 0;
    if (!S.next(0, cur)) return;
    unsigned gAc[2][2] = {{0u, 0u}, {0u, 0u}}, gAn[2][2] = {{0u, 0u}, {0u, 0u}};
    int gR[2], gC[2];
#pragma unroll
    for (int i = 0; i < 2; ++i) stage_rc(tid * 16 + i * 8192, gR[i], gC[i]);
#define PG8_GROWS(dst, un) do { _Pragma("unroll") for (int h_ = 0; h_ < 2; ++h_) _Pragma("unroll") for (int i_ = 0; i_ < 2; ++i_) \
        dst[h_][i_] = (unsigned)S.arow(un, h_ * HALF + gR[i_]) * (unsigned)(K * 2) + (unsigned)(gC[i_] * 2); } while (0)
#define PG8_STAGE_A(bufoff, base, h, nx) do { if constexpr (GATHER) { unsigned v_[2]; v_[0] = (nx) ? gAn[h][0] : gAc[h][0]; v_[1] = (nx) ? gAn[h][1] : gAc[h][1]; PG8_STAGE(bufoff, base, v_); } \
        else { PG8_STAGE(bufoff, (base) + (h) * hstep, voffA); } } while (0)
    if constexpr (GATHER) PG8_GROWS(gAc, cur);
    f32x4 acc[2][2][4][2];
#pragma unroll
    for (int a = 0; a < 2; ++a)
#pragma unroll
        for (int b = 0; b < 2; ++b)
#pragma unroll
            for (int m = 0; m < 4; ++m)
#pragma unroll
                for (int n = 0; n < 2; ++n) acc[a][b][m][n] = (f32x4){0.f, 0.f, 0.f, 0.f};
    bf16x8 At[4][2], B0[2][2], B1[2][2];
    const char* cA = (const char*)g.A + (GATHER ? (size_t)0 : (size_t)cur.pm * tstep); const char* cB = (const char*)g.Bt + (size_t)cur.pn * tstep;
    S.a_ready(cur);
    if constexpr (SP2) {
        PG8_STAGE(PG8_SB(0, 0), cB, voffB); PG8_STAGE(PG8_SB(0, 1), cB + hstep, voffB); PG8_STAGE_A(PG8_SA(0, 0), cA, 0, false); PG8_STAGE_A(PG8_SA(0, 1), cA, 1, false);
        if (wr == 1) PG8_BAR;
        PG8_WAIT_V(2); PG8_BAR;
        PG8_STAGE(PG8_SB(1, 0), cB + kstep, voffB); PG8_STAGE_A(PG8_SA(1, 0), cA + kstep, 0, false); PG8_STAGE(PG8_SB(1, 1), cB + hstep + kstep, voffB);
        PG8_WAIT_V(6); PG8_BAR;
    } else {
        PG8_STAGE(PG8_SB(0, 0), cB, voffB); PG8_STAGE_A(PG8_SA(0, 0), cA, 0, false); PG8_STAGE(PG8_SB(0, 1), cB + hstep, voffB); PG8_STAGE_A(PG8_SA(0, 1), cA, 1, false);
        if (wr == 1) PG8_BAR;
        PG8_WAIT_V(4); PG8_BAR;
        PG8_STAGE(PG8_SB(1, 0), cB + kstep, voffB); PG8_STAGE_A(PG8_SA(1, 0), cA + kstep, 0, false); PG8_STAGE(PG8_SB(1, 1), cB + hstep + kstep, voffB);
        PG8_WAIT_V(6); PG8_BAR;
    }
    for (;;) {
        const bool has_next = S.next(ui + 1, nxt);
        const char* nA = (has_next && !GATHER) ? (const char*)g.A + (size_t)nxt.pm * tstep : cA; const char* nB = has_next ? (const char*)g.Bt + (size_t)nxt.pn * tstep : cB;
        if constexpr (GATHER) { if (has_next) PG8_GROWS(gAn, nxt); else { gAn[0][0] = gAc[0][0]; gAn[0][1] = gAc[0][1]; gAn[1][0] = gAc[1][0]; gAn[1][1] = gAc[1][1]; } }
        for (int t = 0; t < nt; t += 2) {
            if constexpr (Epi::MID) { if (t == E.tmid) E.mid(acc, cur, wr, wc, fr, fq); }
            const bool last = (t == nt - 2);
            const char* a1 = cA + (size_t)(t + 1) * kstep;
            const char* a2 = last ? nA : cA + (size_t)(t + 2) * kstep; const char* b2 = last ? nB : cB + (size_t)(t + 2) * kstep;
            const char* a3 = a2 + kstep; const char* b3 = b2 + kstep;
            if (last && has_next) S.a_ready(nxt);
            if constexpr (SP2) {
            PG8_LDB(B0, 0, 0); PG8_LDB(B1, 0, 1); PG8_SCHED; PG8_LDA(At, 0, 0); PG8_STAGE_A(PG8_SA(1, 1), a1, 1, false);
            PG8_WAIT_V(8); PG8_WAIT_L(0); PG8_BAR; PG8_MMA(0, 0, At, B0); PG8_MMA(0, 1, At, B1); PG8_BAR; PG8_SCHED;
            if (!(HSKIP && cur.hv)) PG8_LDA(At, 0, 1); PG8_STAGE(PG8_SB(0, 0), b2, voffB); PG8_STAGE(PG8_SB(0, 1), b2 + hstep, voffB); PG8_STAGE_A(PG8_SA(0, 0), a2, 0, last);
            PG8_WAIT_V(8); PG8_WAIT_L(0); PG8_BAR; if (!(HSKIP && cur.hv)) { PG8_MMA(1, 0, At, B0); PG8_MMA(1, 1, At, B1); } PG8_BAR; PG8_SCHED;
            PG8_LDB(B0, 1, 0); PG8_LDB(B1, 1, 1); PG8_SCHED; PG8_LDA(At, 1, 0); PG8_STAGE_A(PG8_SA(0, 1), a2, 1, last);
            PG8_WAIT_V(8); PG8_WAIT_L(0); PG8_BAR; PG8_MMA(0, 0, At, B0); PG8_MMA(0, 1, At, B1); PG8_BAR; PG8_SCHED;
            if (!(HSKIP && cur.hv)) PG8_LDA(At, 1, 1); PG8_STAGE(PG8_SB(1, 0), b3, voffB); PG8_STAGE(PG8_SB(1, 1), b3 + hstep, voffB); PG8_STAGE_A(PG8_SA(1, 0), a3, 0, last);
            PG8_WAIT_V(8); PG8_WAIT_L(0); PG8_BAR; if (!(HSKIP && cur.hv)) { PG8_MMA(1, 0, At, B0); PG8_MMA(1, 1, At, B1); } PG8_BAR; PG8_SCHED;
            } else {
            PG8_LDB(B0, 0, 0); PG8_SCHED; PG8_LDA(At, 0, 0); PG8_STAGE_A(PG8_SA(1, 1), a1, 1, false);
            PG8_WAIT_L(8); PG8_BAR; PG8_WAIT_L(0); PG8_MMA(0, 0, At, B0); PG8_BAR; PG8_SCHED;
            PG8_LDB(B1, 0, 1); PG8_STAGE(PG8_SB(0, 0), b2, voffB);
            PG8_BAR; PG8_WAIT_L(0); PG8_MMA(0, 1, At, B1); PG8_BAR;
            PG8_LDA(At, 0, 1); PG8_STAGE_A(PG8_SA(0, 0), a2, 0, last);
            PG8_BAR; PG8_WAIT_L(0); PG8_MMA(1, 0, At, B0); PG8_BAR; PG8_SCHED;
            PG8_STAGE(PG8_SB(0, 1), b2 + hstep, voffB);
            PG8_WAIT_V(6); PG8_BAR; PG8_MMA(1, 1, At, B1); PG8_BAR;
            PG8_LDB(B0, 1, 0); PG8_SCHED; PG8_LDA(At, 1, 0); PG8_STAGE_A(PG8_SA(0, 1), a2, 1, last);
            PG8_WAIT_L(8); PG8_BAR; PG8_WAIT_L(0); PG8_MMA(0, 0, At, B0); PG8_BAR; PG8_SCHED;
            PG8_LDB(B1, 1, 1); PG8_STAGE(PG8_SB(1, 0), b3, voffB);
            PG8_BAR; PG8_WAIT_L(0); PG8_MMA(0, 1, At, B1); PG8_BAR;
            PG8_LDA(At, 1, 1); PG8_STAGE_A(PG8_SA(1, 0), a3, 0, last);
            PG8_BAR; PG8_WAIT_L(0); PG8_MMA(1, 0, At, B0); PG8_BAR; PG8_SCHED;
            PG8_STAGE(PG8_SB(1, 1), b3 + hstep, voffB);
            PG8_WAIT_V(6); PG8_BAR; PG8_MMA(1, 1, At, B1); PG8_BAR;
            }
        }
        if constexpr (ALIGN_EPI) { if (wr == 0) PG8_BAR; }
        if constexpr (!Epi::AFTER_DRAIN) { E(acc, cur, wr, wc, fr, fq); S.done(cur); }
        if (!has_next) break;
#pragma unroll
        for (int a = 0; a < 2; ++a)
#pragma unroll
            for (int b = 0; b < 2; ++b)
#pragma unroll
                for (int m = 0; m < 4; ++m)
#pragma unroll
                    for (int n = 0; n < 2; ++n) acc[a][b][m][n] = (f32x4){0.f, 0.f, 0.f, 0.f};
        cur = nxt; cA = nA; cB = nB; ++ui;
        if constexpr (GATHER) { gAc[0][0] = gAn[0][0]; gAc[0][1] = gAn[0][1]; gAc[1][0] = gAn[1][0]; gAc[1][1] = gAn[1][1]; }
        if constexpr (ALIGN_EPI) { if (wr == 1) PG8_BAR; }
    }
    PG8_WAIT_V(0);
    if constexpr (!ALIGN_EPI) { if (wr == 0) PG8_BAR; }
    PG8_BAR;
    if constexpr (Epi::AFTER_DRAIN) { E.fused(acc, cur, wr, wc, fr, fq, lds, wid, lane); S.done(cur); }
#undef PG8_SA
#undef PG8_SB
#undef PG8_STAGE
#undef PG8_STAGE_A
#undef PG8_GROWS
#undef PG8_LDA
#undef PG8_LDB
#undef PG8_MMA
#undef PG8_WAIT_V
#undef PG8_WAIT_L
#undef PG8_BAR
#undef PG8_SCHED
}
}

#define GAS __attribute__((address_space(1)))
#define LAS __attribute__((address_space(3)))
typedef unsigned short bf16;
typedef unsigned v4u __attribute__((ext_vector_type(4)));
typedef unsigned v2u __attribute__((ext_vector_type(2)));
typedef float f32x4 __attribute__((ext_vector_type(4)));
typedef GAS unsigned gu32;
#define RLX_AGENT __ATOMIC_RELAXED, __HIP_MEMORY_SCOPE_AGENT
#define LDS_WAIT() asm volatile("s_waitcnt lgkmcnt(0)" ::: "memory")
#define VM_WAIT() asm volatile("s_waitcnt vmcnt(0)" ::: "memory")

constexpr int NTOK = 8192, SEQ = 2048, DM = 2048, NP = 13824, NWAVES = 8, NTHR = 512;
constexpr int RW_W = 1024, RW_H = 16, RW_N = 64;
constexpr int P_XW = 3072, P_XA = 3168, P_XG = 3264;
constexpr int P_RQ = 3584, P_RK = 4608, P_RV = 5632, P_RG = 7680, P_GA = 9728, P_GB = 11776;
constexpr int RET_H = 8, RET_DK = 128, RET_DV = 256, RET_VW = 2048;
constexpr int NEXP = 32, EFF = 512, MAXT = 96, MAXSLOT = MAXT * 256;

constexpr size_t MiB = 1u << 20;
constexpr size_t WS_CTL = 0, CTL_ZERO_BYTES = 256 * 1024;
constexpr size_t WS_ROT = 1 * MiB;
constexpr size_t WS_TOKE = 2 * MiB;
constexpr size_t WS_TOKW = WS_TOKE + 65536;
constexpr size_t WS_TOKP = WS_TOKW + 65536;
constexpr size_t WS_TOKS = WS_TOKP + 65536;
constexpr size_t WS_BONUS = WS_TOKS + 65536;
constexpr size_t WS_WUPAB = 3 * MiB, WS_WOUT = 15 * MiB;
constexpr size_t WS_WGU = 23 * MiB, WS_WDN = 151 * MiB;
constexpr size_t WS_P = 215 * MiB;
constexpr size_t WS_RA = 431 * MiB;
constexpr size_t WS_WIN = WS_RA, WS_H1 = WS_RA + 54 * MiB;
constexpr size_t WS_OAB = WS_RA;
constexpr int OAB_LD = 3072;
constexpr size_t WS_RB = 517 * MiB;
constexpr size_t WS_RWE = WS_RB, WS_RWA = WS_RB + 16 * MiB, WS_RWB = WS_RB + 32 * MiB, WS_MERGED = WS_RB;
constexpr size_t WS_SCF = WS_RB + 32 * MiB;
constexpr size_t WS_END = 565 * MiB;
constexpr size_t WS_H2 = WS_P, WS_XG = WS_P + 32 * MiB, WS_LIST = WS_XG + 1 * MiB, WS_LRS = WS_XG + 2 * MiB, WS_YS = WS_XG + 3 * MiB, WS_ACT = WS_YS + 96 * MiB;
constexpr int LCAP = 8192;
constexpr size_t WS_SLOTTOK = WS_BONUS + 524288, WS_SLOTRS = WS_SLOTTOK + 98304;
static_assert(WS_SLOTRS + 98304 <= 3 * MiB, "slot tables fit below the converted weights");
constexpr int CW_BAR = 1024;
constexpr int CW_CNT = 8192;
constexpr int CW_NT = 8256;
constexpr int CW_TE = 8320;
constexpr int CW_PRE = 9024;
constexpr int CW_TV = 8768;
constexpr int CW_PS = 8448;
constexpr int CW_CONV3 = 8640, CW_CONVD = 8704;
constexpr int CW_TSTAMP = 8512;

constexpr int RING_BYTES = 131072, MISC_OFF = RING_BYTES + 320, LDS_BYTES = 147456;
constexpr int MT_OFF = RING_BYTES + 2048, MT_TE = 0, MT_TV = 96, MT_PS = 192, MT_CNT = 232, MT_NT = 264, MT_TORD = 272, MT_FULL = 368, MT_HV = 400;

struct Args { const float* in[27]; float* out; unsigned char* ws; int ph_lo, ph_hi; };

__device__ __forceinline__ float bf2f(unsigned short b) { return __uint_as_float(((unsigned)b) << 16); }
__device__ __forceinline__ float bflo(unsigned u) { return __uint_as_float(u << 16); }
__device__ __forceinline__ float bfhi(unsigned u) { return __uint_as_float(u & 0xffff0000u); }
__device__ __forceinline__ unsigned f2bf(float f) { unsigned u = __float_as_uint(f); return (u + 0x7fffu + ((u >> 16) & 1u)) >> 16; }

typedef __bf16 bf2_t __attribute__((ext_vector_type(2)));
typedef float f2_t __attribute__((ext_vector_type(2)));
__device__ __forceinline__ unsigned cvt2(float a, float b) { const f2_t v = {a, b}; const bf2_t r = __builtin_convertvector(v, bf2_t); return __builtin_bit_cast(unsigned, r); }
__device__ __forceinline__ unsigned pk2(float lo, float hi) { return cvt2(lo, hi); }
__device__ __forceinline__ float sigmoidf_(float x) { return __builtin_amdgcn_rcpf(1.0f + __expf(-x)); }
__device__ __forceinline__ float wave_sum(float v) {
#pragma unroll
    for (int o = 1; o < 64; o <<= 1) v += __shfl_xor(v, o);
    return v;
}

struct EpiP {
    static constexpr bool PERM = true, AFTER_DRAIN = false, MID = false;
    bf16* O;
    __device__ __forceinline__ void operator()(const pg8::f32x4 (&acc)[2][2][4][2], const pg8::Unit& u, int wr, int wc, int fr, int fq) const {
        const int row0 = u.pm * 256 + wr * 64 + fr, col0 = u.pn * 256 + wc * 32 + 8 * fq;
        const int mode = u.pn >= 38 ? 2 : (u.pn >= 30 ? 1 : 0);
#pragma unroll
        for (int ai = 0; ai < 2; ++ai)
#pragma unroll
            for (int m = 0; m < 4; ++m) { bf16* rowp = O + (size_t)(row0 + ai * 128 + m * 16) * NP + col0;
#pragma unroll
                for (int bj = 0; bj < 2; ++bj) { pg8::f32x4 v0 = acc[ai][bj][m][0], v1 = acc[ai][bj][m][1];
                    if (mode) {
#pragma unroll
                        for (int j = 0; j < 4; ++j) { const float s0 = sigmoidf_(v0[j]), s1 = sigmoidf_(v1[j]); v0[j] = mode == 2 ? s0 : v0[j] * s0; v1[j] = mode == 2 ? s1 : v1[j] * s1; } }
                    pg8::u32x4 w; w.x = pg8::cvt_pk_bf16(v0[0], v0[1]); w.y = pg8::cvt_pk_bf16(v0[2], v0[3]); w.z = pg8::cvt_pk_bf16(v1[0], v1[1]); w.w = pg8::cvt_pk_bf16(v1[2], v1[3]);
                    *(pg8::u32x4*)(rowp + bj * 128) = w; } }
    }
};
template <int MODE> struct EpiUp {
    static constexpr bool PERM = true, AFTER_DRAIN = false, MID = false;
    bf16* O; const bf16* P;
    __device__ __forceinline__ void operator()(const pg8::f32x4 (&acc)[2][2][4][2], const pg8::Unit& u, int wr, int wc, int fr, int fq) const {
        const int row0 = u.pm * 256 + wr * 64 + fr, col0 = u.pn * 256 + wc * 32 + 8 * fq;
#pragma unroll
        for (int ai = 0; ai < 2; ++ai)
#pragma unroll
            for (int m = 0; m < 4; ++m) { const int row = row0 + ai * 128 + m * 16; bf16* rowp = O + (size_t)row * DM + col0; const bf16* gp = P + (size_t)row * NP + (MODE ? P_GB : P_GA) + col0;
#pragma unroll
                for (int bj = 0; bj < 2; ++bj) { const pg8::f32x4 v0 = acc[ai][bj][m][0], v1 = acc[ai][bj][m][1];
                    const pg8::u32x4 g = *(const pg8::u32x4*)(gp + bj * 128);
                    float o[8] = { v0[0] * bflo(g.x), v0[1] * bfhi(g.x), v0[2] * bflo(g.y), v0[3] * bfhi(g.y), v1[0] * bflo(g.z), v1[1] * bfhi(g.z), v1[2] * bflo(g.w), v1[3] * bfhi(g.w) };
                    if (MODE) { const pg8::u32x4 p = *(const pg8::u32x4*)(rowp + bj * 128);
                        o[0] += bflo(p.x); o[1] += bfhi(p.x); o[2] += bflo(p.y); o[3] += bfhi(p.y); o[4] += bflo(p.z); o[5] += bfhi(p.z); o[6] += bflo(p.w); o[7] += bfhi(p.w); }
                    pg8::u32x4 w; w.x = pg8::cvt_pk_bf16(o[0], o[1]); w.y = pg8::cvt_pk_bf16(o[2], o[3]); w.z = pg8::cvt_pk_bf16(o[4], o[5]); w.w = pg8::cvt_pk_bf16(o[6], o[7]);
                    *(pg8::u32x4*)(rowp + bj * 128) = w; } }
    }
};
struct EpiUpF {
    static constexpr bool PERM = true, AFTER_DRAIN = false, MID = true;
    bf16* O; const bf16* P; int tmid;
    __device__ __forceinline__ void mid(pg8::f32x4 (&acc)[2][2][4][2], const pg8::Unit& u, int wr, int wc, int fr, int fq) const {
        unsigned off = (unsigned)(u.pm * 256 + wr * 64 + fr) * (unsigned)NP + (unsigned)(u.pn * 256 + wc * 32 + 8 * fq);
#pragma unroll
        for (int ai = 0; ai < 2; ++ai) {
#pragma unroll
            for (int m2 = 0; m2 < 2; ++m2) { pg8::u32x4 ga[2][2], gb[2][2];
#pragma unroll
                for (int mm = 0; mm < 2; ++mm) { const bf16* gp = P + off + (unsigned)mm * 16u * (unsigned)NP;
#pragma unroll
                    for (int bj = 0; bj < 2; ++bj) { ga[mm][bj] = *(const pg8::u32x4*)(gp + P_GA + bj * 128); gb[mm][bj] = *(const pg8::u32x4*)(gp + P_GB + bj * 128); } }
                __builtin_amdgcn_sched_barrier(0);
#pragma unroll
                for (int mm = 0; mm < 2; ++mm)
#pragma unroll
                    for (int bj = 0; bj < 2; ++bj) { const pg8::u32x4 a_ = ga[mm][bj], b_ = gb[mm][bj];
                        pg8::f32x4& v0 = acc[ai][bj][2 * m2 + mm][0]; pg8::f32x4& v1 = acc[ai][bj][2 * m2 + mm][1];
                        v0[0] *= bflo(a_.x) * __builtin_amdgcn_rcpf(bflo(b_.x)); v0[1] *= bfhi(a_.x) * __builtin_amdgcn_rcpf(bfhi(b_.x)); v0[2] *= bflo(a_.y) * __builtin_amdgcn_rcpf(bflo(b_.y)); v0[3] *= bfhi(a_.y) * __builtin_amdgcn_rcpf(bfhi(b_.y));
                        v1[0] *= bflo(a_.z) * __builtin_amdgcn_rcpf(bflo(b_.z)); v1[1] *= bfhi(a_.z) * __builtin_amdgcn_rcpf(bfhi(b_.z)); v1[2] *= bflo(a_.w) * __builtin_amdgcn_rcpf(bflo(b_.w)); v1[3] *= bfhi(a_.w) * __builtin_amdgcn_rcpf(bfhi(b_.w));
                        asm volatile("" : "+v"(v0), "+v"(v1) :: "memory"); }
                off += 32u * (unsigned)NP; asm volatile("" : "+v"(off)); }
            off += 64u * (unsigned)NP; asm volatile("" : "+v"(off)); }
    }
    __device__ __forceinline__ void operator()(const pg8::f32x4 (&acc)[2][2][4][2], const pg8::Unit& u, int wr, int wc, int fr, int fq) const {
        const int row0 = u.pm * 256 + wr * 64 + fr, col0 = u.pn * 256 + wc * 32 + 8 * fq;
#pragma unroll
        for (int ai = 0; ai < 2; ++ai)
#pragma unroll
            for (int m = 0; m < 4; ++m) { const int row = row0 + ai * 128 + m * 16; bf16* rowp = O + (size_t)row * DM + col0; const bf16* gp = P + (size_t)row * NP + P_GB + col0;
#pragma unroll
                for (int bj = 0; bj < 2; ++bj) { const pg8::f32x4 v0 = acc[ai][bj][m][0], v1 = acc[ai][bj][m][1];
                    const pg8::u32x4 g = *(const pg8::u32x4*)(gp + bj * 128);
                    pg8::u32x4 w; w.x = pg8::cvt_pk_bf16(v0[0] * bflo(g.x), v0[1] * bfhi(g.x)); w.y = pg8::cvt_pk_bf16(v0[2] * bflo(g.y), v0[3] * bfhi(g.y)); w.z = pg8::cvt_pk_bf16(v1[0] * bflo(g.z), v1[1] * bfhi(g.z)); w.w = pg8::cvt_pk_bf16(v1[2] * bflo(g.w), v1[3] * bfhi(g.w));
                    *(pg8::u32x4*)(rowp + bj * 128) = w; } }
    }
};
struct EpiX1 {
    static constexpr bool PERM = false, AFTER_DRAIN = false, MID = false;
    const float* X; float* O;
    __device__ __forceinline__ void operator()(const pg8::f32x4 (&acc)[2][2][4][2], const pg8::Unit& u, int wr, int wc, int fr, int fq) const {
        const int row0 = u.pm * 256 + wr * 64 + fr, col0 = u.pn * 256 + wc * 32 + 4 * fq;
#pragma unroll
        for (int ai = 0; ai < 2; ++ai)
#pragma unroll
            for (int m = 0; m < 4; ++m) { const size_t off = (size_t)(row0 + ai * 128 + m * 16) * DM + col0;
#pragma unroll
                for (int bj = 0; bj < 2; ++bj)
#pragma unroll
                    for (int n = 0; n < 2; ++n) { const pg8::f32x4 xv = __builtin_nontemporal_load((const pg8::f32x4*)(X + off + bj * 128 + n * 16)); *(pg8::f32x4*)(O + off + bj * 128 + n * 16) = xv + acc[ai][bj][m][n]; } }
    }
};
__device__ __forceinline__ int moe_row_token(const LAS unsigned* tab, const int* list, int pm, int r) {
    const int e = (int)tab[MT_TE + pm], pos = (pm - (int)(tab[MT_PS + e] >> 8)) * 256 + r;
    return pos < (int)tab[MT_CNT + e] ? list[e * LCAP + pos] : NTOK;
}
struct EpiGU {
    static constexpr bool PERM = true, AFTER_DRAIN = false, MID = false;
    bf16* O; const float* LRS; const LAS unsigned* tab;
    __device__ __forceinline__ void operator()(const pg8::f32x4 (&acc)[2][2][4][2], const pg8::Unit& u, int wr, int wc, int fr, int fq) const {
        const int row0 = u.pm * 256 + wr * 64 + fr, col0 = (u.pn & 3) * 128 + wc * 32 + 8 * fq;
        float rsr[2][4];
#pragma unroll
        for (int ai = 0; ai < 2; ++ai)
#pragma unroll
            for (int m = 0; m < 4; ++m) { const int e = (int)tab[MT_TE + u.pm], pos = (u.pm - (int)(tab[MT_PS + e] >> 8)) * 256 + wr * 64 + fr + ai * 128 + m * 16; rsr[ai][m] = pos < (int)tab[MT_CNT + e] ? LRS[e * LCAP + pos] : 0.f; }
#pragma unroll
        for (int ai = 0; ai < 2; ++ai)
#pragma unroll
            for (int m = 0; m < 4; ++m) { bf16* rowp = O + (size_t)(row0 + ai * 128 + m * 16) * EFF + col0; const float rs_ = rsr[ai][m];
                const pg8::f32x4 g0 = acc[ai][0][m][0] * rs_, g1 = acc[ai][0][m][1] * rs_, u0 = acc[ai][1][m][0] * rs_, u1 = acc[ai][1][m][1] * rs_;
                float o[8];
#pragma unroll
                for (int j = 0; j < 4; ++j) { o[j] = g0[j] * sigmoidf_(g0[j]) * u0[j]; o[4 + j] = g1[j] * sigmoidf_(g1[j]) * u1[j]; }
                pg8::u32x4 w; w.x = pg8::cvt_pk_bf16(o[0], o[1]); w.y = pg8::cvt_pk_bf16(o[2], o[3]); w.z = pg8::cvt_pk_bf16(o[4], o[5]); w.w = pg8::cvt_pk_bf16(o[6], o[7]);
                *(pg8::u32x4*)rowp = w; }
    }
};
struct EpiDn {
    static constexpr bool PERM = true, AFTER_DRAIN = false, MID = false;
    bf16* O;
    __device__ __forceinline__ void operator()(const pg8::f32x4 (&acc)[2][2][4][2], const pg8::Unit& u, int wr, int wc, int fr, int fq) const {
        const int row0 = u.pm * 256 + wr * 64 + fr, col0 = (u.pn & 7) * 256 + wc * 32 + 8 * fq;
#pragma unroll
        for (int ai = 0; ai < 2; ++ai)
#pragma unroll
            for (int m = 0; m < 4; ++m) { bf16* rowp = O + (size_t)(row0 + ai * 128 + m * 16) * DM + col0;
#pragma unroll
                for (int bj = 0; bj < 2; ++bj) { const pg8::f32x4 v0 = acc[ai][bj][m][0], v1 = acc[ai][bj][m][1];
                    pg8::u32x4 w; w.x = pg8::cvt_pk_bf16(v0[0], v0[1]); w.y = pg8::cvt_pk_bf16(v0[2], v0[3]); w.z = pg8::cvt_pk_bf16(v1[0], v1[1]); w.w = pg8::cvt_pk_bf16(v1[2], v1[3]);
                    *(pg8::u32x4*)(rowp + bj * 128) = w; } }
    }
};
struct RevColOrder : pg8::StaticOrder {
    __device__ __forceinline__ bool next(int i, pg8::Unit& u) const { if (!pg8::StaticOrder::next(i, u)) return false; u.pn = nN - 1 - u.pn; return true; }
};
template <int NB> struct MoeOrder {
    const LAS unsigned* tab; const int* list; int first, last, stride, c;
    __device__ __forceinline__ void init(const LAS unsigned* tab_, const int* list_, int first_, int last_, int stride_, int c_) { tab = tab_; list = list_; first = first_; last = last_; stride = stride_; c = c_; }
    __device__ __forceinline__ bool next(int i, pg8::Unit& u) const {
        if (c < 0 || stride <= 0) return false;
        const int L = first + c + i * stride; if (L >= last) return false;
        u.pm = (int)tab[MT_TORD + L / NB]; u.pn = (int)tab[MT_TE + u.pm] * NB + (L % NB); u.hv = tab[MT_TV + u.pm] <= 128u ? 1 : 0; return true;
    }
    __device__ __forceinline__ int arow(const pg8::Unit& u, int r) const { return moe_row_token(tab, list, u.pm, r); }
    __device__ __forceinline__ void a_ready(const pg8::Unit&) const {}
    __device__ __forceinline__ void done(const pg8::Unit&) const {}
};
#define XB_TMO      128
#define XB_XCNT(j)  (256  + 64 * (j))
#define XB_XSUB(j)  (1280 + 64 * (j))
#define XB_XGEN(j)  (2304 + 64 * (j))
#define XB_TOP      3328
#define XB_TOPGEN   3392
#define XCD_BAR_WORDS 3456
#define XB_SPIN_CAP (1u << 18)

__device__ __forceinline__ unsigned xb_ld(unsigned* p)              { return __hip_atomic_load(p, __ATOMIC_RELAXED, __HIP_MEMORY_SCOPE_AGENT); }
__device__ __forceinline__ unsigned xb_add(unsigned* p, unsigned v) { return __hip_atomic_fetch_add(p, v, __ATOMIC_RELAXED, __HIP_MEMORY_SCOPE_AGENT); }
__device__ __forceinline__ unsigned xb_xcc_id() { return (unsigned)__builtin_amdgcn_s_getreg((3 << 11) | 20) & 0xFu; }
#define XB_SPIN(cond, bar) do { unsigned _sp = 0; while (cond) { __builtin_amdgcn_s_sleep(1); \
    if ((++_sp & 255u) == 0u) { if (xb_ld(&(bar)[XB_TMO])) break; if (_sp > XB_SPIN_CAP) { atomicAdd(&(bar)[XB_TMO], 1u); break; } } } } while (0)

struct XcdBarrier {
    unsigned* bar; unsigned x;
    volatile LAS unsigned* st;
};

__device__ __forceinline__ XcdBarrier xcd_barrier_post(unsigned* bar, volatile LAS unsigned* st) {
    XcdBarrier b; b.bar = bar; b.x = xb_xcc_id(); b.st = st;
    if (threadIdx.x == 0) (void)xb_add(&bar[XB_XCNT(b.x)], 1u);
    return b;
}
__device__ __forceinline__ void xcd_barrier_complete(unsigned* bar, unsigned x, unsigned& nloc, unsigned& nx) {
    const unsigned G = gridDim.x * gridDim.y * gridDim.z;
    unsigned sum, cnt, mine, sp = 0u;
    for (;;) {
        sum = 0u; cnt = 0u; mine = 0u;
#pragma unroll
        for (unsigned j = 0; j < 16; ++j) { const unsigned c = xb_ld(&bar[XB_XCNT(j)]); sum += c; cnt += (c > 0u) ? 1u : 0u; mine = (j == x) ? c : mine; }
        if (sum == G) break;
        __builtin_amdgcn_s_sleep(1);
        if ((++sp & 255u) == 0u) { if (xb_ld(&bar[XB_TMO])) break; if (sp > XB_SPIN_CAP) { atomicAdd(&bar[XB_TMO], 1u); break; } }
    }
    nloc = mine > 0u ? mine : 1u; nx = cnt > 0u ? cnt : 1u;
}

__device__ __forceinline__ void xcd_barrier(const XcdBarrier& b) {
    asm volatile("s_waitcnt vmcnt(0)" ::: "memory");
    __syncthreads();
    if (threadIdx.x == 0) {
        unsigned* bar = b.bar;
        __builtin_amdgcn_s_waitcnt(0);
        unsigned nloc = b.st[0], nx = b.st[1];
        if (nloc == 0u) { xcd_barrier_complete(bar, b.x, nloc, nx); b.st[0] = nloc; b.st[1] = nx; }
        const unsigned old = xb_add(&bar[XB_XSUB(b.x)], 1u);
        const unsigned gen = old / nloc;
        if (old + 1u == (gen + 1u) * nloc) {
            __builtin_amdgcn_fence(__ATOMIC_RELEASE, "agent");
            asm volatile("s_waitcnt vmcnt(0)" ::: "memory");
            const unsigned og = xb_add(&bar[XB_TOP], 1u);
            const unsigned tg = og / nx;
            if (og + 1u == (tg + 1u) * nx) xb_add(&bar[XB_TOPGEN], 1u);
            else XB_SPIN(xb_ld(&bar[XB_TOPGEN]) == tg, bar);
            __builtin_amdgcn_fence(__ATOMIC_ACQUIRE, "agent");
            xb_add(&bar[XB_XGEN(b.x)], 1u);
            asm volatile("s_waitcnt vmcnt(0)" ::: "memory");
        } else {
            XB_SPIN(xb_ld(&bar[XB_XGEN(b.x)]) == gen, bar);
            __builtin_amdgcn_fence(__ATOMIC_ACQUIRE, "agent");
            asm volatile("s_waitcnt vmcnt(0)" ::: "memory");
        }
    }
    __syncthreads();
}

__device__ __forceinline__ void tr_load(float (&tmp)[32], const float* W, int ldw, int k0, int n0, int lane) {
#pragma unroll
    for (int i = 0; i < 32; ++i) tmp[i] = __builtin_nontemporal_load(W + (size_t)(k0 + 2 * i + (lane >> 5)) * ldw + n0 + (lane & 31));
}
__device__ __forceinline__ void tr_finish(const float (&tmp)[32], int k0, bf16* WT, int K, size_t drow0, LAS float* scr, int lane) {
#pragma unroll
    for (int i = 0; i < 32; ++i) scr[(2 * i + (lane >> 5)) * 33 + (lane & 31)] = tmp[i];
    LDS_WAIT(); asm volatile("" ::: "memory");
    const int c = lane & 7;
#pragma unroll
    for (int j = 0; j < 4; ++j) { const int n = (lane >> 3) + 8 * j; const LAS float* s = scr + (8 * c) * 33 + n;
        v4u o; o.x = pk2(s[0 * 33], s[1 * 33]); o.y = pk2(s[2 * 33], s[3 * 33]); o.z = pk2(s[4 * 33], s[5 * 33]); o.w = pk2(s[6 * 33], s[7 * 33]);
        *(v4u*)(WT + (drow0 + n) * (size_t)K + k0 + 8 * c) = o; }
    LDS_WAIT(); asm volatile("" ::: "memory");
}
__device__ __forceinline__ void tr_item(const float* W, int ldw, int k0, int n0, bf16* WT, int K, size_t drow0, LAS float* scr, int lane) {
    float tmp[32]; tr_load(tmp, W, ldw, k0, n0, lane); tr_finish(tmp, k0, WT, K, drow0, scr, lane);
}
struct GuItem { const float* W; int k0, n0; size_t drow0; };
__device__ __forceinline__ GuItem gu_item(const Args& a, int r) {
    constexpr int I_EG = 32 * 32 * 16; const int half = r / I_EG, q = r % I_EG, e = q / 512, kb = (q % 512) / 16, nb = q % 16, n0 = nb * 32;
    GuItem it; it.W = (half ? a.in[24] : a.in[23]) + (size_t)e * 2048 * 512; it.k0 = kb * 64; it.n0 = n0; it.drow0 = (size_t)e * 1024 + (n0 >> 7) * 256 + half * 128 + (n0 & 127); return it;
}
__device__ __forceinline__ void phase_prologue(const Args& a, LAS unsigned char* lds, int tid, int lane, int wave, int bid, int G) {
    unsigned char* ws = a.ws;
    LAS float* scr = (LAS float*)(lds + wave * 16384);
    const int gw = bid * NWAVES + wave, NGW = G * NWAVES;
    constexpr int I_IN = 32 * 430, I_UA = 16 * 64, I_UB = 32 * 64, I_WO = 32 * 64, I_EG = 32 * 32 * 16, I_ED = 32 * 8 * 64;
    constexpr int NITEMS = I_IN; (void)I_UA; (void)I_UB; (void)I_WO;
    for (int it = gw; it < NITEMS; it += NGW) {
        int r = it;
        if (r < I_IN) { const int kb = r / 430, nb = r % 430, n0 = nb * 32; tr_item(a.in[2], 13760, kb * 64, n0, (bf16*)(ws + WS_WIN), 2048, (size_t)(n0 + (n0 >= 3520 ? 64 : 0)), scr, lane); continue; } r -= I_IN;
        (void)I_EG; (void)I_ED; break;
    }
    { v4u* z = (v4u*)(ws + WS_WIN + (size_t)3520 * 2048 * 2); const int n16 = 64 * 2048 * 2 / 16;
      for (int i = bid * NTHR + tid; i < n16; i += G * NTHR) z[i] = (v4u){0u, 0u, 0u, 0u}; }
    { bf16* W2T = (bf16*)(ws + WS_RB + 16 * MiB); bf16* A2T = W2T + 1024 * 96; bf16* G2T = A2T + 1024 * 96;
      for (int i = bid * NTHR + tid; i < 1024 * 96; i += G * NTHR) { const int ch = i / 96, j = i % 96; W2T[i] = (bf16)f2bf(a.in[5][j * 1024 + ch]); A2T[i] = (bf16)f2bf(a.in[7][j * 1024 + ch]); }
      for (int i = bid * NTHR + tid; i < 1024 * 256; i += G * NTHR) { const int ch = i >> 8, j = i & 255; G2T[i] = (bf16)f2bf(a.in[8][j * 1024 + ch]); } }
    { float* WTG = (float*)(ws + 262144); const float* g2n = a.in[18];
      for (int i = bid * NTHR + tid; i < 48 * DM; i += G * NTHR) { const int o = i >> 11, d = i & (DM - 1);
          float w = 0.f; if (o < 4) w = a.in[19][d * 4 + o]; else if (o < 36) w = a.in[21][d * 32 + (o - 4)];
          WTG[i] = w * g2n[d]; } }
    { float2* rot = (float2*)(ws + WS_ROT);
      for (int i = bid * NTHR + tid; i < SEQ * 64; i += G * NTHR) { const int pos = i >> 6, d = i & 63;
          const float inv = exp2f(-(float)d * (13.287712379549449f / 64.0f)); const float ang = (float)pos * inv;
          double rev = (double)ang * 0.15915494309189535; rev -= __builtin_rint(rev); const float rf = (float)rev;
          rot[i] = make_float2(__builtin_amdgcn_cosf(rf), __builtin_amdgcn_sinf(rf)); } }
    { const float* g1 = a.in[1]; bf16* H1 = (bf16*)(ws + WS_H1);
      for (int m = gw; m < NTOK; m += NGW) { const f32x4* xr = (const f32x4*)(a.in[0] + (size_t)m * DM) + lane; f32x4 v[8]; float s = 0.f;
#pragma unroll
          for (int j = 0; j < 8; ++j) { v[j] = __builtin_nontemporal_load(xr + 64 * j); s += (v[j].x * v[j].x + v[j].y * v[j].y) + (v[j].z * v[j].z + v[j].w * v[j].w); }
          const float rs = rsqrtf(wave_sum(s) * (1.0f / DM) + 1e-6f);
          v2u* o8 = (v2u*)(H1 + (size_t)m * DM) + lane;
#pragma unroll
          for (int j = 0; j < 8; ++j) { const f32x4 g = ((const f32x4*)g1)[64 * j + lane]; v2u o; o.x = pk2(v[j].x * rs * g.x, v[j].y * rs * g.y); o.y = pk2(v[j].z * rs * g.z, v[j].w * rs * g.w); o8[64 * j] = o; } } }
}

#ifndef DN_TAIL
#define DN_TAIL 0
#endif
__device__ __forceinline__ void phase_conv_w3(const Args& a, LAS unsigned char* lds, int lane, int wave, int rank, int nconv) {
    unsigned char* ws = a.ws; LAS float* scr = (LAS float*)(lds + wave * 16384);
    for (int r = rank * NWAVES + wave; r < 5120; r += nconv * NWAVES) {
        if (r < 1024) { const int kb = r / 64, nb = r % 64; tr_item(a.in[15], 2048, kb * 64, nb * 32, (bf16*)(ws + WS_WUPAB), 3072, (size_t)(nb * 32), scr, lane); }
        else if (r < 3072) { const int q = r - 1024, kb = q / 64, nb = q % 64; tr_item(a.in[16], 2048, kb * 64, nb * 32, (bf16*)(ws + WS_WUPAB) + 1024, 3072, (size_t)(nb * 32), scr, lane); }
        else { const int q = r - 3072, kb = q / 64, nb = q % 64; tr_item(a.in[17], 2048, kb * 64, nb * 32, (bf16*)(ws + WS_WOUT), 2048, (size_t)(nb * 32), scr, lane); } }
    for (int r = rank * NWAVES + wave; r < DN_TAIL; r += nconv * NWAVES) { const int e = r / 512, kb = (r % 512) / 64, nb = r % 64; const float* W = a.in[25] + (size_t)e * 512 * 2048;
        tr_item(W, 2048, kb * 64, nb * 32, (bf16*)(ws + WS_WDN), 512, (size_t)e * 2048 + nb * 32, scr, lane); }
}

__device__ __forceinline__ void phase_expconv_gu(const Args& a, LAS unsigned char* lds, int lane, int wave, int bid, int G) {
    unsigned char* ws = a.ws; LAS float* scr = (LAS float*)(lds + wave * 16384);
    const int gw = bid * NWAVES + wave, NGW = G * NWAVES; constexpr int I_EG = 32 * 32 * 16;
    for (int r = gw; r < 2 * I_EG; r += NGW) { const int half = r / I_EG; const int q = r % I_EG; const int e = q / 512, kb = (q % 512) / 16, nb = q % 16, n0 = nb * 32;
        const float* W = a.in[23 + half] + (size_t)e * 2048 * 512;
        tr_item(W, 512, kb * 64, n0, (bf16*)(ws + WS_WGU), 2048, (size_t)e * 1024 + (n0 >> 7) * 256 + half * 128 + (n0 & 127), scr, lane); }
}
__device__ __forceinline__ void phase_expconv_dn(const Args& a, LAS unsigned char* lds, int lane, int wave, int bid, int G) {
    unsigned char* ws = a.ws; LAS float* scr = (LAS float*)(lds + wave * 16384); LAS unsigned* ctr = (LAS unsigned*)(lds + LDS_BYTES - 64);
    constexpr int I_ED = 32 * 8 * 64;
    for (;;) { unsigned i = 0; if (lane == 0) i = __hip_atomic_fetch_add(ctr, 1u, __ATOMIC_RELAXED, __HIP_MEMORY_SCOPE_WORKGROUP);
        const int r = DN_TAIL + (int)__builtin_amdgcn_readfirstlane(i) * G + bid; if (r >= I_ED) break;
        const int e = r / 512, kb = (r % 512) / 64, nb = r % 64; const float* W = a.in[25] + (size_t)e * 512 * 2048;
        tr_item(W, 2048, kb * 64, nb * 32, (bf16*)(ws + WS_WDN), 512, (size_t)e * 2048 + nb * 32, scr, lane); }
}

__device__ __forceinline__ void phase_retpost(const Args& a, LAS unsigned char* lds, int lane, int wave, int bid, int G, int& ci) {
    unsigned char* ws = a.ws; const bf16* P = (const bf16*)(ws + WS_P);
    const int gw = bid * NWAVES + wave, NGW = G * NWAVES;
    bf16* OB = (bf16*)(ws + WS_OAB) + 1024; const float* ng = a.in[14];
    LAS float* cscr = (LAS float*)(lds + 36864 + wave * 8704); bf16* WGUc = (bf16*)(ws + WS_WGU);
    constexpr int NB = 8;
    for (int it0 = gw; it0 < NTOK * RET_H; it0 += NB * NGW) { v2u raw[NB], gr[NB];
        float tmpc[32], tmpd[32]; GuItem itc = gu_item(a, 0), itd = gu_item(a, 0); const bool hasc = (gw + NGW * ci) < 32768, hasd = (gw + NGW * (ci + 1)) < 32768;
        if (hasc) { itc = gu_item(a, gw + NGW * ci); tr_load(tmpc, itc.W, 512, itc.k0, itc.n0, lane); }
        if (hasd) { itd = gu_item(a, gw + NGW * (ci + 1)); tr_load(tmpd, itd.W, 512, itd.k0, itd.n0, lane); } ci += 2;
#pragma unroll
        for (int k = 0; k < NB; ++k) { const int it = it0 + k * NGW; if (it < NTOK * RET_H) { const int t = it >> 3, h = it & 7;
            raw[k] = __builtin_nontemporal_load((const v2u*)(OB + (size_t)t * OAB_LD + h * 256 + lane * 4)); gr[k] = __builtin_nontemporal_load((const v2u*)(P + (size_t)t * NP + P_RG + h * 256 + lane * 4)); } else { raw[k] = (v2u){0u, 0u}; gr[k] = (v2u){0u, 0u}; } }
#pragma unroll
        for (int k = 0; k < NB; ++k) { const int it = it0 + k * NGW; if (it < NTOK * RET_H) { const int t = it >> 3, h = it & 7;
            const float v0 = bflo(raw[k].x), v1 = bfhi(raw[k].x), v2 = bflo(raw[k].y), v3 = bfhi(raw[k].y);
            const float rs = rsqrtf(wave_sum((v0 * v0 + v1 * v1) + (v2 * v2 + v3 * v3)) * (1.0f / 256.0f) + 1e-6f);
            const f32x4 g = *(const f32x4*)(ng + h * 256 + lane * 4);
            v2u w; w.x = cvt2(v0 * rs * g.x * bflo(gr[k].x), v1 * rs * g.y * bfhi(gr[k].x)); w.y = cvt2(v2 * rs * g.z * bflo(gr[k].y), v3 * rs * g.w * bfhi(gr[k].y));
            *(v2u*)(OB + (size_t)t * OAB_LD + h * 256 + lane * 4) = w; } }
        if (hasc) tr_finish(tmpc, itc.k0, WGUc, 2048, itc.drow0, cscr, lane);
        if (hasd) tr_finish(tmpd, itd.k0, WGUc, 2048, itd.drow0, cscr, lane); }
    for (; gw + NGW * ci < 32768; ++ci) { const GuItem itc = gu_item(a, gw + NGW * ci); tr_item(itc.W, 512, itc.k0, itc.n0, WGUc, 2048, itc.drow0, cscr, lane); }
}

__device__ __forceinline__ void phase_router(const Args& a, int lane, int wave, int bid, int G) {
    unsigned char* ws = a.ws; const float* X1 = a.out; bf16* H2 = (bf16*)(ws + WS_H2);
    const float* g2 = a.in[18]; const float* wg = a.in[19]; const float* bg = a.in[20]; const float* we = a.in[21]; const float* be = a.in[22];
    unsigned* ctl = (unsigned*)(ws + WS_CTL); int* TE = (int*)(ws + WS_TOKE); float* TW = (float*)(ws + WS_TOKW); int* TP = (int*)(ws + WS_TOKP);
    const int gw = bid * NWAVES + wave, NGW = G * NWAVES;
    for (int t = gw; t < NTOK; t += NGW) {
        const f32x4* xr = (const f32x4*)(X1 + (size_t)t * DM) + lane; float s = 0.f;
#pragma unroll
        for (int j = 0; j < 8; ++j) { const f32x4 x = xr[64 * j]; s += (x.x * x.x + x.y * x.y) + (x.z * x.z + x.w * x.w); }
        const float rs = rsqrtf(wave_sum(s) * (1.0f / DM) + 1e-6f);
        float lgt[36];
#pragma unroll
        for (int q = 0; q < 36; ++q) lgt[q] = 0.f;
        v2u* o8 = (v2u*)(H2 + (size_t)t * DM) + lane;
#pragma unroll 1
        for (int j = 0; j < 8; ++j) { const f32x4 x = xr[64 * j]; const f32x4 g = ((const f32x4*)g2)[64 * j + lane]; const f32x4 hv = {x.x * rs * g.x, x.y * rs * g.y, x.z * rs * g.z, x.w * rs * g.w};
            v2u o; o.x = pk2(hv.x, hv.y); o.y = pk2(hv.z, hv.w); o8[64 * j] = o;
            const int col = 256 * j + 4 * lane;
#pragma unroll
            for (int c = 0; c < 4; ++c) { const float hc = hv[c]; const f32x4 w4 = *(const f32x4*)(wg + (size_t)(col + c) * 4);
                lgt[0] += hc * w4.x; lgt[1] += hc * w4.y; lgt[2] += hc * w4.z; lgt[3] += hc * w4.w;
#pragma unroll
                for (int q = 0; q < 8; ++q) { const f32x4 e4 = *(const f32x4*)(we + (size_t)(col + c) * 32 + 4 * q);
                    lgt[4 + 4 * q] += hc * e4.x; lgt[5 + 4 * q] += hc * e4.y; lgt[6 + 4 * q] += hc * e4.z; lgt[7 + 4 * q] += hc * e4.w; } }
            asm volatile("" ::: "memory"); }
#pragma unroll
        for (int q = 0; q < 36; ++q) lgt[q] = wave_sum(lgt[q]);
        float gl[4];
#pragma unroll
        for (int q = 0; q < 4; ++q) gl[q] = lgt[q] + bg[q];
        int gs = 0; float gm = gl[0];
#pragma unroll
        for (int q = 1; q < 4; ++q) if (gl[q] > gm) { gm = gl[q]; gs = q; }
        float den = 0.f;
#pragma unroll
        for (int q = 0; q < 4; ++q) den += expf(gl[q] - gm);
        const float gwt = 1.0f / den;
        float el[8];
#pragma unroll
        for (int q = 0; q < 8; ++q) { float x = 0.f;
#pragma unroll
            for (int gq = 0; gq < 4; ++gq) x = (gs == gq) ? lgt[4 + gq * 8 + q] + be[gq * 8 + q] : x;
            el[q] = x; }
        int i0 = 0; float m0 = el[0];
#pragma unroll
        for (int q = 1; q < 8; ++q) if (el[q] > m0) { m0 = el[q]; i0 = q; }
        int i1 = -1; float m1 = -3.0e38f;
#pragma unroll
        for (int q = 0; q < 8; ++q) if (q != i0 && el[q] > m1) { m1 = el[q]; i1 = q; }
        const float e1 = expf(m1 - m0); const float w0 = gwt / (1.0f + e1), w1 = gwt * e1 / (1.0f + e1);
        if (lane == 0) { const int ex0 = gs * 8 + i0, ex1 = gs * 8 + i1;
            const unsigned p0 = __hip_atomic_fetch_add(ctl + CW_CNT + ex0, 1u, RLX_AGENT), p1 = __hip_atomic_fetch_add(ctl + CW_CNT + ex1, 1u, RLX_AGENT);
            TE[2 * t] = ex0; TE[2 * t + 1] = ex1; TW[2 * t] = w0; TW[2 * t + 1] = w1; TP[2 * t] = (int)p0; TP[2 * t + 1] = (int)p1; }
    }
}

__device__ __forceinline__ void phase_gather(const Args& a, LAS unsigned char* lds, int tid, int lane, int wave, int bid, int G) {
    unsigned char* ws = a.ws; unsigned* ctl = (unsigned*)(ws + WS_CTL); const bf16* H2 = (const bf16*)(ws + WS_H2); bf16* XG = (bf16*)(ws + WS_XG);
    const int* TE = (const int*)(ws + WS_TOKE); const int* TP = (const int*)(ws + WS_TOKP); int* TS = (int*)(ws + WS_TOKS);
    LAS int* ps = (LAS int*)lds;
    __syncthreads();
    if (tid == 0) { int acc = 0, nt = 0;
        for (int e = 0; e < NEXP; ++e) { const int c = (int)__hip_atomic_load(ctl + CW_CNT + e, RLX_AGENT); ps[e] = acc; ps[64 + e] = c; const int tl = (c + 255) >> 8;
            if (bid == 0) for (int q = 0; q < tl; ++q) ctl[CW_TE + nt + q] = (unsigned)e;
            nt += tl; acc += tl * 256; }
        ps[32] = acc; if (bid == 0) ctl[CW_NT] = (unsigned)nt; }
    __syncthreads();
    const int gw = bid * NWAVES + wave, NGW = G * NWAVES;
    for (int it = gw; it < NTOK * 2; it += NGW) { const int t = it >> 1; const int e = TE[it]; const int slot = ps[e] + TP[it];
        const v4u* src = (const v4u*)(H2 + (size_t)t * DM) + lane; v4u* dst = (v4u*)(XG + (size_t)slot * DM) + lane;
#pragma unroll
        for (int j = 0; j < 4; ++j) dst[64 * j] = src[64 * j];
        if (lane == 0) TS[it] = slot; }
    for (int e = 0; e < NEXP; ++e) { const int c = ps[64 + e], base = ps[e] + c, npad = ps[e + 1] - base;
        for (int r = gw; r < npad; r += NGW) { v4u* dst = (v4u*)(XG + (size_t)(base + r) * DM) + lane;
#pragma unroll
            for (int j = 0; j < 4; ++j) dst[64 * j] = (v4u){0u, 0u, 0u, 0u}; } }
}

__device__ __forceinline__ void phase_final(const Args& a, LAS unsigned char* lds, int lane, int wave, int bid, int G) {
    unsigned char* ws = a.ws; float* X1 = a.out; const bf16* YS = (const bf16*)(ws + WS_YS); const int* TE = (const int*)(ws + WS_TOKE); const int* TP = (const int*)(ws + WS_TOKP); const LAS unsigned* tab = (const LAS unsigned*)(lds + MT_OFF); const float* TW = (const float*)(ws + WS_TOKW); const float* fg = a.in[26];
    const int gw = bid * NWAVES + wave, NGW = G * NWAVES;
    for (int tb = gw; tb < NTOK; tb += 4 * NGW) {
        int sl0[4], sl1[4]; float w0[4], w1[4];
#pragma unroll
        for (int i = 0; i < 4; ++i) { const int t = (tb + i * NGW < NTOK) ? tb + i * NGW : tb; sl0[i] = (int)tab[MT_PS + TE[2 * t]] + TP[2 * t]; sl1[i] = (int)tab[MT_PS + TE[2 * t + 1]] + TP[2 * t + 1]; w0[i] = TW[2 * t]; w1[i] = TW[2 * t + 1]; }
        f32x4 xa[8], xb[8]; v2u ya0[8], ya1[8], yb0[8], yb1[8];
#define FIN_LOAD(i_, xv_, y0_, y1_) do { const int t_ = (tb + (i_) * NGW < NTOK) ? tb + (i_) * NGW : tb; const f32x4* xr_ = (const f32x4*)(X1 + (size_t)t_ * DM) + lane; \
            const v2u* p0_ = (const v2u*)(YS + (size_t)sl0[i_] * DM) + lane; const v2u* p1_ = (const v2u*)(YS + (size_t)sl1[i_] * DM) + lane; \
            _Pragma("unroll") for (int j = 0; j < 8; ++j) { xv_[j] = __builtin_nontemporal_load(xr_ + 64 * j); y0_[j] = __builtin_nontemporal_load(p0_ + 64 * j); y1_[j] = __builtin_nontemporal_load(p1_ + 64 * j); } } while (0)
#define FIN_DO(i_, xv_, y0_, y1_) do { const int t_ = tb + (i_) * NGW; float s_ = 0.f; f32x4 v_[8]; \
            _Pragma("unroll") for (int j = 0; j < 8; ++j) { const f32x4 x = xv_[j]; const v2u a0 = y0_[j], a1 = y1_[j]; \
                v_[j].x = x.x + w0[i_] * bflo(a0.x) + w1[i_] * bflo(a1.x); v_[j].y = x.y + w0[i_] * bfhi(a0.x) + w1[i_] * bfhi(a1.x); v_[j].z = x.z + w0[i_] * bflo(a0.y) + w1[i_] * bflo(a1.y); v_[j].w = x.w + w0[i_] * bfhi(a0.y) + w1[i_] * bfhi(a1.y); \
                s_ += (v_[j].x * v_[j].x + v_[j].y * v_[j].y) + (v_[j].z * v_[j].z + v_[j].w * v_[j].w); } \
            __builtin_amdgcn_sched_barrier(0); \
            if ((i_) + 2 < 4) FIN_LOAD((i_) + 2 < 4 ? (i_) + 2 : 0, xv_, y0_, y1_); \
            __builtin_amdgcn_sched_barrier(0); \
            if (t_ < NTOK) { const float rs_ = rsqrtf(wave_sum(s_) * (1.0f / DM) + 1e-6f); f32x4* xo_ = (f32x4*)(X1 + (size_t)t_ * DM) + lane; \
                _Pragma("unroll") for (int j = 0; j < 8; ++j) { const f32x4 g = ((const f32x4*)fg)[64 * j + lane]; __builtin_nontemporal_store((f32x4){v_[j].x * rs_ * g.x, v_[j].y * rs_ * g.y, v_[j].z * rs_ * g.z, v_[j].w * rs_ * g.w}, xo_ + 64 * j); } } } while (0)
        FIN_LOAD(0, xa, ya0, ya1); FIN_LOAD(1, xb, yb0, yb1);
        FIN_DO(0, xa, ya0, ya1); FIN_DO(1, xb, yb0, yb1); FIN_DO(2, xa, ya0, ya1); FIN_DO(3, xb, yb0, yb1);
#undef FIN_LOAD
#undef FIN_DO
    }
}

#define LDS_BARRIER() do { asm volatile("s_waitcnt lgkmcnt(0)" ::: "memory"); __builtin_amdgcn_s_barrier(); asm volatile("" ::: "memory"); } while (0)
typedef short bf16x8 __attribute__((ext_vector_type(8)));
__device__ __forceinline__ f32x4 mfma16(bf16x8 xa, bf16x8 yb, f32x4 c) { return __builtin_amdgcn_mfma_f32_16x16x32_bf16(xa, yb, c, 0, 0, 0); }
__device__ __forceinline__ bf16x8 ldfrag(const LAS bf16* img, int ld, int row0, int k0, int lane) { return *(const LAS bf16x8*)(img + (row0 + (lane & 15)) * ld + k0 + (lane >> 4) * 8); }
typedef short s16x4 __attribute__((ext_vector_type(4)));
__device__ __forceinline__ bf16x8 ldfrag_tr(const LAS bf16* img, int ld, int k0, int c0, int lane) {
    const int q = lane >> 4, i = lane & 15;
    LAS bf16* p = (LAS bf16*)img + (k0 + 8 * q + (i >> 2)) * ld + c0 + 4 * (i & 3);
    const s16x4 lo = __builtin_amdgcn_ds_read_tr16_b64_v4i16((LAS s16x4*)p);
    const s16x4 hi = __builtin_amdgcn_ds_read_tr16_b64_v4i16((LAS s16x4*)(p + 4 * ld));
    return __builtin_shufflevector(lo, hi, 0, 1, 2, 3, 4, 5, 6, 7);
}
__device__ __forceinline__ void unpack8(const v4u& p, float (&f)[8]) { f[0] = bflo(p.x); f[1] = bfhi(p.x); f[2] = bflo(p.y); f[3] = bfhi(p.y); f[4] = bflo(p.z); f[5] = bfhi(p.z); f[6] = bflo(p.w); f[7] = bfhi(p.w); }

__device__ __forceinline__ v2u pack4(f32x4 v) { v2u w; w.x = cvt2(v[0], v[1]); w.y = cvt2(v[2], v[3]); return w; }
__device__ __forceinline__ v4u pack8(const float (&f)[8]) { v4u w; w.x = cvt2(f[0], f[1]); w.y = cvt2(f[2], f[3]); w.z = cvt2(f[4], f[5]); w.w = cvt2(f[6], f[7]); return w; }
__device__ __forceinline__ void phase_retpre(const Args& a, LAS unsigned char* lds, int tid, int lane, int wave, int bid, int G) {
    unsigned char* ws = a.ws; bf16* P = (bf16*)(ws + WS_P); const float* rot = (const float*)(ws + WS_ROT); v4u* SCF = (v4u*)(ws + WS_SCF);
    constexpr int LQ = 136;
    const __amdgpu_buffer_rsrc_t rsP = __builtin_amdgcn_make_buffer_rsrc((void*)P, 0, (int)((size_t)NTOK * NP * 2), 0x00020000), rsS = __builtin_amdgcn_make_buffer_rsrc((void*)SCF, 0, 8 << 20, 0x00020000);
    LAS bf16* Qs = (LAS bf16*)lds;
    LAS bf16* Ks = Qs + 64 * LQ;
    LAS float* gp = (LAS float*)(Ks + 64 * LQ);
    const int q4 = lane >> 4, l16 = lane & 15;
    const int si = tid >> 3, d0 = (tid & 7) * 8;
    const int oi0 = (wave >> 1) * 16, s2 = wave & 1;
    int cur_h = -1, cur_pos = -1; float rc[8], rsn[8];
    v4u nqlo = {0u, 0u, 0u, 0u}, nqhi = nqlo, nklo = nqlo, nkhi = nqlo;
#define RPRE_LOAD(u_) do { const int n_ = (u_) & 31, h_ = ((u_) >> 5) & 7, b_ = (u_) >> 8; const bf16* pr_ = P + (size_t)(b_ * SEQ + n_ * 64 + si) * NP; \
        nqlo = *(const v4u*)(pr_ + P_RQ + h_ * 128 + d0); nqhi = *(const v4u*)(pr_ + P_RQ + h_ * 128 + 64 + d0); nklo = *(const v4u*)(pr_ + P_RK + h_ * 128 + d0); nkhi = *(const v4u*)(pr_ + P_RK + h_ * 128 + 64 + d0); } while (0)
    if (bid < 1024) RPRE_LOAD(bid);
    for (int u = bid; u < 1024; u += G) { const int n = u & 31, h = (u >> 5) & 7, b = u >> 8;
        __syncthreads();
        if (h != cur_h) { const float lg = log1pf(-exp2f(-5.0f - (float)h)); if (tid < 65) gp[tid] = expf((float)tid * lg); cur_h = h; }
        if (n * 64 + si != cur_pos) { const float* r0 = rot + ((size_t)(n * 64 + si) * 64 + d0) * 2; cur_pos = n * 64 + si;
#pragma unroll
          for (int c_ = 0; c_ < 4; ++c_) { const f32x4 t0 = *(const f32x4*)(r0 + c_ * 4); rc[2 * c_] = t0[0]; rsn[2 * c_] = t0[1]; rc[2 * c_ + 1] = t0[2]; rsn[2 * c_ + 1] = t0[3]; } }
        const v4u qlo = nqlo, qhi = nqhi, klo = nklo, khi = nkhi;
        { const int un = (u + G < 1024) ? u + G : u; RPRE_LOAD(un); }
        float ql[8], qh[8], kl[8], kh[8]; unpack8(qlo, ql); unpack8(qhi, qh); unpack8(klo, kl); unpack8(khi, kh);
        float oql[8], oqh[8], okl[8], okh[8];
#pragma unroll
        for (int j = 0; j < 8; ++j) { const float c = rc[j], s = rsn[j];
            oql[j] = ql[j] * c - qh[j] * s; oqh[j] = ql[j] * s + qh[j] * c;
            okl[j] = (kl[j] * c - kh[j] * s) * 0.08838834764831845f; okh[j] = (kl[j] * s + kh[j] * c) * 0.08838834764831845f; }
        const v4u wql = pack8(oql), wqh = pack8(oqh), wkl = pack8(okl), wkh = pack8(okh);
        { const unsigned ob = (unsigned)(((size_t)(b * SEQ + n * 64 + si) * NP + h * 128 + d0) * 2);
          __builtin_amdgcn_raw_buffer_store_b128(wql, rsP, ob + P_RQ * 2, 0, 16); __builtin_amdgcn_raw_buffer_store_b128(wqh, rsP, ob + (P_RQ + 64) * 2, 0, 16);
          __builtin_amdgcn_raw_buffer_store_b128(wkl, rsP, ob + P_RK * 2, 0, 16); __builtin_amdgcn_raw_buffer_store_b128(wkh, rsP, ob + (P_RK + 64) * 2, 0, 16); }
        *(LAS v4u*)(Qs + si * LQ + d0) = wql; *(LAS v4u*)(Qs + si * LQ + 64 + d0) = wqh; *(LAS v4u*)(Ks + si * LQ + d0) = wkl; *(LAS v4u*)(Ks + si * LQ + 64 + d0) = wkh;
        __syncthreads();
        bf16x8 qf[4];
#pragma unroll
        for (int ks = 0; ks < 4; ++ks) qf[ks] = ldfrag(Qs, LQ, oi0, ks * 32, lane);
        const int i = oi0 + l16; f32x4 sc[2];
#pragma unroll
        for (int jj = 0; jj < 2; ++jj) { const int jt = 2 * s2 + jj; f32x4 acc = {0.f, 0.f, 0.f, 0.f};
#pragma unroll
            for (int ks = 0; ks < 4; ++ks) acc = mfma16(ldfrag(Ks, LQ, jt * 16, ks * 32, lane), qf[ks], acc);
#pragma unroll
            for (int r = 0; r < 4; ++r) { const int j = jt * 16 + 4 * q4 + r; const int dist = i > j ? i - j : j - i; acc[r] *= gp[dist]; }
            sc[jj] = acc; }
        { const v2u lo = pack4(sc[0]), hi = pack4(sc[1]); __builtin_amdgcn_raw_buffer_store_b128((v4u){lo.x, lo.y, hi.x, hi.y}, rsS, (unsigned)(((((size_t)u * 4 + (wave >> 1)) * 2 + s2) * 64 + lane) * 16), 0, 16); }
    }
}
#undef RPRE_LOAD
__device__ __forceinline__ void phase_ret3(const Args& a, LAS unsigned char* lds, int tid, int lane, int wave, int bid, int G) {
    unsigned char* ws = a.ws; const bf16* P = (const bf16*)(ws + WS_P); const v4u* SCF = (const v4u*)(ws + WS_SCF); bf16* OB = (bf16*)(ws + WS_OAB) + 1024;
    constexpr int LQ = 136, LV = 40;
    LAS bf16* QsB = (LAS bf16*)lds;
    LAS bf16* KsB = QsB + 2 * 64 * LQ;
    LAS bf16* VnB = KsB + 2 * 64 * LQ;
    LAS bf16* VdB = VnB + 2 * 64 * LV;
    LAS bf16* STB = VdB + 2 * 64 * LV;
    LAS float* gp = (LAS float*)(STB + 2 * 32 * LQ);
    const int q4 = lane >> 4, l16 = lane & 15;
    const int si = tid >> 3, d0 = (tid & 7) * 8, e0 = (tid & 7) * 4;
    const int oi0 = (wave >> 1) * 16, oe0 = (wave & 1) * 16;
    for (int uu = bid; uu < 256; uu += G) {
        const int u = (((uu & 7) * 4 + (uu >> 6)) << 3) | ((uu >> 3) & 7);
        const int b = u >> 6, h = (u >> 3) & 7, vs = u & 7;
        __syncthreads();
        const float lg = log1pf(-exp2f(-5.0f - (float)h));
        if (tid < 65) gp[tid] = expf((float)tid * lg);
        for (int i = tid; i < 32 * LQ / 2; i += NTHR) ((LAS unsigned*)STB)[i] = 0u;
        f32x4 st[2] = {{0.f, 0.f, 0.f, 0.f}, {0.f, 0.f, 0.f, 0.f}};
        const bf16* prow = P + (size_t)(b * SEQ + si) * NP;
        v4u qloA, qhiA, kloA, khiA, pnA0, pnA1, qloB, qhiB, kloB, khiB, pnB0, pnB1; v2u vvA, vvB; v4u pf0, pf1;
        const v4u* scf = SCF + ((size_t)((b << 8) | (h << 5)) * 4 + (wave >> 1)) * 2 * 64 + lane;
#define RET3_LOAD(S_, n_) do { const bf16* pr_ = prow + (size_t)(n_) * 64 * NP; \
            qlo##S_ = *(const v4u*)(pr_ + P_RQ + h * 128 + d0); qhi##S_ = *(const v4u*)(pr_ + P_RQ + h * 128 + 64 + d0); \
            klo##S_ = *(const v4u*)(pr_ + P_RK + h * 128 + d0); khi##S_ = *(const v4u*)(pr_ + P_RK + h * 128 + 64 + d0); \
            vv##S_ = *(const v2u*)(pr_ + P_RV + h * 256 + vs * 32 + e0); pn##S_##0 = scf[(size_t)(n_) * 512]; pn##S_##1 = scf[(size_t)(n_) * 512 + 64]; } while (0)
#define RET3_STAGE(S_, buf_) do { LAS bf16* Qs_ = QsB + (buf_) * 64 * LQ; LAS bf16* Ks_ = KsB + (buf_) * 64 * LQ; LAS bf16* Vn_ = VnB + (buf_) * 64 * LV; LAS bf16* Vd_ = VdB + (buf_) * 64 * LV; \
            const float kd = gp[63 - si]; \
            *(LAS v4u*)(Qs_ + si * LQ + d0) = qlo##S_; *(LAS v4u*)(Qs_ + si * LQ + 64 + d0) = qhi##S_; *(LAS v4u*)(Ks_ + si * LQ + d0) = klo##S_; *(LAS v4u*)(Ks_ + si * LQ + 64 + d0) = khi##S_; \
            *(LAS v2u*)(Vn_ + si * LV + e0) = vv##S_; \
            { v2u wd; wd.x = cvt2(bflo(vv##S_.x) * kd, bfhi(vv##S_.x) * kd); wd.y = cvt2(bflo(vv##S_.y) * kd, bfhi(vv##S_.y) * kd); *(LAS v2u*)(Vd_ + si * LV + e0) = wd; } \
            pf0 = pn##S_##0; pf1 = pn##S_##1; } while (0)
#define RET3_ITER(n_, S_) do { const int cur = (n_) & 1, nxt = cur ^ 1; \
            const v4u pc0 = pf0, pc1 = pf1; \
            if ((n_) + 1 < SEQ / 64) { RET3_STAGE(S_, nxt); if ((n_) + 3 < SEQ / 64) RET3_LOAD(S_, (n_) + 3); } \
            const LAS bf16* Qs = QsB + cur * 64 * LQ; const LAS bf16* Ks = KsB + cur * 64 * LQ; const LAS bf16* Vn = VnB + cur * 64 * LV; const LAS bf16* Vd = VdB + cur * 64 * LV; \
            const LAS bf16* STc = STB + cur * 32 * LQ; LAS bf16* STn = STB + nxt * 32 * LQ; \
            bf16x8 qf[4]; \
            _Pragma("unroll") for (int ks = 0; ks < 4; ++ks) qf[ks] = ldfrag(Qs, LQ, oi0, ks * 32, lane); \
            const int i = oi0 + l16; \
              \
            f32x4 ointra = {0.f, 0.f, 0.f, 0.f}; \
            _Pragma("unroll") for (int s2 = 0; s2 < 2; ++s2) { const v4u pfu = s2 ? pc1 : pc0; \
                LAS bf16* vp = (LAS bf16*)Vn + (32 * s2 + 4 * q4 + (l16 >> 2)) * LV + oe0 + 4 * (l16 & 3); \
                const s16x4 vlo = __builtin_amdgcn_ds_read_tr16_b64_v4i16((LAS s16x4*)vp), vhi = __builtin_amdgcn_ds_read_tr16_b64_v4i16((LAS s16x4*)(vp + 16 * LV)); \
                ointra = mfma16(__builtin_shufflevector(vlo, vhi, 0, 1, 2, 3, 4, 5, 6, 7), __builtin_bit_cast(bf16x8, pfu), ointra); } \
            f32x4 ointer = {0.f, 0.f, 0.f, 0.f}; \
            _Pragma("unroll") for (int ks = 0; ks < 4; ++ks) ointer = mfma16(ldfrag(STc, LQ, oe0, ks * 32, lane), qf[ks], ointer); \
            { const float qd = gp[i + 1]; \
              v2u w; w.x = cvt2(ointra[0] + qd * ointer[0], ointra[1] + qd * ointer[1]); w.y = cvt2(ointra[2] + qd * ointer[2], ointra[3] + qd * ointer[3]); \
              *(v2u*)(OB + (size_t)(b * SEQ + (n_) * 64 + i) * OAB_LD + h * 256 + vs * 32 + oe0 + 4 * q4) = w; } \
              \
            _Pragma("unroll") for (int et = 0; et < 2; ++et) { f32x4 acc = st[et] * chunk_decay; \
                _Pragma("unroll") for (int ks = 0; ks < 2; ++ks) acc = mfma16(ldfrag_tr(Ks, LQ, ks * 32, wave * 16, lane), ldfrag_tr(Vd, LV, ks * 32, et * 16, lane), acc); \
                st[et] = acc; *(LAS v2u*)(STn + (et * 16 + l16) * LQ + wave * 16 + 4 * q4) = pack4(acc); } \
            LDS_BARRIER(); } while (0)
        RET3_LOAD(A, 0);
        __syncthreads();
        const float chunk_decay = gp[64];
        RET3_STAGE(A, 0);
        RET3_LOAD(B, 1); RET3_LOAD(A, 2);
        LDS_BARRIER();
        for (int n = 0; n < SEQ / 64; n += 2) { RET3_ITER(n, B); RET3_ITER(n + 1, A); }
#undef RET3_ITER
#undef RET3_LOAD
#undef RET3_STAGE
    }
}

constexpr int LT = 72, SLOT = 64 * LT;
constexpr size_t RW_GS = 0, RW_GY = 16 * MiB, RW_YS = 32 * MiB, RW_SS = 48 * MiB;
constexpr size_t WS_H0 = WS_RB;
constexpr size_t WS_W2T = WS_RB + 16 * MiB, WS_A2T = WS_W2T + 196608, WS_G2T = WS_A2T + 196608;

__device__ __forceinline__ f32x4 tile2(const LAS bf16* X, int x0, const LAS bf16* Y, int y0, int lane, f32x4 acc) {
    acc = mfma16(ldfrag(X, LT, x0, 0, lane), ldfrag(Y, LT, y0, 0, lane), acc);
    acc = mfma16(ldfrag(X, LT, x0, 32, lane), ldfrag(Y, LT, y0, 32, lane), acc);
    return acc;
}
__device__ __forceinline__ f32x4 unpack4(v2u w) { return (f32x4){bflo(w.x), bfhi(w.x), bflo(w.y), bfhi(w.y)}; }
__device__ __forceinline__ void st4(LAS bf16* img, int yrow, int xcol, f32x4 v) { *(LAS v2u*)(img + yrow * LT + xcol) = pack4(v); }
__device__ __forceinline__ f32x4 ld4(const LAS bf16* img, int yrow, int xcol) { return unpack4(*(const LAS v2u*)(img + yrow * LT + xcol)); }
__device__ __forceinline__ void shift8(const bf16* P, size_t tg, int col, bool first, const float* mu, float (&o)[8]) {
    const v4u cur = *(const v4u*)(P + tg * NP + col); v4u prv = *(const v4u*)(P + (first ? tg : tg - 1) * NP + col); if (first) prv = (v4u){0u, 0u, 0u, 0u};
    const f32x4 m0 = *(const f32x4*)(mu + col), m1 = *(const f32x4*)(mu + col + 4);
    float c[8], p[8]; unpack8(cur, c); unpack8(prv, p);
#pragma unroll
    for (int j = 0; j < 8; ++j) o[j] = c[j] + (p[j] - c[j]) * (j < 4 ? m0[j] : m1[j - 4]);
}

__device__ __forceinline__ f32x4 tile2_ytr(const LAS bf16* X, int x0, const LAS bf16* Yn, int y0, int lane, f32x4 acc) {
    acc = mfma16(ldfrag(X, LT, x0, 0, lane), ldfrag_tr(Yn, LT, 0, y0, lane), acc);
    acc = mfma16(ldfrag(X, LT, x0, 32, lane), ldfrag_tr(Yn, LT, 32, y0, lane), acc);
    return acc;
}
__device__ __forceinline__ f32x4 tile2_xtr(const LAS bf16* Xn, int x0, const LAS bf16* Y, int y0, int lane, f32x4 acc) {
    acc = mfma16(ldfrag_tr(Xn, LT, 0, x0, lane), ldfrag(Y, LT, y0, 0, lane), acc);
    acc = mfma16(ldfrag_tr(Xn, LT, 32, x0, lane), ldfrag(Y, LT, y0, 32, lane), acc);
    return acc;
}
__device__ __forceinline__ f32x4 ld4_tr(const LAS bf16* img, int r0, int c0, int lane) {
    const int q = lane >> 4, i = lane & 15;
    LAS bf16* p = (LAS bf16*)img + (r0 + 4 * q + (i >> 2)) * LT + c0 + 4 * (i & 3);
    const s16x4 v = __builtin_amdgcn_ds_read_tr16_b64_v4i16((LAS s16x4*)p);
    return (f32x4){bf2f((unsigned short)v[0]), bf2f((unsigned short)v[1]), bf2f((unsigned short)v[2]), bf2f((unsigned short)v[3])};
}
struct FragP { bf16x8 x0, x1, y0, y1; };
__device__ __forceinline__ FragP fp_ld(const LAS bf16* X, int x0, const LAS bf16* Y, int y0, int lane) { FragP f; f.x0 = ldfrag(X, LT, x0, 0, lane); f.x1 = ldfrag(X, LT, x0, 32, lane); f.y0 = ldfrag(Y, LT, y0, 0, lane); f.y1 = ldfrag(Y, LT, y0, 32, lane); return f; }
__device__ __forceinline__ FragP fp_ld_ytr(const LAS bf16* X, int x0, const LAS bf16* Yn, int y0, int lane) { FragP f; f.x0 = ldfrag(X, LT, x0, 0, lane); f.x1 = ldfrag(X, LT, x0, 32, lane); f.y0 = ldfrag_tr(Yn, LT, 0, y0, lane); f.y1 = ldfrag_tr(Yn, LT, 32, y0, lane); return f; }
__device__ __forceinline__ FragP fp_ld_xtr(const LAS bf16* Xn, int x0, const LAS bf16* Y, int y0, int lane) { FragP f; f.x0 = ldfrag_tr(Xn, LT, 0, x0, lane); f.x1 = ldfrag_tr(Xn, LT, 32, x0, lane); f.y0 = ldfrag(Y, LT, y0, 0, lane); f.y1 = ldfrag(Y, LT, y0, 32, lane); return f; }
__device__ __forceinline__ f32x4 fp_mm(const FragP& f, f32x4 acc) { acc = mfma16(f.x0, f.y0, acc); return mfma16(f.x1, f.y1, acc); }
#define SB() __builtin_amdgcn_sched_barrier(0)
__device__ __forceinline__ float fast_sigmoid(float x) { return __builtin_amdgcn_rcpf(1.0f + __expf(-x)); }
__device__ __forceinline__ float fast_tanh(float x) { const float e = __expf(2.0f * x); return 1.0f - 2.0f * __builtin_amdgcn_rcpf(e + 1.0f); }

typedef float f32x2v __attribute__((ext_vector_type(2)));
__device__ __forceinline__ f32x2v mix2(unsigned cur, unsigned prv, f32x2v m) { const f32x2v c = {bflo(cur), bfhi(cur)}, p = {bflo(prv), bfhi(prv)}; return c + (p - c) * m; }
#ifndef A_REP
#define A_REP 0
#endif
#define RWA_LOAD(uu_) do { const int b_ = (uu_) >> 9, h_ = ((uu_) >> 5) & 15, c_ = (uu_) & 31; const size_t t0g_ = (size_t)b_ * SEQ + c_ * 64; \
        { const int tl = y0 + l16; const size_t tg = t0g_ + tl; const size_t tp = (c_ == 0 && tl == 0) ? tg : tg - 1; \
          _Pragma("unroll") for (int ks = 0; ks < 3; ++ks) { xlc[ks] = *(const v4u*)(P + tg * NP + lcol + ks * 32 + q4 * 8); xlp[ks] = *(const v4u*)(P + tp * NP + lcol + ks * 32 + q4 * 8); } } \
        { const size_t tg = t0g_ + st_; const size_t tp = (c_ == 0 && st_ == 0) ? tg : tg - 1; \
          _Pragma("unroll") for (int m = 0; m < 3; ++m) { erc[m] = *(const v4u*)(P + tg * NP + m * 1024 + h_ * 64 + c0); erp[m] = *(const v4u*)(P + tp * NP + m * 1024 + h_ * 64 + c0); } } \
    } while (0)
#define RWA_MIX(cur_, prv_, first_, col_, out_) do { float c__[8], p__[8]; unpack8(cur_, c__); unpack8(prv_, p__); const f32x4 m0__ = *(const f32x4*)(mu + (col_)), m1__ = *(const f32x4*)(mu + (col_) + 4); \
        _Pragma("unroll") for (int j = 0; j < 8; ++j) { const float pj__ = (first_) ? 0.f : p__[j]; out_[j] = c__[j] + (pj__ - c__[j]) * (j < 4 ? m0__[j] : m1__[j - 4]); } } while (0)
#define RWA_MIXL(cur_, prv_, first_, lmu_, out_) do { const f32x4 m0__ = *(const LAS f32x4*)(lmu_), m1__ = *(const LAS f32x4*)((lmu_) + 4); const v4u pz__ = (first_) ? (v4u){0u, 0u, 0u, 0u} : (prv_); \
        const f32x2v x0__ = mix2(cur_.x, pz__.x, (f32x2v){m0__[0], m0__[1]}), x1__ = mix2(cur_.y, pz__.y, (f32x2v){m0__[2], m0__[3]}), x2__ = mix2(cur_.z, pz__.z, (f32x2v){m1__[0], m1__[1]}), x3__ = mix2(cur_.w, pz__.w, (f32x2v){m1__[2], m1__[3]}); \
        out_[0] = x0__.x; out_[1] = x0__.y; out_[2] = x1__.x; out_[3] = x1__.y; out_[4] = x2__.x; out_[5] = x2__.y; out_[6] = x3__.x; out_[7] = x3__.y; } while (0)
#define RWA_STG_LOAD(uu_) do { const int h_ = ((uu_) >> 5) & 15; const float* sp_ = wave < 3 ? mu + wave * 1024 : (wave == 3 ? w0 : (wave == 4 ? a0 : (wave == 5 ? k_k : (wave == 6 ? k_a : r_k)))); stg = sp_[h_ * 64 + lane]; } while (0)
#define RWA_S0C(uu_) do { const int h_ = ((uu_) >> 5) & 15, c_ = (uu_) & 31; \
        { const int tl = y0 + l16; const bool firstl = (c_ == 0 && tl == 0); bf16x8 fl[3]; \
          _Pragma("unroll") for (int ks = 0; ks < 3; ++ks) { float x[8]; RWA_MIXL(xlc[ks], xlp[ks], firstl, MUL + lsel * 96 + ks * 32 + q4 * 8, x); \
              if (!lsel) { _Pragma("unroll") for (int j = 0; j < 8; ++j) x[j] = fast_tanh(x[j]); } \
              fl[ks] = __builtin_bit_cast(bf16x8, pack8(x)); } \
          SB(); \
          _Pragma("unroll") for (int ct = 0; ct < 4; ++ct) _Pragma("unroll") for (int ks = 0; ks < 3; ++ks) gl_[ct][ks] = *(const bf16x8*)(LT2 + (size_t)(h_ * 64 + ct * 16 + l16) * 96 + ks * 32 + q4 * 8); \
          SB(); \
          { const bool first_ = (c_ == 0 && st_ == 0); RWA_MIXL(erc[0], erp[0], first_, STG + c0, rr); RWA_MIXL(erc[1], erp[1], first_, STG + 64 + c0, kp); RWA_MIXL(erc[2], erp[2], first_, STG + 128 + c0, vv); } \
          SB(); \
          _Pragma("unroll") for (int ct = 0; ct < 4; ++ct) { f32x4 accl = z4; \
              _Pragma("unroll") for (int ks = 0; ks < 3; ++ks) accl = mfma16(gl_[ct][ks], fl[ks], accl); \
              *(LAS f32x4*)(LL + tl * 68 + ct * 16 + 4 * q4) = accl; } } \
    } while (0)
__device__ __forceinline__ void phase_rwA(const Args& a, LAS unsigned char* lds, int tid, int lane, int wave, int bid, int G) {
    unsigned char* ws = a.ws; const bf16* P = (const bf16*)(ws + WS_P);
    const float* mu = a.in[3]; const float* w0 = a.in[4]; const float* a0 = a.in[6]; const float* k_k = a.in[9]; const float* k_a = a.in[10]; const float* r_k = a.in[11];
    const bf16* W2T = (const bf16*)(ws + WS_W2T); const bf16* A2T = (const bf16*)(ws + WS_A2T);
    bf16* GS = (bf16*)((unsigned char*)a.out + RW_GS); bf16* GY = (bf16*)((unsigned char*)a.out + RW_GY); bf16* YS = (bf16*)((unsigned char*)a.out + RW_YS); bf16* SS = (bf16*)((unsigned char*)a.out + RW_SS);
    float* BON = (float*)(ws + WS_BONUS);
    LAS bf16* img = (LAS bf16*)lds;
    LAS bf16 *s0 = img, *s1 = img + SLOT, *s2 = img + 2 * SLOT, *s3 = img + 3 * SLOT, *s4 = img + 4 * SLOT, *s5 = img + 5 * SLOT, *s6 = img + 6 * SLOT, *s7 = img + 7 * SLOT;
    LAS bf16 *s8 = img + 8 * SLOT, *s9 = img + 9 * SLOT, *s10 = img + 10 * SLOT, *s11 = img + 11 * SLOT, *s12 = img + 12 * SLOT, *s13 = img + 13 * SLOT;
    LAS float* WL = (LAS float*)s10;  LAS float* AL = (LAS float*)s12;
    LAS float* LL = (wave & 1) ? AL : WL;
    LAS float* SEG = (LAS float*)(lds + RING_BYTES + 1024);
    LAS float* GC = SEG + 512;
    LAS float* DIAG = GC + 64;
    LAS float* MUL = DIAG + 1024;
    LAS float* STG = MUL + 192;
    const int q4 = lane >> 4, l16 = lane & 15;
    const int yt = wave >> 1, xb = (wave & 1) * 2, y0 = yt * 16;
    const int st_ = tid >> 3, c0 = (tid & 7) * 8;
    const f32x4 z4 = {0.f, 0.f, 0.f, 0.f};
    float rr[8], kp[8], vv[8];
    const int lsel = wave & 1, lcol = lsel ? P_XA : P_XW; const bf16* LT2 = lsel ? A2T : W2T;
    v4u xlc[3], xlp[3], erc[3], erp[3];
    float stg = 0.f;
    bf16x8 gl_[4][3];
    if (bid < 2048) { if (tid < 192) MUL[tid] = mu[P_XW + tid]; RWA_STG_LOAD(bid); STG[tid] = stg; LDS_BARRIER(); RWA_LOAD(bid); RWA_S0C(bid); }
    for (int u = bid; u < 2048; u += G) {
        const int b = u >> 9, h = (u >> 5) & 15, c = u & 31;
        const size_t t0g = (size_t)b * SEQ + c * 64;
        float av[8], bv[8], ee[8];
        LDS_BARRIER();
        { float wl[8], al[8]; const int chg = h * 64 + c0;
          (void)chg; const LAS float* pp_ = STG + 192 + c0;
          const f32x4 pw0[2] = {*(const LAS f32x4*)(pp_), *(const LAS f32x4*)(pp_ + 4)}, pa0[2] = {*(const LAS f32x4*)(pp_ + 64), *(const LAS f32x4*)(pp_ + 68)}, pkk[2] = {*(const LAS f32x4*)(pp_ + 128), *(const LAS f32x4*)(pp_ + 132)};
          const f32x4 pka[2] = {*(const LAS f32x4*)(pp_ + 192), *(const LAS f32x4*)(pp_ + 196)}, prk[2] = {*(const LAS f32x4*)(pp_ + 256), *(const LAS f32x4*)(pp_ + 260)};
          { const f32x4 t0 = *(const LAS f32x4*)(WL + st_ * 68 + c0), t1 = *(const LAS f32x4*)(WL + st_ * 68 + c0 + 4), u0 = *(const LAS f32x4*)(AL + st_ * 68 + c0), u1 = *(const LAS f32x4*)(AL + st_ * 68 + c0 + 4);
#pragma unroll
            for (int j = 0; j < 4; ++j) { wl[j] = t0[j]; wl[4 + j] = t1[j]; al[j] = u0[j]; al[4 + j] = u1[j]; } }
          float ss = 0.f, bon = 0.f, kk[8], as[8];
#pragma unroll
          for (int j = 0; j < 8; ++j) { const int jv = j >> 2, jc = j & 3; ee[j] = fast_sigmoid(pw0[jv][jc] + wl[j]) * 0.6065306597126334f; as[j] = fast_sigmoid(pa0[jv][jc] + al[j]); kk[j] = kp[j] * pkk[jv][jc]; ss += kk[j] * kk[j]; }
          ss += __shfl_xor(ss, 1); ss += __shfl_xor(ss, 2); ss += __shfl_xor(ss, 4);
          const float rn = rsqrtf(fmaxf(ss, 1e-24f));
#pragma unroll
          for (int j = 0; j < 8; ++j) { const int jv = j >> 2, jc = j & 3; const float kn = kk[j] * rn; kp[j] = kp[j] * (1.0f + (as[j] - 1.0f) * pka[jv][jc]); av[j] = -kn; bv[j] = kn * as[j]; bon += rr[j] * kp[j] * prk[jv][jc]; }
          bon += __shfl_xor(bon, 1); bon += __shfl_xor(bon, 2); bon += __shfl_xor(bon, 4);
          if ((tid & 7) == 0) BON[(t0g + st_) * RW_H + h] = bon;
          *(LAS f32x4*)(WL + st_ * 68 + c0) = (f32x4){ee[0], ee[1], ee[2], ee[3]}; *(LAS f32x4*)(WL + st_ * 68 + c0 + 4) = (f32x4){ee[4], ee[5], ee[6], ee[7]}; }
        LDS_BARRIER();
        { const int ch = tid & 63, seg = tid >> 6; float x[8], run = 0.f;
#pragma unroll
          for (int i = 0; i < 8; ++i) { run += WL[(seg * 8 + i) * 68 + ch]; x[i] = run; }
          SEG[seg * 64 + ch] = run;
          LDS_BARRIER();
          float off = 0.f;
#pragma unroll
          for (int s = 0; s < 8; ++s) off += (s < seg) ? SEG[s * 64 + ch] : 0.f;
#pragma unroll
          for (int i = 0; i < 8; ++i) WL[(seg * 8 + i) * 68 + ch] = x[i] + off; }
        LDS_BARRIER();
        for (int rep0_ = 0; rep0_ < 1 + ((A_REP >> 0) & 1); ++rep0_) {
        { float cs[8], cC[8];
          { const f32x4 t0 = *(const LAS f32x4*)(WL + st_ * 68 + c0), t1 = *(const LAS f32x4*)(WL + st_ * 68 + c0 + 4), u0 = *(const LAS f32x4*)(WL + 63 * 68 + c0), u1 = *(const LAS f32x4*)(WL + 63 * 68 + c0 + 4);
#pragma unroll
            for (int j = 0; j < 4; ++j) { cs[j] = t0[j]; cs[4 + j] = t1[j]; cC[j] = u0[j]; cC[4 + j] = u1[j]; } }
          float At[8], Rt[8], Bt[8], Kt[8], Bh[8], Kh[8];
#pragma unroll
          for (int j = 0; j < 8; ++j) { const float gi = __expf(cs[j]), gt = __builtin_amdgcn_rcpf(gi), gh = gi * __expf(-cC[j]);
              At[j] = av[j] * __expf(ee[j]) * gt; Rt[j] = rr[j] * gt; Bt[j] = bv[j] * gi; Kt[j] = kp[j] * gi; Bh[j] = bv[j] * gh; Kh[j] = kp[j] * gh; }
          *(LAS v4u*)(s0 + st_ * LT + c0) = pack8(At); *(LAS v4u*)(s1 + st_ * LT + c0) = pack8(Rt); *(LAS v4u*)(s2 + st_ * LT + c0) = pack8(Bt); *(LAS v4u*)(s3 + st_ * LT + c0) = pack8(Kt);
          *(LAS v4u*)(s4 + st_ * LT + c0) = pack8(Bh); *(LAS v4u*)(s5 + st_ * LT + c0) = pack8(Kh); *(LAS v4u*)(s6 + st_ * LT + c0) = pack8(vv);
          if (st_ == 63) {
#pragma unroll
              for (int j = 0; j < 8; ++j) GC[c0 + j] = __expf(-cC[j]); }
          for (int i = tid; i < 2 * SLOT * 2 / 16; i += NTHR) ((LAS v4u*)s12)[i] = (v4u){0u, 0u, 0u, 0u}; }
        }
        LDS_BARRIER();
        for (int rep_ = 0; rep_ < 1 + ((A_REP >> 1) & 1); ++rep_) {
        { FragP f_[2];
#pragma unroll
        for (int xi = 0; xi < 2; ++xi) f_[xi] = fp_ld(s2, (xb + xi) * 16, s0, y0, lane);
        SB();
#pragma unroll
        for (int xi = 0; xi < 2; ++xi) { const int xt = xb + xi, x0 = xt * 16; const int yr = y0 + l16, xc = x0 + 4 * q4;
            f32x4 acc = fp_mm(f_[xi], z4);
#pragma unroll
            for (int r = 0; r < 4; ++r) acc[r] = (xc + r < yr) ? acc[r] : 0.f;
            if (yt == xt) *(LAS f32x4*)(DIAG + (yt * 16 + l16) * 16 + 4 * q4) = acc;
            st4(s8, yr, xc, ((yt == 1 && xt == 0) || (yt == 3 && xt == 2)) ? acc : z4);
            st4(s9, yr, xc, (yt >= 2 && xt <= 1) ? acc : z4); } }
        LDS_BARRIER();
        if (wave == 0) { const LAS float* Lb = DIAG + q4 * 256; float x[16];
#pragma unroll
            for (int r = 0; r < 16; ++r) { float s = (r == l16) ? 1.0f : 0.0f;
#pragma unroll
                for (int j = 0; j < r; ++j) s += Lb[r * 16 + j] * x[j];
                x[r] = s; }
#pragma unroll
            for (int r = 0; r < 16; ++r) s12[(q4 * 16 + r) * LT + q4 * 16 + l16] = (bf16)f2bf(x[r]);
            { float lo[8], hi[8];
#pragma unroll
              for (int r = 0; r < 8; ++r) { lo[r] = x[r]; hi[r] = x[8 + r]; }
              *(LAS v4u*)(s13 + (q4 * 16 + l16) * LT + q4 * 16) = pack8(lo); *(LAS v4u*)(s13 + (q4 * 16 + l16) * LT + q4 * 16 + 8) = pack8(hi); } }
        else {
#pragma unroll
            for (int bt = 0; bt < 2; ++bt) { FragP f_[4];
#pragma unroll
                for (int i = 0; i < 4 - bt; ++i) { const int T0 = wave - 1 + 7 * (4 * bt + i), T = T0 < 48 ? T0 : 47; const int p = T >> 4, ty = (T >> 2) & 3, tx = T & 3;
                    const LAS bf16* X = p == 0 ? s0 : (p == 1 ? s2 : s3); const LAS bf16* Y = p == 0 ? s3 : s1; f_[i] = fp_ld(X, tx * 16, Y, ty * 16, lane); }
                SB();
#pragma unroll
                for (int i = 0; i < 4 - bt; ++i) { const int T0 = wave - 1 + 7 * (4 * bt + i), T = T0 < 48 ? T0 : 47; const int p = T >> 4, ty = (T >> 2) & 3, tx = T & 3; const int yr = ty * 16 + l16, xc = tx * 16 + 4 * q4;
                    LAS bf16* D = p == 0 ? s10 : (p == 1 ? s11 : s7);
                    f32x4 acc = fp_mm(f_[i], z4);
#pragma unroll
                    for (int r = 0; r < 4; ++r) { const bool keep = p == 0 ? (yr < xc + r) : (xc + r <= yr); acc[r] = keep ? acc[r] : 0.f; }
                    if (T0 < 48) st4(D, yr, xc, acc); }
                SB(); } }
        LDS_BARRIER();
        }
        const int un = (u + G < 2048) ? u + G : u;
        RWA_STG_LOAD(un);
        RWA_LOAD(un);
        { FragP f_[2];
#pragma unroll
        for (int xi = 0; xi < 2; ++xi) f_[xi] = fp_ld(s8, (xb + xi) * 16, s13, y0, lane);
        SB();
#pragma unroll
        for (int xi = 0; xi < 2; ++xi) { const int x0 = (xb + xi) * 16; st4(s2, y0 + l16, x0 + 4 * q4, fp_mm(f_[xi], z4)); } }
        LDS_BARRIER();
#pragma unroll
        for (int xi = 0; xi < 2; ++xi) { const int x0 = (xb + xi) * 16, yr = y0 + l16, xc = x0 + 4 * q4;
            const FragP fa_ = fp_ld(s2, x0, s12, y0, lane), fb_ = fp_ld(s12, x0, s2, y0, lane); const f32x4 ia_ = ld4(s12, yr, xc), ib_ = ld4(s13, yr, xc);
            SB();
            st4(s3, yr, xc, fp_mm(fa_, ia_));
            st4(s8, yr, xc, fp_mm(fb_, ib_));
            SB(); }
        LDS_BARRIER();
        for (int rep_ = 0; rep_ < 1 + ((A_REP >> 3) & 1); ++rep_) {
        { FragP f_[2];
#pragma unroll
        for (int xi = 0; xi < 2; ++xi) f_[xi] = fp_ld(s9, (xb + xi) * 16, s8, y0, lane);
        SB();
#pragma unroll
        for (int xi = 0; xi < 2; ++xi) { const int x0 = (xb + xi) * 16; st4(s2, y0 + l16, x0 + 4 * q4, fp_mm(f_[xi], z4)); } }
        LDS_BARRIER();
        { FragP f_[2]; f32x4 i_[2];
#pragma unroll
        for (int xi = 0; xi < 2; ++xi) { const int x0 = (xb + xi) * 16; f_[xi] = fp_ld(s2, x0, s3, y0, lane); i_[xi] = ld4(s3, y0 + l16, x0 + 4 * q4); }
        SB();
#pragma unroll
        for (int xi = 0; xi < 2; ++xi) { const int x0 = (xb + xi) * 16, yr = y0 + l16, xc = x0 + 4 * q4; st4(s12, yr, xc, fp_mm(f_[xi], i_[xi])); } }
        LDS_BARRIER();
        }
        for (int rep_ = 0; rep_ < 1 + ((A_REP >> 4) & 1); ++rep_) {
        if (rep_ == 0) STG[tid] = stg;
#pragma unroll
        for (int xi = 0; xi < 2; ++xi) { const int x0 = (xb + xi) * 16, yr = y0 + l16, xc = x0 + 4 * q4;
            const FragP fa_ = fp_ld_ytr(s12, x0, s0, y0, lane), fb_ = fp_ld(s12, x0, s10, y0, lane);
            SB();
            st4(s13, yr, xc, fp_mm(fa_, z4));
            st4(s2, yr, xc, fp_mm(fb_, z4));
            SB(); }
        LDS_BARRIER();
        }
        v2u gyv[2], gsv[2];
#pragma unroll
        for (int xi = 0; xi < 2; ++xi) { const int xt = xb + xi, x0 = xt * 16, yr = y0 + l16, xc = x0 + 4 * q4;
            const FragP f0_ = fp_ld(s13, x0, s11, y0, lane); const f32x4 i0_ = ld4(s1, yr, xc);
            SB();
            const FragP f1_ = fp_ld(s2, x0, s11, y0, lane); const f32x4 i1_ = ld4(s7, yr, xc);
            f32x4 acc = fp_mm(f0_, i0_);
            gyv[xi] = pack4(acc);
            st4(s3, yr, xc, fp_mm(f1_, i1_));
            SB();
            const FragP f2_ = fp_ld_ytr(s13, x0, s4, y0, lane); const float gc_ = GC[yr];
            SB();
            const FragP f3_ = fp_ld_ytr(s2, x0, s4, y0, lane); const f32x4 i3_ = ld4_tr(s5, x0, y0, lane);
            acc = fp_mm(f2_, z4);
#pragma unroll
            for (int r = 0; r < 4; ++r) acc[r] += (xc + r == yr) ? gc_ : 0.f;
            gsv[xi] = pack4(acc);
            st4(s8, yr, xc, fp_mm(f3_, i3_));
            SB(); }
        LDS_BARRIER();
        RWA_S0C(un);
        SB();
#pragma unroll
        for (int xi = 0; xi < 2; ++xi) { const int x0 = (xb + xi) * 16, yr = y0 + l16, xc = x0 + 4 * q4;
            const FragP fa_ = fp_ld_xtr(s6, x0, s3, y0, lane), fb_ = fp_ld_ytr(s8, x0, s6, y0, lane);
            SB();
            *(v2u*)(GY + (size_t)u * 4096 + yr * 64 + xc) = gyv[xi]; *(v2u*)(GS + (size_t)u * 4096 + yr * 64 + xc) = gsv[xi];
            *(v2u*)(YS + (size_t)u * 4096 + yr * 64 + xc) = pack4(fp_mm(fa_, z4));
            *(v2u*)(SS + (size_t)u * 4096 + yr * 64 + xc) = pack4(fp_mm(fb_, z4));
            SB(); }
        LDS_BARRIER();
    }
}

#undef RWA_LOAD
#undef RWA_MIXL
#undef RWA_STG_LOAD
#undef RWA_MIX
#undef RWA_S0C
struct RwBRegs { v2u g[4][2][2]; v2u s[4]; };
__device__ __forceinline__ void rwB_load(RwBRegs& R, const bf16* GS, const bf16* SS, size_t u, int vg, int l16, int q4) {
#pragma unroll
    for (int mt = 0; mt < 4; ++mt) {
#pragma unroll
        for (int s = 0; s < 2; ++s) { const bf16* p = GS + u * 4096 + (mt * 16 + l16) * 64 + 32 * s + 4 * q4; R.g[mt][s][0] = *(const v2u*)p; R.g[mt][s][1] = *(const v2u*)(p + 16); }
        R.s[mt] = *(const v2u*)(SS + u * 4096 + (vg * 16 + l16) * 64 + mt * 16 + 4 * q4); }
}
__device__ __forceinline__ void phase_rwB(const Args& a, int lane, int wave, int bid, int G) {
    if (wave != 0) return;
    unsigned char* ws = a.ws; const bf16* GS = (const bf16*)((const unsigned char*)a.out + RW_GS); const bf16* SS = (const bf16*)((const unsigned char*)a.out + RW_SS); bf16* H0 = (bf16*)(ws + WS_H0);
    const int q4 = lane >> 4, l16 = lane & 15;
    for (int ch = bid; ch < 256; ch += G) {
        const int bh = ch >> 2, vg = ch & 3; const size_t u0 = (size_t)bh * 32;
        f32x4 H[4];
#pragma unroll
        for (int mt = 0; mt < 4; ++mt) H[mt] = (f32x4){0.f, 0.f, 0.f, 0.f};
        RwBRegs nxt; rwB_load(nxt, GS, SS, u0, vg, l16, q4);
        for (int c = 0; c < 32; ++c) {
            const RwBRegs cur = nxt;
            if (c + 1 < 32) rwB_load(nxt, GS, SS, u0 + c + 1, vg, l16, q4);
            v4u hf[2];
#pragma unroll
            for (int s = 0; s < 2; ++s) { const v2u lo = pack4(H[2 * s]), hi = pack4(H[2 * s + 1]); hf[s] = (v4u){lo.x, lo.y, hi.x, hi.y};
                bf16* hp = H0 + (u0 + c) * 4096 + (vg * 16 + l16) * 64 + 32 * s + 4 * q4; *(v2u*)hp = lo; *(v2u*)(hp + 16) = hi; }
#pragma unroll
            for (int mt = 0; mt < 4; ++mt) { f32x4 acc = unpack4(cur.s[mt]);
#pragma unroll
                for (int s = 0; s < 2; ++s) { const v4u af = {cur.g[mt][s][0].x, cur.g[mt][s][0].y, cur.g[mt][s][1].x, cur.g[mt][s][1].y};
                    acc = mfma16(__builtin_bit_cast(bf16x8, af), __builtin_bit_cast(bf16x8, hf[s]), acc); }
                H[mt] = acc; }
        }
    }
}

__device__ __forceinline__ void phase_rwC(const Args& a, int lane, int wave, int bid, int G) {
    unsigned char* ws = a.ws; const bf16* P = (const bf16*)(ws + WS_P);
    const bf16* GY = (const bf16*)((const unsigned char*)a.out + RW_GY); const bf16* YS = (const bf16*)((const unsigned char*)a.out + RW_YS); const bf16* H0 = (const bf16*)(ws + WS_H0);
    const bf16* G2T = (const bf16*)(ws + WS_G2T); const float* BON = (const float*)(ws + WS_BONUS); const float* mu = a.in[3]; const float* lg = a.in[12]; const float* lb = a.in[13];
    bf16* OA = (bf16*)(ws + WS_OAB);
    const int q4 = lane >> 4, l16 = lane & 15; const int gw = bid * NWAVES + wave, NGW = G * NWAVES;
    for (int task = gw; task < 8192; task += NGW) {
        const int u = task >> 2, tt = task & 3; const int b = u >> 9, h = (u >> 5) & 15, c = u & 31;
        const int tl = tt * 16 + l16; const size_t tg = (size_t)b * SEQ + c * 64 + tl; const bool first = (c == 0 && tl == 0);
        f32x4 y[4], g[4];
        { const bf16x8 yf0 = *(const bf16x8*)(GY + (size_t)u * 4096 + tl * 64 + q4 * 8), yf1 = *(const bf16x8*)(GY + (size_t)u * 4096 + tl * 64 + 32 + q4 * 8);
#pragma unroll
          for (int vt = 0; vt < 4; ++vt) { f32x4 acc = unpack4(*(const v2u*)(YS + (size_t)u * 4096 + tl * 64 + vt * 16 + 4 * q4));
              const bf16* hp = H0 + (size_t)u * 4096 + (vt * 16 + l16) * 64 + q4 * 8;
              acc = mfma16(*(const bf16x8*)hp, yf0, acc); acc = mfma16(*(const bf16x8*)(hp + 32), yf1, acc); y[vt] = acc; } }
#pragma unroll
        for (int vt = 0; vt < 4; ++vt) g[vt] = (f32x4){0.f, 0.f, 0.f, 0.f};
#pragma unroll
        for (int ks = 0; ks < 8; ++ks) { float x[8]; shift8(P, tg, P_XG + ks * 32 + q4 * 8, first, mu, x);
#pragma unroll
            for (int j = 0; j < 8; ++j) x[j] = sigmoidf_(x[j]);
            const bf16x8 gf = __builtin_bit_cast(bf16x8, pack8(x));
#pragma unroll
            for (int vt = 0; vt < 4; ++vt) g[vt] = mfma16(*(const bf16x8*)(G2T + (size_t)(h * 64 + vt * 16 + l16) * 256 + ks * 32 + q4 * 8), gf, g[vt]); }
        float s = 0.f;
#pragma unroll
        for (int vt = 0; vt < 4; ++vt) s += (y[vt][0] + y[vt][1]) + (y[vt][2] + y[vt][3]);
        s += __shfl_xor(s, 16); s += __shfl_xor(s, 32);
        const float mean = s * (1.0f / 64.0f); float q = 0.f;
#pragma unroll
        for (int vt = 0; vt < 4; ++vt)
#pragma unroll
            for (int r = 0; r < 4; ++r) { const float d = y[vt][r] - mean; q += d * d; }
        q += __shfl_xor(q, 16); q += __shfl_xor(q, 32);
        const float rstd = rsqrtf(q * (1.0f / 64.0f) + 64e-5f); const float bon = BON[tg * RW_H + h];
#pragma unroll
        for (int vt = 0; vt < 4; ++vt) { const int chn = h * 64 + vt * 16 + 4 * q4;
            const v2u cur = *(const v2u*)(P + tg * NP + 2048 + chn); v2u prv = {0u, 0u}; if (!first) prv = *(const v2u*)(P + (tg - 1) * NP + 2048 + chn);
            const f32x4 cv = unpack4(cur), pv = unpack4(prv), m4 = *(const f32x4*)(mu + 2048 + chn), lg4 = *(const f32x4*)(lg + chn), lb4 = *(const f32x4*)(lb + chn);
            f32x4 o;
#pragma unroll
            for (int r = 0; r < 4; ++r) { const float vsh = cv[r] + (pv[r] - cv[r]) * m4[r]; o[r] = ((y[vt][r] - mean) * rstd * lg4[r] + lb4[r] + bon * vsh) * g[vt][r]; }
            *(v2u*)(OA + tg * OAB_LD + chn) = pack4(o); }
    }
}

__device__ __forceinline__ void phase_rwC2(const Args& a, LAS unsigned char* lds, int tid, int lane, int wave, int bid, int G, int& ci) {
    unsigned char* ws = a.ws; const bf16* P = (const bf16*)(ws + WS_P);
    const bf16* GY = (const bf16*)((const unsigned char*)a.out + RW_GY); const bf16* YS = (const bf16*)((const unsigned char*)a.out + RW_YS); const bf16* H0 = (const bf16*)(ws + WS_H0);
    const bf16* G2T = (const bf16*)(ws + WS_G2T); const float* BON = (const float*)(ws + WS_BONUS); const float* mu = a.in[3]; const float* lg = a.in[12]; const float* lb = a.in[13];
    bf16* OA = (bf16*)(ws + WS_OAB);
    constexpr int LG = 264;
    LAS bf16* G2L = (LAS bf16*)lds;
    const int q4 = lane >> 4, l16 = lane & 15; const int NGW = G * NWAVES; int cur_h = -1;
    LAS float* cscr = (LAS float*)(lds + 36864 + wave * 8704); bf16* WGUc = (bf16*)(ws + WS_WGU); const int gwc = bid * NWAVES + wave;
    for (int base = bid * NWAVES; base < 8192; base += NGW) {
        const int task = base + wave; const int u = task >> 2, tt = task & 3; const int b = u >> 9, h = (u >> 5) & 15, c = u & 31;
        const int hw = ((base >> 2) >> 5) & 15;
        if (hw != cur_h) { __syncthreads();
            for (int i = tid; i < 64 * 32; i += NTHR) { const int r = i >> 5, ck = i & 31; *(LAS v4u*)(G2L + r * LG + ck * 8) = *(const v4u*)(G2T + (size_t)(hw * 64 + r) * 256 + ck * 8); }
            cur_h = hw; __syncthreads(); }
        float tmpc[32], tmpd[32]; GuItem itc = gu_item(a, 0), itd = gu_item(a, 0); const bool hasc = (gwc + NGW * ci) < 32768, hasd = (gwc + NGW * (ci + 1)) < 32768;
        if (hasc) { itc = gu_item(a, gwc + NGW * ci); tr_load(tmpc, itc.W, 512, itc.k0, itc.n0, lane); }
        if (hasd) { itd = gu_item(a, gwc + NGW * (ci + 1)); tr_load(tmpd, itd.W, 512, itd.k0, itd.n0, lane); } ci += 2;
        if (task < 8192) {
        const int tl = tt * 16 + l16; const size_t tg = (size_t)b * SEQ + c * 64 + tl; const bool first = (c == 0 && tl == 0); const size_t tp = first ? tg : tg - 1;
        v4u xc[8], xp[8];
#pragma unroll
        for (int ks = 0; ks < 8; ++ks) { xc[ks] = *(const v4u*)(P + tg * NP + P_XG + ks * 32 + q4 * 8); xp[ks] = *(const v4u*)(P + tp * NP + P_XG + ks * 32 + q4 * 8); }
        const bf16x8 yf0 = *(const bf16x8*)(GY + (size_t)u * 4096 + tl * 64 + q4 * 8), yf1 = *(const bf16x8*)(GY + (size_t)u * 4096 + tl * 64 + 32 + q4 * 8);
        v2u ysv[4], vcur[4], vprv[4]; bf16x8 hf[4][2];
#pragma unroll
        for (int vt = 0; vt < 4; ++vt) { ysv[vt] = *(const v2u*)(YS + (size_t)u * 4096 + tl * 64 + vt * 16 + 4 * q4);
            const bf16* hp = H0 + (size_t)u * 4096 + (vt * 16 + l16) * 64 + q4 * 8; hf[vt][0] = *(const bf16x8*)hp; hf[vt][1] = *(const bf16x8*)(hp + 32);
            const int chn = h * 64 + vt * 16 + 4 * q4; vcur[vt] = *(const v2u*)(P + tg * NP + 2048 + chn); vprv[vt] = *(const v2u*)(P + tp * NP + 2048 + chn); }
        const float bon = BON[tg * RW_H + h];
        f32x4 y[4], g[4];
#pragma unroll
        for (int vt = 0; vt < 4; ++vt) { f32x4 acc = unpack4(ysv[vt]); acc = mfma16(hf[vt][0], yf0, acc); acc = mfma16(hf[vt][1], yf1, acc); y[vt] = acc; g[vt] = (f32x4){0.f, 0.f, 0.f, 0.f}; }
#pragma unroll
        for (int ks = 0; ks < 8; ++ks) { float cf[8], pf[8], x[8]; unpack8(xc[ks], cf); unpack8(xp[ks], pf);
            const f32x4 m0 = *(const f32x4*)(mu + P_XG + ks * 32 + q4 * 8), m1 = *(const f32x4*)(mu + P_XG + ks * 32 + q4 * 8 + 4);
#pragma unroll
            for (int j = 0; j < 8; ++j) { const float pj = first ? 0.f : pf[j]; x[j] = sigmoidf_(cf[j] + (pj - cf[j]) * (j < 4 ? m0[j] : m1[j - 4])); }
            const bf16x8 gf = __builtin_bit_cast(bf16x8, pack8(x));
#pragma unroll
            for (int vt = 0; vt < 4; ++vt) g[vt] = mfma16(*(const LAS bf16x8*)(G2L + (vt * 16 + l16) * LG + ks * 32 + q4 * 8), gf, g[vt]); }
        float s = 0.f;
#pragma unroll
        for (int vt = 0; vt < 4; ++vt) s += (y[vt][0] + y[vt][1]) + (y[vt][2] + y[vt][3]);
        s += __shfl_xor(s, 16); s += __shfl_xor(s, 32);
        const float mean = s * (1.0f / 64.0f); float q = 0.f;
#pragma unroll
        for (int vt = 0; vt < 4; ++vt)
#pragma unroll
            for (int r = 0; r < 4; ++r) { const float d = y[vt][r] - mean; q += d * d; }
        q += __shfl_xor(q, 16); q += __shfl_xor(q, 32);
        const float rstd = rsqrtf(q * (1.0f / 64.0f) + 64e-5f);
#pragma unroll
        for (int vt = 0; vt < 4; ++vt) { const int chn = h * 64 + vt * 16 + 4 * q4;
            const f32x4 cv = unpack4(vcur[vt]), pv = first ? (f32x4){0.f, 0.f, 0.f, 0.f} : unpack4(vprv[vt]), m4 = *(const f32x4*)(mu + 2048 + chn), lg4 = *(const f32x4*)(lg + chn), lb4 = *(const f32x4*)(lb + chn);
            f32x4 o;
#pragma unroll
            for (int r = 0; r < 4; ++r) { const float vsh = cv[r] + (pv[r] - cv[r]) * m4[r]; o[r] = ((y[vt][r] - mean) * rstd * lg4[r] + lb4[r] + bon * vsh) * g[vt][r]; }
            *(v2u*)(OA + tg * OAB_LD + chn) = pack4(o); }
        }
        if (hasc) tr_finish(tmpc, itc.k0, WGUc, 2048, itc.drow0, cscr, lane);
        if (hasd) tr_finish(tmpd, itd.k0, WGUc, 2048, itd.drow0, cscr, lane);
    }
}

constexpr size_t WS_WTG = 262144;
constexpr size_t WS_RS = WS_WTG + 393216;
static_assert(WS_RS + 32768 <= WS_ROT, "small tables fit below the rotary table");
__device__ __forceinline__ void phase_router2(const Args& a, LAS unsigned char* lds, int tid, int lane, int wave, int bid, int G) {
    unsigned char* ws = a.ws; const float* X1 = a.out; const float* WTG = (const float*)(ws + WS_WTG); float* RS = (float*)(ws + WS_RS);
    const float* bg = a.in[20]; const float* be = a.in[22]; const float* g2 = a.in[18]; bf16* H2 = (bf16*)(ws + WS_H2); int* LIST = (int*)(ws + WS_LIST); float* LRS = (float*)(ws + WS_LRS);
    unsigned* ctl = (unsigned*)(ws + WS_CTL); int* TE = (int*)(ws + WS_TOKE); float* TW = (float*)(ws + WS_TOKW); int* TP = (int*)(ws + WS_TOKP);
    LAS float* part = (LAS float*)lds;
    const int q4 = lane >> 4, l16 = lane & 15, tile = wave >> 2, kq = wave & 3;
    if (bid == 0) for (int i = tid; i < DM / 8; i += NTHR) ((v4u*)(H2 + (size_t)NTOK * DM))[i] = (v4u){0u, 0u, 0u, 0u};
    for (int tp = bid; tp < NTOK / 32; tp += G) {
        const int t0 = tp * 32 + tile * 16;
        __syncthreads();
        f32x4 acc[3] = {{0.f, 0.f, 0.f, 0.f}, {0.f, 0.f, 0.f, 0.f}, {0.f, 0.f, 0.f, 0.f}}; float ssq = 0.f;
        const float* xp = X1 + (size_t)(t0 + l16) * DM + kq * 512 + 4 * q4; const float* wp = WTG + (size_t)l16 * DM + kq * 512 + 4 * q4;
#pragma unroll 8
        for (int g = 0; g < 32; ++g) { const f32x4 xv = *(const f32x4*)(xp + 16 * g);
            const f32x4 w0 = *(const f32x4*)(wp + 16 * g), w1 = *(const f32x4*)(wp + 16 * DM + 16 * g), w2 = *(const f32x4*)(wp + 32 * DM + 16 * g);
            ssq += (xv[0] * xv[0] + xv[1] * xv[1]) + (xv[2] * xv[2] + xv[3] * xv[3]);
            { const f32x4 gv = *(const f32x4*)(g2 + kq * 512 + 4 * q4 + 16 * g); v2u hw; hw.x = cvt2(xv[0] * gv[0], xv[1] * gv[1]); hw.y = cvt2(xv[2] * gv[2], xv[3] * gv[3]);
              *(v2u*)(H2 + (size_t)(t0 + l16) * DM + kq * 512 + 4 * q4 + 16 * g) = hw; }
#pragma unroll
            for (int j = 0; j < 4; ++j) { acc[0] = __builtin_amdgcn_mfma_f32_16x16x4f32(w0[j], xv[j], acc[0], 0, 0, 0); acc[1] = __builtin_amdgcn_mfma_f32_16x16x4f32(w1[j], xv[j], acc[1], 0, 0, 0);
                acc[2] = __builtin_amdgcn_mfma_f32_16x16x4f32(w2[j], xv[j], acc[2], 0, 0, 0); } }
        ssq += __shfl_xor(ssq, 16); ssq += __shfl_xor(ssq, 32);
        LAS float* pr = part + ((tile * 4 + kq) * 16 + l16) * 52;
#pragma unroll
        for (int ot = 0; ot < 3; ++ot) *(LAS f32x4*)(pr + ot * 16 + 4 * q4) = acc[ot];
        if (q4 == 0) pr[48] = ssq;
        __syncthreads();
        if (tid < 32) { const int tl = tid >> 4, tk = tid & 15, t = tp * 32 + tl * 16 + tk;
            const LAS float* p0 = part + ((tl * 4 + 0) * 16 + tk) * 52; const int ks = 16 * 52;
            const float sq = (p0[48] + p0[ks + 48]) + (p0[2 * ks + 48] + p0[3 * ks + 48]); const float rs = rsqrtf(sq * (1.0f / DM) + 1e-6f);
            float gl[4];
#pragma unroll
            for (int q = 0; q < 4; ++q) gl[q] = ((p0[q] + p0[ks + q]) + (p0[2 * ks + q] + p0[3 * ks + q])) * rs + bg[q];
            int gs = 0; float gm = gl[0];
#pragma unroll
            for (int q = 1; q < 4; ++q) if (gl[q] > gm) { gm = gl[q]; gs = q; }
            float den = 0.f;
#pragma unroll
            for (int q = 0; q < 4; ++q) den += expf(gl[q] - gm);
            const float gwt = 1.0f / den;
            float el[8];
#pragma unroll
            for (int q = 0; q < 8; ++q) { const int o = 4 + gs * 8 + q; el[q] = ((p0[o] + p0[ks + o]) + (p0[2 * ks + o] + p0[3 * ks + o])) * rs + be[gs * 8 + q]; }
            int i0 = 0; float m0 = el[0];
#pragma unroll
            for (int q = 1; q < 8; ++q) if (el[q] > m0) { m0 = el[q]; i0 = q; }
            int i1 = -1; float m1 = -3.0e38f;
#pragma unroll
            for (int q = 0; q < 8; ++q) if (q != i0 && el[q] > m1) { m1 = el[q]; i1 = q; }
            const float e1 = expf(m1 - m0); const float w0 = gwt / (1.0f + e1), w1 = gwt * e1 / (1.0f + e1);
            const int ex0 = gs * 8 + i0, ex1 = gs * 8 + i1;
            const unsigned c0 = __hip_atomic_fetch_add(ctl + CW_CNT + ex0, 1u, RLX_AGENT), c1 = __hip_atomic_fetch_add(ctl + CW_CNT + ex1, 1u, RLX_AGENT);
            LIST[ex0 * LCAP + (int)c0] = t; LIST[ex1 * LCAP + (int)c1] = t; LRS[ex0 * LCAP + (int)c0] = rs; LRS[ex1 * LCAP + (int)c1] = rs; TE[2 * t] = ex0; TE[2 * t + 1] = ex1; TW[2 * t] = w0; TW[2 * t + 1] = w1; TP[2 * t] = (int)c0; TP[2 * t + 1] = (int)c1; RS[t] = rs; }
    }
}

__device__ __forceinline__ void moe_tables(const Args& a, LAS unsigned char* lds, int tid, int bid, bool zero_row) {
    unsigned char* ws = a.ws; unsigned* ctl = (unsigned*)(ws + WS_CTL); LAS unsigned* tab = (LAS unsigned*)(lds + MT_OFF);
    __syncthreads();
    if (tid < NEXP) tab[MT_CNT + tid] = __hip_atomic_load(ctl + CW_CNT + tid, RLX_AGENT);
    (void)zero_row; (void)bid;
    __syncthreads();
    if (tid <= NEXP) { unsigned acc = 0;
        for (int e = 0; e < tid; ++e) acc += ((tab[MT_CNT + e] + 255u) >> 8) * 256u;
        tab[MT_PS + tid] = acc;
        if (tid < NEXP) { const int c = (int)tab[MT_CNT + tid], tl = (c + 255) >> 8, nt0 = (int)(acc >> 8); for (int q = 0; q < tl; ++q) { tab[MT_TE + nt0 + q] = (unsigned)tid; const int rv = c - 256 * q; tab[MT_TV + nt0 + q] = (unsigned)(rv < 256 ? rv : 256); }
            const int hv = (tl > 0 && c - 256 * (tl - 1) <= 128) ? 1 : 0; tab[MT_HV + tid] = (unsigned)hv; tab[MT_FULL + tid] = (unsigned)(tl - hv); }
        else tab[MT_NT] = acc >> 8; }
    __syncthreads();
    if (tid < NEXP) { int pf = 0, ph = 0, tf = 0;
        for (int e = 0; e < NEXP; ++e) { const int f = (int)tab[MT_FULL + e]; tf += f; if (e < tid) { pf += f; ph += (int)tab[MT_HV + e]; } }
        const int nt0 = (int)(tab[MT_PS + tid] >> 8), f = (int)tab[MT_FULL + tid];
        for (int q = 0; q < f; ++q) tab[MT_TORD + pf + q] = (unsigned)(nt0 + q);
        if (tab[MT_HV + tid]) tab[MT_TORD + tf + ph] = (unsigned)(nt0 + f); }
    __syncthreads();
}

constexpr int NPHASE = 14;
__global__ void __launch_bounds__(NTHR, 2) mega_fwd(Args args) {
    extern __shared__ __attribute__((aligned(16))) unsigned char lds_raw[];
    LAS unsigned char* lds = (LAS unsigned char*)lds_raw;
    const int tid = threadIdx.x, lane = tid & 63, wave = __builtin_amdgcn_readfirstlane(tid >> 6), bid = blockIdx.x, G = gridDim.x;
    unsigned char* ws = args.ws; unsigned* ctl = (unsigned*)(ws + WS_CTL);
    volatile LAS unsigned* MISC = (volatile LAS unsigned*)(lds + MISC_OFF);
    for (int u = tid; u < (LDS_BYTES - RING_BYTES) / 4; u += NTHR) ((LAS unsigned*)(lds + RING_BYTES))[u] = 0u;
    __syncthreads();
    const int lo = args.ph_lo, hi = args.ph_hi;
    const bool multi = (hi - lo) > 1;
    XcdBarrier bar; bar.bar = ctl + CW_BAR; bar.x = 0; bar.st = nullptr;
    if (multi) bar = xcd_barrier_post(ctl + CW_BAR, MISC + 8);
#ifndef PH_MASK
#define PH_MASK 0x3fff
#endif
#define IN(k) (((PH_MASK >> (k)) & 1) && lo <= (k) && (k) < hi)
#define SEAM(k) do { if (IN(k) && IN((k) + 1)) xcd_barrier(bar); } while (0)
    bf16* P = (bf16*)(ws + WS_P);

#ifndef PH_REP
#define PH_REP 0
#endif
#define REP(k) ((PH_REP >> (k)) & 1)
#ifndef PROBE_T
#define PROBE_T -1
#endif
#define STAMP(k) do { if (PROBE_T >= 0 && bid == 0 && tid == 0) { const unsigned long long t_ = __builtin_amdgcn_s_memrealtime(); ctl[CW_TSTAMP + 2 * (k)] = (unsigned)t_; ctl[CW_TSTAMP + 2 * (k) + 1] = (unsigned)(t_ >> 32); } } while (0)
#define P0_BODY { phase_prologue(args, lds, tid, lane, wave, bid, G); }
#define P1_BODY { pg8::Gemm g{(const bf16*)(ws + WS_H1), (const bf16*)(ws + WS_WIN), NTOK, NP, DM}; RevColOrder S; S.init(NTOK, NP, G, bid); EpiP E{P}; pg8::gemm_phase<EpiP, RevColOrder, true, true>(lds, g, S, E); }
#define P2_BODY { phase_rwA(args, lds, tid, lane, wave, bid, G); }
#define P2PRE_BODY { phase_retpre(args, lds, tid, lane, wave, bid, G); }
#define P3_BODY { phase_ret3(args, lds, tid, lane, wave, bid, G); }
#define P4_BODY { phase_rwB(args, lane, wave, bid, G); phase_expconv_dn(args, lds, lane, wave, bid, G); }
#define P6_BODY { pg8::Gemm g{(const bf16*)(ws + WS_OAB), (const bf16*)(ws + WS_WUPAB), NTOK, DM, OAB_LD}; pg8::StaticOrder S; S.init(NTOK, DM, G, bid); EpiUpF E{(bf16*)(ws + WS_MERGED), P, 16}; pg8::gemm_phase<EpiUpF, pg8::StaticOrder, false, true>(lds, g, S, E); }
#define P8_BODY { pg8::Gemm g{(const bf16*)(ws + WS_MERGED), (const bf16*)(ws + WS_WOUT), NTOK, DM, DM}; pg8::StaticOrder S; S.init(NTOK, DM, G, bid); EpiX1 E{args.in[0], args.out}; pg8::gemm_phase<EpiX1, pg8::StaticOrder, false, true>(lds, g, S, E); }
#define MOE_TAB ((const LAS unsigned*)(lds + MT_OFF))
#define MOE_LIST ((const int*)(ws + WS_LIST))
#define MOE_SPLIT const int nt_ = (int)MOE_TAB[MT_NT], U_ = 4 * nt_, full_ = (U_ / G) * G, rest_ = U_ - full_, tdone_ = full_ / 4;
#define GEMM_GU(S_) { pg8::Gemm g{(const bf16*)(ws + WS_H2), (const bf16*)(ws + WS_WGU), MAXSLOT, NEXP * 1024, DM}; EpiGU E{(bf16*)(ws + WS_ACT), (const float*)(ws + WS_LRS), MOE_TAB}; pg8::gemm_phase<EpiGU, MoeOrder<4>, true, true, true, true>(lds, g, S_, E); }
#define GEMM_DN(S_) { pg8::Gemm g{(const bf16*)(ws + WS_ACT), (const bf16*)(ws + WS_WDN), MAXSLOT, NEXP * 2048, EFF}; EpiDn E{(bf16*)(ws + WS_YS)}; pg8::gemm_phase<EpiDn, MoeOrder<8>, true, true, false, true>(lds, g, S_, E); }
#define P11_BODY { MOE_SPLIT (void)rest_; (void)tdone_; MoeOrder<4> S; S.init(MOE_TAB, MOE_LIST, 0, full_, G, bid); GEMM_GU(S) }
#define P11B_BODY { MOE_SPLIT if (bid < rest_) { MoeOrder<4> S; S.init(MOE_TAB, MOE_LIST, full_, U_, G, bid); GEMM_GU(S) } else { MoeOrder<8> S; S.init(MOE_TAB, MOE_LIST, 0, 8 * tdone_, G - rest_, bid - rest_); GEMM_DN(S) } }
#define P12_BODY { MOE_SPLIT (void)rest_; (void)full_; MoeOrder<8> S; S.init(MOE_TAB, MOE_LIST, 8 * tdone_, 8 * nt_, G, bid); GEMM_DN(S) }
    STAMP(0); if (IN(0)) { P0_BODY if (REP(0)) { xcd_barrier(bar); P0_BODY } } SEAM(0);
    STAMP(1); if (IN(1)) { P1_BODY if (REP(1)) { xcd_barrier(bar); P1_BODY }
        { const int nun = (NTOK / 256) * (NP / 256), rem = nun % G;
          if (rem == 0) phase_conv_w3(args, lds, lane, wave, bid, G); else if (bid >= rem) phase_conv_w3(args, lds, lane, wave, bid - rem, G - rem); } } SEAM(1);
    STAMP(2); if (IN(2)) { P2PRE_BODY
        asm volatile("s_waitcnt vmcnt(0)" ::: "memory"); __syncthreads();
        if (tid == 0) __hip_atomic_fetch_add(ctl + CW_PRE, 1u, __ATOMIC_RELAXED, __HIP_MEMORY_SCOPE_AGENT);
        P2_BODY if (REP(2)) { P2_BODY } }
    STAMP(3); if (IN(3)) {
        if (tid == 0) { unsigned sp_ = 0; while (__hip_atomic_load(ctl + CW_PRE, __ATOMIC_RELAXED, __HIP_MEMORY_SCOPE_AGENT) < (unsigned)G) { __builtin_amdgcn_s_sleep(2); if (++sp_ > (1u << 22)) break; }
            __builtin_amdgcn_fence(__ATOMIC_ACQUIRE, "agent"); asm volatile("s_waitcnt vmcnt(0)" ::: "memory"); }
        __syncthreads();
        P3_BODY if (REP(3)) { P3_BODY } } SEAM(3);
    STAMP(4); if (IN(4)) { P4_BODY if (REP(4)) { xcd_barrier(bar); P4_BODY } } SEAM(4);
    STAMP(5); if (IN(5)) { int ci = 0;
        if ((G & 15) == 0) phase_rwC2(args, lds, tid, lane, wave, bid, G, ci); else phase_rwC(args, lane, wave, bid, G);
        phase_retpost(args, lds, lane, wave, bid, G, ci); } SEAM(5);
    STAMP(6); if (IN(6)) P6_BODY
    SEAM(6);
    STAMP(8); if (IN(8)) { P8_BODY if (REP(6)) { xcd_barrier(bar); P6_BODY xcd_barrier(bar); P8_BODY } } SEAM(8);
    STAMP(9); if (IN(9)) { phase_router2(args, lds, tid, lane, wave, bid, G); } SEAM(9);
    STAMP(11); if (IN(11)) { moe_tables(args, lds, tid, bid, true); P11_BODY xcd_barrier(bar); P11B_BODY }
    SEAM(11);
    STAMP(12); if (IN(12)) { if (!multi) moe_tables(args, lds, tid, bid, false); P12_BODY if (REP(10)) { xcd_barrier(bar); P11_BODY xcd_barrier(bar); P11B_BODY xcd_barrier(bar); P12_BODY } } SEAM(12);
    STAMP(13); if (IN(13)) { if (!multi) moe_tables(args, lds, tid, bid, false); phase_final(args, lds, lane, wave, bid, G); }
    if (PROBE_T >= 0) { const unsigned long long t0_ = ((unsigned long long)ctl[CW_TSTAMP + 2 * PROBE_T + 1] << 32) | ctl[CW_TSTAMP + 2 * PROBE_T], t1_ = ((unsigned long long)ctl[CW_TSTAMP + 2 * PROBE_T + 3] << 32) | ctl[CW_TSTAMP + 2 * PROBE_T + 2];
        const float d_ = (float)(t1_ - t0_) * (0.01f / 100.0f); __syncthreads(); for (int i = bid * NTHR + tid; i < 1024 * DM; i += G * NTHR) args.out[i] += d_; }
#undef IN
#undef SEAM
}

#ifndef MK_ONE_LAUNCH
#define MK_ONE_LAUNCH 1
#endif
extern "C" void kernel_launch(void* const* d_in, const int* in_sizes, int n_in, void* d_out, int out_size, void* d_ws, size_t ws_size, hipStream_t stream) {
    static int grid = 0;
    if (grid == 0) {
        if (n_in != 27 || out_size != NTOK * DM || ws_size < WS_END) { fprintf(stderr, "kernel_launch: unexpected shapes (n_in %d out %d ws %zu, need %zu)\n", n_in, out_size, ws_size, (size_t)WS_END); grid = -1; return; }
        int dev = 0, cus = 0, per_cu = 0;
        if (hipGetDevice(&dev) != hipSuccess || hipDeviceGetAttribute(&cus, hipDeviceAttributeMultiprocessorCount, dev) != hipSuccess) { grid = -1; return; }
        if (hipFuncSetAttribute((const void*)mega_fwd, hipFuncAttributeMaxDynamicSharedMemorySize, LDS_BYTES) != hipSuccess) { fprintf(stderr, "kernel_launch: hipFuncSetAttribute failed\n"); grid = -1; return; }
        if (hipOccupancyMaxActiveBlocksPerMultiprocessor(&per_cu, (const void*)mega_fwd, NTHR, LDS_BYTES) != hipSuccess || per_cu < 1) { fprintf(stderr, "kernel_launch: occupancy query says %d\n", per_cu); grid = -1; (void)hipGetLastError(); return; }
        grid = cus;
    }
    if (grid < 0) return;
    (void)in_sizes;
    if (hipMemsetAsync((char*)d_ws + WS_CTL, 0, CTL_ZERO_BYTES, stream) != hipSuccess) return;
    Args a{};
    for (int i = 0; i < 27; ++i) a.in[i] = (const float*)d_in[i];
    a.out = (float*)d_out; a.ws = (unsigned char*)d_ws;
#if MK_ONE_LAUNCH
    a.ph_lo = 0; a.ph_hi = NPHASE;
    hipLaunchKernelGGL(mega_fwd, dim3(grid), dim3(NTHR), LDS_BYTES, stream, a);
#else
    for (int p = 0; p < NPHASE; ++p) { a.ph_lo = p; a.ph_hi = p + 1; hipLaunchKernelGGL(mega_fwd, dim3(grid), dim3(NTHR), LDS_BYTES, stream, a); }
#endif
}
```

```cpp
#include <hip/hip_runtime.h>
#include <cstdio>
#include <cstdint>
namespace pg8 {
#define PG8_LAS __attribute__((address_space(3)))
typedef unsigned short bf16_t;
typedef short bf16x8 __attribute__((ext_vector_type(8)));
typedef float f32x4 __attribute__((ext_vector_type(4)));
typedef unsigned u32x4 __attribute__((ext_vector_type(4)));
constexpr int BM = 256, BK = 64, HALF = 128, HTB = HALF * BK * 2  , STAGE_BYTES = 8 * HTB, NXCD = 8, WGM = 8;

__host__ __device__ __forceinline__ int lds_byte(int r, int c) { const int st = (r >> 4) * 2 + (c >> 5), rr = r & 15, cc = c & 31, ob = rr * 64 + cc * 2; return st * 1024 + (ob ^ (((ob >> 9) & 1) << 5)); }
__host__ __device__ __forceinline__ void stage_rc(int b, int& R, int& C) { const int st = b / 1024, sb = b % 1024, swz = sb ^ (((sb >> 9) & 1) << 5); R = (st >> 1) * 16 + swz / 64; C = (st & 1) * 32 + (swz % 64) / 2; }
__host__ __device__ __forceinline__ int perm32(int rho) { const int n = rho >> 4, i = rho & 15; return 8 * (i >> 2) + 4 * n + (i & 3); }

struct Unit { int pm, pn; int hv; };
struct Gemm { const bf16_t* A; const bf16_t* Bt; int M, N, K; const int* rowmap = nullptr; };

struct StaticOrder {
    int nM, nN, nwg, G, c;
    __host__ __device__ void init(int M, int N, int G_, int c_) { nM = M / BM; nN = N / BM; nwg = nM * nN; G = G_; c = c_; }
    __host__ __device__ bool next(int i, Unit& u) const {
        const long L = (long)i * G + c; if (L >= nwg) return false;
        int wgid = (int)L; { const int q = nwg / NXCD, r = nwg % NXCD, xcd = wgid % NXCD, off = wgid / NXCD; wgid = (xcd < r ? xcd * (q + 1) : r * (q + 1) + (xcd - r) * q) + off; }
        const int nig = WGM * nN, gid = wgid / nig, fm = gid * WGM, gsz = (nM - fm) < WGM ? (nM - fm) : WGM;
        u.pm = fm + ((wgid % nig) % gsz); u.pn = (wgid % nig) / gsz; return true;
    }
    __device__ __forceinline__ void a_ready(const Unit&) const {}
    __device__ __forceinline__ void done(const Unit&) const {}
};

__device__ __forceinline__ unsigned cvt_pk_bf16(float lo, float hi) { unsigned r; asm volatile("v_cvt_pk_bf16_f32 %0, %1, %2" : "=v"(r) : "v"(lo), "v"(hi)); return r; }
typedef float f32x2 __attribute__((ext_vector_type(2)));
template <class Epi, class Sched, bool ALIGN_EPI = false, bool SP2 = false, bool GATHER = false, bool HSKIP = false>
__device__ __forceinline__ void gemm_phase(PG8_LAS unsigned char* lds, const Gemm g, const Sched& S, const Epi& E) {
    const int tid = threadIdx.x, wid = __builtin_amdgcn_readfirstlane(tid >> 6), lane = tid & 63, wr = wid >> 2, wc = wid & 3, fr = lane & 15, fq = lane >> 4;
    const int K = g.K, nt = K / BK;
    unsigned voffA[2], voffB[2];
#pragma unroll
    for (int i = 0; i < 2; ++i) { int R, C; stage_rc(tid * 16 + i * 8192, R, C); const int Rb = Epi::PERM ? ((R & ~31) + perm32(R & 31)) : R;
        voffA[i] = (unsigned)(R * K + C) * 2u; voffB[i] = (unsigned)(Rb * K + C) * 2u; }
    const size_t kstep = (size_t)(BK * 2);
    const size_t hstep = (size_t)HALF * K * 2;
    const size_t tstep = 2 * hstep;
    const unsigned ldsw = (unsigned)wid * 1024u;
    const int aoff = lds_byte(wr * 64 + fr, fq * 8), boff = lds_byte(wc * 32 + fr, fq * 8);
#define PG8_SA(b, h) (((b) * 2 + (h)) * HTB)
#define PG8_SB(b, h) ((4 + (b) * 2 + (h)) * HTB)
#define PG8_STAGE(bufoff, gbase, voff) do { _Pragma("unroll") for (int _i = 0; _i < 2; ++_i) \
        __builtin_amdgcn_global_load_lds((const unsigned*)((const char*)(gbase) + (voff)[_i]), (PG8_LAS unsigned*)(lds + (bufoff) + ldsw + _i * 8192), 16, 0, 0); } while (0)
#define PG8_LDA(dst, b, h) do { _Pragma("unroll") for (int m = 0; m < 4; ++m) _Pragma("unroll") for (int k = 0; k < 2; ++k) dst[m][k] = *(const PG8_LAS bf16x8*)(lds + PG8_SA(b, h) + aoff + m * 2048 + k * 1024); } while (0)
#define PG8_LDB(dst, b, h) do { _Pragma("unroll") for (int n = 0; n < 2; ++n) _Pragma("unroll") for (int k = 0; k < 2; ++k) dst[n][k] = *(const PG8_LAS bf16x8*)(lds + PG8_SB(b, h) + boff + n * 2048 + k * 1024); } while (0)
#define PG8_MMA(ai, bj, At, Bt) do { __builtin_amdgcn_s_setprio(1); _Pragma("unroll") for (int m = 0; m < 4; ++m) _Pragma("unroll") for (int n = 0; n < 2; ++n) _Pragma("unroll") for (int k = 0; k < 2; ++k) \
        acc[ai][bj][m][n] = __builtin_amdgcn_mfma_f32_16x16x32_bf16(Bt[n][k], At[m][k], acc[ai][bj][m][n], 0, 0, 0); __builtin_amdgcn_s_setprio(0); } while (0)
#define PG8_WAIT_V(n) asm volatile("s_waitcnt vmcnt(" #n ")" ::: "memory")
#define PG8_WAIT_L(n) asm volatile("s_waitcnt lgkmcnt(" #n ")" ::: "memory")
#define PG8_BAR __builtin_amdgcn_s_barrier()
#define PG8_SCHED __builtin_amdgcn_sched_barrier(0)
    Unit cur, nxt; int ui = 0;
    if (!S.next(0, cur)) return;
    unsigned gAc[2][2] = {{0u, 0u}, {0u, 0u}}, gAn[2][2] = {{0u, 0u}, {0u, 0u}};
    int gR[2], gC[2];
#pragma unroll
    for (int i = 0; i < 2; ++i) stage_rc(tid * 16 + i * 8192, gR[i], gC[i]);
#define PG8_GROWS(dst, un) do { _Pragma("unroll") for (int h_ = 0; h_ < 2; ++h_) _Pragma("unroll") for (int i_ = 0; i_ < 2; ++i_) \
        dst[h_][i_] = (unsigned)S.arow(un, h_ * HALF + gR[i_]) * (unsigned)(K * 2) + (unsigned)(gC[i_] * 2); } while (0)
#define PG8_STAGE_A(bufoff, base, h, nx) do { if constexpr (GATHER) { unsigned v_[2]; v_[0] = (nx) ? gAn[h][0] : gAc[h][0]; v_[1] = (nx) ? gAn[h][1] : gAc[h][1]; PG8_STAGE(bufoff, base, v_); } \
        else { PG8_STAGE(bufoff, (base) + (h) * hstep, voffA); } } while (0)
    if constexpr (GATHER) PG8_GROWS(gAc, cur);
    f32x4 acc[2][2][4][2];
#pragma unroll
    for (int a = 0; a < 2; ++a)
#pragma unroll
        for (int b = 0; b < 2; ++b)
#pragma unroll
            for (int m = 0; m < 4; ++m)
#pragma unroll
                for (int n = 0; n < 2; ++n) acc[a][b][m][n] = (f32x4){0.f, 0.f, 0.f, 0.f};
    bf16x8 At[4][2], B0[2][2], B1[2][2];
    const char* cA = (const char*)g.A + (GATHER ? (size_t)0 : (size_t)cur.pm * tstep); const char* cB = (const char*)g.Bt + (size_t)cur.pn * tstep;
    S.a_ready(cur);
    if constexpr (SP2) {
        PG8_STAGE(PG8_SB(0, 0), cB, voffB); PG8_STAGE(PG8_SB(0, 1), cB + hstep, voffB); PG8_STAGE_A(PG8_SA(0, 0), cA, 0, false); PG8_STAGE_A(PG8_SA(0, 1), cA, 1, false);
        if (wr == 1) PG8_BAR;
        PG8_WAIT_V(2); PG8_BAR;
        PG8_STAGE(PG8_SB(1, 0), cB + kstep, voffB); PG8_STAGE_A(PG8_SA(1, 0), cA + kstep, 0, false); PG8_STAGE(PG8_SB(1, 1), cB + hstep + kstep, voffB);
        PG8_WAIT_V(6); PG8_BAR;
    } else {
        PG8_STAGE(PG8_SB(0, 0), cB, voffB); PG8_STAGE_A(PG8_SA(0, 0), cA, 0, false); PG8_STAGE(PG8_SB(0, 1), cB + hstep, voffB); PG8_STAGE_A(PG8_SA(0, 1), cA, 1, false);
        if (wr == 1) PG8_BAR;
        PG8_WAIT_V(4); PG8_BAR;
        PG8_STAGE(PG8_SB(1, 0), cB + kstep, voffB); PG8_STAGE_A(PG8_SA(1, 0), cA + kstep, 0, false); PG8_STAGE(PG8_SB(1, 1), cB + hstep + kstep, voffB);
        PG8_WAIT_V(6); PG8_BAR;
    }
    for (;;) {
        const bool has_next = S.next(ui + 1, nxt);
        const char* nA = (has_next && !GATHER) ? (const char*)g.A + (size_t)nxt.pm * tstep : cA; const char* nB = has_next ? (const char*)g.Bt + (size_t)nxt.pn * tstep : cB;
        if constexpr (GATHER) { if (has_next) PG8_GROWS(gAn, nxt); else { gAn[0][0] = gAc[0][0]; gAn[0][1] = gAc[0][1]; gAn[1][0] = gAc[1][0]; gAn[1][1] = gAc[1][1]; } }
        for (int t = 0; t < nt; t += 2) {
            if constexpr (Epi::MID) { if (t == E.tmid) E.mid(acc, cur, wr, wc, fr, fq); }
            const bool last = (t == nt - 2);
            const char* a1 = cA + (size_t)(t + 1) * kstep;
            const char* a2 = last ? nA : cA + (size_t)(t + 2) * kstep; const char* b2 = last ? nB : cB + (size_t)(t + 2) * kstep;
            const char* a3 = a2 + kstep; const char* b3 = b2 + kstep;
            if (last && has_next) S.a_ready(nxt);
            if constexpr (SP2) {
            PG8_LDB(B0, 0, 0); PG8_LDB(B1, 0, 1); PG8_SCHED; PG8_LDA(At, 0, 0); PG8_STAGE_A(PG8_SA(1, 1), a1, 1, false);
            PG8_WAIT_V(8); PG8_WAIT_L(0); PG8_BAR; PG8_MMA(0, 0, At, B0); PG8_MMA(0, 1, At, B1); PG8_BAR; PG8_SCHED;
            if (!(HSKIP && cur.hv)) PG8_LDA(At, 0, 1); PG8_STAGE(PG8_SB(0, 0), b2, voffB); PG8_STAGE(PG8_SB(0, 1), b2 + hstep, voffB); PG8_STAGE_A(PG8_SA(0, 0), a2, 0, last);
            PG8_WAIT_V(8); PG8_WAIT_L(0); PG8_BAR; if (!(HSKIP && cur.hv)) { PG8_MMA(1, 0, At, B0); PG8_MMA(1, 1, At, B1); } PG8_BAR; PG8_SCHED;
            PG8_LDB(B0, 1, 0); PG8_LDB(B1, 1, 1); PG8_SCHED; PG8_LDA(At, 1, 0); PG8_STAGE_A(PG8_SA(0, 1), a2, 1, last);
            PG8_WAIT_V(8); PG8_WAIT_L(0); PG8_BAR; PG8_MMA(0, 0, At, B0); PG8_MMA(0, 1, At, B1); PG8_BAR; PG8_SCHED;
            if (!(HSKIP && cur.hv)) PG8_LDA(At, 1, 1); PG8_STAGE(PG8_SB(1, 0), b3, voffB); PG8_STAGE(PG8_SB(1, 1), b3 + hstep, voffB); PG8_STAGE_A(PG8_SA(1, 0), a3, 0, last);
            PG8_WAIT_V(8); PG8_WAIT_L(0); PG8_BAR; if (!(HSKIP && cur.hv)) { PG8_MMA(1, 0, At, B0); PG8_MMA(1, 1, At, B1); } PG8_BAR; PG8_SCHED;
            } else {
            PG8_LDB(B0, 0, 0); PG8_SCHED; PG8_LDA(At, 0, 0); PG8_STAGE_A(PG8_SA(1, 1), a1, 1, false);
            PG8_WAIT_L(8); PG8_BAR; PG8_WAIT_L(0); PG8_MMA(0, 0, At, B0); PG8_BAR; PG8_SCHED;
            PG8_LDB(B1, 0, 1); PG8_STAGE(PG8_SB(0, 0), b2, voffB);
            PG8_BAR; PG8_WAIT_L(0); PG8_MMA(0, 1, At, B1); PG8_BAR;
            PG8_LDA(At, 0, 1); PG8_STAGE_A(PG8_SA(0, 0), a2, 0, last);
            PG8_BAR; PG8_WAIT_L(0); PG8_MMA(1, 0, At, B0); PG8_BAR; PG8_SCHED;
            PG8_STAGE(PG8_SB(0, 1), b2 + hstep, voffB);
            PG8_WAIT_V(6); PG8_BAR; PG8_MMA(1, 1, At, B1); PG8_BAR;
            PG8_LDB(B0, 1, 0); PG8_SCHED; PG8_LDA(At, 1, 0); PG8_STAGE_A(PG8_SA(0, 1), a2, 1, last);
            PG8_WAIT_L(8); PG8_BAR; PG8_WAIT_L(0); PG8_MMA(0, 0, At, B0); PG8_BAR; PG8_SCHED;
            PG8_LDB(B1, 1, 1); PG8_STAGE(PG8_SB(1, 0), b3, voffB);
            PG8_BAR; PG8_WAIT_L(0); PG8_MMA(0, 1, At, B1); PG8_BAR;
            PG8_LDA(At, 1, 1); PG8_STAGE_A(PG8_SA(1, 0), a3, 0, last);
            PG8_BAR; PG8_WAIT_L(0); PG8_MMA(1, 0, At, B0); PG8_BAR; PG8_SCHED;
            PG8_STAGE(PG8_SB(1, 1), b3 + hstep, voffB);
            PG8_WAIT_V(6); PG8_BAR; PG8_MMA(1, 1, At, B1); PG8_BAR;
            }
        }
        if constexpr (ALIGN_EPI) { if (wr == 0) PG8_BAR; }
        if constexpr (!Epi::AFTER_DRAIN) { E(acc, cur, wr, wc, fr, fq); S.done(cur); }
        if (!has_next) break;
#pragma unroll
        for (int a = 0; a < 2; ++a)
#pragma unroll
            for (int b = 0; b < 2; ++b)
#pragma unroll
                for (int m = 0; m < 4; ++m)
#pragma unroll
                    for (int n = 0; n < 2; ++n) acc[a][b][m][n] = (f32x4){0.f, 0.f, 0.f, 0.f};
        cur = nxt; cA = nA; cB = nB; ++ui;
        if constexpr (GATHER) { gAc[0][0] = gAn[0][0]; gAc[0][1] = gAn[0][1]; gAc[1][0] = gAn[1][0]; gAc[1][1] = gAn[1][1]; }
        if constexpr (ALIGN_EPI) { if (wr == 1) PG8_BAR; }
    }
    PG8_WAIT_V(0);
    if constexpr (!ALIGN_EPI) { if (wr == 0) PG8_BAR; }
    PG8_BAR;
    if constexpr (Epi::AFTER_DRAIN) { E.fused(acc, cur, wr, wc, fr, fq, lds, wid, lane); S.done(cur); }
#undef PG8_SA
#undef PG8_SB
#undef PG8_STAGE
#undef PG8_STAGE_A
#undef PG8_GROWS
#undef PG8_LDA
#undef PG8_LDB
#undef PG8_MMA
#undef PG8_WAIT_V
#undef PG8_WAIT_L
#undef PG8_BAR
#undef PG8_SCHED
}
}

#define GAS __attribute__((address_space(1)))
#define LAS __attribute__((address_space(3)))
typedef unsigned short bf16;
typedef unsigned v4u __attribute__((ext_vector_type(4)));
typedef unsigned v2u __attribute__((ext_vector_type(2)));
typedef float f32x4 __attribute__((ext_vector_type(4)));
typedef GAS unsigned gu32;
#define RLX_AGENT __ATOMIC_RELAXED, __HIP_MEMORY_SCOPE_AGENT
#define LDS_WAIT() asm volatile("s_waitcnt lgkmcnt(0)" ::: "memory")
#define VM_WAIT() asm volatile("s_waitcnt vmcnt(0)" ::: "memory")

constexpr int NTOK = 8192, SEQ = 2048, DM = 2048, NP = 13824, NWAVES = 8, NTHR = 512;
constexpr int RW_W = 1024, RW_H = 16, RW_N = 64;
constexpr int P_XW = 3072, P_XA = 3168, P_XG = 3264;
constexpr int P_RQ = 3584, P_RK = 4608, P_RV = 5632, P_RG = 7680, P_GA = 9728, P_GB = 11776;
constexpr int RET_H = 8, RET_DK = 128, RET_DV = 256, RET_VW = 2048;
constexpr int NEXP = 32, EFF = 512, MAXT = 96, MAXSLOT = MAXT * 256;

constexpr size_t MiB = 1u << 20;
constexpr size_t WS_CTL = 0, CTL_ZERO_BYTES = 256 * 1024;
constexpr size_t WS_ROT = 1 * MiB;
constexpr size_t WS_TOKE = 2 * MiB;
constexpr size_t WS_TOKW = WS_TOKE + 65536;
constexpr size_t WS_TOKP = WS_TOKW + 65536;
constexpr size_t WS_TOKS = WS_TOKP + 65536;
constexpr size_t WS_BONUS = WS_TOKS + 65536;
constexpr size_t WS_WUPAB = 3 * MiB, WS_WOUT = 15 * MiB;
constexpr size_t WS_WGU = 23 * MiB, WS_WDN = 151 * MiB;
constexpr size_t WS_P = 215 * MiB;
constexpr size_t WS_RA = 431 * MiB;
constexpr size_t WS_WIN = WS_RA, WS_H1 = WS_RA + 54 * MiB;
constexpr size_t WS_OAB = WS_RA;
constexpr int OAB_LD = 3072;
constexpr size_t WS_RB = 517 * MiB;
constexpr size_t WS_RWE = WS_RB, WS_RWA = WS_RB + 16 * MiB, WS_RWB = WS_RB + 32 * MiB, WS_MERGED = WS_RB;
constexpr size_t WS_SCF = WS_RB + 32 * MiB;
constexpr size_t WS_END = 565 * MiB;
constexpr size_t WS_H2 = WS_P, WS_XG = WS_P + 32 * MiB, WS_LIST = WS_XG + 1 * MiB, WS_LRS = WS_XG + 2 * MiB, WS_YS = WS_XG + 3 * MiB, WS_ACT = WS_YS + 96 * MiB;
constexpr int LCAP = 8192;
constexpr size_t WS_SLOTTOK = WS_BONUS + 524288, WS_SLOTRS = WS_SLOTTOK + 98304;
static_assert(WS_SLOTRS + 98304 <= 3 * MiB, "slot tables fit below the converted weights");
constexpr int CW_BAR = 1024;
constexpr int CW_CNT = 8192;
constexpr int CW_NT = 8256;
constexpr int CW_TE = 8320;
constexpr int CW_PRE = 9024;
constexpr int CW_TV = 8768;
constexpr int CW_PS = 8448;
constexpr int CW_CONV3 = 8640, CW_CONVD = 8704;
constexpr int CW_TSTAMP = 8512;

constexpr int RING_BYTES = 131072, MISC_OFF = RING_BYTES + 320, LDS_BYTES = 147456;
constexpr int MT_OFF = RING_BYTES + 2048, MT_TE = 0, MT_TV = 96, MT_PS = 192, MT_CNT = 232, MT_NT = 264, MT_TORD = 272, MT_FULL = 368, MT_HV = 400;

struct Args { const float* in[27]; float* out; unsigned char* ws; int ph_lo, ph_hi; };

__device__ __forceinline__ float bf2f(unsigned short b) { return __uint_as_float(((unsigned)b) << 16); }
__device__ __forceinline__ float bflo(unsigned u) { return __uint_as_float(u << 16); }
__device__ __forceinline__ float bfhi(unsigned u) { return __uint_as_float(u & 0xffff0000u); }
__device__ __forceinline__ unsigned f2bf(float f) { unsigned u = __float_as_uint(f); return (u + 0x7fffu + ((u >> 16) & 1u)) >> 16; }

typedef __bf16 bf2_t __attribute__((ext_vector_type(2)));
typedef float f2_t __attribute__((ext_vector_type(2)));
__device__ __forceinline__ unsigned cvt2(float a, float b) { const f2_t v = {a, b}; const bf2_t r = __builtin_convertvector(v, bf2_t); return __builtin_bit_cast(unsigned, r); }
__device__ __forceinline__ unsigned pk2(float lo, float hi) { return cvt2(lo, hi); }
__device__ __forceinline__ float sigmoidf_(float x) { return __builtin_amdgcn_rcpf(1.0f + __expf(-x)); }
__device__ __forceinline__ float wave_sum(float v) {
#pragma unroll
    for (int o = 1; o < 64; o <<= 1) v += __shfl_xor(v, o);
    return v;
}

struct EpiP {
    static constexpr bool PERM = true, AFTER_DRAIN = false, MID = false;
    bf16* O;
    __device__ __forceinline__ void operator()(const pg8::f32x4 (&acc)[2][2][4][2], const pg8::Unit& u, int wr, int wc, int fr, int fq) const {
        const int row0 = u.pm * 256 + wr * 64 + fr, col0 = u.pn * 256 + wc * 32 + 8 * fq;
        const int mode = u.pn >= 38 ? 2 : (u.pn >= 30 ? 1 : 0);
#pragma unroll
        for (int ai = 0; ai < 2; ++ai)
#pragma unroll
            for (int m = 0; m < 4; ++m) { bf16* rowp = O + (size_t)(row0 + ai * 128 + m * 16) * NP + col0;
#pragma unroll
                for (int bj = 0; bj < 2; ++bj) { pg8::f32x4 v0 = acc[ai][bj][m][0], v1 = acc[ai][bj][m][1];
                    if (mode) {
#pragma unroll
                        for (int j = 0; j < 4; ++j) { const float s0 = sigmoidf_(v0[j]), s1 = sigmoidf_(v1[j]); v0[j] = mode == 2 ? s0 : v0[j] * s0; v1[j] = mode == 2 ? s1 : v1[j] * s1; } }
                    pg8::u32x4 w; w.x = pg8::cvt_pk_bf16(v0[0], v0[1]); w.y = pg8::cvt_pk_bf16(v0[2], v0[3]); w.z = pg8::cvt_pk_bf16(v1[0], v1[1]); w.w = pg8::cvt_pk_bf16(v1[2], v1[3]);
                    *(pg8::u32x4*)(rowp + bj * 128) = w; } }
    }
};
template <int MODE> struct EpiUp {
    static constexpr bool PERM = true, AFTER_DRAIN = false, MID = false;
    bf16* O; const bf16* P;
    __device__ __forceinline__ void operator()(const pg8::f32x4 (&acc)[2][2][4][2], const pg8::Unit& u, int wr, int wc, int fr, int fq) const {
        const int row0 = u.pm * 256 + wr * 64 + fr, col0 = u.pn * 256 + wc * 32 + 8 * fq;
#pragma unroll
        for (int ai = 0; ai < 2; ++ai)
#pragma unroll
            for (int m = 0; m < 4; ++m) { const int row = row0 + ai * 128 + m * 16; bf16* rowp = O + (size_t)row * DM + col0; const bf16* gp = P + (size_t)row * NP + (MODE ? P_GB : P_GA) + col0;
#pragma unroll
                for (int bj = 0; bj < 2; ++bj) { const pg8::f32x4 v0 = acc[ai][bj][m][0], v1 = acc[ai][bj][m][1];
                    const pg8::u32x4 g = *(const pg8::u32x4*)(gp + bj * 128);
                    float o[8] = { v0[0] * bflo(g.x), v0[1] * bfhi(g.x), v0[2] * bflo(g.y), v0[3] * bfhi(g.y), v1[0] * bflo(g.z), v1[1] * bfhi(g.z), v1[2] * bflo(g.w), v1[3] * bfhi(g.w) };
                    if (MODE) { const pg8::u32x4 p = *(const pg8::u32x4*)(rowp + bj * 128);
                        o[0] += bflo(p.x); o[1] += bfhi(p.x); o[2] += bflo(p.y); o[3] += bfhi(p.y); o[4] += bflo(p.z); o[5] += bfhi(p.z); o[6] += bflo(p.w); o[7] += bfhi(p.w); }
                    pg8::u32x4 w; w.x = pg8::cvt_pk_bf16(o[0], o[1]); w.y = pg8::cvt_pk_bf16(o[2], o[3]); w.z = pg8::cvt_pk_bf16(o[4], o[5]); w.w = pg8::cvt_pk_bf16(o[6], o[7]);
                    *(pg8::u32x4*)(rowp + bj * 128) = w; } }
    }
};
struct EpiUpF {
    static constexpr bool PERM = true, AFTER_DRAIN = false, MID = true;
    bf16* O; const bf16* P; int tmid;
    __device__ __forceinline__ void mid(pg8::f32x4 (&acc)[2][2][4][2], const pg8::Unit& u, int wr, int wc, int fr, int fq) const {
        unsigned off = (unsigned)(u.pm * 256 + wr * 64 + fr) * (unsigned)NP + (unsigned)(u.pn * 256 + wc * 32 + 8 * fq);
#pragma unroll
        for (int ai = 0; ai < 2; ++ai) {
#pragma unroll
            for (int m2 = 0; m2 < 2; ++m2) { pg8::u32x4 ga[2][2], gb[2][2];
#pragma unroll
                for (int mm = 0; mm < 2; ++mm) { const bf16* gp = P + off + (unsigned)mm * 16u * (unsigned)NP;
#pragma unroll
                    for (int bj = 0; bj < 2; ++bj) { ga[mm][bj] = *(const pg8::u32x4*)(gp + P_GA + bj * 128); gb[mm][bj] = *(const pg8::u32x4*)(gp + P_GB + bj * 128); } }
                __builtin_amdgcn_sched_barrier(0);
#pragma unroll
                for (int mm = 0; mm < 2; ++mm)
#pragma unroll
                    for (int bj = 0; bj < 2; ++bj) { const pg8::u32x4 a_ = ga[mm][bj], b_ = gb[mm][bj];
                        pg8::f32x4& v0 = acc[ai][bj][2 * m2 + mm][0]; pg8::f32x4& v1 = acc[ai][bj][2 * m2 + mm][1];
                        v0[0] *= bflo(a_.x) * __builtin_amdgcn_rcpf(bflo(b_.x)); v0[1] *= bfhi(a_.x) * __builtin_amdgcn_rcpf(bfhi(b_.x)); v0[2] *= bflo(a_.y) * __builtin_amdgcn_rcpf(bflo(b_.y)); v0[3] *= bfhi(a_.y) * __builtin_amdgcn_rcpf(bfhi(b_.y));
                        v1[0] *= bflo(a_.z) * __builtin_amdgcn_rcpf(bflo(b_.z)); v1[1] *= bfhi(a_.z) * __builtin_amdgcn_rcpf(bfhi(b_.z)); v1[2] *= bflo(a_.w) * __builtin_amdgcn_rcpf(bflo(b_.w)); v1[3] *= bfhi(a_.w) * __builtin_amdgcn_rcpf(bfhi(b_.w));
                        asm volatile("" : "+v"(v0), "+v"(v1) :: "memory"); }
                off += 32u * (unsigned)NP; asm volatile("" : "+v"(off)); }
            off += 64u * (unsigned)NP; asm volatile("" : "+v"(off)); }
    }
    __device__ __forceinline__ void operator()(const pg8::f32x4 (&acc)[2][2][4][2], const pg8::Unit& u, int wr, int wc, int fr, int fq) const {
        const int row0 = u.pm * 256 + wr * 64 + fr, col0 = u.pn * 256 + wc * 32 + 8 * fq;
#pragma unroll
        for (int ai = 0; ai < 2; ++ai)
#pragma unroll
            for (int m = 0; m < 4; ++m) { const int row = row0 + ai * 128 + m * 16; bf16* rowp = O + (size_t)row * DM + col0; const bf16* gp = P + (size_t)row * NP + P_GB + col0;
#pragma unroll
                for (int bj = 0; bj < 2; ++bj) { const pg8::f32x4 v0 = acc[ai][bj][m][0], v1 = acc[ai][bj][m][1];
                    const pg8::u32x4 g = *(const pg8::u32x4*)(gp + bj * 128);
                    pg8::u32x4 w; w.x = pg8::cvt_pk_bf16(v0[0] * bflo(g.x), v0[1] * bfhi(g.x)); w.y = pg8::cvt_pk_bf16(v0[2] * bflo(g.y), v0[3] * bfhi(g.y)); w.z = pg8::cvt_pk_bf16(v1[0] * bflo(g.z), v1[1] * bfhi(g.z)); w.w = pg8::cvt_pk_bf16(v1[2] * bflo(g.w), v1[3] * bfhi(g.w));
                    *(pg8::u32x4*)(rowp + bj * 128) = w; } }
    }
};
struct EpiX1 {
    static constexpr bool PERM = false, AFTER_DRAIN = false, MID = false;
    const float* X; float* O;
    __device__ __forceinline__ void operator()(const pg8::f32x4 (&acc)[2][2][4][2], const pg8::Unit& u, int wr, int wc, int fr, int fq) const {
        const int row0 = u.pm * 256 + wr * 64 + fr, col0 = u.pn * 256 + wc * 32 + 4 * fq;
#pragma unroll
        for (int ai = 0; ai < 2; ++ai)
#pragma unroll
            for (int m = 0; m < 4; ++m) { const size_t off = (size_t)(row0 + ai * 128 + m * 16) * DM + col0;
#pragma unroll
                for (int bj = 0; bj < 2; ++bj)
#pragma unroll
                    for (int n = 0; n < 2; ++n) { const pg8::f32x4 xv = __builtin_nontemporal_load((const pg8::f32x4*)(X + off + bj * 128 + n * 16)); *(pg8::f32x4*)(O + off + bj * 128 + n * 16) = xv + acc[ai][bj][m][n]; } }
    }
};
__device__ __forceinline__ int moe_row_token(const LAS unsigned* tab, const int* list, int pm, int r) {
    const int e = (int)tab[MT_TE + pm], pos = (pm - (int)(tab[MT_PS + e] >> 8)) * 256 + r;
    return pos < (int)tab[MT_CNT + e] ? list[e * LCAP + pos] : NTOK;
}
struct EpiGU {
    static constexpr bool PERM = true, AFTER_DRAIN = false, MID = false;
    bf16* O; const float* LRS; const LAS unsigned* tab;
    __device__ __forceinline__ void operator()(const pg8::f32x4 (&acc)[2][2][4][2], const pg8::Unit& u, int wr, int wc, int fr, int fq) const {
        const int row0 = u.pm * 256 + wr * 64 + fr, col0 = (u.pn & 3) * 128 + wc * 32 + 8 * fq;
        float rsr[2][4];
#pragma unroll
        for (int ai = 0; ai < 2; ++ai)
#pragma unroll
            for (int m = 0; m < 4; ++m) { const int e = (int)tab[MT_TE + u.pm], pos = (u.pm - (int)(tab[MT_PS + e] >> 8)) * 256 + wr * 64 + fr + ai * 128 + m * 16; rsr[ai][m] = pos < (int)tab[MT_CNT + e] ? LRS[e * LCAP + pos] : 0.f; }
#pragma unroll
        for (int ai = 0; ai < 2; ++ai)
#pragma unroll
            for (int m = 0; m < 4; ++m) { bf16* rowp = O + (size_t)(row0 + ai * 128 + m * 16) * EFF + col0; const float rs_ = rsr[ai][m];
                const pg8::f32x4 g0 = acc[ai][0][m][0] * rs_, g1 = acc[ai][0][m][1] * rs_, u0 = acc[ai][1][m][0] * rs_, u1 = acc[ai][1][m][1] * rs_;
                float o[8];
#pragma unroll
                for (int j = 0; j < 4; ++j) { o[j] = g0[j] * sigmoidf_(g0[j]) * u0[j]; o[4 + j] = g1[j] * sigmoidf_(g1[j]) * u1[j]; }
                pg8::u32x4 w; w.x = pg8::cvt_pk_bf16(o[0], o[1]); w.y = pg8::cvt_pk_bf16(o[2], o[3]); w.z = pg8::cvt_pk_bf16(o[4], o[5]); w.w = pg8::cvt_pk_bf16(o[6], o[7]);
                *(pg8::u32x4*)rowp = w; }
    }
};
struct EpiDn {
    static constexpr bool PERM = true, AFTER_DRAIN = false, MID = false;
    bf16* O;
    __device__ __forceinline__ void operator()(const pg8::f32x4 (&acc)[2][2][4][2], const pg8::Unit& u, int wr, int wc, int fr, int fq) const {
        const int row0 = u.pm * 256 + wr * 64 + fr, col0 = (u.pn & 7) * 256 + wc * 32 + 8 * fq;
#pragma unroll
        for (int ai = 0; ai < 2; ++ai)
#pragma unroll
            for (int m = 0; m < 4; ++m) { bf16* rowp = O + (size_t)(row0 + ai * 128 + m * 16) * DM + col0;
#pragma unroll
                for (int bj = 0; bj < 2; ++bj) { const pg8::f32x4 v0 = acc[ai][bj][m][0], v1 = acc[ai][bj][m][1];
                    pg8::u32x4 w; w.x = pg8::cvt_pk_bf16(v0[0], v0[1]); w.y = pg8::cvt_pk_bf16(v0[2], v0[3]); w.z = pg8::cvt_pk_bf16(v1[0], v1[1]); w.w = pg8::cvt_pk_bf16(v1[2], v1[3]);
                    *(pg8::u32x4*)(rowp + bj * 128) = w; } }
    }
};
struct RevColOrder : pg8::StaticOrder {
    __device__ __forceinline__ bool next(int i, pg8::Unit& u) const { if (!pg8::StaticOrder::next(i, u)) return false; u.pn = nN - 1 - u.pn; return true; }
};
template <int NB> struct MoeOrder {
    const LAS unsigned* tab; const int* list; int first, last, stride, c;
    __device__ __forceinline__ void init(const LAS unsigned* tab_, const int* list_, int first_, int last_, int stride_, int c_) { tab = tab_; list = list_; first = first_; last = last_; stride = stride_; c = c_; }
    __device__ __forceinline__ bool next(int i, pg8::Unit& u) const {
        if (c < 0 || stride <= 0) return false;
        const int L = first + c + i * stride; if (L >= last) return false;
        u.pm = (int)tab[MT_TORD + L / NB]; u.pn = (int)tab[MT_TE + u.pm] * NB + (L % NB); u.hv = tab[MT_TV + u.pm] <= 128u ? 1 : 0; return true;
    }
    __device__ __forceinline__ int arow(const pg8::Unit& u, int r) const { return moe_row_token(tab, list, u.pm, r); }
    __device__ __forceinline__ void a_ready(const pg8::Unit&) const {}
    __device__ __forceinline__ void done(const pg8::Unit&) const {}
};
#define XB_TMO      128
#define XB_XCNT(j)  (256  + 64 * (j))
#define XB_XSUB(j)  (1280 + 64 * (j))
#define XB_XGEN(j)  (2304 + 64 * (j))
#define XB_TOP      3328
#define XB_TOPGEN   3392
#define XCD_BAR_WORDS 3456
#define XB_SPIN_CAP (1u << 18)

__device__ __forceinline__ unsigned xb_ld(unsigned* p)              { return __hip_atomic_load(p, __ATOMIC_RELAXED, __HIP_MEMORY_SCOPE_AGENT); }
__device__ __forceinline__ unsigned xb_add(unsigned* p, unsigned v) { return __hip_atomic_fetch_add(p, v, __ATOMIC_RELAXED, __HIP_MEMORY_SCOPE_AGENT); }
__device__ __forceinline__ unsigned xb_xcc_id() { return (unsigned)__builtin_amdgcn_s_getreg((3 << 11) | 20) & 0xFu; }
#define XB_SPIN(cond, bar) do { unsigned _sp = 0; while (cond) { __builtin_amdgcn_s_sleep(1); \
    if ((++_sp & 255u) == 0u) { if (xb_ld(&(bar)[XB_TMO])) break; if (_sp > XB_SPIN_CAP) { atomicAdd(&(bar)[XB_TMO], 1u); break; } } } } while (0)

struct XcdBarrier {
    unsigned* bar; unsigned x;
    volatile LAS unsigned* st;
};

__device__ __forceinline__ XcdBarrier xcd_barrier_post(unsigned* bar, volatile LAS unsigned* st) {
    XcdBarrier b; b.bar = bar; b.x = xb_xcc_id(); b.st = st;
    if (threadIdx.x == 0) (void)xb_add(&bar[XB_XCNT(b.x)], 1u);
    return b;
}
__device__ __forceinline__ void xcd_barrier_complete(unsigned* bar, unsigned x, unsigned& nloc, unsigned& nx) {
    const unsigned G = gridDim.x * gridDim.y * gridDim.z;
    unsigned sum, cnt, mine, sp = 0u;
    for (;;) {
        sum = 0u; cnt = 0u; mine = 0u;
#pragma unroll
        for (unsigned j = 0; j < 16; ++j) { const unsigned c = xb_ld(&bar[XB_XCNT(j)]); sum += c; cnt += (c > 0u) ? 1u : 0u; mine = (j == x) ? c : mine; }
        if (sum == G) break;
        __builtin_amdgcn_s_sleep(1);
        if ((++sp & 255u) == 0u) { if (xb_ld(&bar[XB_TMO])) break; if (sp > XB_SPIN_CAP) { atomicAdd(&bar[XB_TMO], 1u); break; } }
    }
    nloc = mine > 0u ? mine : 1u; nx = cnt > 0u ? cnt : 1u;
}

__device__ __forceinline__ void xcd_barrier(const XcdBarrier& b) {
    asm volatile("s_waitcnt vmcnt(0)" ::: "memory");
    __syncthreads();
    if (threadIdx.x == 0) {
        unsigned* bar = b.bar;
        __builtin_amdgcn_s_waitcnt(0);
        unsigned nloc = b.st[0], nx = b.st[1];
        if (nloc == 0u) { xcd_barrier_complete(bar, b.x, nloc, nx); b.st[0] = nloc; b.st[1] = nx; }
        const unsigned old = xb_add(&bar[XB_XSUB(b.x)], 1u);
        const unsigned gen = old / nloc;
        if (old + 1u == (gen + 1u) * nloc) {
            __builtin_amdgcn_fence(__ATOMIC_RELEASE, "agent");
            asm volatile("s_waitcnt vmcnt(0)" ::: "memory");
            const unsigned og = xb_add(&bar[XB_TOP], 1u);
            const unsigned tg = og / nx;
            if (og + 1u == (tg + 1u) * nx) xb_add(&bar[XB_TOPGEN], 1u);
            else XB_SPIN(xb_ld(&bar[XB_TOPGEN]) == tg, bar);
            __builtin_amdgcn_fence(__ATOMIC_ACQUIRE, "agent");
            xb_add(&bar[XB_XGEN(b.x)], 1u);
            asm volatile("s_waitcnt vmcnt(0)" ::: "memory");
        } else {
            XB_SPIN(xb_ld(&bar[XB_XGEN(b.x)]) == gen, bar);
            __builtin_amdgcn_fence(__ATOMIC_ACQUIRE, "agent");
            asm volatile("s_waitcnt vmcnt(0)" ::: "memory");
        }
    }
    __syncthreads();
}

__device__ __forceinline__ void tr_load(float (&tmp)[32], const float* W, int ldw, int k0, int n0, int lane) {
#pragma unroll
    for (int i = 0; i < 32; ++i) tmp[i] = __builtin_nontemporal_load(W + (size_t)(k0 + 2 * i + (lane >> 5)) * ldw + n0 + (lane & 31));
}
__device__ __forceinline__ void tr_finish(const float (&tmp)[32], int k0, bf16* WT, int K, size_t drow0, LAS float* scr, int lane) {
#pragma unroll
    for (int i = 0; i < 32; ++i) scr[(2 * i + (lane >> 5)) * 33 + (lane & 31)] = tmp[i];
    LDS_WAIT(); asm volatile("" ::: "memory");
    const int c = lane & 7;
#pragma unroll
    for (int j = 0; j < 4; ++j) { const int n = (lane >> 3) + 8 * j; const LAS float* s = scr + (8 * c) * 33 + n;
        v4u o; o.x = pk2(s[0 * 33], s[1 * 33]); o.y = pk2(s[2 * 33], s[3 * 33]); o.z = pk2(s[4 * 33], s[5 * 33]); o.w = pk2(s[6 * 33], s[7 * 33]);
        *(v4u*)(WT + (drow0 + n) * (size_t)K + k0 + 8 * c) = o; }
    LDS_WAIT(); asm volatile("" ::: "memory");
}
__device__ __forceinline__ void tr_item(const float* W, int ldw, int k0, int n0, bf16* WT, int K, size_t drow0, LAS float* scr, int lane) {
    float tmp[32]; tr_load(tmp, W, ldw, k0, n0, lane); tr_finish(tmp, k0, WT, K, drow0, scr, lane);
}
struct GuItem { const float* W; int k0, n0; size_t drow0; };
__device__ __forceinline__ GuItem gu_item(const Args& a, int r) {
    constexpr int I_EG = 32 * 32 * 16; const int half = r / I_EG, q = r % I_EG, e = q / 512, kb = (q % 512) / 16, nb = q % 16, n0 = nb * 32;
    GuItem it; it.W = (half ? a.in[24] : a.in[23]) + (size_t)e * 2048 * 512; it.k0 = kb * 64; it.n0 = n0; it.drow0 = (size_t)e * 1024 + (n0 >> 7) * 256 + half * 128 + (n0 & 127); return it;
}
__device__ __forceinline__ void phase_prologue(const Args& a, LAS unsigned char* lds, int tid, int lane, int wave, int bid, int G) {
    unsigned char* ws = a.ws;
    LAS float* scr = (LAS float*)(lds + wave * 16384);
    const int gw = bid * NWAVES + wave, NGW = G * NWAVES;
    constexpr int I_IN = 32 * 430, I_UA = 16 * 64, I_UB = 32 * 64, I_WO = 32 * 64, I_EG = 32 * 32 * 16, I_ED = 32 * 8 * 64;
    constexpr int NITEMS = I_IN; (void)I_UA; (void)I_UB; (void)I_WO;
    for (int it = gw; it < NITEMS; it += NGW) {
        int r = it;
        if (r < I_IN) { const int kb = r / 430, nb = r % 430, n0 = nb * 32; tr_item(a.in[2], 13760, kb * 64, n0, (bf16*)(ws + WS_WIN), 2048, (size_t)(n0 + (n0 >= 3520 ? 64 : 0)), scr, lane); continue; } r -= I_IN;
        (void)I_EG; (void)I_ED; break;
    }
    { v4u* z = (v4u*)(ws + WS_WIN + (size_t)3520 * 2048 * 2); const int n16 = 64 * 2048 * 2 / 16;
      for (int i = bid * NTHR + tid; i < n16; i += G * NTHR) z[i] = (v4u){0u, 0u, 0u, 0u}; }
    { bf16* W2T = (bf16*)(ws + WS_RB + 16 * MiB); bf16* A2T = W2T + 1024 * 96; bf16* G2T = A2T + 1024 * 96;
      for (int i = bid * NTHR + tid; i < 1024 * 96; i += G * NTHR) { const int ch = i / 96, j = i % 96; W2T[i] = (bf16)f2bf(a.in[5][j * 1024 + ch]); A2T[i] = (bf16)f2bf(a.in[7][j * 1024 + ch]); }
      for (int i = bid * NTHR + tid; i < 1024 * 256; i += G * NTHR) { const int ch = i >> 8, j = i & 255; G2T[i] = (bf16)f2bf(a.in[8][j * 1024 + ch]); } }
    { float* WTG = (float*)(ws + 262144); const float* g2n = a.in[18];
      for (int i = bid * NTHR + tid; i < 48 * DM; i += G * NTHR) { const int o = i >> 11, d = i & (DM - 1);
          float w = 0.f; if (o < 4) w = a.in[19][d * 4 + o]; else if (o < 36) w = a.in[21][d * 32 + (o - 4)];
          WTG[i] = w * g2n[d]; } }
    { float2* rot = (float2*)(ws + WS_ROT);
      for (int i = bid * NTHR + tid; i < SEQ * 64; i += G * NTHR) { const int pos = i >> 6, d = i & 63;
          const float inv = exp2f(-(float)d * (13.287712379549449f / 64.0f)); const float ang = (float)pos * inv;
          double rev = (double)ang * 0.15915494309189535; rev -= __builtin_rint(rev); const float rf = (float)rev;
          rot[i] = make_float2(__builtin_amdgcn_cosf(rf), __builtin_amdgcn_sinf(rf)); } }
    { const float* g1 = a.in[1]; bf16* H1 = (bf16*)(ws + WS_H1);
      for (int m = gw; m < NTOK; m += NGW) { const f32x4* xr = (const f32x4*)(a.in[0] + (size_t)m * DM) + lane; f32x4 v[8]; float s = 0.f;
#pragma unroll
          for (int j = 0; j < 8; ++j) { v[j] = __builtin_nontemporal_load(xr + 64 * j); s += (v[j].x * v[j].x + v[j].y * v[j].y) + (v[j].z * v[j].z + v[j].w * v[j].w); }
          const float rs = rsqrtf(wave_sum(s) * (1.0f / DM) + 1e-6f);
          v2u* o8 = (v2u*)(H1 + (size_t)m * DM) + lane;
#pragma unroll
          for (int j = 0; j < 8; ++j) { const f32x4 g = ((const f32x4*)g1)[64 * j + lane]; v2u o; o.x = pk2(v[j].x * rs * g.x, v[j].y * rs * g.y); o.y = pk2(v[j].z * rs * g.z, v[j].w * rs * g.w); o8[64 * j] = o; } } }
}

#ifndef DN_TAIL
#define DN_TAIL 1536
#endif
__device__ __forceinline__ void phase_conv_w3(const Args& a, LAS unsigned char* lds, int lane, int wave, int rank, int nconv) {
    unsigned char* ws = a.ws; LAS float* scr = (LAS float*)(lds + wave * 16384);
    for (int r = rank * NWAVES + wave; r < 5120; r += nconv * NWAVES) {
        if (r < 1024) { const int kb = r / 64, nb = r % 64; tr_item(a.in[15], 2048, kb * 64, nb * 32, (bf16*)(ws + WS_WUPAB), 3072, (size_t)(nb * 32), scr, lane); }
        else if (r < 3072) { const int q = r - 1024, kb = q / 64, nb = q % 64; tr_item(a.in[16], 2048, kb * 64, nb * 32, (bf16*)(ws + WS_WUPAB) + 1024, 3072, (size_t)(nb * 32), scr, lane); }
        else { const int q = r - 3072, kb = q / 64, nb = q % 64; tr_item(a.in[17], 2048, kb * 64, nb * 32, (bf16*)(ws + WS_WOUT), 2048, (size_t)(nb * 32), scr, lane); } }
    for (int r = rank * NWAVES + wave; r < DN_TAIL; r += nconv * NWAVES) { const int e = r / 512, kb = (r % 512) / 64, nb = r % 64; const float* W = a.in[25] + (size_t)e * 512 * 2048;
        tr_item(W, 2048, kb * 64, nb * 32, (bf16*)(ws + WS_WDN), 512, (size_t)e * 2048 + nb * 32, scr, lane); }
}

__device__ __forceinline__ void phase_expconv_gu(const Args& a, LAS unsigned char* lds, int lane, int wave, int bid, int G) {
    unsigned char* ws = a.ws; LAS float* scr = (LAS float*)(lds + wave * 16384);
    const int gw = bid * NWAVES + wave, NGW = G * NWAVES; constexpr int I_EG = 32 * 32 * 16;
    for (int r = gw; r < 2 * I_EG; r += NGW) { const int half = r / I_EG; const int q = r % I_EG; const int e = q / 512, kb = (q % 512) / 16, nb = q % 16, n0 = nb * 32;
        const float* W = a.in[23 + half] + (size_t)e * 2048 * 512;
        tr_item(W, 512, kb * 64, n0, (bf16*)(ws + WS_WGU), 2048, (size_t)e * 1024 + (n0 >> 7) * 256 + half * 128 + (n0 & 127), scr, lane); }
}
__device__ __forceinline__ void phase_expconv_dn(const Args& a, LAS unsigned char* lds, int lane, int wave, int bid, int G) {
    unsigned char* ws = a.ws; LAS float* scr = (LAS float*)(lds + wave * 16384); LAS unsigned* ctr = (LAS unsigned*)(lds + LDS_BYTES - 64);
    constexpr int I_ED = 32 * 8 * 64;
    for (;;) { unsigned i = 0; if (lane == 0) i = __hip_atomic_fetch_add(ctr, 1u, __ATOMIC_RELAXED, __HIP_MEMORY_SCOPE_WORKGROUP);
        const int r = DN_TAIL + (int)__builtin_amdgcn_readfirstlane(i) * G + bid; if (r >= I_ED) break;
        const int e = r / 512, kb = (r % 512) / 64, nb = r % 64; const float* W = a.in[25] + (size_t)e * 512 * 2048;
        tr_item(W, 2048, kb * 64, nb * 32, (bf16*)(ws + WS_WDN), 512, (size_t)e * 2048 + nb * 32, scr, lane); }
}

__device__ __forceinline__ void phase_retpost(const Args& a, LAS unsigned char* lds, int lane, int wave, int bid, int G, int& ci) {
    unsigned char* ws = a.ws; const bf16* P = (const bf16*)(ws + WS_P);
    const int gw = bid * NWAVES + wave, NGW = G * NWAVES;
    bf16* OB = (bf16*)(ws + WS_OAB) + 1024; const float* ng = a.in[14];
    LAS float* cscr = (LAS float*)(lds + 36864 + wave * 8704); bf16* WGUc = (bf16*)(ws + WS_WGU);
    constexpr int NB = 8;
    for (int it0 = gw; it0 < NTOK * RET_H; it0 += NB * NGW) { v2u raw[NB], gr[NB];
        float tmpc[32], tmpd[32]; GuItem itc = gu_item(a, 0), itd = gu_item(a, 0); const bool hasc = (gw + NGW * ci) < 32768, hasd = (gw + NGW * (ci + 1)) < 32768;
        if (hasc) { itc = gu_item(a, gw + NGW * ci); tr_load(tmpc, itc.W, 512, itc.k0, itc.n0, lane); }
        if (hasd) { itd = gu_item(a, gw + NGW * (ci + 1)); tr_load(tmpd, itd.W, 512, itd.k0, itd.n0, lane); } ci += 2;
#pragma unroll
        for (int k = 0; k < NB; ++k) { const int it = it0 + k * NGW; if (it < NTOK * RET_H) { const int t = it >> 3, h = it & 7;
            raw[k] = __builtin_nontemporal_load((const v2u*)(OB + (size_t)t * OAB_LD + h * 256 + lane * 4)); gr[k] = __builtin_nontemporal_load((const v2u*)(P + (size_t)t * NP + P_RG + h * 256 + lane * 4)); } else { raw[k] = (v2u){0u, 0u}; gr[k] = (v2u){0u, 0u}; } }
#pragma unroll
        for (int k = 0; k < NB; ++k) { const int it = it0 + k * NGW; if (it < NTOK * RET_H) { const int t = it >> 3, h = it & 7;
            const float v0 = bflo(raw[k].x), v1 = bfhi(raw[k].x), v2 = bflo(raw[k].y), v3 = bfhi(raw[k].y);
            const float rs = rsqrtf(wave_sum((v0 * v0 + v1 * v1) + (v2 * v2 + v3 * v3)) * (1.0f / 256.0f) + 1e-6f);
            const f32x4 g = *(const f32x4*)(ng + h * 256 + lane * 4);
            v2u w; w.x = cvt2(v0 * rs * g.x * bflo(gr[k].x), v1 * rs * g.y * bfhi(gr[k].x)); w.y = cvt2(v2 * rs * g.z * bflo(gr[k].y), v3 * rs * g.w * bfhi(gr[k].y));
            *(v2u*)(OB + (size_t)t * OAB_LD + h * 256 + lane * 4) = w; } }
        if (hasc) tr_finish(tmpc, itc.k0, WGUc, 2048, itc.drow0, cscr, lane);
        if (hasd) tr_finish(tmpd, itd.k0, WGUc, 2048, itd.drow0, cscr, lane); }
    for (; gw + NGW * ci < 32768; ++ci) { const GuItem itc = gu_item(a, gw + NGW * ci); tr_item(itc.W, 512, itc.k0, itc.n0, WGUc, 2048, itc.drow0, cscr, lane); }
}

__device__ __forceinline__ void phase_router(const Args& a, int lane, int wave, int bid, int G) {
    unsigned char* ws = a.ws; const float* X1 = a.out; bf16* H2 = (bf16*)(ws + WS_H2);
    const float* g2 = a.in[18]; const float* wg = a.in[19]; const float* bg = a.in[20]; const float* we = a.in[21]; const float* be = a.in[22];
    unsigned* ctl = (unsigned*)(ws + WS_CTL); int* TE = (int*)(ws + WS_TOKE); float* TW = (float*)(ws + WS_TOKW); int* TP = (int*)(ws + WS_TOKP);
    const int gw = bid * NWAVES + wave, NGW = G * NWAVES;
    for (int t = gw; t < NTOK; t += NGW) {
        const f32x4* xr = (const f32x4*)(X1 + (size_t)t * DM) + lane; float s = 0.f;
#pragma unroll
        for (int j = 0; j < 8; ++j) { const f32x4 x = xr[64 * j]; s += (x.x * x.x + x.y * x.y) + (x.z * x.z + x.w * x.w); }
        const float rs = rsqrtf(wave_sum(s) * (1.0f / DM) + 1e-6f);
        float lgt[36];
#pragma unroll
        for (int q = 0; q < 36; ++q) lgt[q] = 0.f;
        v2u* o8 = (v2u*)(H2 + (size_t)t * DM) + lane;
#pragma unroll 1
        for (int j = 0; j < 8; ++j) { const f32x4 x = xr[64 * j]; const f32x4 g = ((const f32x4*)g2)[64 * j + lane]; const f32x4 hv = {x.x * rs * g.x, x.y * rs * g.y, x.z * rs * g.z, x.w * rs * g.w};
            v2u o; o.x = pk2(hv.x, hv.y); o.y = pk2(hv.z, hv.w); o8[64 * j] = o;
            const int col = 256 * j + 4 * lane;
#pragma unroll
            for (int c = 0; c < 4; ++c) { const float hc = hv[c]; const f32x4 w4 = *(const f32x4*)(wg + (size_t)(col + c) * 4);
                lgt[0] += hc * w4.x; lgt[1] += hc * w4.y; lgt[2] += hc * w4.z; lgt[3] += hc * w4.w;
#pragma unroll
                for (int q = 0; q < 8; ++q) { const f32x4 e4 = *(const f32x4*)(we + (size_t)(col + c) * 32 + 4 * q);
                    lgt[4 + 4 * q] += hc * e4.x; lgt[5 + 4 * q] += hc * e4.y; lgt[6 + 4 * q] += hc * e4.z; lgt[7 + 4 * q] += hc * e4.w; } }
            asm volatile("" ::: "memory"); }
#pragma unroll
        for (int q = 0; q < 36; ++q) lgt[q] = wave_sum(lgt[q]);
        float gl[4];
#pragma unroll
        for (int q = 0; q < 4; ++q) gl[q] = lgt[q] + bg[q];
        int gs = 0; float gm = gl[0];
#pragma unroll
        for (int q = 1; q < 4; ++q) if (gl[q] > gm) { gm = gl[q]; gs = q; }
        float den = 0.f;
#pragma unroll
        for (int q = 0; q < 4; ++q) den += expf(gl[q] - gm);
        const float gwt = 1.0f / den;
        float el[8];
#pragma unroll
        for (int q = 0; q < 8; ++q) { float x = 0.f;
#pragma unroll
            for (int gq = 0; gq < 4; ++gq) x = (gs == gq) ? lgt[4 + gq * 8 + q] + be[gq * 8 + q] : x;
            el[q] = x; }
        int i0 = 0; float m0 = el[0];
#pragma unroll
        for (int q = 1; q < 8; ++q) if (el[q] > m0) { m0 = el[q]; i0 = q; }
        int i1 = -1; float m1 = -3.0e38f;
#pragma unroll
        for (int q = 0; q < 8; ++q) if (q != i0 && el[q] > m1) { m1 = el[q]; i1 = q; }
        const float e1 = expf(m1 - m0); const float w0 = gwt / (1.0f + e1), w1 = gwt * e1 / (1.0f + e1);
        if (lane == 0) { const int ex0 = gs * 8 + i0, ex1 = gs * 8 + i1;
            const unsigned p0 = __hip_atomic_fetch_add(ctl + CW_CNT + ex0, 1u, RLX_AGENT), p1 = __hip_atomic_fetch_add(ctl + CW_CNT + ex1, 1u, RLX_AGENT);
            TE[2 * t] = ex0; TE[2 * t + 1] = ex1; TW[2 * t] = w0; TW[2 * t + 1] = w1; TP[2 * t] = (int)p0; TP[2 * t + 1] = (int)p1; }
    }
}

__device__ __forceinline__ void phase_gather(const Args& a, LAS unsigned char* lds, int tid, int lane, int wave, int bid, int G) {
    unsigned char* ws = a.ws; unsigned* ctl = (unsigned*)(ws + WS_CTL); const bf16* H2 = (const bf16*)(ws + WS_H2); bf16* XG = (bf16*)(ws + WS_XG);
    const int* TE = (const int*)(ws + WS_TOKE); const int* TP = (const int*)(ws + WS_TOKP); int* TS = (int*)(ws + WS_TOKS);
    LAS int* ps = (LAS int*)lds;
    __syncthreads();
    if (tid == 0) { int acc = 0, nt = 0;
        for (int e = 0; e < NEXP; ++e) { const int c = (int)__hip_atomic_load(ctl + CW_CNT + e, RLX_AGENT); ps[e] = acc; ps[64 + e] = c; const int tl = (c + 255) >> 8;
            if (bid == 0) for (int q = 0; q < tl; ++q) ctl[CW_TE + nt + q] = (unsigned)e;
            nt += tl; acc += tl * 256; }
        ps[32] = acc; if (bid == 0) ctl[CW_NT] = (unsigned)nt; }
    __syncthreads();
    const int gw = bid * NWAVES + wave, NGW = G * NWAVES;
    for (int it = gw; it < NTOK * 2; it += NGW) { const int t = it >> 1; const int e = TE[it]; const int slot = ps[e] + TP[it];
        const v4u* src = (const v4u*)(H2 + (size_t)t * DM) + lane; v4u* dst = (v4u*)(XG + (size_t)slot * DM) + lane;
#pragma unroll
        for (int j = 0; j < 4; ++j) dst[64 * j] = src[64 * j];
        if (lane == 0) TS[it] = slot; }
    for (int e = 0; e < NEXP; ++e) { const int c = ps[64 + e], base = ps[e] + c, npad = ps[e + 1] - base;
        for (int r = gw; r < npad; r += NGW) { v4u* dst = (v4u*)(XG + (size_t)(base + r) * DM) + lane;
#pragma unroll
            for (int j = 0; j < 4; ++j) dst[64 * j] = (v4u){0u, 0u, 0u, 0u}; } }
}

__device__ __forceinline__ void phase_final(const Args& a, LAS unsigned char* lds, int lane, int wave, int bid, int G) {
    unsigned char* ws = a.ws; float* X1 = a.out; const bf16* YS = (const bf16*)(ws + WS_YS); const int* TE = (const int*)(ws + WS_TOKE); const int* TP = (const int*)(ws + WS_TOKP); const LAS unsigned* tab = (const LAS unsigned*)(lds + MT_OFF); const float* TW = (const float*)(ws + WS_TOKW); const float* fg = a.in[26];
    const int gw = bid * NWAVES + wave, NGW = G * NWAVES;
    for (int tb = gw; tb < NTOK; tb += 4 * NGW) {
        int sl0[4], sl1[4]; float w0[4], w1[4];
#pragma unroll
        for (int i = 0; i < 4; ++i) { const int t = (tb + i * NGW < NTOK) ? tb + i * NGW : tb; sl0[i] = (int)tab[MT_PS + TE[2 * t]] + TP[2 * t]; sl1[i] = (int)tab[MT_PS + TE[2 * t + 1]] + TP[2 * t + 1]; w0[i] = TW[2 * t]; w1[i] = TW[2 * t + 1]; }
        f32x4 xa[8], xb[8]; v2u ya0[8], ya1[8], yb0[8], yb1[8];
#define FIN_LOAD(i_, xv_, y0_, y1_) do { const int t_ = (tb + (i_) * NGW < NTOK) ? tb + (i_) * NGW : tb; const f32x4* xr_ = (const f32x4*)(X1 + (size_t)t_ * DM) + lane; \
            const v2u* p0_ = (const v2u*)(YS + (size_t)sl0[i_] * DM) + lane; const v2u* p1_ = (const v2u*)(YS + (size_t)sl1[i_] * DM) + lane; \
            _Pragma("unroll") for (int j = 0; j < 8; ++j) { xv_[j] = __builtin_nontemporal_load(xr_ + 64 * j); y0_[j] = __builtin_nontemporal_load(p0_ + 64 * j); y1_[j] = __builtin_nontemporal_load(p1_ + 64 * j); } } while (0)
#define FIN_DO(i_, xv_, y0_, y1_) do { const int t_ = tb + (i_) * NGW; float s_ = 0.f; f32x4 v_[8]; \
            _Pragma("unroll") for (int j = 0; j < 8; ++j) { const f32x4 x = xv_[j]; const v2u a0 = y0_[j], a1 = y1_[j]; \
                v_[j].x = x.x + w0[i_] * bflo(a0.x) + w1[i_] * bflo(a1.x); v_[j].y = x.y + w0[i_] * bfhi(a0.x) + w1[i_] * bfhi(a1.x); v_[j].z = x.z + w0[i_] * bflo(a0.y) + w1[i_] * bflo(a1.y); v_[j].w = x.w + w0[i_] * bfhi(a0.y) + w1[i_] * bfhi(a1.y); \
                s_ += (v_[j].x * v_[j].x + v_[j].y * v_[j].y) + (v_[j].z * v_[j].z + v_[j].w * v_[j].w); } \
            __builtin_amdgcn_sched_barrier(0); \
            if ((i_) + 2 < 4) FIN_LOAD((i_) + 2 < 4 ? (i_) + 2 : 0, xv_, y0_, y1_); \
            __builtin_amdgcn_sched_barrier(0); \
            if (t_ < NTOK) { const float rs_ = rsqrtf(wave_sum(s_) * (1.0f / DM) + 1e-6f); f32x4* xo_ = (f32x4*)(X1 + (size_t)t_ * DM) + lane; \
                _Pragma("unroll") for (int j = 0; j < 8; ++j) { const f32x4 g = ((const f32x4*)fg)[64 * j + lane]; __builtin_nontemporal_store((f32x4){v_[j].x * rs_ * g.x, v_[j].y * rs_ * g.y, v_[j].z * rs_ * g.z, v_[j].w * rs_ * g.w}, xo_ + 64 * j); } } } while (0)
        FIN_LOAD(0, xa, ya0, ya1); FIN_LOAD(1, xb, yb0, yb1);
        FIN_DO(0, xa, ya0, ya1); FIN_DO(1, xb, yb0, yb1); FIN_DO(2, xa, ya0, ya1); FIN_DO(3, xb, yb0, yb1);
#undef FIN_LOAD
#undef FIN_DO
    }
}

#define LDS_BARRIER() do { asm volatile("s_waitcnt lgkmcnt(0)" ::: "memory"); __builtin_amdgcn_s_barrier(); asm volatile("" ::: "memory"); } while (0)
typedef short bf16x8 __attribute__((ext_vector_type(8)));
__device__ __forceinline__ f32x4 mfma16(bf16x8 xa, bf16x8 yb, f32x4 c) { return __builtin_amdgcn_mfma_f32_16x16x32_bf16(xa, yb, c, 0, 0, 0); }
__device__ __forceinline__ bf16x8 ldfrag(const LAS bf16* img, int ld, int row0, int k0, int lane) { return *(const LAS bf16x8*)(img + (row0 + (lane & 15)) * ld + k0 + (lane >> 4) * 8); }
typedef short s16x4 __attribute__((ext_vector_type(4)));
__device__ __forceinline__ bf16x8 ldfrag_tr(const LAS bf16* img, int ld, int k0, int c0, int lane) {
    const int q = lane >> 4, i = lane & 15;
    LAS bf16* p = (LAS bf16*)img + (k0 + 8 * q + (i >> 2)) * ld + c0 + 4 * (i & 3);
    const s16x4 lo = __builtin_amdgcn_ds_read_tr16_b64_v4i16((LAS s16x4*)p);
    const s16x4 hi = __builtin_amdgcn_ds_read_tr16_b64_v4i16((LAS s16x4*)(p + 4 * ld));
    return __builtin_shufflevector(lo, hi, 0, 1, 2, 3, 4, 5, 6, 7);
}
__device__ __forceinline__ void unpack8(const v4u& p, float (&f)[8]) { f[0] = bflo(p.x); f[1] = bfhi(p.x); f[2] = bflo(p.y); f[3] = bfhi(p.y); f[4] = bflo(p.z); f[5] = bfhi(p.z); f[6] = bflo(p.w); f[7] = bfhi(p.w); }

__device__ __forceinline__ v2u pack4(f32x4 v) { v2u w; w.x = cvt2(v[0], v[1]); w.y = cvt2(v[2], v[3]); return w; }
__device__ __forceinline__ v4u pack8(const float (&f)[8]) { v4u w; w.x = cvt2(f[0], f[1]); w.y = cvt2(f[2], f[3]); w.z = cvt2(f[4], f[5]); w.w = cvt2(f[6], f[7]); return w; }
__device__ __forceinline__ void phase_retpre(const Args& a, LAS unsigned char* lds, int tid, int lane, int wave, int bid, int G) {
    unsigned char* ws = a.ws; bf16* P = (bf16*)(ws + WS_P); const float* rot = (const float*)(ws + WS_ROT); v4u* SCF = (v4u*)(ws + WS_SCF);
    constexpr int LQ = 136;
    const __amdgpu_buffer_rsrc_t rsP = __builtin_amdgcn_make_buffer_rsrc((void*)P, 0, (int)((size_t)NTOK * NP * 2), 0x00020000), rsS = __builtin_amdgcn_make_buffer_rsrc((void*)SCF, 0, 8 << 20, 0x00020000);
    LAS bf16* Qs = (LAS bf16*)lds;
    LAS bf16* Ks = Qs + 64 * LQ;
    LAS float* gp = (LAS float*)(Ks + 64 * LQ);
    const int q4 = lane >> 4, l16 = lane & 15;
    const int si = tid >> 3, d0 = (tid & 7) * 8;
    const int oi0 = (wave >> 1) * 16, s2 = wave & 1;
    int cur_h = -1, cur_pos = -1; float rc[8], rsn[8];
    v4u nqlo = {0u, 0u, 0u, 0u}, nqhi = nqlo, nklo = nqlo, nkhi = nqlo;
#define RPRE_LOAD(u_) do { const int n_ = (u_) & 31, h_ = ((u_) >> 5) & 7, b_ = (u_) >> 8; const bf16* pr_ = P + (size_t)(b_ * SEQ + n_ * 64 + si) * NP; \
        nqlo = *(const v4u*)(pr_ + P_RQ + h_ * 128 + d0); nqhi = *(const v4u*)(pr_ + P_RQ + h_ * 128 + 64 + d0); nklo = *(const v4u*)(pr_ + P_RK + h_ * 128 + d0); nkhi = *(const v4u*)(pr_ + P_RK + h_ * 128 + 64 + d0); } while (0)
    if (bid < 1024) RPRE_LOAD(bid);
    for (int u = bid; u < 1024; u += G) { const int n = u & 31, h = (u >> 5) & 7, b = u >> 8;
        __syncthreads();
        if (h != cur_h) { const float lg = log1pf(-exp2f(-5.0f - (float)h)); if (tid < 65) gp[tid] = expf((float)tid * lg); cur_h = h; }
        if (n * 64 + si != cur_pos) { const float* r0 = rot + ((size_t)(n * 64 + si) * 64 + d0) * 2; cur_pos = n * 64 + si;
#pragma unroll
          for (int c_ = 0; c_ < 4; ++c_) { const f32x4 t0 = *(const f32x4*)(r0 + c_ * 4); rc[2 * c_] = t0[0]; rsn[2 * c_] = t0[1]; rc[2 * c_ + 1] = t0[2]; rsn[2 * c_ + 1] = t0[3]; } }
        const v4u qlo = nqlo, qhi = nqhi, klo = nklo, khi = nkhi;
        { const int un = (u + G < 1024) ? u + G : u; RPRE_LOAD(un); }
        float ql[8], qh[8], kl[8], kh[8]; unpack8(qlo, ql); unpack8(qhi, qh); unpack8(klo, kl); unpack8(khi, kh);
        float oql[8], oqh[8], okl[8], okh[8];
#pragma unroll
        for (int j = 0; j < 8; ++j) { const float c = rc[j], s = rsn[j];
            oql[j] = ql[j] * c - qh[j] * s; oqh[j] = ql[j] * s + qh[j] * c;
            okl[j] = (kl[j] * c - kh[j] * s) * 0.08838834764831845f; okh[j] = (kl[j] * s + kh[j] * c) * 0.08838834764831845f; }
        const v4u wql = pack8(oql), wqh = pack8(oqh), wkl = pack8(okl), wkh = pack8(okh);
        { const unsigned ob = (unsigned)(((size_t)(b * SEQ + n * 64 + si) * NP + h * 128 + d0) * 2);
          __builtin_amdgcn_raw_buffer_store_b128(wql, rsP, ob + P_RQ * 2, 0, 16); __builtin_amdgcn_raw_buffer_store_b128(wqh, rsP, ob + (P_RQ + 64) * 2, 0, 16);
          __builtin_amdgcn_raw_buffer_store_b128(wkl, rsP, ob + P_RK * 2, 0, 16); __builtin_amdgcn_raw_buffer_store_b128(wkh, rsP, ob + (P_RK + 64) * 2, 0, 16); }
        *(LAS v4u*)(Qs + si * LQ + d0) = wql; *(LAS v4u*)(Qs + si * LQ + 64 + d0) = wqh; *(LAS v4u*)(Ks + si * LQ + d0) = wkl; *(LAS v4u*)(Ks + si * LQ + 64 + d0) = wkh;
        __syncthreads();
        bf16x8 qf[4];
#pragma unroll
        for (int ks = 0; ks < 4; ++ks) qf[ks] = ldfrag(Qs, LQ, oi0, ks * 32, lane);
        const int i = oi0 + l16; f32x4 sc[2];
#pragma unroll
        for (int jj = 0; jj < 2; ++jj) { const int jt = 2 * s2 + jj; f32x4 acc = {0.f, 0.f, 0.f, 0.f};
#pragma unroll
            for (int ks = 0; ks < 4; ++ks) acc = mfma16(ldfrag(Ks, LQ, jt * 16, ks * 32, lane), qf[ks], acc);
#pragma unroll
            for (int r = 0; r < 4; ++r) { const int j = jt * 16 + 4 * q4 + r; const int dist = i > j ? i - j : j - i; acc[r] *= gp[dist]; }
            sc[jj] = acc; }
        { const v2u lo = pack4(sc[0]), hi = pack4(sc[1]); __builtin_amdgcn_raw_buffer_store_b128((v4u){lo.x, lo.y, hi.x, hi.y}, rsS, (unsigned)(((((size_t)u * 4 + (wave >> 1)) * 2 + s2) * 64 + lane) * 16), 0, 16); }
    }
}
#undef RPRE_LOAD
__device__ __forceinline__ void phase_ret3(const Args& a, LAS unsigned char* lds, int tid, int lane, int wave, int bid, int G) {
    unsigned char* ws = a.ws; const bf16* P = (const bf16*)(ws + WS_P); const v4u* SCF = (const v4u*)(ws + WS_SCF); bf16* OB = (bf16*)(ws + WS_OAB) + 1024;
    constexpr int LQ = 136, LV = 40;
    LAS bf16* QsB = (LAS bf16*)lds;
    LAS bf16* KsB = QsB + 2 * 64 * LQ;
    LAS bf16* VnB = KsB + 2 * 64 * LQ;
    LAS bf16* VdB = VnB + 2 * 64 * LV;
    LAS bf16* STB = VdB + 2 * 64 * LV;
    LAS float* gp = (LAS float*)(STB + 2 * 32 * LQ);
    const int q4 = lane >> 4, l16 = lane & 15;
    const int si = tid >> 3, d0 = (tid & 7) * 8, e0 = (tid & 7) * 4;
    const int oi0 = (wave >> 1) * 16, oe0 = (wave & 1) * 16;
    for (int uu = bid; uu < 256; uu += G) {
        const int u = (((uu & 7) * 4 + (uu >> 6)) << 3) | ((uu >> 3) & 7);
        const int b = u >> 6, h = (u >> 3) & 7, vs = u & 7;
        __syncthreads();
        const float lg = log1pf(-exp2f(-5.0f - (float)h));
        if (tid < 65) gp[tid] = expf((float)tid * lg);
        for (int i = tid; i < 32 * LQ / 2; i += NTHR) ((LAS unsigned*)STB)[i] = 0u;
        f32x4 st[2] = {{0.f, 0.f, 0.f, 0.f}, {0.f, 0.f, 0.f, 0.f}};
        const bf16* prow = P + (size_t)(b * SEQ + si) * NP;
        v4u qloA, qhiA, kloA, khiA, pnA0, pnA1, qloB, qhiB, kloB, khiB, pnB0, pnB1; v2u vvA, vvB; v4u pf0, pf1;
        const v4u* scf = SCF + ((size_t)((b << 8) | (h << 5)) * 4 + (wave >> 1)) * 2 * 64 + lane;
#define RET3_LOAD(S_, n_) do { const bf16* pr_ = prow + (size_t)(n_) * 64 * NP; \
            qlo##S_ = *(const v4u*)(pr_ + P_RQ + h * 128 + d0); qhi##S_ = *(const v4u*)(pr_ + P_RQ + h * 128 + 64 + d0); \
            klo##S_ = *(const v4u*)(pr_ + P_RK + h * 128 + d0); khi##S_ = *(const v4u*)(pr_ + P_RK + h * 128 + 64 + d0); \
            vv##S_ = *(const v2u*)(pr_ + P_RV + h * 256 + vs * 32 + e0); pn##S_##0 = scf[(size_t)(n_) * 512]; pn##S_##1 = scf[(size_t)(n_) * 512 + 64]; } while (0)
#define RET3_STAGE(S_, buf_) do { LAS bf16* Qs_ = QsB + (buf_) * 64 * LQ; LAS bf16* Ks_ = KsB + (buf_) * 64 * LQ; LAS bf16* Vn_ = VnB + (buf_) * 64 * LV; LAS bf16* Vd_ = VdB + (buf_) * 64 * LV; \
            const float kd = gp[63 - si]; \
            *(LAS v4u*)(Qs_ + si * LQ + d0) = qlo##S_; *(LAS v4u*)(Qs_ + si * LQ + 64 + d0) = qhi##S_; *(LAS v4u*)(Ks_ + si * LQ + d0) = klo##S_; *(LAS v4u*)(Ks_ + si * LQ + 64 + d0) = khi##S_; \
            *(LAS v2u*)(Vn_ + si * LV + e0) = vv##S_; \
            { v2u wd; wd.x = cvt2(bflo(vv##S_.x) * kd, bfhi(vv##S_.x) * kd); wd.y = cvt2(bflo(vv##S_.y) * kd, bfhi(vv##S_.y) * kd); *(LAS v2u*)(Vd_ + si * LV + e0) = wd; } \
            pf0 = pn##S_##0; pf1 = pn##S_##1; } while (0)
#define RET3_ITER(n_, S_) do { const int cur = (n_) & 1, nxt = cur ^ 1; \
            const v4u pc0 = pf0, pc1 = pf1; \
            if ((n_) + 1 < SEQ / 64) { RET3_STAGE(S_, nxt); if ((n_) + 3 < SEQ / 64) RET3_LOAD(S_, (n_) + 3); } \
            const LAS bf16* Qs = QsB + cur * 64 * LQ; const LAS bf16* Ks = KsB + cur * 64 * LQ; const LAS bf16* Vn = VnB + cur * 64 * LV; const LAS bf16* Vd = VdB + cur * 64 * LV; \
            const LAS bf16* STc = STB + cur * 32 * LQ; LAS bf16* STn = STB + nxt * 32 * LQ; \
            bf16x8 qf[4]; \
            _Pragma("unroll") for (int ks = 0; ks < 4; ++ks) qf[ks] = ldfrag(Qs, LQ, oi0, ks * 32, lane); \
            const int i = oi0 + l16; \
              \
            f32x4 ointra = {0.f, 0.f, 0.f, 0.f}; \
            _Pragma("unroll") for (int s2 = 0; s2 < 2; ++s2) { const v4u pfu = s2 ? pc1 : pc0; \
                LAS bf16* vp = (LAS bf16*)Vn + (32 * s2 + 4 * q4 + (l16 >> 2)) * LV + oe0 + 4 * (l16 & 3); \
                const s16x4 vlo = __builtin_amdgcn_ds_read_tr16_b64_v4i16((LAS s16x4*)vp), vhi = __builtin_amdgcn_ds_read_tr16_b64_v4i16((LAS s16x4*)(vp + 16 * LV)); \
                ointra = mfma16(__builtin_shufflevector(vlo, vhi, 0, 1, 2, 3, 4, 5, 6, 7), __builtin_bit_cast(bf16x8, pfu), ointra); } \
            f32x4 ointer = {0.f, 0.f, 0.f, 0.f}; \
            _Pragma("unroll") for (int ks = 0; ks < 4; ++ks) ointer = mfma16(ldfrag(STc, LQ, oe0, ks * 32, lane), qf[ks], ointer); \
            { const float qd = gp[i + 1]; \
              v2u w; w.x = cvt2(ointra[0] + qd * ointer[0], ointra[1] + qd * ointer[1]); w.y = cvt2(ointra[2] + qd * ointer[2], ointra[3] + qd * ointer[3]); \
              *(v2u*)(OB + (size_t)(b * SEQ + (n_) * 64 + i) * OAB_LD + h * 256 + vs * 32 + oe0 + 4 * q4) = w; } \
              \
            _Pragma("unroll") for (int et = 0; et < 2; ++et) { f32x4 acc = st[et] * chunk_decay; \
                _Pragma("unroll") for (int ks = 0; ks < 2; ++ks) acc = mfma16(ldfrag_tr(Ks, LQ, ks * 32, wave * 16, lane), ldfrag_tr(Vd, LV, ks * 32, et * 16, lane), acc); \
                st[et] = acc; *(LAS v2u*)(STn + (et * 16 + l16) * LQ + wave * 16 + 4 * q4) = pack4(acc); } \
            LDS_BARRIER(); } while (0)
        RET3_LOAD(A, 0);
        __syncthreads();
        const float chunk_decay = gp[64];
        RET3_STAGE(A, 0);
        RET3_LOAD(B, 1); RET3_LOAD(A, 2);
        LDS_BARRIER();
        for (int n = 0; n < SEQ / 64; n += 2) { RET3_ITER(n, B); RET3_ITER(n + 1, A); }
#undef RET3_ITER
#undef RET3_LOAD
#undef RET3_STAGE
    }
}

constexpr int LT = 72, SLOT = 64 * LT;
constexpr size_t RW_GS = 0, RW_GY = 16 * MiB, RW_YS = 32 * MiB, RW_SS = 48 * MiB;
constexpr size_t WS_H0 = WS_RB;
constexpr size_t WS_W2T = WS_RB + 16 * MiB, WS_A2T = WS_W2T + 196608, WS_G2T = WS_A2T + 196608;

__device__ __forceinline__ f32x4 tile2(const LAS bf16* X, int x0, const LAS bf16* Y, int y0, int lane, f32x4 acc) {
    acc = mfma16(ldfrag(X, LT, x0, 0, lane), ldfrag(Y, LT, y0, 0, lane), acc);
    acc = mfma16(ldfrag(X, LT, x0, 32, lane), ldfrag(Y, LT, y0, 32, lane), acc);
    return acc;
}
__device__ __forceinline__ f32x4 unpack4(v2u w) { return (f32x4){bflo(w.x), bfhi(w.x), bflo(w.y), bfhi(w.y)}; }
__device__ __forceinline__ void st4(LAS bf16* img, int yrow, int xcol, f32x4 v) { *(LAS v2u*)(img + yrow * LT + xcol) = pack4(v); }
__device__ __forceinline__ f32x4 ld4(const LAS bf16* img, int yrow, int xcol) { return unpack4(*(const LAS v2u*)(img + yrow * LT + xcol)); }
__device__ __forceinline__ void shift8(const bf16* P, size_t tg, int col, bool first, const float* mu, float (&o)[8]) {
    const v4u cur = *(const v4u*)(P + tg * NP + col); v4u prv = *(const v4u*)(P + (first ? tg : tg - 1) * NP + col); if (first) prv = (v4u){0u, 0u, 0u, 0u};
    const f32x4 m0 = *(const f32x4*)(mu + col), m1 = *(const f32x4*)(mu + col + 4);
    float c[8], p[8]; unpack8(cur, c); unpack8(prv, p);
#pragma unroll
    for (int j = 0; j < 8; ++j) o[j] = c[j] + (p[j] - c[j]) * (j < 4 ? m0[j] : m1[j - 4]);
}

__device__ __forceinline__ f32x4 tile2_ytr(const LAS bf16* X, int x0, const LAS bf16* Yn, int y0, int lane, f32x4 acc) {
    acc = mfma16(ldfrag(X, LT, x0, 0, lane), ldfrag_tr(Yn, LT, 0, y0, lane), acc);
    acc = mfma16(ldfrag(X, LT, x0, 32, lane), ldfrag_tr(Yn, LT, 32, y0, lane), acc);
    return acc;
}
__device__ __forceinline__ f32x4 tile2_xtr(const LAS bf16* Xn, int x0, const LAS bf16* Y, int y0, int lane, f32x4 acc) {
    acc = mfma16(ldfrag_tr(Xn, LT, 0, x0, lane), ldfrag(Y, LT, y0, 0, lane), acc);
    acc = mfma16(ldfrag_tr(Xn, LT, 32, x0, lane), ldfrag(Y, LT, y0, 32, lane), acc);
    return acc;
}
__device__ __forceinline__ f32x4 ld4_tr(const LAS bf16* img, int r0, int c0, int lane) {
    const int q = lane >> 4, i = lane & 15;
    LAS bf16* p = (LAS bf16*)img + (r0 + 4 * q + (i >> 2)) * LT + c0 + 4 * (i & 3);
    const s16x4 v = __builtin_amdgcn_ds_read_tr16_b64_v4i16((LAS s16x4*)p);
    return (f32x4){bf2f((unsigned short)v[0]), bf2f((unsigned short)v[1]), bf2f((unsigned short)v[2]), bf2f((unsigned short)v[3])};
}
struct FragP { bf16x8 x0, x1, y0, y1; };
__device__ __forceinline__ FragP fp_ld(const LAS bf16* X, int x0, const LAS bf16* Y, int y0, int lane) { FragP f; f.x0 = ldfrag(X, LT, x0, 0, lane); f.x1 = ldfrag(X, LT, x0, 32, lane); f.y0 = ldfrag(Y, LT, y0, 0, lane); f.y1 = ldfrag(Y, LT, y0, 32, lane); return f; }
__device__ __forceinline__ FragP fp_ld_ytr(const LAS bf16* X, int x0, const LAS bf16* Yn, int y0, int lane) { FragP f; f.x0 = ldfrag(X, LT, x0, 0, lane); f.x1 = ldfrag(X, LT, x0, 32, lane); f.y0 = ldfrag_tr(Yn, LT, 0, y0, lane); f.y1 = ldfrag_tr(Yn, LT, 32, y0, lane); return f; }
__device__ __forceinline__ FragP fp_ld_xtr(const LAS bf16* Xn, int x0, const LAS bf16* Y, int y0, int lane) { FragP f; f.x0 = ldfrag_tr(Xn, LT, 0, x0, lane); f.x1 = ldfrag_tr(Xn, LT, 32, x0, lane); f.y0 = ldfrag(Y, LT, y0, 0, lane); f.y1 = ldfrag(Y, LT, y0, 32, lane); return f; }
__device__ __forceinline__ f32x4 fp_mm(const FragP& f, f32x4 acc) { acc = mfma16(f.x0, f.y0, acc); return mfma16(f.x1, f.y1, acc); }
#define SB() __builtin_amdgcn_sched_barrier(0)
__device__ __forceinline__ float fast_sigmoid(float x) { return __builtin_amdgcn_rcpf(1.0f + __expf(-x)); }
__device__ __forceinline__ float fast_tanh(float x) { const float e = __expf(2.0f * x); return 1.0f - 2.0f * __builtin_amdgcn_rcpf(e + 1.0f); }

typedef float f32x2v __attribute__((ext_vector_type(2)));
__device__ __forceinline__ f32x2v mix2(unsigned cur, unsigned prv, f32x2v m) { const f32x2v c = {bflo(cur), bfhi(cur)}, p = {bflo(prv), bfhi(prv)}; return c + (p - c) * m; }
#ifndef A_REP
#define A_REP 0
#endif
#define RWA_LOAD(uu_) do { const int b_ = (uu_) >> 9, h_ = ((uu_) >> 5) & 15, c_ = (uu_) & 31; const size_t t0g_ = (size_t)b_ * SEQ + c_ * 64; \
        { const int tl = y0 + l16; const size_t tg = t0g_ + tl; const size_t tp = (c_ == 0 && tl == 0) ? tg : tg - 1; \
          _Pragma("unroll") for (int ks = 0; ks < 3; ++ks) { xlc[ks] = *(const v4u*)(P + tg * NP + lcol + ks * 32 + q4 * 8); xlp[ks] = *(const v4u*)(P + tp * NP + lcol + ks * 32 + q4 * 8); } } \
        { const size_t tg = t0g_ + st_; const size_t tp = (c_ == 0 && st_ == 0) ? tg : tg - 1; \
          _Pragma("unroll") for (int m = 0; m < 3; ++m) { erc[m] = *(const v4u*)(P + tg * NP + m * 1024 + h_ * 64 + c0); erp[m] = *(const v4u*)(P + tp * NP + m * 1024 + h_ * 64 + c0); } } \
    } while (0)
#define RWA_MIX(cur_, prv_, first_, col_, out_) do { float c__[8], p__[8]; unpack8(cur_, c__); unpack8(prv_, p__); const f32x4 m0__ = *(const f32x4*)(mu + (col_)), m1__ = *(const f32x4*)(mu + (col_) + 4); \
        _Pragma("unroll") for (int j = 0; j < 8; ++j) { const float pj__ = (first_) ? 0.f : p__[j]; out_[j] = c__[j] + (pj__ - c__[j]) * (j < 4 ? m0__[j] : m1__[j - 4]); } } while (0)
#define RWA_MIXL(cur_, prv_, first_, lmu_, out_) do { const f32x4 m0__ = *(const LAS f32x4*)(lmu_), m1__ = *(const LAS f32x4*)((lmu_) + 4); const v4u pz__ = (first_) ? (v4u){0u, 0u, 0u, 0u} : (prv_); \
        const f32x2v x0__ = mix2(cur_.x, pz__.x, (f32x2v){m0__[0], m0__[1]}), x1__ = mix2(cur_.y, pz__.y, (f32x2v){m0__[2], m0__[3]}), x2__ = mix2(cur_.z, pz__.z, (f32x2v){m1__[0], m1__[1]}), x3__ = mix2(cur_.w, pz__.w, (f32x2v){m1__[2], m1__[3]}); \
        out_[0] = x0__.x; out_[1] = x0__.y; out_[2] = x1__.x; out_[3] = x1__.y; out_[4] = x2__.x; out_[5] = x2__.y; out_[6] = x3__.x; out_[7] = x3__.y; } while (0)
#define RWA_STG_LOAD(uu_) do { const int h_ = ((uu_) >> 5) & 15; const float* sp_ = wave < 3 ? mu + wave * 1024 : (wave == 3 ? w0 : (wave == 4 ? a0 : (wave == 5 ? k_k : (wave == 6 ? k_a : r_k)))); stg = sp_[h_ * 64 + lane]; } while (0)
#define RWA_S0C(uu_) do { const int h_ = ((uu_) >> 5) & 15, c_ = (uu_) & 31; \
        { const int tl = y0 + l16; const bool firstl = (c_ == 0 && tl == 0); bf16x8 fl[3]; \
          _Pragma("unroll") for (int ks = 0; ks < 3; ++ks) { float x[8]; RWA_MIXL(xlc[ks], xlp[ks], firstl, MUL + lsel * 96 + ks * 32 + q4 * 8, x); \
              if (!lsel) { _Pragma("unroll") for (int j = 0; j < 8; ++j) x[j] = fast_tanh(x[j]); } \
              fl[ks] = __builtin_bit_cast(bf16x8, pack8(x)); } \
          SB(); \
          _Pragma("unroll") for (int ct = 0; ct < 4; ++ct) _Pragma("unroll") for (int ks = 0; ks < 3; ++ks) gl_[ct][ks] = *(const bf16x8*)(LT2 + (size_t)(h_ * 64 + ct * 16 + l16) * 96 + ks * 32 + q4 * 8); \
          SB(); \
          { const bool first_ = (c_ == 0 && st_ == 0); RWA_MIXL(erc[0], erp[0], first_, STG + c0, rr); RWA_MIXL(erc[1], erp[1], first_, STG + 64 + c0, kp); RWA_MIXL(erc[2], erp[2], first_, STG + 128 + c0, vv); } \
          SB(); \
          _Pragma("unroll") for (int ct = 0; ct < 4; ++ct) { f32x4 accl = z4; \
              _Pragma("unroll") for (int ks = 0; ks < 3; ++ks) accl = mfma16(gl_[ct][ks], fl[ks], accl); \
              *(LAS f32x4*)(LL + tl * 68 + ct * 16 + 4 * q4) = accl; } } \
    } while (0)
__device__ __forceinline__ void phase_rwA(const Args& a, LAS unsigned char* lds, int tid, int lane, int wave, int bid, int G) {
    unsigned char* ws = a.ws; const bf16* P = (const bf16*)(ws + WS_P);
    const float* mu = a.in[3]; const float* w0 = a.in[4]; const float* a0 = a.in[6]; const float* k_k = a.in[9]; const float* k_a = a.in[10]; const float* r_k = a.in[11];
    const bf16* W2T = (const bf16*)(ws + WS_W2T); const bf16* A2T = (const bf16*)(ws + WS_A2T);
    bf16* GS = (bf16*)((unsigned char*)a.out + RW_GS); bf16* GY = (bf16*)((unsigned char*)a.out + RW_GY); bf16* YS = (bf16*)((unsigned char*)a.out + RW_YS); bf16* SS = (bf16*)((unsigned char*)a.out + RW_SS);
    float* BON = (float*)(ws + WS_BONUS);
    LAS bf16* img = (LAS bf16*)lds;
    LAS bf16 *s0 = img, *s1 = img + SLOT, *s2 = img + 2 * SLOT, *s3 = img + 3 * SLOT, *s4 = img + 4 * SLOT, *s5 = img + 5 * SLOT, *s6 = img + 6 * SLOT, *s7 = img + 7 * SLOT;
    LAS bf16 *s8 = img + 8 * SLOT, *s9 = img + 9 * SLOT, *s10 = img + 10 * SLOT, *s11 = img + 11 * SLOT, *s12 = img + 12 * SLOT, *s13 = img + 13 * SLOT;
    LAS float* WL = (LAS float*)s10;  LAS float* AL = (LAS float*)s12;
    LAS float* LL = (wave & 1) ? AL : WL;
    LAS float* SEG = (LAS float*)(lds + RING_BYTES + 1024);
    LAS float* GC = SEG + 512;
    LAS float* DIAG = GC + 64;
    LAS float* MUL = DIAG + 1024;
    LAS float* STG = MUL + 192;
    const int q4 = lane >> 4, l16 = lane & 15;
    const int yt = wave >> 1, xb = (wave & 1) * 2, y0 = yt * 16;
    const int st_ = tid >> 3, c0 = (tid & 7) * 8;
    const f32x4 z4 = {0.f, 0.f, 0.f, 0.f};
    float rr[8], kp[8], vv[8];
    const int lsel = wave & 1, lcol = lsel ? P_XA : P_XW; const bf16* LT2 = lsel ? A2T : W2T;
    v4u xlc[3], xlp[3], erc[3], erp[3];
    float stg = 0.f;
    bf16x8 gl_[4][3];
    if (bid < 2048) { if (tid < 192) MUL[tid] = mu[P_XW + tid]; RWA_STG_LOAD(bid); STG[tid] = stg; LDS_BARRIER(); RWA_LOAD(bid); RWA_S0C(bid); }
    for (int u = bid; u < 2048; u += G) {
        const int b = u >> 9, h = (u >> 5) & 15, c = u & 31;
        const size_t t0g = (size_t)b * SEQ + c * 64;
        float av[8], bv[8], ee[8];
        LDS_BARRIER();
        { float wl[8], al[8]; const int chg = h * 64 + c0;
          (void)chg; const LAS float* pp_ = STG + 192 + c0;
          const f32x4 pw0[2] = {*(const LAS f32x4*)(pp_), *(const LAS f32x4*)(pp_ + 4)}, pa0[2] = {*(const LAS f32x4*)(pp_ + 64), *(const LAS f32x4*)(pp_ + 68)}, pkk[2] = {*(const LAS f32x4*)(pp_ + 128), *(const LAS f32x4*)(pp_ + 132)};
          const f32x4 pka[2] = {*(const LAS f32x4*)(pp_ + 192), *(const LAS f32x4*)(pp_ + 196)}, prk[2] = {*(const LAS f32x4*)(pp_ + 256), *(const LAS f32x4*)(pp_ + 260)};
          { const f32x4 t0 = *(const LAS f32x4*)(WL + st_ * 68 + c0), t1 = *(const LAS f32x4*)(WL + st_ * 68 + c0 + 4), u0 = *(const LAS f32x4*)(AL + st_ * 68 + c0), u1 = *(const LAS f32x4*)(AL + st_ * 68 + c0 + 4);
#pragma unroll
            for (int j = 0; j < 4; ++j) { wl[j] = t0[j]; wl[4 + j] = t1[j]; al[j] = u0[j]; al[4 + j] = u1[j]; } }
          float ss = 0.f, bon = 0.f, kk[8], as[8];
#pragma unroll
          for (int j = 0; j < 8; ++j) { const int jv = j >> 2, jc = j & 3; ee[j] = fast_sigmoid(pw0[jv][jc] + wl[j]) * 0.6065306597126334f; as[j] = fast_sigmoid(pa0[jv][jc] + al[j]); kk[j] = kp[j] * pkk[jv][jc]; ss += kk[j] * kk[j]; }
          ss += __shfl_xor(ss, 1); ss += __shfl_xor(ss, 2); ss += __shfl_xor(ss, 4);
          const float rn = rsqrtf(fmaxf(ss, 1e-24f));
#pragma unroll
          for (int j = 0; j < 8; ++j) { const int jv = j >> 2, jc = j & 3; const float kn = kk[j] * rn; kp[j] = kp[j] * (1.0f + (as[j] - 1.0f) * pka[jv][jc]); av[j] = -kn; bv[j] = kn * as[j]; bon += rr[j] * kp[j] * prk[jv][jc]; }
          bon += __shfl_xor(bon, 1); bon += __shfl_xor(bon, 2); bon += __shfl_xor(bon, 4);
          if ((tid & 7) == 0) BON[(t0g + st_) * RW_H + h] = bon;
          *(LAS f32x4*)(WL + st_ * 68 + c0) = (f32x4){ee[0], ee[1], ee[2], ee[3]}; *(LAS f32x4*)(WL + st_ * 68 + c0 + 4) = (f32x4){ee[4], ee[5], ee[6], ee[7]}; }
        LDS_BARRIER();
        { const int ch = tid & 63, seg = tid >> 6; float x[8], run = 0.f;
#pragma unroll
          for (int i = 0; i < 8; ++i) { run += WL[(seg * 8 + i) * 68 + ch]; x[i] = run; }
          SEG[seg * 64 + ch] = run;
          LDS_BARRIER();
          float off = 0.f;
#pragma unroll
          for (int s = 0; s < 8; ++s) off += (s < seg) ? SEG[s * 64 + ch] : 0.f;
#pragma unroll
          for (int i = 0; i < 8; ++i) WL[(seg * 8 + i) * 68 + ch] = x[i] + off; }
        LDS_BARRIER();
        for (int rep0_ = 0; rep0_ < 1 + ((A_REP >> 0) & 1); ++rep0_) {
        { float cs[8], cC[8];
          { const f32x4 t0 = *(const LAS f32x4*)(WL + st_ * 68 + c0), t1 = *(const LAS f32x4*)(WL + st_ * 68 + c0 + 4), u0 = *(const LAS f32x4*)(WL + 63 * 68 + c0), u1 = *(const LAS f32x4*)(WL + 63 * 68 + c0 + 4);
#pragma unroll
            for (int j = 0; j < 4; ++j) { cs[j] = t0[j]; cs[4 + j] = t1[j]; cC[j] = u0[j]; cC[4 + j] = u1[j]; } }
          float At[8], Rt[8], Bt[8], Kt[8], Bh[8], Kh[8];
#pragma unroll
          for (int j = 0; j < 8; ++j) { const float gi = __expf(cs[j]), gt = __builtin_amdgcn_rcpf(gi), gh = gi * __expf(-cC[j]);
              At[j] = av[j] * __expf(ee[j]) * gt; Rt[j] = rr[j] * gt; Bt[j] = bv[j] * gi; Kt[j] = kp[j] * gi; Bh[j] = bv[j] * gh; Kh[j] = kp[j] * gh; }
          *(LAS v4u*)(s0 + st_ * LT + c0) = pack8(At); *(LAS v4u*)(s1 + st_ * LT + c0) = pack8(Rt); *(LAS v4u*)(s2 + st_ * LT + c0) = pack8(Bt); *(LAS v4u*)(s3 + st_ * LT + c0) = pack8(Kt);
          *(LAS v4u*)(s4 + st_ * LT + c0) = pack8(Bh); *(LAS v4u*)(s5 + st_ * LT + c0) = pack8(Kh); *(LAS v4u*)(s6 + st_ * LT + c0) = pack8(vv);
          if (st_ == 63) {
#pragma unroll
              for (int j = 0; j < 8; ++j) GC[c0 + j] = __expf(-cC[j]); }
          for (int i = tid; i < 2 * SLOT * 2 / 16; i += NTHR) ((LAS v4u*)s12)[i] = (v4u){0u, 0u, 0u, 0u}; }
        }
        LDS_BARRIER();
        for (int rep_ = 0; rep_ < 1 + ((A_REP >> 1) & 1); ++rep_) {
        { FragP f_[2];
#pragma unroll
        for (int xi = 0; xi < 2; ++xi) f_[xi] = fp_ld(s2, (xb + xi) * 16, s0, y0, lane);
        SB();
#pragma unroll
        for (int xi = 0; xi < 2; ++xi) { const int xt = xb + xi, x0 = xt * 16; const int yr = y0 + l16, xc = x0 + 4 * q4;
            f32x4 acc = fp_mm(f_[xi], z4);
#pragma unroll
            for (int r = 0; r < 4; ++r) acc[r] = (xc + r < yr) ? acc[r] : 0.f;
            if (yt == xt) *(LAS f32x4*)(DIAG + (yt * 16 + l16) * 16 + 4 * q4) = acc;
            st4(s8, yr, xc, ((yt == 1 && xt == 0) || (yt == 3 && xt == 2)) ? acc : z4);
            st4(s9, yr, xc, (yt >= 2 && xt <= 1) ? acc : z4); } }
        LDS_BARRIER();
        if (wave == 0) { const LAS float* Lb = DIAG + q4 * 256; float x[16];
#pragma unroll
            for (int r = 0; r < 16; ++r) { float s = (r == l16) ? 1.0f : 0.0f;
#pragma unroll
                for (int j = 0; j < r; ++j) s += Lb[r * 16 + j] * x[j];
                x[r] = s; }
#pragma unroll
            for (int r = 0; r < 16; ++r) s12[(q4 * 16 + r) * LT + q4 * 16 + l16] = (bf16)f2bf(x[r]);
            { float lo[8], hi[8];
#pragma unroll
              for (int r = 0; r < 8; ++r) { lo[r] = x[r]; hi[r] = x[8 + r]; }
              *(LAS v4u*)(s13 + (q4 * 16 + l16) * LT + q4 * 16) = pack8(lo); *(LAS v4u*)(s13 + (q4 * 16 + l16) * LT + q4 * 16 + 8) = pack8(hi); } }
        else {
#pragma unroll
            for (int bt = 0; bt < 2; ++bt) { FragP f_[4];
#pragma unroll
                for (int i = 0; i < 4 - bt; ++i) { const int T0 = wave - 1 + 7 * (4 * bt + i), T = T0 < 48 ? T0 : 47; const int p = T >> 4, ty = (T >> 2) & 3, tx = T & 3;
                    const LAS bf16* X = p == 0 ? s0 : (p == 1 ? s2 : s3); const LAS bf16* Y = p == 0 ? s3 : s1; f_[i] = fp_ld(X, tx * 16, Y, ty * 16, lane); }
                SB();
#pragma unroll
                for (int i = 0; i < 4 - bt; ++i) { const int T0 = wave - 1 + 7 * (4 * bt + i), T = T0 < 48 ? T0 : 47; const int p = T >> 4, ty = (T >> 2) & 3, tx = T & 3; const int yr = ty * 16 + l16, xc = tx * 16 + 4 * q4;
                    LAS bf16* D = p == 0 ? s10 : (p == 1 ? s11 : s7);
                    f32x4 acc = fp_mm(f_[i], z4);
#pragma unroll
                    for (int r = 0; r < 4; ++r) { const bool keep = p == 0 ? (yr < xc + r) : (xc + r <= yr); acc[r] = keep ? acc[r] : 0.f; }
                    if (T0 < 48) st4(D, yr, xc, acc); }
                SB(); } }
        LDS_BARRIER();
        }
        const int un = (u + G < 2048) ? u + G : u;
        RWA_STG_LOAD(un);
        RWA_LOAD(un);
        { FragP f_[2];
#pragma unroll
        for (int xi = 0; xi < 2; ++xi) f_[xi] = fp_ld(s8, (xb + xi) * 16, s13, y0, lane);
        SB();
#pragma unroll
        for (int xi = 0; xi < 2; ++xi) { const int x0 = (xb + xi) * 16; st4(s2, y0 + l16, x0 + 4 * q4, fp_mm(f_[xi], z4)); } }
        LDS_BARRIER();
#pragma unroll
        for (int xi = 0; xi < 2; ++xi) { const int x0 = (xb + xi) * 16, yr = y0 + l16, xc = x0 + 4 * q4;
            const FragP fa_ = fp_ld(s2, x0, s12, y0, lane), fb_ = fp_ld(s12, x0, s2, y0, lane); const f32x4 ia_ = ld4(s12, yr, xc), ib_ = ld4(s13, yr, xc);
            SB();
            st4(s3, yr, xc, fp_mm(fa_, ia_));
            st4(s8, yr, xc, fp_mm(fb_, ib_));
            SB(); }
        LDS_BARRIER();
        for (int rep_ = 0; rep_ < 1 + ((A_REP >> 3) & 1); ++rep_) {
        { FragP f_[2];
#pragma unroll
        for (int xi = 0; xi < 2; ++xi) f_[xi] = fp_ld(s9, (xb + xi) * 16, s8, y0, lane);
        SB();
#pragma unroll
        for (int xi = 0; xi < 2; ++xi) { const int x0 = (xb + xi) * 16; st4(s2, y0 + l16, x0 + 4 * q4, fp_mm(f_[xi], z4)); } }
        LDS_BARRIER();
        { FragP f_[2]; f32x4 i_[2];
#pragma unroll
        for (int xi = 0; xi < 2; ++xi) { const int x0 = (xb + xi) * 16; f_[xi] = fp_ld(s2, x0, s3, y0, lane); i_[xi] = ld4(s3, y0 + l16, x0 + 4 * q4); }
        SB();
#pragma unroll
        for (int xi = 0; xi < 2; ++xi) { const int x0 = (xb + xi) * 16, yr = y0 + l16, xc = x0 + 4 * q4; st4(s12, yr, xc, fp_mm(f_[xi], i_[xi])); } }
        LDS_BARRIER();
        }
        for (int rep_ = 0; rep_ < 1 + ((A_REP >> 4) & 1); ++rep_) {
        if (rep_ == 0) STG[tid] = stg;
#pragma unroll
        for (int xi = 0; xi < 2; ++xi) { const int x0 = (xb + xi) * 16, yr = y0 + l16, xc = x0 + 4 * q4;
            const FragP fa_ = fp_ld_ytr(s12, x0, s0, y0, lane), fb_ = fp_ld(s12, x0, s10, y0, lane);
            SB();
            st4(s13, yr, xc, fp_mm(fa_, z4));
            st4(s2, yr, xc, fp_mm(fb_, z4));
            SB(); }
        LDS_BARRIER();
        }
        v2u gyv[2], gsv[2];
#pragma unroll
        for (int xi = 0; xi < 2; ++xi) { const int xt = xb + xi, x0 = xt * 16, yr = y0 + l16, xc = x0 + 4 * q4;
            const FragP f0_ = fp_ld(s13, x0, s11, y0, lane); const f32x4 i0_ = ld4(s1, yr, xc);
            SB();
            const FragP f1_ = fp_ld(s2, x0, s11, y0, lane); const f32x4 i1_ = ld4(s7, yr, xc);
            f32x4 acc = fp_mm(f0_, i0_);
            gyv[xi] = pack4(acc);
            st4(s3, yr, xc, fp_mm(f1_, i1_));
            SB();
            const FragP f2_ = fp_ld_ytr(s13, x0, s4, y0, lane); const float gc_ = GC[yr];
            SB();
            const FragP f3_ = fp_ld_ytr(s2, x0, s4, y0, lane); const f32x4 i3_ = ld4_tr(s5, x0, y0, lane);
            acc = fp_mm(f2_, z4);
#pragma unroll
            for (int r = 0; r < 4; ++r) acc[r] += (xc + r == yr) ? gc_ : 0.f;
            gsv[xi] = pack4(acc);
            st4(s8, yr, xc, fp_mm(f3_, i3_));
            SB(); }
        LDS_BARRIER();
        RWA_S0C(un);
        SB();
#pragma unroll
        for (int xi = 0; xi < 2; ++xi) { const int x0 = (xb + xi) * 16, yr = y0 + l16, xc = x0 + 4 * q4;
            const FragP fa_ = fp_ld_xtr(s6, x0, s3, y0, lane), fb_ = fp_ld_ytr(s8, x0, s6, y0, lane);
            SB();
            *(v2u*)(GY + (size_t)u * 4096 + yr * 64 + xc) = gyv[xi]; *(v2u*)(GS + (size_t)u * 4096 + yr * 64 + xc) = gsv[xi];
            *(v2u*)(YS + (size_t)u * 4096 + yr * 64 + xc) = pack4(fp_mm(fa_, z4));
            *(v2u*)(SS + (size_t)u * 4096 + yr * 64 + xc) = pack4(fp_mm(fb_, z4));
            SB(); }
        LDS_BARRIER();
    }
}

#undef RWA_LOAD
#undef RWA_MIXL
#undef RWA_STG_LOAD
#undef RWA_MIX
#undef RWA_S0C
struct RwBRegs { v2u g[4][2][2]; v2u s[4]; };
__device__ __forceinline__ void rwB_load(RwBRegs& R, const bf16* GS, const bf16* SS, size_t u, int vg, int l16, int q4) {
#pragma unroll
    for (int mt = 0; mt < 4; ++mt) {
#pragma unroll
        for (int s = 0; s < 2; ++s) { const bf16* p = GS + u * 4096 + (mt * 16 + l16) * 64 + 32 * s + 4 * q4; R.g[mt][s][0] = *(const v2u*)p; R.g[mt][s][1] = *(const v2u*)(p + 16); }
        R.s[mt] = *(const v2u*)(SS + u * 4096 + (vg * 16 + l16) * 64 + mt * 16 + 4 * q4); }
}
__device__ __forceinline__ void phase_rwB(const Args& a, int lane, int wave, int bid, int G) {
    if (wave != 0) return;
    unsigned char* ws = a.ws; const bf16* GS = (const bf16*)((const unsigned char*)a.out + RW_GS); const bf16* SS = (const bf16*)((const unsigned char*)a.out + RW_SS); bf16* H0 = (bf16*)(ws + WS_H0);
    const int q4 = lane >> 4, l16 = lane & 15;
    for (int ch = bid; ch < 256; ch += G) {
        const int bh = ch >> 2, vg = ch & 3; const size_t u0 = (size_t)bh * 32;
        f32x4 H[4];
#pragma unroll
        for (int mt = 0; mt < 4; ++mt) H[mt] = (f32x4){0.f, 0.f, 0.f, 0.f};
        RwBRegs nxt; rwB_load(nxt, GS, SS, u0, vg, l16, q4);
        for (int c = 0; c < 32; ++c) {
            const RwBRegs cur = nxt;
            if (c + 1 < 32) rwB_load(nxt, GS, SS, u0 + c + 1, vg, l16, q4);
            v4u hf[2];
#pragma unroll
            for (int s = 0; s < 2; ++s) { const v2u lo = pack4(H[2 * s]), hi = pack4(H[2 * s + 1]); hf[s] = (v4u){lo.x, lo.y, hi.x, hi.y};
                bf16* hp = H0 + (u0 + c) * 4096 + (vg * 16 + l16) * 64 + 32 * s + 4 * q4; *(v2u*)hp = lo; *(v2u*)(hp + 16) = hi; }
#pragma unroll
            for (int mt = 0; mt < 4; ++mt) { f32x4 acc = unpack4(cur.s[mt]);
#pragma unroll
                for (int s = 0; s < 2; ++s) { const v4u af = {cur.g[mt][s][0].x, cur.g[mt][s][0].y, cur.g[mt][s][1].x, cur.g[mt][s][1].y};
                    acc = mfma16(__builtin_bit_cast(bf16x8, af), __builtin_bit_cast(bf16x8, hf[s]), acc); }
                H[mt] = acc; }
        }
    }
}

__device__ __forceinline__ void phase_rwC(const Args& a, int lane, int wave, int bid, int G) {
    unsigned char* ws = a.ws; const bf16* P = (const bf16*)(ws + WS_P);
    const bf16* GY = (const bf16*)((const unsigned char*)a.out + RW_GY); const bf16* YS = (const bf16*)((const unsigned char*)a.out + RW_YS); const bf16* H0 = (const bf16*)(ws + WS_H0);
    const bf16* G2T = (const bf16*)(ws + WS_G2T); const float* BON = (const float*)(ws + WS_BONUS); const float* mu = a.in[3]; const float* lg = a.in[12]; const float* lb = a.in[13];
    bf16* OA = (bf16*)(ws + WS_OAB);
    const int q4 = lane >> 4, l16 = lane & 15; const int gw = bid * NWAVES + wave, NGW = G * NWAVES;
    for (int task = gw; task < 8192; task += NGW) {
        const int u = task >> 2, tt = task & 3; const int b = u >> 9, h = (u >> 5) & 15, c = u & 31;
        const int tl = tt * 16 + l16; const size_t tg = (size_t)b * SEQ + c * 64 + tl; const bool first = (c == 0 && tl == 0);
        f32x4 y[4], g[4];
        { const bf16x8 yf0 = *(const bf16x8*)(GY + (size_t)u * 4096 + tl * 64 + q4 * 8), yf1 = *(const bf16x8*)(GY + (size_t)u * 4096 + tl * 64 + 32 + q4 * 8);
#pragma unroll
          for (int vt = 0; vt < 4; ++vt) { f32x4 acc = unpack4(*(const v2u*)(YS + (size_t)u * 4096 + tl * 64 + vt * 16 + 4 * q4));
              const bf16* hp = H0 + (size_t)u * 4096 + (vt * 16 + l16) * 64 + q4 * 8;
              acc = mfma16(*(const bf16x8*)hp, yf0, acc); acc = mfma16(*(const bf16x8*)(hp + 32), yf1, acc); y[vt] = acc; } }
#pragma unroll
        for (int vt = 0; vt < 4; ++vt) g[vt] = (f32x4){0.f, 0.f, 0.f, 0.f};
#pragma unroll
        for (int ks = 0; ks < 8; ++ks) { float x[8]; shift8(P, tg, P_XG + ks * 32 + q4 * 8, first, mu, x);
#pragma unroll
            for (int j = 0; j < 8; ++j) x[j] = sigmoidf_(x[j]);
            const bf16x8 gf = __builtin_bit_cast(bf16x8, pack8(x));
#pragma unroll
            for (int vt = 0; vt < 4; ++vt) g[vt] = mfma16(*(const bf16x8*)(G2T + (size_t)(h * 64 + vt * 16 + l16) * 256 + ks * 32 + q4 * 8), gf, g[vt]); }
        float s = 0.f;
#pragma unroll
        for (int vt = 0; vt < 4; ++vt) s += (y[vt][0] + y[vt][1]) + (y[vt][2] + y[vt][3]);
        s += __shfl_xor(s, 16); s += __shfl_xor(s, 32);
        const float mean = s * (1.0f / 64.0f); float q = 0.f;
#pragma unroll
        for (int vt = 0; vt < 4; ++vt)
#pragma unroll
            for (int r = 0; r < 4; ++r) { const float d = y[vt][r] - mean; q += d * d; }
        q += __shfl_xor(q, 16); q += __shfl_xor(q, 32);
        const float rstd = rsqrtf(q * (1.0f / 64.0f) + 64e-5f); const float bon = BON[tg * RW_H + h];
#pragma unroll
        for (int vt = 0; vt < 4; ++vt) { const int chn = h * 64 + vt * 16 + 4 * q4;
            const v2u cur = *(const v2u*)(P + tg * NP + 2048 + chn); v2u prv = {0u, 0u}; if (!first) prv = *(const v2u*)(P + (tg - 1) * NP + 2048 + chn);
            const f32x4 cv = unpack4(cur), pv = unpack4(prv), m4 = *(const f32x4*)(mu + 2048 + chn), lg4 = *(const f32x4*)(lg + chn), lb4 = *(const f32x4*)(lb + chn);
            f32x4 o;
#pragma unroll
            for (int r = 0; r < 4; ++r) { const float vsh = cv[r] + (pv[r] - cv[r]) * m4[r]; o[r] = ((y[vt][r] - mean) * rstd * lg4[r] + lb4[r] + bon * vsh) * g[vt][r]; }
            *(v2u*)(OA + tg * OAB_LD + chn) = pack4(o); }
    }
}

__device__ __forceinline__ void phase_rwC2(const Args& a, LAS unsigned char* lds, int tid, int lane, int wave, int bid, int G, int& ci) {
    unsigned char* ws = a.ws; const bf16* P = (const bf16*)(ws + WS_P);
    const bf16* GY = (const bf16*)((const unsigned char*)a.out + RW_GY); const bf16* YS = (const bf16*)((const unsigned char*)a.out + RW_YS); const bf16* H0 = (const bf16*)(ws + WS_H0);
    const bf16* G2T = (const bf16*)(ws + WS_G2T); const float* BON = (const float*)(ws + WS_BONUS); const float* mu = a.in[3]; const float* lg = a.in[12]; const float* lb = a.in[13];
    bf16* OA = (bf16*)(ws + WS_OAB);
    constexpr int LG = 264;
    LAS bf16* G2L = (LAS bf16*)lds;
    const int q4 = lane >> 4, l16 = lane & 15; const int NGW = G * NWAVES; int cur_h = -1;
    LAS float* cscr = (LAS float*)(lds + 36864 + wave * 8704); bf16* WGUc = (bf16*)(ws + WS_WGU); const int gwc = bid * NWAVES + wave;
    for (int base = bid * NWAVES; base < 8192; base += NGW) {
        const int task = base + wave; const int u = task >> 2, tt = task & 3; const int b = u >> 9, h = (u >> 5) & 15, c = u & 31;
        const int hw = ((base >> 2) >> 5) & 15;
        if (hw != cur_h) { __syncthreads();
            for (int i = tid; i < 64 * 32; i += NTHR) { const int r = i >> 5, ck = i & 31; *(LAS v4u*)(G2L + r * LG + ck * 8) = *(const v4u*)(G2T + (size_t)(hw * 64 + r) * 256 + ck * 8); }
            cur_h = hw; __syncthreads(); }
        float tmpc[32], tmpd[32]; GuItem itc = gu_item(a, 0), itd = gu_item(a, 0); const bool hasc = (gwc + NGW * ci) < 32768, hasd = (gwc + NGW * (ci + 1)) < 32768;
        if (hasc) { itc = gu_item(a, gwc + NGW * ci); tr_load(tmpc, itc.W, 512, itc.k0, itc.n0, lane); }
        if (hasd) { itd = gu_item(a, gwc + NGW * (ci + 1)); tr_load(tmpd, itd.W, 512, itd.k0, itd.n0, lane); } ci += 2;
        if (task < 8192) {
        const int tl = tt * 16 + l16; const size_t tg = (size_t)b * SEQ + c * 64 + tl; const bool first = (c == 0 && tl == 0); const size_t tp = first ? tg : tg - 1;
        v4u xc[8], xp[8];
#pragma unroll
        for (int ks = 0; ks < 8; ++ks) { xc[ks] = *(const v4u*)(P + tg * NP + P_XG + ks * 32 + q4 * 8); xp[ks] = *(const v4u*)(P + tp * NP + P_XG + ks * 32 + q4 * 8); }
        const bf16x8 yf0 = *(const bf16x8*)(GY + (size_t)u * 4096 + tl * 64 + q4 * 8), yf1 = *(const bf16x8*)(GY + (size_t)u * 4096 + tl * 64 + 32 + q4 * 8);
        v2u ysv[4], vcur[4], vprv[4]; bf16x8 hf[4][2];
#pragma unroll
        for (int vt = 0; vt < 4; ++vt) { ysv[vt] = *(const v2u*)(YS + (size_t)u * 4096 + tl * 64 + vt * 16 + 4 * q4);
            const bf16* hp = H0 + (size_t)u * 4096 + (vt * 16 + l16) * 64 + q4 * 8; hf[vt][0] = *(const bf16x8*)hp; hf[vt][1] = *(const bf16x8*)(hp + 32);
            const int chn = h * 64 + vt * 16 + 4 * q4; vcur[vt] = *(const v2u*)(P + tg * NP + 2048 + chn); vprv[vt] = *(const v2u*)(P + tp * NP + 2048 + chn); }
        const float bon = BON[tg * RW_H + h];
        f32x4 y[4], g[4];
#pragma unroll
        for (int vt = 0; vt < 4; ++vt) { f32x4 acc = unpack4(ysv[vt]); acc = mfma16(hf[vt][0], yf0, acc); acc = mfma16(hf[vt][1], yf1, acc); y[vt] = acc; g[vt] = (f32x4){0.f, 0.f, 0.f, 0.f}; }
#pragma unroll
        for (int ks = 0; ks < 8; ++ks) { float cf[8], pf[8], x[8]; unpack8(xc[ks], cf); unpack8(xp[ks], pf);
            const f32x4 m0 = *(const f32x4*)(mu + P_XG + ks * 32 + q4 * 8), m1 = *(const f32x4*)(mu + P_XG + ks * 32 + q4 * 8 + 4);
#pragma unroll
            for (int j = 0; j < 8; ++j) { const float pj = first ? 0.f : pf[j]; x[j] = sigmoidf_(cf[j] + (pj - cf[j]) * (j < 4 ? m0[j] : m1[j - 4])); }
            const bf16x8 gf = __builtin_bit_cast(bf16x8, pack8(x));
#pragma unroll
            for (int vt = 0; vt < 4; ++vt) g[vt] = mfma16(*(const LAS bf16x8*)(G2L + (vt * 16 + l16) * LG + ks * 32 + q4 * 8), gf, g[vt]); }
        float s = 0.f;
#pragma unroll
        for (int vt = 0; vt < 4; ++vt) s += (y[vt][0] + y[vt][1]) + (y[vt][2] + y[vt][3]);
        s += __shfl_xor(s, 16); s += __shfl_xor(s, 32);
        const float mean = s * (1.0f / 64.0f); float q = 0.f;
#pragma unroll
        for (int vt = 0; vt < 4; ++vt)
#pragma unroll
            for (int r = 0; r < 4; ++r) { const float d = y[vt][r] - mean; q += d * d; }
        q += __shfl_xor(q, 16); q += __shfl_xor(q, 32);
        const float rstd = rsqrtf(q * (1.0f / 64.0f) + 64e-5f);
#pragma unroll
        for (int vt = 0; vt < 4; ++vt) { const int chn = h * 64 + vt * 16 + 4 * q4;
            const f32x4 cv = unpack4(vcur[vt]), pv = first ? (f32x4){0.f, 0.f, 0.f, 0.f} : unpack4(vprv[vt]), m4 = *(const f32x4*)(mu + 2048 + chn), lg4 = *(const f32x4*)(lg + chn), lb4 = *(const f32x4*)(lb + chn);
            f32x4 o;
#pragma unroll
            for (int r = 0; r < 4; ++r) { const float vsh = cv[r] + (pv[r] - cv[r]) * m4[r]; o[r] = ((y[vt][r] - mean) * rstd * lg4[r] + lb4[r] + bon * vsh) * g[vt][r]; }
            *(v2u*)(OA + tg * OAB_LD + chn) = pack4(o); }
        }
        if (hasc) tr_finish(tmpc, itc.k0, WGUc, 2048, itc.drow0, cscr, lane);
        if (hasd) tr_finish(tmpd, itd.k0, WGUc, 2048, itd.drow0, cscr, lane);
    }
}

constexpr size_t WS_WTG = 262144;
constexpr size_t WS_RS = WS_WTG + 393216;
static_assert(WS_RS + 32768 <= WS_ROT, "small tables fit below the rotary table");
__device__ __forceinline__ void phase_router2(const Args& a, LAS unsigned char* lds, int tid, int lane, int wave, int bid, int G) {
    unsigned char* ws = a.ws; const float* X1 = a.out; const float* WTG = (const float*)(ws + WS_WTG); float* RS = (float*)(ws + WS_RS);
    const float* bg = a.in[20]; const float* be = a.in[22]; const float* g2 = a.in[18]; bf16* H2 = (bf16*)(ws + WS_H2); int* LIST = (int*)(ws + WS_LIST); float* LRS = (float*)(ws + WS_LRS);
    unsigned* ctl = (unsigned*)(ws + WS_CTL); int* TE = (int*)(ws + WS_TOKE); float* TW = (float*)(ws + WS_TOKW); int* TP = (int*)(ws + WS_TOKP);
    LAS float* part = (LAS float*)lds;
    const int q4 = lane >> 4, l16 = lane & 15, tile = wave >> 2, kq = wave & 3;
    if (bid == 0) for (int i = tid; i < DM / 8; i += NTHR) ((v4u*)(H2 + (size_t)NTOK * DM))[i] = (v4u){0u, 0u, 0u, 0u};
    for (int tp = bid; tp < NTOK / 32; tp += G) {
        const int t0 = tp * 32 + tile * 16;
        __syncthreads();
        f32x4 acc[3] = {{0.f, 0.f, 0.f, 0.f}, {0.f, 0.f, 0.f, 0.f}, {0.f, 0.f, 0.f, 0.f}}; float ssq = 0.f;
        const float* xp = X1 + (size_t)(t0 + l16) * DM + kq * 512 + 4 * q4; const float* wp = WTG + (size_t)l16 * DM + kq * 512 + 4 * q4;
#pragma unroll 8
        for (int g = 0; g < 32; ++g) { const f32x4 xv = *(const f32x4*)(xp + 16 * g);
            const f32x4 w0 = *(const f32x4*)(wp + 16 * g), w1 = *(const f32x4*)(wp + 16 * DM + 16 * g), w2 = *(const f32x4*)(wp + 32 * DM + 16 * g);
            ssq += (xv[0] * xv[0] + xv[1] * xv[1]) + (xv[2] * xv[2] + xv[3] * xv[3]);
            { const f32x4 gv = *(const f32x4*)(g2 + kq * 512 + 4 * q4 + 16 * g); v2u hw; hw.x = cvt2(xv[0] * gv[0], xv[1] * gv[1]); hw.y = cvt2(xv[2] * gv[2], xv[3] * gv[3]);
              *(v2u*)(H2 + (size_t)(t0 + l16) * DM + kq * 512 + 4 * q4 + 16 * g) = hw; }
#pragma unroll
            for (int j = 0; j < 4; ++j) { acc[0] = __builtin_amdgcn_mfma_f32_16x16x4f32(w0[j], xv[j], acc[0], 0, 0, 0); acc[1] = __builtin_amdgcn_mfma_f32_16x16x4f32(w1[j], xv[j], acc[1], 0, 0, 0);
                acc[2] = __builtin_amdgcn_mfma_f32_16x16x4f32(w2[j], xv[j], acc[2], 0, 0, 0); } }
        ssq += __shfl_xor(ssq, 16); ssq += __shfl_xor(ssq, 32);
        LAS float* pr = part + ((tile * 4 + kq) * 16 + l16) * 52;
#pragma unroll
        for (int ot = 0; ot < 3; ++ot) *(LAS f32x4*)(pr + ot * 16 + 4 * q4) = acc[ot];
        if (q4 == 0) pr[48] = ssq;
        __syncthreads();
        if (tid < 32) { const int tl = tid >> 4, tk = tid & 15, t = tp * 32 + tl * 16 + tk;
            const LAS float* p0 = part + ((tl * 4 + 0) * 16 + tk) * 52; const int ks = 16 * 52;
            const float sq = (p0[48] + p0[ks + 48]) + (p0[2 * ks + 48] + p0[3 * ks + 48]); const float rs = rsqrtf(sq * (1.0f / DM) + 1e-6f);
            float gl[4];
#pragma unroll
            for (int q = 0; q < 4; ++q) gl[q] = ((p0[q] + p0[ks + q]) + (p0[2 * ks + q] + p0[3 * ks + q])) * rs + bg[q];
            int gs = 0; float gm = gl[0];
#pragma unroll
            for (int q = 1; q < 4; ++q) if (gl[q] > gm) { gm = gl[q]; gs = q; }
            float den = 0.f;
#pragma unroll
            for (int q = 0; q < 4; ++q) den += expf(gl[q] - gm);
            const float gwt = 1.0f / den;
            float el[8];
#pragma unroll
            for (int q = 0; q < 8; ++q) { const int o = 4 + gs * 8 + q; el[q] = ((p0[o] + p0[ks + o]) + (p0[2 * ks + o] + p0[3 * ks + o])) * rs + be[gs * 8 + q]; }
            int i0 = 0; float m0 = el[0];
#pragma unroll
            for (int q = 1; q < 8; ++q) if (el[q] > m0) { m0 = el[q]; i0 = q; }
            int i1 = -1; float m1 = -3.0e38f;
#pragma unroll
            for (int q = 0; q < 8; ++q) if (q != i0 && el[q] > m1) { m1 = el[q]; i1 = q; }
            const float e1 = expf(m1 - m0); const float w0 = gwt / (1.0f + e1), w1 = gwt * e1 / (1.0f + e1);
            const int ex0 = gs * 8 + i0, ex1 = gs * 8 + i1;
            const unsigned c0 = __hip_atomic_fetch_add(ctl + CW_CNT + ex0, 1u, RLX_AGENT), c1 = __hip_atomic_fetch_add(ctl + CW_CNT + ex1, 1u, RLX_AGENT);
            LIST[ex0 * LCAP + (int)c0] = t; LIST[ex1 * LCAP + (int)c1] = t; LRS[ex0 * LCAP + (int)c0] = rs; LRS[ex1 * LCAP + (int)c1] = rs; TE[2 * t] = ex0; TE[2 * t + 1] = ex1; TW[2 * t] = w0; TW[2 * t + 1] = w1; TP[2 * t] = (int)c0; TP[2 * t + 1] = (int)c1; RS[t] = rs; }
    }
}

__device__ __forceinline__ void moe_tables(const Args& a, LAS unsigned char* lds, int tid, int bid, bool zero_row) {
    unsigned char* ws = a.ws; unsigned* ctl = (unsigned*)(ws + WS_CTL); LAS unsigned* tab = (LAS unsigned*)(lds + MT_OFF);
    __syncthreads();
    if (tid < NEXP) tab[MT_CNT + tid] = __hip_atomic_load(ctl + CW_CNT + tid, RLX_AGENT);
    (void)zero_row; (void)bid;
    __syncthreads();
    if (tid <= NEXP) { unsigned acc = 0;
        for (int e = 0; e < tid; ++e) acc += ((tab[MT_CNT + e] + 255u) >> 8) * 256u;
        tab[MT_PS + tid] = acc;
        if (tid < NEXP) { const int c = (int)tab[MT_CNT + tid], tl = (c + 255) >> 8, nt0 = (int)(acc >> 8); for (int q = 0; q < tl; ++q) { tab[MT_TE + nt0 + q] = (unsigned)tid; const int rv = c - 256 * q; tab[MT_TV + nt0 + q] = (unsigned)(rv < 256 ? rv : 256); }
            const int hv = (tl > 0 && c - 256 * (tl - 1) <= 128) ? 1 : 0; tab[MT_HV + tid] = (unsigned)hv; tab[MT_FULL + tid] = (unsigned)(tl - hv); }
        else tab[MT_NT] = acc >> 8; }
    __syncthreads();
    if (tid < NEXP) { int pf = 0, ph = 0, tf = 0;
        for (int e = 0; e < NEXP; ++e) { const int f = (int)tab[MT_FULL + e]; tf += f; if (e < tid) { pf += f; ph += (int)tab[MT_HV + e]; } }
        const int nt0 = (int)(tab[MT_PS + tid] >> 8), f = (int)tab[MT_FULL + tid];
        for (int q = 0; q < f; ++q) tab[MT_TORD + pf + q] = (unsigned)(nt0 + q);
        if (tab[MT_HV + tid]) tab[MT_TORD + tf + ph] = (unsigned)(nt0 + f); }
    __syncthreads();
}

constexpr int NPHASE = 14;
__global__ void __launch_bounds__(NTHR, 2) mega_fwd(Args args) {
    extern __shared__ __attribute__((aligned(16))) unsigned char lds_raw[];
    LAS unsigned char* lds = (LAS unsigned char*)lds_raw;
    const int tid = threadIdx.x, lane = tid & 63, wave = __builtin_amdgcn_readfirstlane(tid >> 6), bid = blockIdx.x, G = gridDim.x;
    unsigned char* ws = args.ws; unsigned* ctl = (unsigned*)(ws + WS_CTL);
    volatile LAS unsigned* MISC = (volatile LAS unsigned*)(lds + MISC_OFF);
    for (int u = tid; u < (LDS_BYTES - RING_BYTES) / 4; u += NTHR) ((LAS unsigned*)(lds + RING_BYTES))[u] = 0u;
    __syncthreads();
    const int lo = args.ph_lo, hi = args.ph_hi;
    const bool multi = (hi - lo) > 1;
    XcdBarrier bar; bar.bar = ctl + CW_BAR; bar.x = 0; bar.st = nullptr;
    if (multi) bar = xcd_barrier_post(ctl + CW_BAR, MISC + 8);
#ifndef PH_MASK
#define PH_MASK 0x3fff
#endif
#define IN(k) (((PH_MASK >> (k)) & 1) && lo <= (k) && (k) < hi)
#define SEAM(k) do { if (IN(k) && IN((k) + 1)) xcd_barrier(bar); } while (0)
    bf16* P = (bf16*)(ws + WS_P);

#ifndef PH_REP
#define PH_REP 0
#endif
#define REP(k) ((PH_REP >> (k)) & 1)
#ifndef PROBE_T
#define PROBE_T -1
#endif
#define STAMP(k) do { if (PROBE_T >= 0 && bid == 0 && tid == 0) { const unsigned long long t_ = __builtin_amdgcn_s_memrealtime(); ctl[CW_TSTAMP + 2 * (k)] = (unsigned)t_; ctl[CW_TSTAMP + 2 * (k) + 1] = (unsigned)(t_ >> 32); } } while (0)
#define P0_BODY { phase_prologue(args, lds, tid, lane, wave, bid, G); }
#define P1_BODY { pg8::Gemm g{(const bf16*)(ws + WS_H1), (const bf16*)(ws + WS_WIN), NTOK, NP, DM}; RevColOrder S; S.init(NTOK, NP, G, bid); EpiP E{P}; pg8::gemm_phase<EpiP, RevColOrder, true, true>(lds, g, S, E); }
#define P2_BODY { phase_rwA(args, lds, tid, lane, wave, bid, G); }
#define P2PRE_BODY { phase_retpre(args, lds, tid, lane, wave, bid, G); }
#define P3_BODY { phase_ret3(args, lds, tid, lane, wave, bid, G); }
#define P4_BODY { phase_rwB(args, lane, wave, bid, G); phase_expconv_dn(args, lds, lane, wave, bid, G); }
#define P6_BODY { pg8::Gemm g{(const bf16*)(ws + WS_OAB), (const bf16*)(ws + WS_WUPAB), NTOK, DM, OAB_LD}; pg8::StaticOrder S; S.init(NTOK, DM, G, bid); EpiUpF E{(bf16*)(ws + WS_MERGED), P, 16}; pg8::gemm_phase<EpiUpF, pg8::StaticOrder, false, true>(lds, g, S, E); }
#define P8_BODY { pg8::Gemm g{(const bf16*)(ws + WS_MERGED), (const bf16*)(ws + WS_WOUT), NTOK, DM, DM}; pg8::StaticOrder S; S.init(NTOK, DM, G, bid); EpiX1 E{args.in[0], args.out}; pg8::gemm_phase<EpiX1, pg8::StaticOrder, false, true>(lds, g, S, E); }
#define MOE_TAB ((const LAS unsigned*)(lds + MT_OFF))
#define MOE_LIST ((const int*)(ws + WS_LIST))
#define MOE_SPLIT const int nt_ = (int)MOE_TAB[MT_NT], U_ = 4 * nt_, full_ = (U_ / G) * G, rest_ = U_ - full_, tdone_ = full_ / 4;
#define GEMM_GU(S_) { pg8::Gemm g{(const bf16*)(ws + WS_H2), (const bf16*)(ws + WS_WGU), MAXSLOT, NEXP * 1024, DM}; EpiGU E{(bf16*)(ws + WS_ACT), (const float*)(ws + WS_LRS), MOE_TAB}; pg8::gemm_phase<EpiGU, MoeOrder<4>, true, true, true, true>(lds, g, S_, E); }
#define GEMM_DN(S_) { pg8::Gemm g{(const bf16*)(ws + WS_ACT), (const bf16*)(ws + WS_WDN), MAXSLOT, NEXP * 2048, EFF}; EpiDn E{(bf16*)(ws + WS_YS)}; pg8::gemm_phase<EpiDn, MoeOrder<8>, true, true, false, true>(lds, g, S_, E); }
#define P11_BODY { MOE_SPLIT (void)rest_; (void)tdone_; MoeOrder<4> S; S.init(MOE_TAB, MOE_LIST, 0, full_, G, bid); GEMM_GU(S) }
#define P11B_BODY { MOE_SPLIT if (bid < rest_) { MoeOrder<4> S; S.init(MOE_TAB, MOE_LIST, full_, U_, G, bid); GEMM_GU(S) } else { MoeOrder<8> S; S.init(MOE_TAB, MOE_LIST, 0, 8 * tdone_, G - rest_, bid - rest_); GEMM_DN(S) } }
#define P12_BODY { MOE_SPLIT (void)rest_; (void)full_; MoeOrder<8> S; S.init(MOE_TAB, MOE_LIST, 8 * tdone_, 8 * nt_, G, bid); GEMM_DN(S) }
    STAMP(0); if (IN(0)) { P0_BODY if (REP(0)) { xcd_barrier(bar); P0_BODY } } SEAM(0);
    STAMP(1); if (IN(1)) { P1_BODY if (REP(1)) { xcd_barrier(bar); P1_BODY }
        { const int nun = (NTOK / 256) * (NP / 256), rem = nun % G;
          if (rem == 0) phase_conv_w3(args, lds, lane, wave, bid, G); else if (bid >= rem) phase_conv_w3(args, lds, lane, wave, bid - rem, G - rem); } } SEAM(1);
    STAMP(2); if (IN(2)) { P2PRE_BODY
        asm volatile("s_waitcnt vmcnt(0)" ::: "memory"); __syncthreads();
        if (tid == 0) __hip_atomic_fetch_add(ctl + CW_PRE, 1u, __ATOMIC_RELAXED, __HIP_MEMORY_SCOPE_AGENT);
        P2_BODY if (REP(2)) { P2_BODY } }
    STAMP(3); if (IN(3)) {
        if (tid == 0) { unsigned sp_ = 0; while (__hip_atomic_load(ctl + CW_PRE, __ATOMIC_RELAXED, __HIP_MEMORY_SCOPE_AGENT) < (unsigned)G) { __builtin_amdgcn_s_sleep(2); if (++sp_ > (1u << 22)) break; }
            __builtin_amdgcn_fence(__ATOMIC_ACQUIRE, "agent"); asm volatile("s_waitcnt vmcnt(0)" ::: "memory"); }
        __syncthreads();
        P3_BODY if (REP(3)) { P3_BODY } } SEAM(3);
    STAMP(4); if (IN(4)) { P4_BODY if (REP(4)) { xcd_barrier(bar); P4_BODY } } SEAM(4);
    STAMP(5); if (IN(5)) { int ci = 0;
        if ((G & 15) == 0) phase_rwC2(args, lds, tid, lane, wave, bid, G, ci); else phase_rwC(args, lane, wave, bid, G);
        phase_retpost(args, lds, lane, wave, bid, G, ci); } SEAM(5);
    STAMP(6); if (IN(6)) P6_BODY
    SEAM(6);
    STAMP(8); if (IN(8)) { P8_BODY if (REP(6)) { xcd_barrier(bar); P6_BODY xcd_barrier(bar); P8_BODY } } SEAM(8);
    STAMP(9); if (IN(9)) { phase_router2(args, lds, tid, lane, wave, bid, G); } SEAM(9);
    STAMP(11); if (IN(11)) { moe_tables(args, lds, tid, bid, true); P11_BODY xcd_barrier(bar); P11B_BODY }
    SEAM(11);
    STAMP(12); if (IN(12)) { if (!multi) moe_tables(args, lds, tid, bid, false); P12_BODY if (REP(10)) { xcd_barrier(bar); P11_BODY xcd_barrier(bar); P11B_BODY xcd_barrier(bar); P12_BODY } } SEAM(12);
    STAMP(13); if (IN(13)) { if (!multi) moe_tables(args, lds, tid, bid, false); phase_final(args, lds, lane, wave, bid, G); }
    if (PROBE_T >= 0) { const unsigned long long t0_ = ((unsigned long long)ctl[CW_TSTAMP + 2 * PROBE_T + 1] << 32) | ctl[CW_TSTAMP + 2 * PROBE_T], t1_ = ((unsigned long long)ctl[CW_TSTAMP + 2 * PROBE_T + 3] << 32) | ctl[CW_TSTAMP + 2 * PROBE_T + 2];
        const float d_ = (float)(t1_ - t0_) * (0.01f / 100.0f); __syncthreads(); for (int i = bid * NTHR + tid; i < 1024 * DM; i += G * NTHR) args.out[i] += d_; }
#undef IN
#undef SEAM
}

#ifndef MK_ONE_LAUNCH
#define MK_ONE_LAUNCH 1
#endif
extern "C" void kernel_launch(void* const* d_in, const int* in_sizes, int n_in, void* d_out, int out_size, void* d_ws, size_t ws_size, hipStream_t stream) {
    static int grid = 0;
    if (grid == 0) {
        if (n_in != 27 || out_size != NTOK * DM || ws_size < WS_END) { fprintf(stderr, "kernel_launch: unexpected shapes (n_in %d out %d ws %zu, need %zu)\n", n_in, out_size, ws_size, (size_t)WS_END); grid = -1; return; }
        int dev = 0, cus = 0, per_cu = 0;
        if (hipGetDevice(&dev) != hipSuccess || hipDeviceGetAttribute(&cus, hipDeviceAttributeMultiprocessorCount, dev) != hipSuccess) { grid = -1; return; }
        if (hipFuncSetAttribute((const void*)mega_fwd, hipFuncAttributeMaxDynamicSharedMemorySize, LDS_BYTES) != hipSuccess) { fprintf(stderr, "kernel_launch: hipFuncSetAttribute failed\n"); grid = -1; return; }
        if (hipOccupancyMaxActiveBlocksPerMultiprocessor(&per_cu, (const void*)mega_fwd, NTHR, LDS_BYTES) != hipSuccess || per_cu < 1) { fprintf(stderr, "kernel_launch: occupancy query says %d\n", per_cu); grid = -1; (void)hipGetLastError(); return; }
        grid = cus;
    }
    if (grid < 0) return;
    (void)in_sizes;
    if (hipMemsetAsync((char*)d_ws + WS_CTL, 0, CTL_ZERO_BYTES, stream) != hipSuccess) return;
    Args a{};
    for (int i = 0; i < 27; ++i) a.in[i] = (const float*)d_in[i];
    a.out = (float*)d_out; a.ws = (unsigned char*)d_ws;
#if MK_ONE_LAUNCH
    a.ph_lo = 0; a.ph_hi = NPHASE;
    hipLaunchKernelGGL(mega_fwd, dim3(grid), dim3(NTHR), LDS_BYTES, stream, a);
#else
    for (int p = 0; p < NPHASE; ++p) { a.ph_lo = p; a.ph_hi = p + 1; hipLaunchKernelGGL(mega_fwd, dim3(grid), dim3(NTHR), LDS_BYTES, stream, a); }
#endif
}
```
